# Optimizing an MI355X kernel written in HIP

```python
import jax, jax.numpy as jnp
from jax import lax
import numpy as np

D_MODEL = 2048
BATCH = 2
SEQ = 4096
DEPTH = 2

N_MIXERS = 2
CHUNK = 128
GMLP_EXPAND = 2
GMLP_WIDTH = GMLP_EXPAND * D_MODEL
GMLP_GROUPS = 16
GMLP_GROUP_DIM = GMLP_WIDTH // GMLP_GROUPS
SB_HEAD_DIM = 128
SB_HEADS = D_MODEL // SB_HEAD_DIM
SB_WIDTH = SB_HEADS * SB_HEAD_DIM
Q_BLOCK = 128
N_A = (DEPTH + 1) // 2
N_B = DEPTH // 2
EPS = 1e-6

kernel_name = "hybrid_gmlp_stickbreaking_trunk"


def rms_norm(x, g):
    xf = x.astype(jnp.float32)
    y = xf * lax.rsqrt(jnp.mean(xf * xf, axis=-1, keepdims=True) + EPS)
    return (y * g.astype(jnp.float32)).astype(x.dtype)


def gmlp_branch(xn, w_in, v_g, w_s, b_s, w_out):
    B, S, _ = xn.shape
    proj = xn @ w_in
    uv = jax.nn.gelu(proj[..., :2 * GMLP_WIDTH])
    zg = proj[..., 2 * GMLP_WIDTH:]
    u, v = jnp.split(uv, 2, axis=-1)
    v = rms_norm(v, v_g)
    vc = v.reshape(B, S // CHUNK, CHUNK, GMLP_GROUPS, GMLP_GROUP_DIM)
    causal = jnp.tril(jnp.ones((CHUNK, CHUNK), dtype=w_s.dtype))
    ws = w_s * causal[None]
    mixed = jnp.einsum('gts,bnsgc->bntgc', ws, vc) + jnp.transpose(b_s)[None, None, :, :, None]
    mixed = mixed.reshape(B, S, GMLP_WIDTH)
    y = u * mixed * jax.nn.silu(zg)
    return y @ w_out


def stick_breaking_attention(q, k, v):
    B, S, H, dh = q.shape
    nb = S // Q_BLOCK
    qh = jnp.transpose(q, (0, 2, 1, 3)) * (dh ** -0.5)
    kh = jnp.transpose(k, (0, 2, 1, 3))
    vh = jnp.transpose(v, (0, 2, 1, 3))
    qb = jnp.transpose(qh.reshape(B, H, nb, Q_BLOCK, dh), (2, 0, 1, 3, 4))
    t0 = jnp.arange(nb, dtype=jnp.int32) * Q_BLOCK
    s_idx = jnp.arange(S, dtype=jnp.int32)[None, :]

    def block(args):
        qblk, start = args
        z = jnp.einsum('bhqd,bhkd->bhqk', qblk, kh).astype(jnp.float32)
        t_idx = start + jnp.arange(Q_BLOCK, dtype=jnp.int32)[:, None]
        mask = s_idx < t_idx
        log_fail = jnp.where(mask, jax.nn.log_sigmoid(-z), 0.0)
        tail = lax.cumsum(log_fail, axis=3, reverse=True) - log_fail
        log_a = jax.nn.log_sigmoid(z) + tail
        a = jnp.where(mask, jnp.exp(log_a), 0.0)
        return jnp.einsum('bhqk,bhkd->bhqd', a.astype(vh.dtype), vh)

    ob = lax.map(block, (qb, t0))
    return jnp.transpose(ob, (1, 0, 3, 2, 4)).reshape(B, S, H, dh)


def stick_breaking_branch(xn, w_in, w_out):
    B, S, _ = xn.shape
    proj = xn @ w_in
    q, k, v, zg = jnp.split(proj, 4, axis=-1)
    shp = (B, S, SB_HEADS, SB_HEAD_DIM)
    o = stick_breaking_attention(q.reshape(shp), k.reshape(shp), v.reshape(shp))
    o = o.reshape(B, S, SB_WIDTH) * jax.nn.silu(zg)
    return o @ w_out


def setup_inputs(seed: int = 0) -> dict:
    key = jax.random.key(seed)
    ks = jax.random.split(key, 12)
    f32 = jnp.float32
    x = jax.random.normal(ks[0], (BATCH, SEQ, D_MODEL), f32)
    norm_g = 1.0 + 0.02 * jax.random.normal(ks[1], (DEPTH, D_MODEL), f32)
    a_w_in = jax.random.normal(ks[2], (N_A, D_MODEL, 3 * GMLP_WIDTH), f32) * D_MODEL ** -0.5
    a_v_norm_g = 1.0 + 0.02 * jax.random.normal(ks[3], (N_A, GMLP_WIDTH), f32)
    a_w_s = jax.random.normal(ks[4], (N_A, GMLP_GROUPS, CHUNK, CHUNK), f32) * (0.5 * CHUNK ** -0.5)
    a_b_s = 1.0 + 0.1 * jax.random.normal(ks[5], (N_A, GMLP_GROUPS, CHUNK), f32)
    a_w_out = jax.random.normal(ks[6], (N_A, GMLP_WIDTH, D_MODEL), f32) * GMLP_WIDTH ** -0.5
    b_w_in = jax.random.normal(ks[7], (N_B, D_MODEL, 4 * SB_WIDTH), f32) * D_MODEL ** -0.5
    b_w_out = jax.random.normal(ks[8], (N_B, SB_WIDTH, D_MODEL), f32) * SB_WIDTH ** -0.5
    final_g = 1.0 + 0.02 * jax.random.normal(ks[9], (D_MODEL,), f32)
    return {"x": x, "norm_g": norm_g, "a_w_in": a_w_in, "a_v_norm_g": a_v_norm_g,
            "a_w_s": a_w_s, "a_b_s": a_b_s, "a_w_out": a_w_out,
            "b_w_in": b_w_in, "b_w_out": b_w_out, "final_g": final_g}


def reference(x, norm_g, a_w_in, a_v_norm_g, a_w_s, a_b_s, a_w_out, b_w_in, b_w_out, final_g):
    h = x
    for i in range(DEPTH):
        hn = rms_norm(h, norm_g[i])
        j = i // N_MIXERS
        if i % N_MIXERS == 0:
            y = gmlp_branch(hn, a_w_in[j], a_v_norm_g[j], a_w_s[j], a_b_s[j], a_w_out[j])
        else:
            y = stick_breaking_branch(hn, b_w_in[j], b_w_out[j])
        h = h + y
    return rms_norm(h, final_g)
```

```cpp
#include <hip/hip_runtime.h>
#include <hip/hip_cooperative_groups.h>
#include <cstdio>
#include <cstdint>
namespace cg = cooperative_groups;
__device__ __forceinline__ int lane_id() { return (int)__builtin_amdgcn_mbcnt_hi(~0u, __builtin_amdgcn_mbcnt_lo(~0u, 0u)); }
__device__ __forceinline__ int tid_of(int wave) { return wave * 64 + lane_id(); }
#ifndef PG8_WGM
#define PG8_WGM 8
#endif
namespace pg8 {
#define PG8_LAS __attribute__((address_space(3)))
typedef unsigned short bf16_t;
typedef short bf16x8 __attribute__((ext_vector_type(8)));
typedef float f32x4 __attribute__((ext_vector_type(4)));
typedef unsigned u32x4 __attribute__((ext_vector_type(4)));
constexpr int BM = 256, BK = 64, HALF = 128, HTB = HALF * BK * 2  , STAGE_BYTES = 8 * HTB, NXCD = 8, WGM = PG8_WGM;

__host__ __device__ __forceinline__ int lds_byte(int r, int c) { const int st = (r >> 4) * 2 + (c >> 5), rr = r & 15, cc = c & 31, ob = rr * 64 + cc * 2; return st * 1024 + (ob ^ (((ob >> 9) & 1) << 5)); }
__host__ __device__ __forceinline__ void stage_rc(int b, int& R, int& C) { const int st = b / 1024, sb = b % 1024, swz = sb ^ (((sb >> 9) & 1) << 5); R = (st >> 1) * 16 + swz / 64; C = (st & 1) * 32 + (swz % 64) / 2; }
__host__ __device__ __forceinline__ int perm32(int rho) { const int n = rho >> 4, i = rho & 15; return 8 * (i >> 2) + 4 * n + (i & 3); }

struct Unit { int pm, pn; };
struct Gemm { const bf16_t* A; const bf16_t* Bt; int M, N, K; };

struct StaticOrder {
    int nM, nN, nwg, G, c;
    __host__ __device__ void init(int M, int N, int G_, int c_) { nM = M / BM; nN = N / BM; nwg = nM * nN; G = G_; c = c_; }
    __host__ __device__ bool next(int i, Unit& u) const {
        const long L = (long)i * G + c; if (L >= nwg) return false;
        int wgid = (int)L; { const int q = nwg / NXCD, r = nwg % NXCD, xcd = wgid % NXCD, off = wgid / NXCD; wgid = (xcd < r ? xcd * (q + 1) : r * (q + 1) + (xcd - r) * q) + off; }
        const int nig = WGM * nN, gid = wgid / nig, fm = gid * WGM, gsz = (nM - fm) < WGM ? (nM - fm) : WGM;
        u.pm = fm + ((wgid % nig) % gsz); u.pn = (wgid % nig) / gsz; return true;
    }
    __device__ __forceinline__ void a_ready(const Unit&) const {}
    __device__ __forceinline__ void done(const Unit&) const {}
};

__device__ __forceinline__ unsigned cvt_pk_bf16(float lo, float hi) { unsigned r; asm volatile("v_cvt_pk_bf16_f32 %0, %1, %2" : "=v"(r) : "v"(lo), "v"(hi)); return r; }
typedef float f32x2 __attribute__((ext_vector_type(2)));
typedef float f32x2 __attribute__((ext_vector_type(2)));
template <class Epi, class Sched, bool ALIGN_EPI = false, bool SP2 = false>
__device__ __forceinline__ void gemm_phase(PG8_LAS unsigned char* lds, const Gemm g, const Sched& S, const Epi& E, const int wave_) {
    const int tid = tid_of(wave_), wid = wave_, lane = tid & 63, wr = wid >> 2, wc = wid & 3, fr = lane & 15, fq = lane >> 4;
    const int K = g.K, nt = K / BK;
    unsigned voffA[2], voffB[2];
#pragma unroll
    for (int i = 0; i < 2; ++i) { int R, C; stage_rc(tid * 16 + i * 8192, R, C); const int Rb = Epi::PERM ? ((R & ~31) + perm32(R & 31)) : R;
        voffA[i] = (unsigned)(R * K + C) * 2u; voffB[i] = (unsigned)(Rb * K + C) * 2u; }
    const size_t kstep = (size_t)(BK * 2);
    const size_t hstep = (size_t)HALF * K * 2;
    const size_t tstep = 2 * hstep;
    const unsigned ldsw = (unsigned)wid * 1024u;
    const int aoff = lds_byte(wr * 64 + fr, fq * 8), boff = lds_byte(wc * 32 + fr, fq * 8);
#define PG8_SA(b, h) (((b) * 2 + (h)) * HTB)
#define PG8_SB(b, h) ((4 + (b) * 2 + (h)) * HTB)
#define PG8_STAGE(bufoff, gbase, voff) do { _Pragma("unroll") for (int _i = 0; _i < 2; ++_i) \
        __builtin_amdgcn_global_load_lds((const unsigned*)((const char*)(gbase) + (voff)[_i]), (PG8_LAS unsigned*)(lds + (bufoff) + ldsw + _i * 8192), 16, 0, 0); } while (0)
#define PG8_LDA(dst, b, h) do { _Pragma("unroll") for (int m = 0; m < 4; ++m) _Pragma("unroll") for (int k = 0; k < 2; ++k) dst[m][k] = *(const PG8_LAS bf16x8*)(lds + PG8_SA(b, h) + aoff + m * 2048 + k * 1024); } while (0)
#define PG8_LDB(dst, b, h) do { _Pragma("unroll") for (int n = 0; n < 2; ++n) _Pragma("unroll") for (int k = 0; k < 2; ++k) dst[n][k] = *(const PG8_LAS bf16x8*)(lds + PG8_SB(b, h) + boff + n * 2048 + k * 1024); } while (0)
#define PG8_MMA(ai, bj, At, Bt) do { __builtin_amdgcn_s_setprio(1); _Pragma("unroll") for (int m = 0; m < 4; ++m) _Pragma("unroll") for (int n = 0; n < 2; ++n) _Pragma("unroll") for (int k = 0; k < 2; ++k) \
        acc[ai][bj][m][n] = __builtin_amdgcn_mfma_f32_16x16x32_bf16(Bt[n][k], At[m][k], acc[ai][bj][m][n], 0, 0, 0); __builtin_amdgcn_s_setprio(0); } while (0)
#define PG8_WAIT_V(n) asm volatile("s_waitcnt vmcnt(" #n ")" ::: "memory")
#define PG8_WAIT_L(n) asm volatile("s_waitcnt lgkmcnt(" #n ")" ::: "memory")
#define PG8_BAR __builtin_amdgcn_s_barrier()
#define PG8_SCHED __builtin_amdgcn_sched_barrier(0)
    Unit cur, nxt; int ui = 0;
    if (!S.next(0, cur)) return;
    f32x4 acc[2][2][4][2];
#pragma unroll
    for (int a = 0; a < 2; ++a)
#pragma unroll
        for (int b = 0; b < 2; ++b)
#pragma unroll
            for (int m = 0; m < 4; ++m)
#pragma unroll
                for (int n = 0; n < 2; ++n) acc[a][b][m][n] = (f32x4){0.f, 0.f, 0.f, 0.f};
    bf16x8 At[4][2], B0[2][2], B1[2][2];
    const char* cA = (const char*)g.A + (size_t)cur.pm * tstep; const char* cB = (const char*)g.Bt + (size_t)cur.pn * tstep;
    S.a_ready(cur);
    if constexpr (SP2) {
        PG8_STAGE(PG8_SB(0, 0), cB, voffB); PG8_STAGE(PG8_SB(0, 1), cB + hstep, voffB); PG8_STAGE(PG8_SA(0, 0), cA, voffA); PG8_STAGE(PG8_SA(0, 1), cA + hstep, voffA);
        if (wr == 1) PG8_BAR;
        PG8_WAIT_V(2); PG8_BAR;
        PG8_STAGE(PG8_SB(1, 0), cB + kstep, voffB); PG8_STAGE(PG8_SA(1, 0), cA + kstep, voffA); PG8_STAGE(PG8_SB(1, 1), cB + hstep + kstep, voffB);
        PG8_WAIT_V(6); PG8_BAR;
    } else {
        PG8_STAGE(PG8_SB(0, 0), cB, voffB); PG8_STAGE(PG8_SA(0, 0), cA, voffA); PG8_STAGE(PG8_SB(0, 1), cB + hstep, voffB); PG8_STAGE(PG8_SA(0, 1), cA + hstep, voffA);
        if (wr == 1) PG8_BAR;
        PG8_WAIT_V(4); PG8_BAR;
        PG8_STAGE(PG8_SB(1, 0), cB + kstep, voffB); PG8_STAGE(PG8_SA(1, 0), cA + kstep, voffA); PG8_STAGE(PG8_SB(1, 1), cB + hstep + kstep, voffB);
        PG8_WAIT_V(6); PG8_BAR;
    }
    for (;;) {
        const bool has_next = S.next(ui + 1, nxt);
        const char* nA = has_next ? (const char*)g.A + (size_t)nxt.pm * tstep : cA; const char* nB = has_next ? (const char*)g.Bt + (size_t)nxt.pn * tstep : cB;
        for (int t = 0; t < nt; t += 2) {
            const bool last = (t == nt - 2);
            const char* a1 = cA + (size_t)(t + 1) * kstep;
            const char* a2 = last ? nA : cA + (size_t)(t + 2) * kstep; const char* b2 = last ? nB : cB + (size_t)(t + 2) * kstep;
            const char* a3 = a2 + kstep; const char* b3 = b2 + kstep;
            if (last && has_next) S.a_ready(nxt);
            if constexpr (SP2) {
            PG8_LDB(B0, 0, 0); PG8_LDB(B1, 0, 1); PG8_SCHED; PG8_LDA(At, 0, 0); PG8_STAGE(PG8_SA(1, 1), a1 + hstep, voffA);
            PG8_WAIT_V(8); PG8_WAIT_L(0); PG8_BAR; PG8_MMA(0, 0, At, B0); PG8_MMA(0, 1, At, B1); PG8_BAR; PG8_SCHED;
            PG8_LDA(At, 0, 1); PG8_STAGE(PG8_SB(0, 0), b2, voffB); PG8_STAGE(PG8_SB(0, 1), b2 + hstep, voffB); PG8_STAGE(PG8_SA(0, 0), a2, voffA);
            PG8_WAIT_V(8); PG8_WAIT_L(0); PG8_BAR; PG8_MMA(1, 0, At, B0); PG8_MMA(1, 1, At, B1); PG8_BAR; PG8_SCHED;
            PG8_LDB(B0, 1, 0); PG8_LDB(B1, 1, 1); PG8_SCHED; PG8_LDA(At, 1, 0); PG8_STAGE(PG8_SA(0, 1), a2 + hstep, voffA);
            PG8_WAIT_V(8); PG8_WAIT_L(0); PG8_BAR; PG8_MMA(0, 0, At, B0); PG8_MMA(0, 1, At, B1); PG8_BAR; PG8_SCHED;
            PG8_LDA(At, 1, 1); PG8_STAGE(PG8_SB(1, 0), b3, voffB); PG8_STAGE(PG8_SB(1, 1), b3 + hstep, voffB); PG8_STAGE(PG8_SA(1, 0), a3, voffA);
            PG8_WAIT_V(8); PG8_WAIT_L(0); PG8_BAR; PG8_MMA(1, 0, At, B0); PG8_MMA(1, 1, At, B1); PG8_BAR; PG8_SCHED;
            } else {
            PG8_LDB(B0, 0, 0); PG8_SCHED; PG8_LDA(At, 0, 0); PG8_STAGE(PG8_SA(1, 1), a1 + hstep, voffA);
            PG8_WAIT_L(8); PG8_BAR; PG8_WAIT_L(0); PG8_MMA(0, 0, At, B0); PG8_BAR; PG8_SCHED;
            PG8_LDB(B1, 0, 1); PG8_STAGE(PG8_SB(0, 0), b2, voffB);
            PG8_BAR; PG8_WAIT_L(0); PG8_MMA(0, 1, At, B1); PG8_BAR;
            PG8_LDA(At, 0, 1); PG8_STAGE(PG8_SA(0, 0), a2, voffA);
            PG8_BAR; PG8_WAIT_L(0); PG8_MMA(1, 0, At, B0); PG8_BAR; PG8_SCHED;
            PG8_STAGE(PG8_SB(0, 1), b2 + hstep, voffB);
            PG8_WAIT_V(6); PG8_BAR; PG8_MMA(1, 1, At, B1); PG8_BAR;
            PG8_LDB(B0, 1, 0); PG8_SCHED; PG8_LDA(At, 1, 0); PG8_STAGE(PG8_SA(0, 1), a2 + hstep, voffA);
            PG8_WAIT_L(8); PG8_BAR; PG8_WAIT_L(0); PG8_MMA(0, 0, At, B0); PG8_BAR; PG8_SCHED;
            PG8_LDB(B1, 1, 1); PG8_STAGE(PG8_SB(1, 0), b3, voffB);
            PG8_BAR; PG8_WAIT_L(0); PG8_MMA(0, 1, At, B1); PG8_BAR;
            PG8_LDA(At, 1, 1); PG8_STAGE(PG8_SA(1, 0), a3, voffA);
            PG8_BAR; PG8_WAIT_L(0); PG8_MMA(1, 0, At, B0); PG8_BAR; PG8_SCHED;
            PG8_STAGE(PG8_SB(1, 1), b3 + hstep, voffB);
            PG8_WAIT_V(6); PG8_BAR; PG8_MMA(1, 1, At, B1); PG8_BAR;
            }
        }
        if constexpr (ALIGN_EPI) { if (wr == 0) PG8_BAR; }
        if constexpr (!Epi::AFTER_DRAIN) { E(acc, cur, wr, wc, fr, fq); S.done(cur); }
        if (!has_next) break;
#pragma unroll
        for (int a = 0; a < 2; ++a)
#pragma unroll
            for (int b = 0; b < 2; ++b)
#pragma unroll
                for (int m = 0; m < 4; ++m)
#pragma unroll
                    for (int n = 0; n < 2; ++n) acc[a][b][m][n] = (f32x4){0.f, 0.f, 0.f, 0.f};
        cur = nxt; cA = nA; cB = nB; ++ui;
        if constexpr (ALIGN_EPI) { if (wr == 1) PG8_BAR; }
    }
    PG8_WAIT_V(0);
    if constexpr (!ALIGN_EPI) { if (wr == 0) PG8_BAR; }
    PG8_BAR;
    if constexpr (Epi::AFTER_DRAIN) { E.fused(acc, cur, wr, wc, fr, fq, lds, wid, lane); S.done(cur); }
#undef PG8_SA
#undef PG8_SB
#undef PG8_STAGE
#undef PG8_LDA
#undef PG8_LDB
#undef PG8_MMA
#undef PG8_WAIT_V
#undef PG8_WAIT_L
#undef PG8_BAR
#undef PG8_SCHED
}
}

constexpr int DM = 2048, NTOK = 8192, SEQ = 4096, GW = 4096, NGRP = 16, GDIM = 256, CHUNK = 128, NHEAD = 16, HD = 128;
constexpr float EPS = 1e-6f;
constexpr float LOG2E = 1.4426950408889634f;
constexpr float QSCALE = 0.08838834764831845f * LOG2E;

constexpr float GELU_C1 = -1.5957691216057308f * LOG2E, GELU_C2 = -0.07135481627260025f * LOG2E;
__device__ __forceinline__ float gelu_tanh(float x) {
    const float e = __builtin_amdgcn_exp2f(x * __builtin_fmaf(x * x, GELU_C2, GELU_C1));
    return x * __builtin_amdgcn_rcpf(1.0f + e);
}
__device__ __forceinline__ float gelu_silu(float u, float z) {
    const float e1 = __builtin_amdgcn_exp2f(u * __builtin_fmaf(u * u, GELU_C2, GELU_C1));
    const float e2 = __builtin_amdgcn_exp2f(z * -LOG2E);
    return (u * z) * __builtin_amdgcn_rcpf((1.0f + e1) * (1.0f + e2));
}
__device__ __forceinline__ float silu_f(float z) { return z * __builtin_amdgcn_rcpf(1.0f + __builtin_amdgcn_exp2f(-LOG2E * z)); }

namespace pg8 {
typedef unsigned u32x2 __attribute__((ext_vector_type(2)));
__device__ __forceinline__ void conv_load4(const float* __restrict__ W, int N, int item, int lane, f32x4 (&x)[16]) {
    const int nblk = N / 64, k0 = 64 * (item / nblk), n0 = 64 * (item % nblk);
#pragma unroll
    for (int i = 0; i < 16; ++i) x[i] = *(const f32x4*)(W + (size_t)(k0 + 4 * i + (lane >> 4)) * N + n0 + 4 * (lane & 15));
}
__device__ __forceinline__ void conv_xpose(f32x4 (&x)[16], int lane) {
    const bool a = (lane >> 4) & 1, b = (lane >> 5) & 1;
#pragma unroll
    for (int i = 0; i < 16; ++i) {
        f32x4 v = x[i];
        {
            const float s0 = a ? v[0] : v[1], s1 = a ? v[2] : v[3];
            const float r0 = __shfl_xor(s0, 16), r1 = __shfl_xor(s1, 16);
            if (a) { v[0] = r0; v[2] = r1; } else { v[1] = r0; v[3] = r1; }
        }
        {
            const float s0 = b ? v[0] : v[2], s1 = b ? v[1] : v[3];
            const float r0 = __shfl_xor(s0, 32), r1 = __shfl_xor(s1, 32);
            if (b) { v[0] = r0; v[1] = r1; } else { v[2] = r0; v[3] = r1; }
        }
        x[i] = v;
    }
}
__device__ __forceinline__ void conv_store4(int K, int N, bf16_t* __restrict__ WT, int item, int lane, const float* __restrict__ gk, const f32x4 (&x)[16]) {
    const int nblk = N / 64, k0 = 64 * (item / nblk), n0 = 64 * (item % nblk);
    const int n = n0 + 4 * (lane & 15) + (lane >> 4);
#pragma unroll
    for (int kc = 0; kc < 8; ++kc) {
        float g[8];
#pragma unroll
        for (int j = 0; j < 8; ++j) g[j] = gk ? gk[k0 + 8 * kc + j] : 1.0f;
        const f32x4 lo = x[2 * kc], hi = x[2 * kc + 1];
        u32x4 o; o.x = cvt_pk_bf16(lo[0] * g[0], lo[1] * g[1]); o.y = cvt_pk_bf16(lo[2] * g[2], lo[3] * g[3]);
        o.z = cvt_pk_bf16(hi[0] * g[4], hi[1] * g[5]); o.w = cvt_pk_bf16(hi[2] * g[6], hi[3] * g[7]);
        *(u32x4*)(WT + (size_t)n * K + k0 + 8 * kc) = o;
    }
}
__device__ __forceinline__ void conv_store4_lds(int K, int N, bf16_t* __restrict__ WT, int item, int lane, const float* __restrict__ gk, const f32x4 (&x)[16], PG8_LAS unsigned char* sw) {
    const int nblk = N / 64, k0 = 64 * (item / nblk), n0 = 64 * (item % nblk);
    const int nq = lane & 15, r = lane >> 4;
    u32x4 o[8];
#pragma unroll
    for (int kc = 0; kc < 8; ++kc) {
        float g[8];
#pragma unroll
        for (int j = 0; j < 8; ++j) g[j] = gk ? gk[k0 + 8 * kc + j] : 1.0f;
        const f32x4 lo = x[2 * kc], hi = x[2 * kc + 1];
        o[kc].x = cvt_pk_bf16(lo[0] * g[0], lo[1] * g[1]); o[kc].y = cvt_pk_bf16(lo[2] * g[2], lo[3] * g[3]);
        o[kc].z = cvt_pk_bf16(hi[0] * g[4], hi[1] * g[5]); o[kc].w = cvt_pk_bf16(hi[2] * g[6], hi[3] * g[7]);
    }
#pragma unroll
    for (int q = 0; q < 4; ++q) {
        if ((nq >> 2) == q) {
            PG8_LAS u32x4* wp = (PG8_LAS u32x4*)(sw + (4 * (nq & 3) + r) * 128);
#pragma unroll
            for (int kc = 0; kc < 8; ++kc) wp[kc] = o[kc];
        }
        asm volatile("s_waitcnt lgkmcnt(0)" ::: "memory");
#pragma unroll
        for (int h = 0; h < 2; ++h) { const int rl = (lane >> 3) + 8 * h;
            const u32x4 v = *(const PG8_LAS u32x4*)(sw + rl * 128 + (lane & 7) * 16);
            *(u32x4*)(WT + (size_t)(n0 + 16 * q + rl) * K + k0 + 8 * (lane & 7)) = v; }
        asm volatile("s_waitcnt lgkmcnt(0)" ::: "memory");
    }
}
struct ConvOrder : StaticOrder {
    const float *w2, *w3, *w4, *g1; bf16_t *t2, *t3, *t4; int gw, ngw, trigger, ln; PG8_LAS unsigned char* sw; mutable int n_done;
    __device__ __forceinline__ void done(const Unit&) const {
        constexpr int I2 = (GW / 64) * (DM / 64), I3 = (DM / 64) * (4 * DM / 64), I4 = (DM / 64) * (DM / 64);
        const int u = n_done++;
#ifdef HOOK_SPREAD
        f32x4 va[16];
        if (u == 0 || u == 1) { for (int it = gw + u * ngw; it < I3; it += 2 * ngw) { conv_load4(w3, 4 * DM, it, ln, va); conv_xpose(va, ln); conv_store4(DM, 4 * DM, t3, it, ln, g1, va); } }
        else if (u == 2) { for (int it = gw; it < I2; it += ngw) { conv_load4(w2, DM, it, ln, va); conv_xpose(va, ln); conv_store4(GW, DM, t2, it, ln, nullptr, va); } }
        else if (u == 3) { for (int it = gw; it < I4; it += ngw) { conv_load4(w4, DM, it, ln, va); conv_xpose(va, ln); conv_store4(DM, DM, t4, it, ln, nullptr, va); } }
#else
        if (u != trigger) return;
        f32x4 va[16], vb[16];
        for (int it = gw; it < I3; it += 2 * ngw) {
            const bool two = it + ngw < I3;
            conv_load4(w3, 4 * DM, it, ln, va); if (two) conv_load4(w3, 4 * DM, it + ngw, ln, vb);
            conv_xpose(va, ln); if (two) conv_xpose(vb, ln);
            conv_store4_lds(DM, 4 * DM, t3, it, ln, g1, va, sw); if (two) conv_store4_lds(DM, 4 * DM, t3, it + ngw, ln, g1, vb, sw);
        }
        for (int it = gw; it < I2; it += ngw) {
            const bool two = it < I4;
            conv_load4(w2, DM, it, ln, va); if (two) conv_load4(w4, DM, it, ln, vb);
            conv_xpose(va, ln); if (two) conv_xpose(vb, ln);
            conv_store4_lds(GW, DM, t2, it, ln, nullptr, va, sw); if (two) conv_store4_lds(DM, DM, t4, it, ln, nullptr, vb, sw);
        }
#endif
    }
};
struct EpiGmlpIn {
    static constexpr bool PERM = true, AFTER_DRAIN = false;
    bf16_t *UZ, *V; float* vss;
    __device__ __forceinline__ void operator()(const f32x4 (&acc)[2][2][4][2], const Unit& u, int wr, int wc, int fr, int fq) const {
        const int row0 = u.pm * BM + wr * 64 + fr;
        const int tq = u.pn / 3, tr = u.pn - 3 * tq;
        if (tr < 2) {
            const int col0 = (2 * tq + tr) * HALF + wc * 32 + 8 * fq;
#pragma unroll
            for (int ai = 0; ai < 2; ++ai)
#pragma unroll
                for (int m = 0; m < 4; ++m) {
                    const int row = row0 + ai * HALF + m * 16;
                    f32x4 v0 = acc[ai][0][m][0], v1 = acc[ai][0][m][1]; const f32x4 z0 = acc[ai][1][m][0], z1 = acc[ai][1][m][1];
#pragma unroll
                    for (int e = 0; e < 4; ++e) { v0[e] = gelu_silu(v0[e], z0[e]); v1[e] = gelu_silu(v1[e], z1[e]); }
                    u32x4 w; w.x = cvt_pk_bf16(v0[0], v0[1]); w.y = cvt_pk_bf16(v0[2], v0[3]); w.z = cvt_pk_bf16(v1[0], v1[1]); w.w = cvt_pk_bf16(v1[2], v1[3]);
                    *(u32x4*)(UZ + (size_t)row * GW + col0) = w;
                }
        } else {
            const int tl = tq, col0 = tl * BM + wc * 32 + 8 * fq;
#pragma unroll
            for (int ai = 0; ai < 2; ++ai)
#pragma unroll
                for (int m = 0; m < 4; ++m) {
                    const int row = row0 + ai * HALF + m * 16;
                    bf16_t* rowp = V + (size_t)row * GW + col0;
                    float ss = 0.f;
#pragma unroll
                    for (int bj = 0; bj < 2; ++bj) {
                        f32x4 v0 = acc[ai][bj][m][0], v1 = acc[ai][bj][m][1];
#pragma unroll
                        for (int e = 0; e < 4; ++e) { v0[e] = gelu_tanh(v0[e]); v1[e] = gelu_tanh(v1[e]); ss += v0[e] * v0[e] + v1[e] * v1[e]; }
                        u32x4 w; w.x = cvt_pk_bf16(v0[0], v0[1]); w.y = cvt_pk_bf16(v0[2], v0[3]); w.z = cvt_pk_bf16(v1[0], v1[1]); w.w = cvt_pk_bf16(v1[2], v1[3]);
                        *(u32x4*)(rowp + bj * HALF) = w;
                    }
                    ss += __shfl_xor(ss, 16); ss += __shfl_xor(ss, 32);
                    if (fq == 0) vss[(size_t)row * 64 + tl * 4 + wc] = ss;
                }
        }
    }
};
struct EpiRes1 {
    static constexpr bool PERM = false, AFTER_DRAIN = false;
    const bf16_t* hn; const float* irs; const float* g0; bf16_t* hb; float* hss;
    __device__ __forceinline__ void operator()(const f32x4 (&acc)[2][2][4][2], const Unit& u, int wr, int wc, int fr, int fq) const {
        const int row0 = u.pm * BM + wr * 64 + fr, col0 = u.pn * BM + wc * 32 + 4 * fq;
        float rs[2][4];
#pragma unroll
        for (int ai = 0; ai < 2; ++ai)
#pragma unroll
            for (int m = 0; m < 4; ++m) rs[ai][m] = irs[row0 + ai * HALF + m * 16];
        f32x4 ig[2][2];
#pragma unroll
        for (int bj = 0; bj < 2; ++bj)
#pragma unroll
            for (int n = 0; n < 2; ++n) { const f32x4 gv = *(const f32x4*)(g0 + col0 + bj * HALF + n * 16);
                ig[bj][n] = (f32x4){__builtin_amdgcn_rcpf(gv[0]), __builtin_amdgcn_rcpf(gv[1]), __builtin_amdgcn_rcpf(gv[2]), __builtin_amdgcn_rcpf(gv[3])}; }
#pragma unroll
        for (int ai = 0; ai < 2; ++ai) {
            u32x2 xv[4][2][2];
#pragma unroll
            for (int m = 0; m < 4; ++m)
#pragma unroll
                for (int bj = 0; bj < 2; ++bj)
#pragma unroll
                    for (int n = 0; n < 2; ++n) xv[m][bj][n] = *(const u32x2*)(hn + (size_t)(row0 + ai * HALF + m * 16) * DM + col0 + bj * HALF + n * 16);
#pragma unroll
            for (int m = 0; m < 4; ++m) {
                const int row = row0 + ai * HALF + m * 16;
                const size_t off = (size_t)row * DM + col0;
                float ss = 0.f;
#pragma unroll
                for (int bj = 0; bj < 2; ++bj)
#pragma unroll
                    for (int n = 0; n < 2; ++n) {
                        const u32x2 w2 = xv[m][bj][n];
                        f32x4 xh; xh[0] = __uint_as_float(w2.x << 16); xh[1] = __uint_as_float(w2.x & 0xffff0000u); xh[2] = __uint_as_float(w2.y << 16); xh[3] = __uint_as_float(w2.y & 0xffff0000u);
                        const f32x4 h = xh * ig[bj][n] * rs[ai][m] + acc[ai][bj][m][n];
                        ss += (h[0] * h[0] + h[1] * h[1]) + (h[2] * h[2] + h[3] * h[3]);
                        const unsigned long long w = (unsigned long long)cvt_pk_bf16(h[0], h[1]) | ((unsigned long long)cvt_pk_bf16(h[2], h[3]) << 32);
                        *(unsigned long long*)(hb + off + bj * HALF + n * 16) = w;
                    }
                ss += __shfl_xor(ss, 16); ss += __shfl_xor(ss, 32);
                if (fq == 0) __hip_atomic_fetch_add(hss + row, ss, __ATOMIC_RELAXED, __HIP_MEMORY_SCOPE_AGENT);
            }
        }
    }
};
struct EpiFinal {
    static constexpr bool PERM = false, AFTER_DRAIN = false;
    const bf16_t* hb; const float* fg; float* out; float* hss; unsigned* cnt; bool fused;
    __device__ __forceinline__ void operator()(f32x4 (&acc)[2][2][4][2], const Unit& u, int wr, int wc, int fr, int fq) const {
        const int row0 = u.pm * BM + wr * 64 + fr, col0 = u.pn * BM + wc * 32 + 4 * fq;
#pragma unroll
        for (int ai = 0; ai < 2; ++ai)
#pragma unroll
            for (int m = 0; m < 4; ++m) {
                const int row = row0 + ai * HALF + m * 16;
                const size_t off = (size_t)row * DM + col0;
                float ss = 0.f;
#pragma unroll
                for (int bj = 0; bj < 2; ++bj)
#pragma unroll
                    for (int n = 0; n < 2; ++n) {
                        const u32x2 w = *(const u32x2*)(hb + off + bj * HALF + n * 16);
                        f32x4 h; h[0] = __uint_as_float(w.x << 16); h[1] = __uint_as_float(w.x & 0xffff0000u); h[2] = __uint_as_float(w.y << 16); h[3] = __uint_as_float(w.y & 0xffff0000u);
                        h += acc[ai][bj][m][n];
                        acc[ai][bj][m][n] = h;
                        ss += (h[0] * h[0] + h[1] * h[1]) + (h[2] * h[2] + h[3] * h[3]);
                    }
                ss += __shfl_xor(ss, 16); ss += __shfl_xor(ss, 32);
                if (fq == 0) __hip_atomic_fetch_add(hss + row, ss, __ATOMIC_RELAXED, __HIP_MEMORY_SCOPE_AGENT);
            }
        if (!fused) {
#pragma unroll
            for (int ai = 0; ai < 2; ++ai)
#pragma unroll
                for (int m = 0; m < 4; ++m)
#pragma unroll
                    for (int bj = 0; bj < 2; ++bj)
#pragma unroll
                        for (int n = 0; n < 2; ++n) *(f32x4*)(out + (size_t)(row0 + ai * HALF + m * 16) * DM + col0 + bj * HALF + n * 16) = acc[ai][bj][m][n];
            return;
        }
        asm volatile("s_waitcnt vmcnt(0)" ::: "memory");
        unsigned* pc = cnt + 64 * u.pm;
        if (lane_id() == 0) __hip_atomic_fetch_add(pc, 1u, __ATOMIC_RELAXED, __HIP_MEMORY_SCOPE_AGENT);
        for (int it = 0; it < (1 << 22); ++it) {
            if (__hip_atomic_load(pc, __ATOMIC_RELAXED, __HIP_MEMORY_SCOPE_AGENT) >= 64u) break;
            __builtin_amdgcn_s_sleep(2);
        }
        asm volatile("" ::: "memory");
        f32x4 gv[2][2];
#pragma unroll
        for (int bj = 0; bj < 2; ++bj)
#pragma unroll
            for (int n = 0; n < 2; ++n) gv[bj][n] = *(const f32x4*)(fg + col0 + bj * HALF + n * 16);
        float ssr[2][4];
#pragma unroll
        for (int ai = 0; ai < 2; ++ai)
#pragma unroll
            for (int m = 0; m < 4; ++m) ssr[ai][m] = __hip_atomic_load(hss + row0 + ai * HALF + m * 16, __ATOMIC_RELAXED, __HIP_MEMORY_SCOPE_AGENT);
#pragma unroll
        for (int ai = 0; ai < 2; ++ai)
#pragma unroll
            for (int m = 0; m < 4; ++m) {
                const int row = row0 + ai * HALF + m * 16;
                const size_t off = (size_t)row * DM + col0;
                const float rstd = __builtin_amdgcn_rsqf(ssr[ai][m] * (1.0f / DM) + EPS);
#pragma unroll
                for (int bj = 0; bj < 2; ++bj)
#pragma unroll
                    for (int n = 0; n < 2; ++n) *(f32x4*)(out + off + bj * HALF + n * 16) = acc[ai][bj][m][n] * rstd * gv[bj][n];
            }
    }
};
struct EpiSbIn {
    static constexpr bool PERM = true, AFTER_DRAIN = false;
    bf16_t* Q; size_t rstride; const float* hss;
    __device__ __forceinline__ void operator()(const f32x4 (&acc)[2][2][4][2], const Unit& u, int wr, int wc, int fr, int fq) const {
        const int region = u.pn >> 3, tl = u.pn & 7;
        bf16_t* base = Q + (size_t)region * rstride;
        const int row0 = u.pm * BM + wr * 64 + fr, col0 = tl * BM + wc * 32 + 8 * fq;
        float ssr[2][4];
#pragma unroll
        for (int ai = 0; ai < 2; ++ai)
#pragma unroll
            for (int m = 0; m < 4; ++m) ssr[ai][m] = hss[row0 + ai * HALF + m * 16];
#pragma unroll
        for (int ai = 0; ai < 2; ++ai)
#pragma unroll
            for (int m = 0; m < 4; ++m) {
                const int row = row0 + ai * HALF + m * 16;
                float sc = __builtin_amdgcn_rsqf(ssr[ai][m] * (1.0f / DM) + EPS);
                if (region == 0) sc *= QSCALE;
                bf16_t* rowp = base + (size_t)row * DM + col0;
#pragma unroll
                for (int bj = 0; bj < 2; ++bj) {
                    f32x4 v0 = acc[ai][bj][m][0] * sc, v1 = acc[ai][bj][m][1] * sc;
                    if (region == 3) {
#pragma unroll
                        for (int e = 0; e < 4; ++e) { v0[e] = silu_f(v0[e]); v1[e] = silu_f(v1[e]); }
                    }
                    u32x4 w; w.x = cvt_pk_bf16(v0[0], v0[1]); w.y = cvt_pk_bf16(v0[2], v0[3]); w.z = cvt_pk_bf16(v1[0], v1[1]); w.w = cvt_pk_bf16(v1[2], v1[3]);
                    *(u32x4*)(rowp + bj * HALF) = w;
                }
            }
    }
};
}

#define LAS __attribute__((address_space(3)))
typedef unsigned short bf16_t;
typedef short bf16x8 __attribute__((ext_vector_type(8)));
typedef short s16x4 __attribute__((ext_vector_type(4)));
typedef float f32x4 __attribute__((ext_vector_type(4)));
typedef float f32x16 __attribute__((ext_vector_type(16)));
typedef unsigned u32x4 __attribute__((ext_vector_type(4)));
typedef unsigned u32x2 __attribute__((ext_vector_type(2)));
__device__ __forceinline__ unsigned off_b(unsigned row, unsigned ch) { return 256u * row + 16u * (ch ^ (((row & 3u) << 2) | ((row >> 2) & 3u))); }
__device__ __forceinline__ s16x4 vtr(const LAS unsigned char* p) { return __builtin_bit_cast(s16x4, __builtin_amdgcn_ds_read_tr16_b64_v4i16((LAS s16x4*)p)); }
__device__ __forceinline__ unsigned pk_bf16(float lo, float hi) { return pg8::cvt_pk_bf16(lo, hi); }
__device__ __forceinline__ float bf_lo(unsigned w) { return __uint_as_float(w << 16); }
__device__ __forceinline__ float bf_hi(unsigned w) { return __uint_as_float(w & 0xffff0000u); }
__device__ __forceinline__ int crow(int r, int hi) { return (r & 3) + 8 * (r >> 2) + 4 * hi; }

#ifdef ATT_NOSB
#define ATT_SB() do {} while (0)
#else
#ifndef ATT_USE_SB
#define ATT_SB() do {} while (0)
#else
#define ATT_SB() __builtin_amdgcn_sched_barrier(0)
#endif
#endif
#define ATT_VLD(f) do { const int c_ = (f) >> 2, s_ = (f) & 3; const s16x4 lo_ = vtr(vbp + 4096 * s_ + vbase[0] + vcq[c_]); const s16x4 hh_ = vtr(vbp + 4096 * s_ + vbase[1] + vcq[c_]); \
        vf[f] = (bf16x8){lo_[0], lo_[1], lo_[2], lo_[3], hh_[0], hh_[1], hh_[2], hh_[3]}; } while (0)
#define ATT_PV(f) do { if (DO_PV) { o[(f) >> 2] = __builtin_amdgcn_mfma_f32_32x32x16_bf16(pa[(f) & 3], vf[f], o[(f) >> 2], 0, 0, 0); if ((f) + 4 < 16) ATT_VLD((f) + 4); } } while (0)
#define ATT_EXP8(i) do { _Pragma("unroll") for (int r_ = 0; r_ < 8; ++r_) p[(i) >> 1][8 * ((i) & 1) + r_] = __builtin_amdgcn_exp2f(fminf(p[(i) >> 1][8 * ((i) & 1) + r_], 30.f)); } while (0)
#define ATT_LBLK(j) do { const int ph_ = 1 - ((j) >> 2), g_ = 3 - ((j) & 3); \
        const float w0_ = 1.0f + p[ph_][4 * g_], w1_ = 1.0f + p[ph_][4 * g_ + 1], w2_ = 1.0f + p[ph_][4 * g_ + 2], w3_ = 1.0f + p[ph_][4 * g_ + 3]; \
        L[j] = __builtin_amdgcn_logf((w0_ * w1_) * (w2_ * w3_)); } while (0)
#define ATT_XCH(j) do { const float own_ = L[j]; const auto rr_ = __builtin_amdgcn_permlane32_swap(__float_as_uint(own_), __float_as_uint(own_), false, false); \
        const float a0_ = __uint_as_float(rr_[0]), a1_ = __uint_as_float(rr_[1]); const float oth_ = (a0_ == own_) ? a1_ : a0_; \
        T[j] = run + (hi ? 0.f : oth_) + own_; run += a0_ + a1_; } while (0)
#define ATT_WGT(j) do { const int ph_ = 1 - ((j) >> 2), g_ = 3 - ((j) & 3); float cf_ = __builtin_amdgcn_exp2f(-T[j]); \
        _Pragma("unroll") for (int e_ = 0; e_ < 4; ++e_) { const float ev_ = p[ph_][4 * g_ + e_]; p[ph_][4 * g_ + e_] = ev_ * cf_; if (e_ < 3) cf_ *= (1.0f + ev_); } } while (0)

template <bool DO_PV>
__device__ __forceinline__ void attn_tile(const LAS unsigned char* kb, const LAS unsigned char* vbp, const bf16x8 (&qf)[8], f32x16 (&o)[4], bf16x8 (&pa)[4], float& carry,
                                          const unsigned (&koff)[8], const unsigned (&vbase)[2], const unsigned (&vcq)[4], int k0, int qw0, int qabs, int hi) {
    f32x16 p[2];
#pragma unroll
    for (int r = 0; r < 16; ++r) { p[0][r] = 0.f; p[1][r] = 0.f; }
    bf16x8 vf[16];
    if (DO_PV) { ATT_VLD(0); ATT_VLD(1); ATT_VLD(2); ATT_VLD(3); }
    {
        bf16x8 ka[8], kc[8];
#pragma unroll
        for (int d0 = 0; d0 < 8; ++d0) { ka[d0] = *(const LAS bf16x8*)(kb + koff[d0]); kc[d0] = *(const LAS bf16x8*)(kb + 8192 + koff[d0]); }
        ATT_SB();
#pragma unroll
        for (int d0 = 0; d0 < 8; ++d0) {
            p[0] = __builtin_amdgcn_mfma_f32_32x32x16_bf16(ka[d0], qf[d0], p[0], 0, 0, 0);
            p[1] = __builtin_amdgcn_mfma_f32_32x32x16_bf16(kc[d0], qf[d0], p[1], 0, 0, 0);
        }
    }
    ATT_SB();
    const bool need_mask = (k0 + 63 >= qw0);
    float L[8], T[8];
    ATT_PV(0); ATT_EXP8(0); ATT_SB();
    ATT_PV(1); ATT_EXP8(1); ATT_SB();
    ATT_PV(2); ATT_EXP8(2); ATT_SB();
    ATT_PV(3); ATT_EXP8(3); ATT_SB();
    if (need_mask) {
#pragma unroll
        for (int ph = 0; ph < 2; ++ph)
#pragma unroll
            for (int r = 0; r < 16; ++r) { const int key = k0 + 32 * ph + crow(r, hi); if (key >= qabs) p[ph][r] = 0.f; }
    }
    ATT_SB();
    ATT_PV(4); ATT_LBLK(0); ATT_LBLK(1); ATT_SB();
    ATT_PV(5); ATT_LBLK(2); ATT_LBLK(3); ATT_SB();
    ATT_PV(6); ATT_LBLK(4); ATT_LBLK(5); ATT_SB();
    ATT_PV(7); ATT_LBLK(6); ATT_LBLK(7); ATT_SB();
    float run = carry;
    ATT_PV(8); ATT_XCH(0); ATT_XCH(1); ATT_SB();
    ATT_PV(9); ATT_XCH(2); ATT_XCH(3); ATT_SB();
    ATT_PV(10); ATT_XCH(4); ATT_XCH(5); ATT_SB();
    ATT_PV(11); ATT_XCH(6); ATT_XCH(7); ATT_SB();
    carry = run;
    ATT_PV(12); ATT_WGT(0); ATT_WGT(1); ATT_SB();
    ATT_PV(13); ATT_WGT(2); ATT_WGT(3); ATT_SB();
    ATT_PV(14); ATT_WGT(4); ATT_WGT(5); ATT_SB();
    ATT_PV(15); ATT_WGT(6); ATT_WGT(7); ATT_SB();
#pragma unroll
    for (int s = 0; s < 4; ++s) { const int ph = s >> 1, rb = 8 * (s & 1);
        u32x4 w; w.x = pk_bf16(p[ph][rb], p[ph][rb + 1]); w.y = pk_bf16(p[ph][rb + 2], p[ph][rb + 3]); w.z = pk_bf16(p[ph][rb + 4], p[ph][rb + 5]); w.w = pk_bf16(p[ph][rb + 6], p[ph][rb + 7]);
        pa[s] = __builtin_bit_cast(bf16x8, w); }
}

__device__ __forceinline__ void attn_unit(LAS unsigned char* lds, const int wid, int b, int h, int qb, const bf16_t* __restrict__ Q, const bf16_t* __restrict__ K,
                                          const bf16_t* __restrict__ V, const bf16_t* __restrict__ ZS, bf16_t* __restrict__ OG) {
    const int tid = tid_of(wid), lane = tid & 63, r32 = lane & 31, hi = lane >> 5;
    const size_t tok0 = (size_t)b * SEQ;
    const int q0 = qb * 256, qw0 = q0 + 32 * wid, qabs = qw0 + r32;
    bf16x8 qf[8];
    { const bf16_t* qp = Q + (tok0 + qabs) * DM + h * HD + 8 * hi;
#pragma unroll
      for (int d0 = 0; d0 < 8; ++d0) qf[d0] = *(const bf16x8*)(qp + 16 * d0); }
    f32x16 o[4];
#pragma unroll
    for (int c = 0; c < 4; ++c)
#pragma unroll
        for (int r = 0; r < 16; ++r) o[c][r] = 0.f;
    bf16x8 pa[4];
#pragma unroll
    for (int s = 0; s < 4; ++s) pa[s] = (bf16x8){0, 0, 0, 0, 0, 0, 0, 0};
    float carry = 0.f;
    const int NT = (q0 + 256) / 64;
    const int srow = tid >> 4, sch = (tid & 15) ^ (((srow & 3) << 2) | ((srow >> 2) & 3));
    const bf16_t* kg = K + (tok0 + srow) * DM + h * HD + sch * 8;
    const bf16_t* vg = V + (tok0 + srow) * DM + h * HD + sch * 8;
    LAS unsigned char* ldsw = lds + wid * 1024;
#define ATT_STAGE(t_, koff_, voff_) do { const size_t go_ = (size_t)(t_) * 64 * DM; \
        __builtin_amdgcn_global_load_lds((const unsigned*)(kg + go_), (LAS unsigned*)(ldsw + (koff_)), 16, 0, 0); \
        __builtin_amdgcn_global_load_lds((const unsigned*)(kg + go_ + 32 * DM), (LAS unsigned*)(ldsw + (koff_) + 8192), 16, 0, 0); \
        __builtin_amdgcn_global_load_lds((const unsigned*)(vg + go_), (LAS unsigned*)(ldsw + (voff_)), 16, 0, 0); \
        __builtin_amdgcn_global_load_lds((const unsigned*)(vg + go_ + 32 * DM), (LAS unsigned*)(ldsw + (voff_) + 8192), 16, 0, 0); } while (0)
    ATT_STAGE(NT - 1, 0, 32768);
    asm volatile("s_waitcnt vmcnt(0)" ::: "memory");
    __syncthreads();
    unsigned koff[8];
#pragma unroll
    for (int d0 = 0; d0 < 8; ++d0) koff[d0] = off_b(r32, 2 * d0 + hi);
    const unsigned qa = (lane & 15) >> 2, blk = (lane >> 4) & 1, pp = lane & 3;
    unsigned vbase[2], vcq[4];
#pragma unroll
    for (int t = 0; t < 2; ++t) vbase[t] = 256u * (8 * t + 4 * hi + qa) + 16u * ((2 * blk + (pp >> 1)) ^ ((2 * t + hi) & 3)) + 8u * (pp & 1);
#pragma unroll
    for (int c = 0; c < 4; ++c) vcq[c] = 64u * ((unsigned)c ^ qa);
    int kcur = 0, vprev = 2, vcur = 0, vnext = 1;
    bool prev_valid = false;
    for (int t = NT - 1; t >= 0; --t) {
        if (t > 0) ATT_STAGE(t - 1, (kcur ^ 1) * 16384, 32768 + vnext * 16384);
        const LAS unsigned char* kb = lds + kcur * 16384;
        const LAS unsigned char* vbp = lds + 32768 + vprev * 16384;
        const int k0 = 64 * t;
        const bool valid = (k0 < qw0 + 31);
        if (valid) {
            if (prev_valid) attn_tile<true>(kb, vbp, qf, o, pa, carry, koff, vbase, vcq, k0, qw0, qabs, hi);
            else            attn_tile<false>(kb, vbp, qf, o, pa, carry, koff, vbase, vcq, k0, qw0, qabs, hi);
        }
        prev_valid = valid;
        asm volatile("s_waitcnt vmcnt(0)" ::: "memory");
        __syncthreads();
        kcur ^= 1; { const int tmp = vprev; vprev = vcur; vcur = vnext; vnext = tmp; }
    }
    { const LAS unsigned char* vbp = lds + 32768 + vprev * 16384;
#pragma unroll
      for (int c = 0; c < 4; ++c)
#pragma unroll
          for (int s = 0; s < 4; ++s) {
              const s16x4 lo = vtr(vbp + 4096 * s + vbase[0] + vcq[c]);
              const s16x4 hh = vtr(vbp + 4096 * s + vbase[1] + vcq[c]);
              const bf16x8 vfr = (bf16x8){lo[0], lo[1], lo[2], lo[3], hh[0], hh[1], hh[2], hh[3]};
              o[c] = __builtin_amdgcn_mfma_f32_32x32x16_bf16(pa[s], vfr, o[c], 0, 0, 0);
          } }
    {
        int lane_e = lane_id(); asm volatile("" : "+v"(lane_e));
        const int r32e = lane_e & 31, hie = lane_e >> 5, rowq = lane_e >> 4, c4 = (lane_e & 15) * 4;
        LAS float* stg = (LAS float*)(lds + 81920 + wid * 8192);
        const size_t gbase = (tok0 + qw0) * DM + h * HD + c4;
        u32x2 zv[2][8];
#pragma unroll
        for (int ps = 0; ps < 2; ++ps)
#pragma unroll
            for (int j = 0; j < 8; ++j) zv[ps][j] = *(const u32x2*)(ZS + gbase + (size_t)(4 * j + rowq) * DM + 64 * ps);
#pragma unroll
        for (int ps = 0; ps < 2; ++ps) {
#pragma unroll
            for (int r = 0; r < 16; ++r) {
                stg[crow(r, hie) * 64 + r32e] = o[2 * ps][r];
                stg[crow(r, hie) * 64 + 32 + r32e] = o[2 * ps + 1][r];
            }
            asm volatile("s_waitcnt lgkmcnt(0)" ::: "memory");
#pragma unroll
            for (int j = 0; j < 8; ++j) {
                const f32x4 ov = *(const LAS f32x4*)(stg + (4 * j + rowq) * 64 + c4);
                const u32x2 z = zv[ps][j];
                u32x2 w; w.x = pk_bf16(ov[0] * bf_lo(z.x), ov[1] * bf_hi(z.x)); w.y = pk_bf16(ov[2] * bf_lo(z.y), ov[3] * bf_hi(z.y));
                *(u32x2*)(OG + gbase + (size_t)(4 * j + rowq) * DM + 64 * ps) = w;
            }
            asm volatile("s_waitcnt lgkmcnt(0)" ::: "memory");
        }
    }
    __syncthreads();
}
__device__ __forceinline__ void attn_phase(LAS unsigned char* lds, const int wid_, int vcu, int G, const bf16_t* Q, const bf16_t* K, const bf16_t* V, const bf16_t* ZS, bf16_t* OG) {
#ifndef NO_ATTN_PRIO
    if (wid_ >= 4) __builtin_amdgcn_s_setprio(1);
#endif
    for (int p = vcu; p < 256; p += G) {
        const int bh = p >> 3, s = p & 7;
#ifdef ATT_ONE_INSTANCE
#pragma unroll 1
        for (int uu = 0; uu < 2; ++uu) attn_unit(lds, wid_, bh >> 4, bh & 15, uu ? 15 - s : s, Q, K, V, ZS, OG);
#else
        attn_unit(lds, wid_, bh >> 4, bh & 15, s, Q, K, V, ZS, OG);
        attn_unit(lds, wid_, bh >> 4, bh & 15, 15 - s, Q, K, V, ZS, OG);
#endif
    }
    __builtin_amdgcn_s_setprio(0);
}

__device__ __forceinline__ void mix_unit(LAS unsigned char* lds, const int wid, int n, int g, const bf16_t* __restrict__ UZ, const bf16_t* __restrict__ V, const float* __restrict__ vss,
                                         const float* __restrict__ w_s, const float* __restrict__ b_s, const float* __restrict__ vg, bf16_t* __restrict__ Y) {
    const int tid = tid_of(wid), lane = tid & 63, r32 = lane & 31, hi = lane >> 5;
    const size_t row0 = (size_t)n * CHUNK;
    LAS float* rstdL = (LAS float*)(lds + 98304);
    const int cc = tid & 31;
    u32x4 uu[8];
#pragma unroll
    for (int i = 0; i < 8; ++i) { const int t = (tid >> 5) + 16 * i; uu[i] = *(const u32x4*)(UZ + (row0 + t) * GW + g * GDIM + cc * 8); }
    {
        u32x4 vr[8];
#pragma unroll
        for (int i = 0; i < 8; ++i) { const int c = tid + 512 * i, s = c >> 5, cc = c & 31;
            vr[i] = *(const u32x4*)(V + (row0 + s) * GW + g * GDIM + cc * 8); }
        if (tid < 128) { const f32x4* vp = (const f32x4*)(vss + (row0 + tid) * 64); f32x4 s4 = vp[0];
#pragma unroll
            for (int i = 1; i < 16; ++i) s4 += vp[i];
            rstdL[tid] = __builtin_amdgcn_rsqf(((s4[0] + s4[1]) + (s4[2] + s4[3])) * (1.0f / GW) + EPS); }
#pragma unroll
        for (int i = 0; i < 8; ++i) { const int c = tid + 512 * i, s = c >> 5, cc = c & 31;
            *(LAS u32x4*)(lds + 32768 + (cc >> 4) * 32768 + off_b(s, cc & 15)) = vr[i]; }
    }
    __syncthreads();
#pragma unroll
    for (int i = 0; i < 4; ++i) { const int c = tid + 512 * i, t = c >> 4, ch = c & 15, s0 = ch * 8;
        const f32x4 w0 = *(const f32x4*)(w_s + ((size_t)g * CHUNK + t) * CHUNK + s0), w1 = *(const f32x4*)(w_s + ((size_t)g * CHUNK + t) * CHUNK + s0 + 4);
        float wv[8] = {w0[0], w0[1], w0[2], w0[3], w1[0], w1[1], w1[2], w1[3]};
#pragma unroll
        for (int j = 0; j < 8; ++j) wv[j] = (s0 + j <= t) ? wv[j] * rstdL[s0 + j] : 0.f;
        u32x4 w; w.x = pk_bf16(wv[0], wv[1]); w.y = pk_bf16(wv[2], wv[3]); w.z = pk_bf16(wv[4], wv[5]); w.w = pk_bf16(wv[6], wv[7]);
        *(LAS u32x4*)(lds + off_b(t, ch)) = w; }
    __syncthreads();
    f32x16 acc[4];
#pragma unroll
    for (int i = 0; i < 4; ++i)
#pragma unroll
        for (int r = 0; r < 16; ++r) acc[i][r] = 0.f;
    {
        const LAS unsigned char* vimg = lds + 32768 + (wid >> 2) * 32768;
        const unsigned cblk = wid & 3, qa = (lane & 15) >> 2, blk = (lane >> 4) & 1, pp = lane & 3;
#pragma unroll
        for (int ks = 0; ks < 8; ++ks) {
            const s16x4 lo = vtr(vimg + off_b(16 * ks + 8 * hi + qa, 4 * cblk + 2 * blk + (pp >> 1)) + 8 * (pp & 1));
            const s16x4 hh = vtr(vimg + off_b(16 * ks + 8 * hi + 4 + qa, 4 * cblk + 2 * blk + (pp >> 1)) + 8 * (pp & 1));
            const bf16x8 vf = (bf16x8){lo[0], lo[1], lo[2], lo[3], hh[0], hh[1], hh[2], hh[3]};
#pragma unroll
            for (int i = 0; i < 4; ++i) if (ks <= 2 * i + 1) {
                const bf16x8 af = *(const LAS bf16x8*)(lds + off_b(32 * i + r32, 2 * ks + hi));
                acc[i] = __builtin_amdgcn_mfma_f32_32x32x16_bf16(af, vf, acc[i], 0, 0, 0);
            }
        }
    }
    __syncthreads();
    {
        LAS float* mx = (LAS float*)lds;
        const int c = 128 * (wid >> 2) + 32 * (wid & 3) + r32;
#pragma unroll
        for (int i = 0; i < 4; ++i)
#pragma unroll
            for (int r = 0; r < 16; ++r) mx[(32 * i + crow(r, hi)) * 256 + c] = acc[i][r];
    }
    __syncthreads();
    {
        const f32x4 g0 = *(const f32x4*)(vg + g * GDIM + cc * 8), g1 = *(const f32x4*)(vg + g * GDIM + cc * 8 + 4);
        float bb[8];
#pragma unroll
        for (int i = 0; i < 8; ++i) bb[i] = b_s[g * CHUNK + (tid >> 5) + 16 * i];
#pragma unroll
        for (int i = 0; i < 8; ++i) { const int t = (tid >> 5) + 16 * i;
            const f32x4 m0 = *(const LAS f32x4*)(lds + (t * 256 + cc * 8) * 4), m1 = *(const LAS f32x4*)(lds + (t * 256 + cc * 8 + 4) * 4);
            float y[8];
            y[0] = bf_lo(uu[i].x) * (m0[0] * g0[0] + bb[i]); y[1] = bf_hi(uu[i].x) * (m0[1] * g0[1] + bb[i]);
            y[2] = bf_lo(uu[i].y) * (m0[2] * g0[2] + bb[i]); y[3] = bf_hi(uu[i].y) * (m0[3] * g0[3] + bb[i]);
            y[4] = bf_lo(uu[i].z) * (m1[0] * g1[0] + bb[i]); y[5] = bf_hi(uu[i].z) * (m1[1] * g1[1] + bb[i]);
            y[6] = bf_lo(uu[i].w) * (m1[2] * g1[2] + bb[i]); y[7] = bf_hi(uu[i].w) * (m1[3] * g1[3] + bb[i]);
            u32x4 w; w.x = pk_bf16(y[0], y[1]); w.y = pk_bf16(y[2], y[3]); w.z = pk_bf16(y[4], y[5]); w.w = pk_bf16(y[6], y[7]);
            *(u32x4*)(Y + (row0 + t) * GW + g * GDIM + cc * 8) = w; }
    }
    __syncthreads();
}

__device__ __forceinline__ float wave_sum(float v) {
#pragma unroll
    for (int o = 1; o < 64; o <<= 1) v += __shfl_xor(v, o);
    return v;
}
__device__ __forceinline__ void tr_load(const float* __restrict__ W, int N, int item, int lane, f32x4 (&wv)[16]) {
    const int nblk = N / 64, k0 = 64 * (item / nblk), n0 = 64 * (item % nblk);
#pragma unroll
    for (int i = 0; i < 16; ++i) wv[i] = *(const f32x4*)(W + (size_t)(k0 + 4 * i + (lane >> 4)) * N + n0 + 4 * (lane & 15));
}
__device__ __forceinline__ void tr_to_lds(LAS float* scr, int lane, const f32x4 (&wv)[16]) {
#pragma unroll
    for (int i = 0; i < 16; ++i) { const int kk = 4 * i + (lane >> 4), nn = 4 * (lane & 15);
        LAS float* s = scr + kk * 65 + nn; s[0] = wv[i][0]; s[1] = wv[i][1]; s[2] = wv[i][2]; s[3] = wv[i][3]; }
    asm volatile("s_waitcnt lgkmcnt(0)" ::: "memory");
}
__device__ __forceinline__ void tr_store(int K, int N, bf16_t* __restrict__ WT, const LAS float* scr, int item, int lane, const float* __restrict__ gk, bool gmlp_perm) {
    const int nblk = N / 64, k0 = 64 * (item / nblk), n0 = 64 * (item % nblk);
    int r0 = n0;
    if (gmlp_perm) {
        if (n0 < GW) { const int cb = n0 >> 7; r0 = 256 * (3 * (cb >> 1) + (cb & 1)) + (n0 & 127); }
        else if (n0 < 2 * GW) { const int mv = n0 - GW; r0 = 256 * (3 * (mv >> 8) + 2) + (mv & 255); }
        else { const int mz = n0 - 2 * GW, cb = mz >> 7; r0 = 256 * (3 * (cb >> 1) + (cb & 1)) + 128 + (mz & 127); }
    }
    const int c = lane & 7;
    f32x4 ga = {1.f, 1.f, 1.f, 1.f}, gb = {1.f, 1.f, 1.f, 1.f};
    if (gk) { ga = *(const f32x4*)(gk + k0 + 8 * c); gb = *(const f32x4*)(gk + k0 + 8 * c + 4); }
#pragma unroll
    for (int j = 0; j < 8; ++j) { const int nn = (lane >> 3) + 8 * j; const LAS float* s = scr + (8 * c) * 65 + nn;
        u32x4 o; o.x = pk_bf16(s[0] * ga[0], s[65] * ga[1]); o.y = pk_bf16(s[2 * 65] * ga[2], s[3 * 65] * ga[3]); o.z = pk_bf16(s[4 * 65] * gb[0], s[5 * 65] * gb[1]); o.w = pk_bf16(s[6 * 65] * gb[2], s[7 * 65] * gb[3]);
        *(u32x4*)(WT + (size_t)(r0 + nn) * K + k0 + 8 * c) = o; }
    asm volatile("s_waitcnt lgkmcnt(0)" ::: "memory");
}
__device__ __forceinline__ void transpose_matrix(const float* __restrict__ W, int K, int N, bf16_t* __restrict__ WT, LAS float* scr, int first, int stride, int nitems, int lane,
                                                 const float* __restrict__ gk = nullptr, bool gmlp_perm = false) {
    f32x4 wv[16], wn[16];
    int it = first;
    if (it < nitems) tr_load(W, N, it, lane, wv);
    while (it < nitems) {
        const int nx = it + stride;
        tr_to_lds(scr, lane, wv);
        if (nx < nitems) tr_load(W, N, nx, lane, wn);
        tr_store(K, N, WT, scr, it, lane, gk, gmlp_perm);
#pragma unroll
        for (int i = 0; i < 16; ++i) wv[i] = wn[i];
        it = nx;
    }
}

#define XB_TMO      128
#define XB_XCNT(j)  (256  + 64 * (j))
#define XB_XSUB(j)  (1280 + 64 * (j))
#define XB_XGEN(j)  (2304 + 64 * (j))
#define XB_TOP      3328
#define XB_TOPGEN   3392
#define XCD_BAR_WORDS 3456
#define XB_SPIN_CAP (1u << 18)

__device__ __forceinline__ unsigned xb_ld(unsigned* p)              { return __hip_atomic_load(p, __ATOMIC_RELAXED, __HIP_MEMORY_SCOPE_AGENT); }
__device__ __forceinline__ unsigned xb_add(unsigned* p, unsigned v) { return __hip_atomic_fetch_add(p, v, __ATOMIC_RELAXED, __HIP_MEMORY_SCOPE_AGENT); }
__device__ __forceinline__ unsigned xb_xcc_id() { return (unsigned)__builtin_amdgcn_s_getreg((3 << 11) | 20) & 0xFu; }
#define XB_SPIN(cond, bar) do { unsigned _sp = 0; while (cond) { __builtin_amdgcn_s_sleep(1); \
    if ((++_sp & 255u) == 0u) { if (xb_ld(&(bar)[XB_TMO])) break; if (_sp > XB_SPIN_CAP) { atomicAdd(&(bar)[XB_TMO], 1u); break; } } } } while (0)

struct XcdBarrier {
    unsigned* bar; unsigned x; int w;
    volatile LAS unsigned* st;
};

__device__ __forceinline__ XcdBarrier xcd_barrier_post(unsigned* bar, volatile LAS unsigned* st, int wave) {
    XcdBarrier b; b.bar = bar; b.x = xb_xcc_id(); b.st = st; b.w = wave;
    if (tid_of(wave) == 0) (void)xb_add(&bar[XB_XCNT(b.x)], 1u);
    return b;
}
__device__ __forceinline__ void xcd_barrier_complete(unsigned* bar, unsigned x, unsigned& nloc, unsigned& nx) {
    const unsigned G = gridDim.x * gridDim.y * gridDim.z;
    unsigned sum, cnt, mine, sp = 0u;
    for (;;) {
        sum = 0u; cnt = 0u; mine = 0u;
#pragma unroll
        for (unsigned j = 0; j < 16; ++j) { const unsigned c = xb_ld(&bar[XB_XCNT(j)]); sum += c; cnt += (c > 0u) ? 1u : 0u; mine = (j == x) ? c : mine; }
        if (sum == G) break;
        __builtin_amdgcn_s_sleep(1);
        if ((++sp & 255u) == 0u) { if (xb_ld(&bar[XB_TMO])) break; if (sp > XB_SPIN_CAP) { atomicAdd(&bar[XB_TMO], 1u); break; } }
    }
    nloc = mine > 0u ? mine : 1u; nx = cnt > 0u ? cnt : 1u;
}

__device__ __forceinline__ void xcd_barrier(const XcdBarrier& b) {
    asm volatile("s_waitcnt vmcnt(0)" ::: "memory");
    __syncthreads();
    if (tid_of(b.w) == 0) {
        unsigned* bar = b.bar;
        __builtin_amdgcn_s_waitcnt(0);
        unsigned nloc = b.st[0], nx = b.st[1];
        if (nloc == 0u) { xcd_barrier_complete(bar, b.x, nloc, nx); b.st[0] = nloc; b.st[1] = nx; }
        const unsigned old = xb_add(&bar[XB_XSUB(b.x)], 1u);
        const unsigned gen = old / nloc;
        if (old + 1u == (gen + 1u) * nloc) {
            __builtin_amdgcn_fence(__ATOMIC_RELEASE, "agent");
            asm volatile("s_waitcnt vmcnt(0)" ::: "memory");
            const unsigned og = xb_add(&bar[XB_TOP], 1u);
            const unsigned tg = og / nx;
            if (og + 1u == (tg + 1u) * nx) xb_add(&bar[XB_TOPGEN], 1u);
            else XB_SPIN(xb_ld(&bar[XB_TOPGEN]) == tg, bar);
            __builtin_amdgcn_fence(__ATOMIC_ACQUIRE, "agent");
            xb_add(&bar[XB_XGEN(b.x)], 1u);
            asm volatile("s_waitcnt vmcnt(0)" ::: "memory");
        } else {
            XB_SPIN(xb_ld(&bar[XB_XGEN(b.x)]) == gen, bar);
            __builtin_amdgcn_fence(__ATOMIC_ACQUIRE, "agent");
            asm volatile("s_waitcnt vmcnt(0)" ::: "memory");
        }
    }
    __syncthreads();
}

constexpr size_t MiB = 1u << 20;
constexpr size_t WS_VSS = 0, WS_HSS1 = 2 * MiB, WS_HSS2 = 3 * MiB, WS_IRS0 = 3 * MiB + 32768, WS_CNT = 3 * MiB + 65536;
constexpr size_t WS_WT1 = 4 * MiB, WS_HN0 = 268 * MiB  , WS_WT2 = 84 * MiB, WS_WT3 = 100 * MiB, WS_WT4 = 132 * MiB;
constexpr size_t WS_U = 140 * MiB, WS_V = 204 * MiB, WS_ZS = 268 * MiB, WS_CTL = 364 * MiB, CTL_ZERO_BYTES = 32768, WS_END = 365 * MiB;
constexpr size_t WS_Y = 4 * MiB;
constexpr size_t WS_H1 = 140 * MiB, WS_H1B = 332 * MiB;
constexpr size_t WS_Q = 204 * MiB, WS_K = 236 * MiB, WS_V2 = 268 * MiB, WS_ZS2 = 300 * MiB, WS_OG = 4 * MiB;

constexpr int NWAVES = 8, LDS_BYTES = 151552;
#ifndef N_LAUNCHES
#define N_LAUNCHES 1
#endif
constexpr int N_PHASES = 7;
#ifndef CONV_TRIGGER
#define CONV_TRIGGER ((bx >> 3) % 6)
#endif
#ifndef GEMM_SP2
#define GEMM_SP2 true
#endif
#ifndef GEMM_ALIGN
#define GEMM_ALIGN true
#endif
#ifndef REPEAT_PHASE
#define REPEAT_PHASE -1
#endif
#define NREP(k) ((REPEAT_PHASE == (k)) ? 2 : 1)

struct Args { const float* in[10]; float* out; unsigned char* ws; int ph_lo, ph_hi, li, pad; };

__global__ void __launch_bounds__(NWAVES * 64, 2) fwd_kernel(Args a) {
    extern __shared__ __attribute__((aligned(16))) unsigned char lds_raw[];
    LAS unsigned char* lds = (LAS unsigned char*)lds_raw;
    cg::grid_group grid = cg::this_grid();
    const int wave = __builtin_amdgcn_readfirstlane(threadIdx.x >> 6);
#define tid tid_of(wave)
#define lane lane_id()
    const int G = gridDim.x, bx = blockIdx.x;
    const int vcu = (G % 8 == 0) ? (bx % 8) * (G / 8) + bx / 8 : bx;
    const float* x = a.in[0]; const float* norm_g = a.in[1]; const float* a_w_in = a.in[2]; const float* a_vg = a.in[3]; const float* a_w_s = a.in[4];
    const float* a_b_s = a.in[5]; const float* a_w_out = a.in[6]; const float* b_w_in = a.in[7]; const float* b_w_out = a.in[8]; const float* final_g = a.in[9];
    unsigned char* ws = a.ws;
    float* VSS = (float*)(ws + WS_VSS); float* HSS1 = (float*)(ws + WS_HSS1); float* HSS2 = (float*)(ws + WS_HSS2); float* IRS0 = (float*)(ws + WS_IRS0); unsigned* CNT = (unsigned*)(ws + WS_CNT);
    bf16_t* WT1 = (bf16_t*)(ws + WS_WT1); bf16_t* WT2 = (bf16_t*)(ws + WS_WT2); bf16_t* WT3 = (bf16_t*)(ws + WS_WT3); bf16_t* WT4 = (bf16_t*)(ws + WS_WT4);
    bf16_t* HN0 = (bf16_t*)(ws + WS_HN0); bf16_t* U = (bf16_t*)(ws + WS_U); bf16_t* V = (bf16_t*)(ws + WS_V); bf16_t* ZS = (bf16_t*)(ws + WS_ZS);
    bf16_t* Y = (bf16_t*)(ws + WS_Y); bf16_t* H1B = (bf16_t*)(ws + WS_H1B);
    bf16_t* Qb = (bf16_t*)(ws + WS_Q); bf16_t* Kb = (bf16_t*)(ws + WS_K); bf16_t* V2 = (bf16_t*)(ws + WS_V2); bf16_t* ZS2 = (bf16_t*)(ws + WS_ZS2); bf16_t* OG = (bf16_t*)(ws + WS_OG);
    const int lo = a.ph_lo, hi = a.ph_hi;
#define IN(k) (lo <= (k) && (k) < hi)
#define SEAM(k) do { if (IN(k) && IN((k) + 1)) xcd_barrier(bar); } while (0)
    volatile LAS unsigned* MISC = (volatile LAS unsigned*)(lds + LDS_BYTES - 64);
    if (tid < 16) MISC[tid] = 0u;
    __syncthreads();
    XcdBarrier bar = xcd_barrier_post((unsigned*)(ws + WS_CTL) + a.li * XCD_BAR_WORDS, MISC + 8, wave);
    if (lo > 1000) grid.sync();
    const int gw = vcu * NWAVES + wave, NGW = G * NWAVES;

    if (IN(0)) for (int rep = 0; rep < NREP(0); ++rep) {
        LAS float* scr = (LAS float*)(lds + wave * 16640);
        constexpr int I1 = (DM / 64) * (3 * GW / 64), I2 = (GW / 64) * (DM / 64), I3 = (DM / 64) * (4 * DM / 64), I4 = (DM / 64) * (DM / 64);
        transpose_matrix(a_w_in, DM, 3 * GW, WT1, scr, gw, NGW, I1, lane, nullptr, true);
        for (int m = bx * (NWAVES * 64) + tid; m < NTOK; m += G * NWAVES * 64) { HSS1[m] = 0.f; HSS2[m] = 0.f; if (m < 2048) CNT[m] = 0u; }
        for (int m = gw; m < NTOK; m += NGW) {
            const f32x4* xr = (const f32x4*)(x + (size_t)m * DM) + lane; const f32x4* gr = (const f32x4*)norm_g + lane;
            f32x4 v[8]; float ss = 0.f;
#pragma unroll
            for (int j = 0; j < 8; ++j) { v[j] = xr[64 * j]; ss += (v[j][0] * v[j][0] + v[j][1] * v[j][1]) + (v[j][2] * v[j][2] + v[j][3] * v[j][3]); }
            const float ms = wave_sum(ss) * (1.0f / DM) + EPS;
            const float rstd = __builtin_amdgcn_rsqf(ms);
            if (lane == 0) IRS0[m] = __builtin_amdgcn_sqrtf(ms);
            u32x2* o8 = (u32x2*)(HN0 + (size_t)m * DM) + lane;
#pragma unroll
            for (int j = 0; j < 8; ++j) { const f32x4 gg = gr[64 * j]; u32x2 w; w.x = pk_bf16(v[j][0] * rstd * gg[0], v[j][1] * rstd * gg[1]); w.y = pk_bf16(v[j][2] * rstd * gg[2], v[j][3] * rstd * gg[3]); o8[64 * j] = w; }
        }
    }
    SEAM(0);
#ifdef EXTRA_SYNCS
    for (int i = 0; i < EXTRA_SYNCS; ++i) xcd_barrier(bar);
#endif
    if (IN(1)) for (int rep = 0; rep < NREP(1); ++rep) {
        pg8::Gemm g{HN0, WT1, NTOK, 3 * GW, DM}; pg8::ConvOrder S; S.init(NTOK, 3 * GW, G, bx);
        S.w2 = a_w_out; S.w3 = b_w_in; S.w4 = b_w_out; S.g1 = norm_g + DM; S.t2 = WT2; S.t3 = WT3; S.t4 = WT4; S.gw = gw; S.ngw = NGW; S.trigger = (G == 256) ? CONV_TRIGGER : 0; S.ln = lane; S.sw = lds + 131072 + wave * 2048; S.n_done = 0;
        pg8::EpiGmlpIn E{U, V, VSS};
        pg8::gemm_phase<pg8::EpiGmlpIn, pg8::ConvOrder, GEMM_ALIGN, GEMM_SP2>(lds, g, S, E, wave);
    }
    SEAM(1);
    if (IN(2)) for (int rep = 0; rep < NREP(2); ++rep) {
        for (int it = vcu; it < (NTOK / CHUNK) * NGRP; it += G) mix_unit(lds, wave, it >> 4, it & 15, U, V, VSS, a_w_s, a_b_s, a_vg, Y);
    }
    SEAM(2);
    if (IN(3)) for (int rep = 0; rep < NREP(3); ++rep) {
        pg8::Gemm g{Y, WT2, NTOK, DM, GW}; pg8::StaticOrder S; S.init(NTOK, DM, G, bx);
        pg8::EpiRes1 E{HN0, IRS0, norm_g, H1B, HSS1};
        pg8::gemm_phase<pg8::EpiRes1, pg8::StaticOrder, GEMM_ALIGN, GEMM_SP2>(lds, g, S, E, wave);
    }
    SEAM(3);
    if (IN(4)) for (int rep = 0; rep < NREP(4); ++rep) {
        pg8::Gemm g{H1B, WT3, NTOK, 4 * DM, DM}; pg8::StaticOrder S; S.init(NTOK, 4 * DM, G, bx);
        pg8::EpiSbIn E{Qb, (size_t)(WS_K - WS_Q) / 2, HSS1};
        pg8::gemm_phase<pg8::EpiSbIn, pg8::StaticOrder, GEMM_ALIGN, GEMM_SP2>(lds, g, S, E, wave);
    }
    SEAM(4);
    if (IN(5)) for (int rep = 0; rep < NREP(5); ++rep) attn_phase(lds, wave, vcu, G, Qb, Kb, V2, ZS2, OG);
    SEAM(5);
    if (IN(6)) for (int rep = 0; rep < NREP(6); ++rep) {
        pg8::Gemm g{OG, WT4, NTOK, DM, DM}; pg8::StaticOrder S; S.init(NTOK, DM, G, bx);
        pg8::EpiFinal E{H1B, final_g, a.out, HSS2, CNT, G == 256};
        pg8::gemm_phase<pg8::EpiFinal, pg8::StaticOrder, GEMM_ALIGN, GEMM_SP2>(lds, g, S, E, wave);
    }
    if (IN(6) && G != 256) {
        xcd_barrier(bar);
        for (int m = gw; m < NTOK; m += NGW) {
            const float rstd = __builtin_amdgcn_rsqf(HSS2[m] * (1.0f / DM) + EPS);
            f32x4* orow = (f32x4*)(a.out + (size_t)m * DM) + lane; const f32x4* gr = (const f32x4*)final_g + lane;
#pragma unroll
            for (int j = 0; j < 8; ++j) { const f32x4 v = orow[64 * j]; orow[64 * j] = v * rstd * gr[64 * j]; }
        }
    }
#undef IN
#undef SEAM
#undef tid
#undef lane
}

extern "C" void kernel_launch(void* const* d_in, const int* in_sizes, int n_in, void* d_out, int out_size, void* d_ws, size_t ws_size, hipStream_t stream) {
    static int grid = 0;
    if (grid == 0) {
        if (n_in != 10 || out_size != NTOK * DM || ws_size < WS_END) { fprintf(stderr, "kernel_launch: unexpected shapes (n_in %d, out %d, ws %zu)\n", n_in, out_size, ws_size); grid = -1; return; }
        int dev = 0, cus = 0, per_cu = 0;
        (void)hipGetDevice(&dev); (void)hipDeviceGetAttribute(&cus, hipDeviceAttributeMultiprocessorCount, dev);
        if (hipFuncSetAttribute((const void*)fwd_kernel, hipFuncAttributeMaxDynamicSharedMemorySize, LDS_BYTES) != hipSuccess) { fprintf(stderr, "kernel_launch: hipFuncSetAttribute failed\n"); grid = -1; return; }
        if (hipOccupancyMaxActiveBlocksPerMultiprocessor(&per_cu, (const void*)fwd_kernel, NWAVES * 64, LDS_BYTES) != hipSuccess || per_cu < 1) { fprintf(stderr, "kernel_launch: occupancy query says %d\n", per_cu); per_cu = 1; }
        (void)hipGetLastError();
        grid = cus > 0 ? cus : 256;
    }
    if (grid < 0) return;
    if (hipMemsetAsync((char*)d_ws + WS_CTL, 0, CTL_ZERO_BYTES, stream) != hipSuccess) { fprintf(stderr, "kernel_launch: memset failed\n"); return; }
    Args a{};
    for (int i = 0; i < 10; ++i) a.in[i] = (const float*)d_in[i];
    a.out = (float*)d_out; a.ws = (unsigned char*)d_ws;
#ifdef PROBE_SPLIT
    const int nl = 2;
#else
    const int nl = N_LAUNCHES;
#endif
    for (int li = 0; li < nl; ++li) {
        a.ph_lo = (N_LAUNCHES == 1) ? 0 : li; a.ph_hi = (N_LAUNCHES == 1) ? N_PHASES : li + 1;
#ifdef PROBE_SPLIT
        a.ph_lo = li == 0 ? 0 : PROBE_SPLIT; a.ph_hi = li == 0 ? PROBE_SPLIT + 1 : N_PHASES;
#endif
        a.li = li;
        void* args[] = {&a};
        hipError_t e = hipLaunchCooperativeKernel((const void*)fwd_kernel, dim3(grid), dim3(NWAVES * 64), args, LDS_BYTES, stream);
        if (e != hipSuccess) { fprintf(stderr, "kernel_launch: cooperative launch %d failed: %s (grid %d)\n", li, hipGetErrorString(e), grid); break; }
    }
}
```

```cpp
#include <hip/hip_runtime.h>
#include <hip/hip_cooperative_groups.h>
#include <cstdio>
#include <cstdint>
namespace cg = cooperative_groups;
__device__ __forceinline__ int lane_id() { return (int)__builtin_amdgcn_mbcnt_hi(~0u, __builtin_amdgcn_mbcnt_lo(~0u, 0u)); }
__device__ __forceinline__ int tid_of(int wave) { return wave * 64 + lane_id(); }
#ifndef PG8_WGM
#define PG8_WGM 8
#endif
namespace pg8 {
#define PG8_LAS __attribute__((address_space(3)))
typedef unsigned short bf16_t;
typedef short bf16x8 __attribute__((ext_vector_type(8)));
typedef float f32x4 __attribute__((ext_vector_type(4)));
typedef unsigned u32x4 __attribute__((ext_vector_type(4)));
constexpr int BM = 256, BK = 64, HALF = 128, HTB = HALF * BK * 2  , STAGE_BYTES = 8 * HTB, NXCD = 8, WGM = PG8_WGM;

__host__ __device__ __forceinline__ int lds_byte(int r, int c) { const int st = (r >> 4) * 2 + (c >> 5), rr = r & 15, cc = c & 31, ob = rr * 64 + cc * 2; return st * 1024 + (ob ^ (((ob >> 9) & 1) << 5)); }
__host__ __device__ __forceinline__ void stage_rc(int b, int& R, int& C) { const int st = b / 1024, sb = b % 1024, swz = sb ^ (((sb >> 9) & 1) << 5); R = (st >> 1) * 16 + swz / 64; C = (st & 1) * 32 + (swz % 64) / 2; }
__host__ __device__ __forceinline__ int perm32(int rho) { const int n = rho >> 4, i = rho & 15; return 8 * (i >> 2) + 4 * n + (i & 3); }

struct Unit { int pm, pn; };
struct Gemm { const bf16_t* A; const bf16_t* Bt; int M, N, K; };

struct StaticOrder {
    int nM, nN, nwg, G, c;
    __host__ __device__ void init(int M, int N, int G_, int c_) { nM = M / BM; nN = N / BM; nwg = nM * nN; G = G_; c = c_; }
    __host__ __device__ bool next(int i, Unit& u) const {
        const long L = (long)i * G + c; if (L >= nwg) return false;
        int wgid = (int)L; { const int q = nwg / NXCD, r = nwg % NXCD, xcd = wgid % NXCD, off = wgid / NXCD; wgid = (xcd < r ? xcd * (q + 1) : r * (q + 1) + (xcd - r) * q) + off; }
        const int nig = WGM * nN, gid = wgid / nig, fm = gid * WGM, gsz = (nM - fm) < WGM ? (nM - fm) : WGM;
        u.pm = fm + ((wgid % nig) % gsz); u.pn = (wgid % nig) / gsz; return true;
    }
    __device__ __forceinline__ void a_ready(const Unit&) const {}
    __device__ __forceinline__ void done(const Unit&) const {}
};

__device__ __forceinline__ unsigned cvt_pk_bf16(float lo, float hi) { unsigned r; asm volatile("v_cvt_pk_bf16_f32 %0, %1, %2" : "=v"(r) : "v"(lo), "v"(hi)); return r; }
typedef float f32x2 __attribute__((ext_vector_type(2)));
typedef float f32x2 __attribute__((ext_vector_type(2)));
template <class Epi, class Sched, bool ALIGN_EPI = false, bool SP2 = false>
__device__ __forceinline__ void gemm_phase(PG8_LAS unsigned char* lds, const Gemm g, const Sched& S, const Epi& E, const int wave_) {
    const int tid = tid_of(wave_), wid = wave_, lane = tid & 63, wr = wid >> 2, wc = wid & 3, fr = lane & 15, fq = lane >> 4;
    const int K = g.K, nt = K / BK;
    unsigned voffA[2], voffB[2];
#pragma unroll
    for (int i = 0; i < 2; ++i) { int R, C; stage_rc(tid * 16 + i * 8192, R, C); const int Rb = Epi::PERM ? ((R & ~31) + perm32(R & 31)) : R;
        voffA[i] = (unsigned)(R * K + C) * 2u; voffB[i] = (unsigned)(Rb * K + C) * 2u; }
    const size_t kstep = (size_t)(BK * 2);
    const size_t hstep = (size_t)HALF * K * 2;
    const size_t tstep = 2 * hstep;
    const unsigned ldsw = (unsigned)wid * 1024u;
    const int aoff = lds_byte(wr * 64 + fr, fq * 8), boff = lds_byte(wc * 32 + fr, fq * 8);
#define PG8_SA(b, h) (((b) * 2 + (h)) * HTB)
#define PG8_SB(b, h) ((4 + (b) * 2 + (h)) * HTB)
#define PG8_STAGE(bufoff, gbase, voff) do { _Pragma("unroll") for (int _i = 0; _i < 2; ++_i) \
        __builtin_amdgcn_global_load_lds((const unsigned*)((const char*)(gbase) + (voff)[_i]), (PG8_LAS unsigned*)(lds + (bufoff) + ldsw + _i * 8192), 16, 0, 0); } while (0)
#define PG8_LDA(dst, b, h) do { _Pragma("unroll") for (int m = 0; m < 4; ++m) _Pragma("unroll") for (int k = 0; k < 2; ++k) dst[m][k] = *(const PG8_LAS bf16x8*)(lds + PG8_SA(b, h) + aoff + m * 2048 + k * 1024); } while (0)
#define PG8_LDB(dst, b, h) do { _Pragma("unroll") for (int n = 0; n < 2; ++n) _Pragma("unroll") for (int k = 0; k < 2; ++k) dst[n][k] = *(const PG8_LAS bf16x8*)(lds + PG8_SB(b, h) + boff + n * 2048 + k * 1024); } while (0)
#define PG8_MMA(ai, bj, At, Bt) do { __builtin_amdgcn_s_setprio(1); _Pragma("unroll") for (int m = 0; m < 4; ++m) _Pragma("unroll") for (int n = 0; n < 2; ++n) _Pragma("unroll") for (int k = 0; k < 2; ++k) \
        acc[ai][bj][m][n] = __builtin_amdgcn_mfma_f32_16x16x32_bf16(Bt[n][k], At[m][k], acc[ai][bj][m][n], 0, 0, 0); __builtin_amdgcn_s_setprio(0); } while (0)
#define PG8_WAIT_V(n) asm volatile("s_waitcnt vmcnt(" #n ")" ::: "memory")
#define PG8_WAIT_L(n) asm volatile("s_waitcnt lgkmcnt(" #n ")" ::: "memory")
#define PG8_BAR __builtin_amdgcn_s_barrier()
#define PG8_SCHED __builtin_amdgcn_sched_barrier(0)
    Unit cur, nxt; int ui = 0;
    if (!S.next(0, cur)) return;
    f32x4 acc[2][2][4][2];
#pragma unroll
    for (int a = 0; a < 2; ++a)
#pragma unroll
        for (int b = 0; b < 2; ++b)
#pragma unroll
            for (int m = 0; m < 4; ++m)
#pragma unroll
                for (int n = 0; n < 2; ++n) acc[a][b][m][n] = (f32x4){0.f, 0.f, 0.f, 0.f};
    bf16x8 At[4][2], B0[2][2], B1[2][2];
    const char* cA = (const char*)g.A + (size_t)cur.pm * tstep; const char* cB = (const char*)g.Bt + (size_t)cur.pn * tstep;
    S.a_ready(cur);
    if constexpr (SP2) {
        PG8_STAGE(PG8_SB(0, 0), cB, voffB); PG8_STAGE(PG8_SB(0, 1), cB + hstep, voffB); PG8_STAGE(PG8_SA(0, 0), cA, voffA); PG8_STAGE(PG8_SA(0, 1), cA + hstep, voffA);
        if (wr == 1) PG8_BAR;
        PG8_WAIT_V(2); PG8_BAR;
        PG8_STAGE(PG8_SB(1, 0), cB + kstep, voffB); PG8_STAGE(PG8_SA(1, 0), cA + kstep, voffA); PG8_STAGE(PG8_SB(1, 1), cB + hstep + kstep, voffB);
        PG8_WAIT_V(6); PG8_BAR;
    } else {
        PG8_STAGE(PG8_SB(0, 0), cB, voffB); PG8_STAGE(PG8_SA(0, 0), cA, voffA); PG8_STAGE(PG8_SB(0, 1), cB + hstep, voffB); PG8_STAGE(PG8_SA(0, 1), cA + hstep, voffA);
        if (wr == 1) PG8_BAR;
        PG8_WAIT_V(4); PG8_BAR;
        PG8_STAGE(PG8_SB(1, 0), cB + kstep, voffB); PG8_STAGE(PG8_SA(1, 0), cA + kstep, voffA); PG8_STAGE(PG8_SB(1, 1), cB + hstep + kstep, voffB);
        PG8_WAIT_V(6); PG8_BAR;
    }
    for (;;) {
        const bool has_next = S.next(ui + 1, nxt);
        const char* nA = has_next ? (const char*)g.A + (size_t)nxt.pm * tstep : cA; const char* nB = has_next ? (const char*)g.Bt + (size_t)nxt.pn * tstep : cB;
        for (int t = 0; t < nt; t += 2) {
            const bool last = (t == nt - 2);
            const char* a1 = cA + (size_t)(t + 1) * kstep;
            const char* a2 = last ? nA : cA + (size_t)(t + 2) * kstep; const char* b2 = last ? nB : cB + (size_t)(t + 2) * kstep;
            const char* a3 = a2 + kstep; const char* b3 = b2 + kstep;
            if (last && has_next) S.a_ready(nxt);
            if constexpr (SP2) {
            PG8_LDB(B0, 0, 0); PG8_LDB(B1, 0, 1); PG8_SCHED; PG8_LDA(At, 0, 0); PG8_STAGE(PG8_SA(1, 1), a1 + hstep, voffA);
            PG8_WAIT_V(8); PG8_WAIT_L(0); PG8_BAR; PG8_MMA(0, 0, At, B0); PG8_MMA(0, 1, At, B1); PG8_BAR; PG8_SCHED;
            PG8_LDA(At, 0, 1); PG8_STAGE(PG8_SB(0, 0), b2, voffB); PG8_STAGE(PG8_SB(0, 1), b2 + hstep, voffB); PG8_STAGE(PG8_SA(0, 0), a2, voffA);
            PG8_WAIT_V(8); PG8_WAIT_L(0); PG8_BAR; PG8_MMA(1, 0, At, B0); PG8_MMA(1, 1, At, B1); PG8_BAR; PG8_SCHED;
            PG8_LDB(B0, 1, 0); PG8_LDB(B1, 1, 1); PG8_SCHED; PG8_LDA(At, 1, 0); PG8_STAGE(PG8_SA(0, 1), a2 + hstep, voffA);
            PG8_WAIT_V(8); PG8_WAIT_L(0); PG8_BAR; PG8_MMA(0, 0, At, B0); PG8_MMA(0, 1, At, B1); PG8_BAR; PG8_SCHED;
            PG8_LDA(At, 1, 1); PG8_STAGE(PG8_SB(1, 0), b3, voffB); PG8_STAGE(PG8_SB(1, 1), b3 + hstep, voffB); PG8_STAGE(PG8_SA(1, 0), a3, voffA);
            PG8_WAIT_V(8); PG8_WAIT_L(0); PG8_BAR; PG8_MMA(1, 0, At, B0); PG8_MMA(1, 1, At, B1); PG8_BAR; PG8_SCHED;
            } else {
            PG8_LDB(B0, 0, 0); PG8_SCHED; PG8_LDA(At, 0, 0); PG8_STAGE(PG8_SA(1, 1), a1 + hstep, voffA);
            PG8_WAIT_L(8); PG8_BAR; PG8_WAIT_L(0); PG8_MMA(0, 0, At, B0); PG8_BAR; PG8_SCHED;
            PG8_LDB(B1, 0, 1); PG8_STAGE(PG8_SB(0, 0), b2, voffB);
            PG8_BAR; PG8_WAIT_L(0); PG8_MMA(0, 1, At, B1); PG8_BAR;
            PG8_LDA(At, 0, 1); PG8_STAGE(PG8_SA(0, 0), a2, voffA);
            PG8_BAR; PG8_WAIT_L(0); PG8_MMA(1, 0, At, B0); PG8_BAR; PG8_SCHED;
            PG8_STAGE(PG8_SB(0, 1), b2 + hstep, voffB);
            PG8_WAIT_V(6); PG8_BAR; PG8_MMA(1, 1, At, B1); PG8_BAR;
            PG8_LDB(B0, 1, 0); PG8_SCHED; PG8_LDA(At, 1, 0); PG8_STAGE(PG8_SA(0, 1), a2 + hstep, voffA);
            PG8_WAIT_L(8); PG8_BAR; PG8_WAIT_L(0); PG8_MMA(0, 0, At, B0); PG8_BAR; PG8_SCHED;
            PG8_LDB(B1, 1, 1); PG8_STAGE(PG8_SB(1, 0), b3, voffB);
            PG8_BAR; PG8_WAIT_L(0); PG8_MMA(0, 1, At, B1); PG8_BAR;
            PG8_LDA(At, 1, 1); PG8_STAGE(PG8_SA(1, 0), a3, voffA);
            PG8_BAR; PG8_WAIT_L(0); PG8_MMA(1, 0, At, B0); PG8_BAR; PG8_SCHED;
            PG8_STAGE(PG8_SB(1, 1), b3 + hstep, voffB);
            PG8_WAIT_V(6); PG8_BAR; PG8_MMA(1, 1, At, B1); PG8_BAR;
            }
        }
        if constexpr (ALIGN_EPI) { if (wr == 0) PG8_BAR; }
        if constexpr (!Epi::AFTER_DRAIN) { E(acc, cur, wr, wc, fr, fq); S.done(cur); }
        if (!has_next) break;
#pragma unroll
        for (int a = 0; a < 2; ++a)
#pragma unroll
            for (int b = 0; b < 2; ++b)
#pragma unroll
                for (int m = 0; m < 4; ++m)
#pragma unroll
                    for (int n = 0; n < 2; ++n) acc[a][b][m][n] = (f32x4){0.f, 0.f, 0.f, 0.f};
        cur = nxt; cA = nA; cB = nB; ++ui;
        if constexpr (ALIGN_EPI) { if (wr == 1) PG8_BAR; }
    }
    PG8_WAIT_V(0);
    if constexpr (!ALIGN_EPI) { if (wr == 0) PG8_BAR; }
    PG8_BAR;
    if constexpr (Epi::AFTER_DRAIN) { E.fused(acc, cur, wr, wc, fr, fq, lds, wid, lane); S.done(cur); }
#undef PG8_SA
#undef PG8_SB
#undef PG8_STAGE
#undef PG8_LDA
#undef PG8_LDB
#undef PG8_MMA
#undef PG8_WAIT_V
#undef PG8_WAIT_L
#undef PG8_BAR
#undef PG8_SCHED
}
}

constexpr int DM = 2048, NTOK = 8192, SEQ = 4096, GW = 4096, NGRP = 16, GDIM = 256, CHUNK = 128, NHEAD = 16, HD = 128;
constexpr float EPS = 1e-6f;
constexpr float LOG2E = 1.4426950408889634f;
constexpr float QSCALE = 0.08838834764831845f * LOG2E;

constexpr float GELU_C1 = -1.5957691216057308f * LOG2E, GELU_C2 = -0.07135481627260025f * LOG2E;
__device__ __forceinline__ float gelu_tanh(float x) {
    const float e = __builtin_amdgcn_exp2f(x * __builtin_fmaf(x * x, GELU_C2, GELU_C1));
    return x * __builtin_amdgcn_rcpf(1.0f + e);
}
__device__ __forceinline__ float gelu_silu(float u, float z) {
    const float e1 = __builtin_amdgcn_exp2f(u * __builtin_fmaf(u * u, GELU_C2, GELU_C1));
    const float e2 = __builtin_amdgcn_exp2f(z * -LOG2E);
    return (u * z) * __builtin_amdgcn_rcpf((1.0f + e1) * (1.0f + e2));
}
__device__ __forceinline__ float silu_f(float z) { return z * __builtin_amdgcn_rcpf(1.0f + __builtin_amdgcn_exp2f(-LOG2E * z)); }

namespace pg8 {
typedef unsigned u32x2 __attribute__((ext_vector_type(2)));
__device__ __forceinline__ void conv_load4(const float* __restrict__ W, int N, int item, int lane, f32x4 (&x)[16]) {
    const int nblk = N / 64, k0 = 64 * (item / nblk), n0 = 64 * (item % nblk);
#pragma unroll
    for (int i = 0; i < 16; ++i) x[i] = *(const f32x4*)(W + (size_t)(k0 + 4 * i + (lane >> 4)) * N + n0 + 4 * (lane & 15));
}
__device__ __forceinline__ void conv_xpose(f32x4 (&x)[16], int lane) {
    const bool a = (lane >> 4) & 1, b = (lane >> 5) & 1;
#pragma unroll
    for (int i = 0; i < 16; ++i) {
        f32x4 v = x[i];
        {
            const float s0 = a ? v[0] : v[1], s1 = a ? v[2] : v[3];
            const float r0 = __shfl_xor(s0, 16), r1 = __shfl_xor(s1, 16);
            if (a) { v[0] = r0; v[2] = r1; } else { v[1] = r0; v[3] = r1; }
        }
        {
            const float s0 = b ? v[0] : v[2], s1 = b ? v[1] : v[3];
            const float r0 = __shfl_xor(s0, 32), r1 = __shfl_xor(s1, 32);
            if (b) { v[0] = r0; v[1] = r1; } else { v[2] = r0; v[3] = r1; }
        }
        x[i] = v;
    }
}
__device__ __forceinline__ void conv_store4(int K, int N, bf16_t* __restrict__ WT, int item, int lane, const float* __restrict__ gk, const f32x4 (&x)[16]) {
    const int nblk = N / 64, k0 = 64 * (item / nblk), n0 = 64 * (item % nblk);
    const int n = n0 + 4 * (lane & 15) + (lane >> 4);
#pragma unroll
    for (int kc = 0; kc < 8; ++kc) {
        float g[8];
#pragma unroll
        for (int j = 0; j < 8; ++j) g[j] = gk ? gk[k0 + 8 * kc + j] : 1.0f;
        const f32x4 lo = x[2 * kc], hi = x[2 * kc + 1];
        u32x4 o; o.x = cvt_pk_bf16(lo[0] * g[0], lo[1] * g[1]); o.y = cvt_pk_bf16(lo[2] * g[2], lo[3] * g[3]);
        o.z = cvt_pk_bf16(hi[0] * g[4], hi[1] * g[5]); o.w = cvt_pk_bf16(hi[2] * g[6], hi[3] * g[7]);
        *(u32x4*)(WT + (size_t)n * K + k0 + 8 * kc) = o;
    }
}
__device__ __forceinline__ void conv_store4_lds(int K, int N, bf16_t* __restrict__ WT, int item, int lane, const float* __restrict__ gk, const f32x4 (&x)[16], PG8_LAS unsigned char* sw) {
    const int nblk = N / 64, k0 = 64 * (item / nblk), n0 = 64 * (item % nblk);
    const int nq = lane & 15, r = lane >> 4;
    u32x4 o[8];
#pragma unroll
    for (int kc = 0; kc < 8; ++kc) {
        float g[8];
#pragma unroll
        for (int j = 0; j < 8; ++j) g[j] = gk ? gk[k0 + 8 * kc + j] : 1.0f;
        const f32x4 lo = x[2 * kc], hi = x[2 * kc + 1];
        o[kc].x = cvt_pk_bf16(lo[0] * g[0], lo[1] * g[1]); o[kc].y = cvt_pk_bf16(lo[2] * g[2], lo[3] * g[3]);
        o[kc].z = cvt_pk_bf16(hi[0] * g[4], hi[1] * g[5]); o[kc].w = cvt_pk_bf16(hi[2] * g[6], hi[3] * g[7]);
    }
#pragma unroll
    for (int q = 0; q < 4; ++q) {
        if ((nq >> 2) == q) {
            PG8_LAS u32x4* wp = (PG8_LAS u32x4*)(sw + (4 * (nq & 3) + r) * 128);
#pragma unroll
            for (int kc = 0; kc < 8; ++kc) wp[kc] = o[kc];
        }
        asm volatile("s_waitcnt lgkmcnt(0)" ::: "memory");
#pragma unroll
        for (int h = 0; h < 2; ++h) { const int rl = (lane >> 3) + 8 * h;
            const u32x4 v = *(const PG8_LAS u32x4*)(sw + rl * 128 + (lane & 7) * 16);
            *(u32x4*)(WT + (size_t)(n0 + 16 * q + rl) * K + k0 + 8 * (lane & 7)) = v; }
        asm volatile("s_waitcnt lgkmcnt(0)" ::: "memory");
    }
}
struct ConvOrder : StaticOrder {
    const float *w2, *w3, *w4, *g1; bf16_t *t2, *t3, *t4; int gw, ngw, trigger, ln; PG8_LAS unsigned char* sw; mutable int n_done;
    __device__ __forceinline__ void done(const Unit&) const {
        constexpr int I2 = (GW / 64) * (DM / 64), I3 = (DM / 64) * (4 * DM / 64), I4 = (DM / 64) * (DM / 64);
        const int u = n_done++;
#ifdef HOOK_SPREAD
        f32x4 va[16];
        if (u == 0 || u == 1) { for (int it = gw + u * ngw; it < I3; it += 2 * ngw) { conv_load4(w3, 4 * DM, it, ln, va); conv_xpose(va, ln); conv_store4(DM, 4 * DM, t3, it, ln, g1, va); } }
        else if (u == 2) { for (int it = gw; it < I2; it += ngw) { conv_load4(w2, DM, it, ln, va); conv_xpose(va, ln); conv_store4(GW, DM, t2, it, ln, nullptr, va); } }
        else if (u == 3) { for (int it = gw; it < I4; it += ngw) { conv_load4(w4, DM, it, ln, va); conv_xpose(va, ln); conv_store4(DM, DM, t4, it, ln, nullptr, va); } }
#else
        if (u != trigger) return;
        f32x4 va[16], vb[16];
        for (int it = gw; it < I3; it += 2 * ngw) {
            const bool two = it + ngw < I3;
            conv_load4(w3, 4 * DM, it, ln, va); if (two) conv_load4(w3, 4 * DM, it + ngw, ln, vb);
            conv_xpose(va, ln); if (two) conv_xpose(vb, ln);
            conv_store4_lds(DM, 4 * DM, t3, it, ln, g1, va, sw); if (two) conv_store4_lds(DM, 4 * DM, t3, it + ngw, ln, g1, vb, sw);
        }
        for (int it = gw; it < I2; it += ngw) {
            const bool two = it < I4;
            conv_load4(w2, DM, it, ln, va); if (two) conv_load4(w4, DM, it, ln, vb);
            conv_xpose(va, ln); if (two) conv_xpose(vb, ln);
            conv_store4_lds(GW, DM, t2, it, ln, nullptr, va, sw); if (two) conv_store4_lds(DM, DM, t4, it, ln, nullptr, vb, sw);
        }
#endif
    }
};
struct EpiGmlpIn {
    static constexpr bool PERM = true, AFTER_DRAIN = false;
    bf16_t *UZ, *V; float* vss;
    __device__ __forceinline__ void operator()(const f32x4 (&acc)[2][2][4][2], const Unit& u, int wr, int wc, int fr, int fq) const {
        const int row0 = u.pm * BM + wr * 64 + fr;
        const int tq = u.pn / 3, tr = u.pn - 3 * tq;
        if (tr < 2) {
            const int col0 = (2 * tq + tr) * HALF + wc * 32 + 8 * fq;
#pragma unroll
            for (int ai = 0; ai < 2; ++ai)
#pragma unroll
                for (int m = 0; m < 4; ++m) {
                    const int row = row0 + ai * HALF + m * 16;
                    f32x4 v0 = acc[ai][0][m][0], v1 = acc[ai][0][m][1]; const f32x4 z0 = acc[ai][1][m][0], z1 = acc[ai][1][m][1];
#pragma unroll
                    for (int e = 0; e < 4; ++e) { v0[e] = gelu_silu(v0[e], z0[e]); v1[e] = gelu_silu(v1[e], z1[e]); }
                    u32x4 w; w.x = cvt_pk_bf16(v0[0], v0[1]); w.y = cvt_pk_bf16(v0[2], v0[3]); w.z = cvt_pk_bf16(v1[0], v1[1]); w.w = cvt_pk_bf16(v1[2], v1[3]);
                    *(u32x4*)(UZ + (size_t)row * GW + col0) = w;
                }
        } else {
            const int tl = tq, col0 = tl * BM + wc * 32 + 8 * fq;
#pragma unroll
            for (int ai = 0; ai < 2; ++ai)
#pragma unroll
                for (int m = 0; m < 4; ++m) {
                    const int row = row0 + ai * HALF + m * 16;
                    bf16_t* rowp = V + (size_t)row * GW + col0;
                    float ss = 0.f;
#pragma unroll
                    for (int bj = 0; bj < 2; ++bj) {
                        f32x4 v0 = acc[ai][bj][m][0], v1 = acc[ai][bj][m][1];
#pragma unroll
                        for (int e = 0; e < 4; ++e) { v0[e] = gelu_tanh(v0[e]); v1[e] = gelu_tanh(v1[e]); ss += v0[e] * v0[e] + v1[e] * v1[e]; }
                        u32x4 w; w.x = cvt_pk_bf16(v0[0], v0[1]); w.y = cvt_pk_bf16(v0[2], v0[3]); w.z = cvt_pk_bf16(v1[0], v1[1]); w.w = cvt_pk_bf16(v1[2], v1[3]);
                        *(u32x4*)(rowp + bj * HALF) = w;
                    }
                    ss += __shfl_xor(ss, 16); ss += __shfl_xor(ss, 32);
                    if (fq == 0) vss[(size_t)row * 64 + tl * 4 + wc] = ss;
                }
        }
    }
};
struct EpiRes1 {
    static constexpr bool PERM = false, AFTER_DRAIN = false;
    const bf16_t* hn; const float* irs; const float* g0; bf16_t* hb; float* hss;
    __device__ __forceinline__ void operator()(const f32x4 (&acc)[2][2][4][2], const Unit& u, int wr, int wc, int fr, int fq) const {
        const int row0 = u.pm * BM + wr * 64 + fr, col0 = u.pn * BM + wc * 32 + 4 * fq;
        float rs[2][4];
#pragma unroll
        for (int ai = 0; ai < 2; ++ai)
#pragma unroll
            for (int m = 0; m < 4; ++m) rs[ai][m] = irs[row0 + ai * HALF + m * 16];
        f32x4 ig[2][2];
#pragma unroll
        for (int bj = 0; bj < 2; ++bj)
#pragma unroll
            for (int n = 0; n < 2; ++n) { const f32x4 gv = *(const f32x4*)(g0 + col0 + bj * HALF + n * 16);
                ig[bj][n] = (f32x4){__builtin_amdgcn_rcpf(gv[0]), __builtin_amdgcn_rcpf(gv[1]), __builtin_amdgcn_rcpf(gv[2]), __builtin_amdgcn_rcpf(gv[3])}; }
#pragma unroll
        for (int ai = 0; ai < 2; ++ai) {
            u32x2 xv[4][2][2];
#pragma unroll
            for (int m = 0; m < 4; ++m)
#pragma unroll
                for (int bj = 0; bj < 2; ++bj)
#pragma unroll
                    for (int n = 0; n < 2; ++n) xv[m][bj][n] = *(const u32x2*)(hn + (size_t)(row0 + ai * HALF + m * 16) * DM + col0 + bj * HALF + n * 16);
#pragma unroll
            for (int m = 0; m < 4; ++m) {
                const int row = row0 + ai * HALF + m * 16;
                const size_t off = (size_t)row * DM + col0;
                float ss = 0.f;
#pragma unroll
                for (int bj = 0; bj < 2; ++bj)
#pragma unroll
                    for (int n = 0; n < 2; ++n) {
                        const u32x2 w2 = xv[m][bj][n];
                        f32x4 xh; xh[0] = __uint_as_float(w2.x << 16); xh[1] = __uint_as_float(w2.x & 0xffff0000u); xh[2] = __uint_as_float(w2.y << 16); xh[3] = __uint_as_float(w2.y & 0xffff0000u);
                        const f32x4 h = xh * ig[bj][n] * rs[ai][m] + acc[ai][bj][m][n];
                        ss += (h[0] * h[0] + h[1] * h[1]) + (h[2] * h[2] + h[3] * h[3]);
                        const unsigned long long w = (unsigned long long)cvt_pk_bf16(h[0], h[1]) | ((unsigned long long)cvt_pk_bf16(h[2], h[3]) << 32);
                        *(unsigned long long*)(hb + off + bj * HALF + n * 16) = w;
                    }
                ss += __shfl_xor(ss, 16); ss += __shfl_xor(ss, 32);
                if (fq == 0) __hip_atomic_fetch_add(hss + row, ss, __ATOMIC_RELAXED, __HIP_MEMORY_SCOPE_AGENT);
            }
        }
    }
};
struct EpiFinal {
    static constexpr bool PERM = false, AFTER_DRAIN = false;
    const bf16_t* hb; const float* fg; float* out; float* hss; unsigned* cnt; bool fused;
    __device__ __forceinline__ void operator()(f32x4 (&acc)[2][2][4][2], const Unit& u, int wr, int wc, int fr, int fq) const {
        const int row0 = u.pm * BM + wr * 64 + fr, col0 = u.pn * BM + wc * 32 + 4 * fq;
#pragma unroll
        for (int ai = 0; ai < 2; ++ai)
#pragma unroll
            for (int m = 0; m < 4; ++m) {
                const int row = row0 + ai * HALF + m * 16;
                const size_t off = (size_t)row * DM + col0;
                float ss = 0.f;
#pragma unroll
                for (int bj = 0; bj < 2; ++bj)
#pragma unroll
                    for (int n = 0; n < 2; ++n) {
                        const u32x2 w = *(const u32x2*)(hb + off + bj * HALF + n * 16);
                        f32x4 h; h[0] = __uint_as_float(w.x << 16); h[1] = __uint_as_float(w.x & 0xffff0000u); h[2] = __uint_as_float(w.y << 16); h[3] = __uint_as_float(w.y & 0xffff0000u);
                        h += acc[ai][bj][m][n];
                        acc[ai][bj][m][n] = h;
                        ss += (h[0] * h[0] + h[1] * h[1]) + (h[2] * h[2] + h[3] * h[3]);
                    }
                ss += __shfl_xor(ss, 16); ss += __shfl_xor(ss, 32);
                if (fq == 0) __hip_atomic_fetch_add(hss + row, ss, __ATOMIC_RELAXED, __HIP_MEMORY_SCOPE_AGENT);
            }
        if (!fused) {
#pragma unroll
            for (int ai = 0; ai < 2; ++ai)
#pragma unroll
                for (int m = 0; m < 4; ++m)
#pragma unroll
                    for (int bj = 0; bj < 2; ++bj)
#pragma unroll
                        for (int n = 0; n < 2; ++n) *(f32x4*)(out + (size_t)(row0 + ai * HALF + m * 16) * DM + col0 + bj * HALF + n * 16) = acc[ai][bj][m][n];
            return;
        }
        asm volatile("s_waitcnt vmcnt(0)" ::: "memory");
        unsigned* pc = cnt + 64 * u.pm;
        if (lane_id() == 0) __hip_atomic_fetch_add(pc, 1u, __ATOMIC_RELAXED, __HIP_MEMORY_SCOPE_AGENT);
        for (int it = 0; it < (1 << 22); ++it) {
            if (__hip_atomic_load(pc, __ATOMIC_RELAXED, __HIP_MEMORY_SCOPE_AGENT) >= 64u) break;
            __builtin_amdgcn_s_sleep(2);
        }
        asm volatile("" ::: "memory");
        f32x4 gv[2][2];
#pragma unroll
        for (int bj = 0; bj < 2; ++bj)
#pragma unroll
            for (int n = 0; n < 2; ++n) gv[bj][n] = *(const f32x4*)(fg + col0 + bj * HALF + n * 16);
        float ssr[2][4];
#pragma unroll
        for (int ai = 0; ai < 2; ++ai)
#pragma unroll
            for (int m = 0; m < 4; ++m) ssr[ai][m] = __hip_atomic_load(hss + row0 + ai * HALF + m * 16, __ATOMIC_RELAXED, __HIP_MEMORY_SCOPE_AGENT);
#pragma unroll
        for (int ai = 0; ai < 2; ++ai)
#pragma unroll
            for (int m = 0; m < 4; ++m) {
                const int row = row0 + ai * HALF + m * 16;
                const size_t off = (size_t)row * DM + col0;
                const float rstd = __builtin_amdgcn_rsqf(ssr[ai][m] * (1.0f / DM) + EPS);
#pragma unroll
                for (int bj = 0; bj < 2; ++bj)
#pragma unroll
                    for (int n = 0; n < 2; ++n) *(f32x4*)(out + off + bj * HALF + n * 16) = acc[ai][bj][m][n] * rstd * gv[bj][n];
            }
    }
};
struct EpiSbIn {
    static constexpr bool PERM = true, AFTER_DRAIN = false;
    bf16_t* Q; size_t rstride; const float* hss;
    __device__ __forceinline__ void operator()(const f32x4 (&acc)[2][2][4][2], const Unit& u, int wr, int wc, int fr, int fq) const {
        const int region = u.pn >> 3, tl = u.pn & 7;
        bf16_t* base = Q + (size_t)region * rstride;
        const int row0 = u.pm * BM + wr * 64 + fr, col0 = tl * BM + wc * 32 + 8 * fq;
        float ssr[2][4];
#pragma unroll
        for (int ai = 0; ai < 2; ++ai)
#pragma unroll
            for (int m = 0; m < 4; ++m) ssr[ai][m] = hss[row0 + ai * HALF + m * 16];
#pragma unroll
        for (int ai = 0; ai < 2; ++ai)
#pragma unroll
            for (int m = 0; m < 4; ++m) {
                const int row = row0 + ai * HALF + m * 16;
                float sc = __builtin_amdgcn_rsqf(ssr[ai][m] * (1.0f / DM) + EPS);
                if (region == 0) sc *= QSCALE;
                bf16_t* rowp = base + (size_t)row * DM + col0;
#pragma unroll
                for (int bj = 0; bj < 2; ++bj) {
                    f32x4 v0 = acc[ai][bj][m][0] * sc, v1 = acc[ai][bj][m][1] * sc;
                    if (region == 3) {
#pragma unroll
                        for (int e = 0; e < 4; ++e) { v0[e] = silu_f(v0[e]); v1[e] = silu_f(v1[e]); }
                    }
                    u32x4 w; w.x = cvt_pk_bf16(v0[0], v0[1]); w.y = cvt_pk_bf16(v0[2], v0[3]); w.z = cvt_pk_bf16(v1[0], v1[1]); w.w = cvt_pk_bf16(v1[2], v1[3]);
                    *(u32x4*)(rowp + bj * HALF) = w;
                }
            }
    }
};
}

#define LAS __attribute__((address_space(3)))
typedef unsigned short bf16_t;
typedef short bf16x8 __attribute__((ext_vector_type(8)));
typedef short s16x4 __attribute__((ext_vector_type(4)));
typedef float f32x4 __attribute__((ext_vector_type(4)));
typedef float f32x16 __attribute__((ext_vector_type(16)));
typedef unsigned u32x4 __attribute__((ext_vector_type(4)));
typedef unsigned u32x2 __attribute__((ext_vector_type(2)));
__device__ __forceinline__ unsigned off_b(unsigned row, unsigned ch) { return 256u * row + 16u * (ch ^ (((row & 3u) << 2) | ((row >> 2) & 3u))); }
__device__ __forceinline__ s16x4 vtr(const LAS unsigned char* p) { return __builtin_bit_cast(s16x4, __builtin_amdgcn_ds_read_tr16_b64_v4i16((LAS s16x4*)p)); }
__device__ __forceinline__ unsigned pk_bf16(float lo, float hi) { return pg8::cvt_pk_bf16(lo, hi); }
__device__ __forceinline__ float bf_lo(unsigned w) { return __uint_as_float(w << 16); }
__device__ __forceinline__ float bf_hi(unsigned w) { return __uint_as_float(w & 0xffff0000u); }
__device__ __forceinline__ int crow(int r, int hi) { return (r & 3) + 8 * (r >> 2) + 4 * hi; }

#ifdef ATT_NOSB
#define ATT_SB() do {} while (0)
#else
#ifndef ATT_USE_SB
#define ATT_SB() do {} while (0)
#else
#define ATT_SB() __builtin_amdgcn_sched_barrier(0)
#endif
#endif
#define ATT_VLD(f) do { const int c_ = (f) >> 2, s_ = (f) & 3; const s16x4 lo_ = vtr(vbp + 4096 * s_ + vbase[0] + vcq[c_]); const s16x4 hh_ = vtr(vbp + 4096 * s_ + vbase[1] + vcq[c_]); \
        vf[f] = (bf16x8){lo_[0], lo_[1], lo_[2], lo_[3], hh_[0], hh_[1], hh_[2], hh_[3]}; } while (0)
#define ATT_PV(f) do { if (DO_PV) { o[(f) >> 2] = __builtin_amdgcn_mfma_f32_32x32x16_bf16(pa[(f) & 3], vf[f], o[(f) >> 2], 0, 0, 0); if ((f) + 4 < 16) ATT_VLD((f) + 4); } } while (0)
#define ATT_EXP8(i) do { _Pragma("unroll") for (int r_ = 0; r_ < 8; ++r_) p[(i) >> 1][8 * ((i) & 1) + r_] = __builtin_amdgcn_exp2f(fminf(p[(i) >> 1][8 * ((i) & 1) + r_], 30.f)); } while (0)
#define ATT_LBLK(j) do { const int ph_ = 1 - ((j) >> 2), g_ = 3 - ((j) & 3); \
        const float w0_ = 1.0f + p[ph_][4 * g_], w1_ = 1.0f + p[ph_][4 * g_ + 1], w2_ = 1.0f + p[ph_][4 * g_ + 2], w3_ = 1.0f + p[ph_][4 * g_ + 3]; \
        L[j] = __builtin_amdgcn_logf((w0_ * w1_) * (w2_ * w3_)); } while (0)
#define ATT_XCH(j) do { const float own_ = L[j]; const auto rr_ = __builtin_amdgcn_permlane32_swap(__float_as_uint(own_), __float_as_uint(own_), false, false); \
        const float a0_ = __uint_as_float(rr_[0]), a1_ = __uint_as_float(rr_[1]); const float oth_ = (a0_ == own_) ? a1_ : a0_; \
        T[j] = run + (hi ? 0.f : oth_) + own_; run += a0_ + a1_; } while (0)
#define ATT_WGT(j) do { const int ph_ = 1 - ((j) >> 2), g_ = 3 - ((j) & 3); float cf_ = __builtin_amdgcn_exp2f(-T[j]); \
        _Pragma("unroll") for (int e_ = 0; e_ < 4; ++e_) { const float ev_ = p[ph_][4 * g_ + e_]; p[ph_][4 * g_ + e_] = ev_ * cf_; if (e_ < 3) cf_ *= (1.0f + ev_); } } while (0)

template <bool DO_PV>
__device__ __forceinline__ void attn_tile(const LAS unsigned char* kb, const LAS unsigned char* vbp, const bf16x8 (&qf)[8], f32x16 (&o)[4], bf16x8 (&pa)[4], float& carry,
                                          const unsigned (&koff)[8], const unsigned (&vbase)[2], const unsigned (&vcq)[4], int k0, int qw0, int qabs, int hi) {
    f32x16 p[2];
#pragma unroll
    for (int r = 0; r < 16; ++r) { p[0][r] = 0.f; p[1][r] = 0.f; }
    bf16x8 vf[16];
    if (DO_PV) { ATT_VLD(0); ATT_VLD(1); ATT_VLD(2); ATT_VLD(3); }
    {
        bf16x8 ka[8], kc[8];
#pragma unroll
        for (int d0 = 0; d0 < 8; ++d0) { ka[d0] = *(const LAS bf16x8*)(kb + koff[d0]); kc[d0] = *(const LAS bf16x8*)(kb + 8192 + koff[d0]); }
        ATT_SB();
#pragma unroll
        for (int d0 = 0; d0 < 8; ++d0) {
            p[0] = __builtin_amdgcn_mfma_f32_32x32x16_bf16(ka[d0], qf[d0], p[0], 0, 0, 0);
            p[1] = __builtin_amdgcn_mfma_f32_32x32x16_bf16(kc[d0], qf[d0], p[1], 0, 0, 0);
        }
    }
    ATT_SB();
    const bool need_mask = (k0 + 63 >= qw0);
    float L[8], T[8];
    ATT_PV(0); ATT_EXP8(0); ATT_SB();
    ATT_PV(1); ATT_EXP8(1); ATT_SB();
    ATT_PV(2); ATT_EXP8(2); ATT_SB();
    ATT_PV(3); ATT_EXP8(3); ATT_SB();
    if (need_mask) {
#pragma unroll
        for (int ph = 0; ph < 2; ++ph)
#pragma unroll
            for (int r = 0; r < 16; ++r) { const int key = k0 + 32 * ph + crow(r, hi); if (key >= qabs) p[ph][r] = 0.f; }
    }
    ATT_SB();
    ATT_PV(4); ATT_LBLK(0); ATT_LBLK(1); ATT_SB();
    ATT_PV(5); ATT_LBLK(2); ATT_LBLK(3); ATT_SB();
    ATT_PV(6); ATT_LBLK(4); ATT_LBLK(5); ATT_SB();
    ATT_PV(7); ATT_LBLK(6); ATT_LBLK(7); ATT_SB();
    float run = carry;
    ATT_PV(8); ATT_XCH(0); ATT_XCH(1); ATT_SB();
    ATT_PV(9); ATT_XCH(2); ATT_XCH(3); ATT_SB();
    ATT_PV(10); ATT_XCH(4); ATT_XCH(5); ATT_SB();
    ATT_PV(11); ATT_XCH(6); ATT_XCH(7); ATT_SB();
    carry = run;
    ATT_PV(12); ATT_WGT(0); ATT_WGT(1); ATT_SB();
    ATT_PV(13); ATT_WGT(2); ATT_WGT(3); ATT_SB();
    ATT_PV(14); ATT_WGT(4); ATT_WGT(5); ATT_SB();
    ATT_PV(15); ATT_WGT(6); ATT_WGT(7); ATT_SB();
#pragma unroll
    for (int s = 0; s < 4; ++s) { const int ph = s >> 1, rb = 8 * (s & 1);
        u32x4 w; w.x = pk_bf16(p[ph][rb], p[ph][rb + 1]); w.y = pk_bf16(p[ph][rb + 2], p[ph][rb + 3]); w.z = pk_bf16(p[ph][rb + 4], p[ph][rb + 5]); w.w = pk_bf16(p[ph][rb + 6], p[ph][rb + 7]);
        pa[s] = __builtin_bit_cast(bf16x8, w); }
}

__device__ __forceinline__ void attn_unit(LAS unsigned char* lds, const int wid, int b, int h, int qb, const bf16_t* __restrict__ Q, const bf16_t* __restrict__ K,
                                          const bf16_t* __restrict__ V, const bf16_t* __restrict__ ZS, bf16_t* __restrict__ OG) {
    const int tid = tid_of(wid), lane = tid & 63, r32 = lane & 31, hi = lane >> 5;
    const size_t tok0 = (size_t)b * SEQ;
    const int q0 = qb * 256, qw0 = q0 + 32 * wid, qabs = qw0 + r32;
    bf16x8 qf[8];
    { const bf16_t* qp = Q + (tok0 + qabs) * DM + h * HD + 8 * hi;
#pragma unroll
      for (int d0 = 0; d0 < 8; ++d0) qf[d0] = *(const bf16x8*)(qp + 16 * d0); }
    f32x16 o[4];
#pragma unroll
    for (int c = 0; c < 4; ++c)
#pragma unroll
        for (int r = 0; r < 16; ++r) o[c][r] = 0.f;
    bf16x8 pa[4];
#pragma unroll
    for (int s = 0; s < 4; ++s) pa[s] = (bf16x8){0, 0, 0, 0, 0, 0, 0, 0};
    float carry = 0.f;
    const int NT = (q0 + 256) / 64;
    const int srow = tid >> 4, sch = (tid & 15) ^ (((srow & 3) << 2) | ((srow >> 2) & 3));
    const bf16_t* kg = K + (tok0 + srow) * DM + h * HD + sch * 8;
    const bf16_t* vg = V + (tok0 + srow) * DM + h * HD + sch * 8;
    LAS unsigned char* ldsw = lds + wid * 1024;
#define ATT_STAGE(t_, koff_, voff_) do { const size_t go_ = (size_t)(t_) * 64 * DM; \
        __builtin_amdgcn_global_load_lds((const unsigned*)(kg + go_), (LAS unsigned*)(ldsw + (koff_)), 16, 0, 0); \
        __builtin_amdgcn_global_load_lds((const unsigned*)(kg + go_ + 32 * DM), (LAS unsigned*)(ldsw + (koff_) + 8192), 16, 0, 0); \
        __builtin_amdgcn_global_load_lds((const unsigned*)(vg + go_), (LAS unsigned*)(ldsw + (voff_)), 16, 0, 0); \
        __builtin_amdgcn_global_load_lds((const unsigned*)(vg + go_ + 32 * DM), (LAS unsigned*)(ldsw + (voff_) + 8192), 16, 0, 0); } while (0)
    ATT_STAGE(NT - 1, 0, 32768);
    asm volatile("s_waitcnt vmcnt(0)" ::: "memory");
    __syncthreads();
    unsigned koff[8];
#pragma unroll
    for (int d0 = 0; d0 < 8; ++d0) koff[d0] = off_b(r32, 2 * d0 + hi);
    const unsigned qa = (lane & 15) >> 2, blk = (lane >> 4) & 1, pp = lane & 3;
    unsigned vbase[2], vcq[4];
#pragma unroll
    for (int t = 0; t < 2; ++t) vbase[t] = 256u * (8 * t + 4 * hi + qa) + 16u * ((2 * blk + (pp >> 1)) ^ ((2 * t + hi) & 3)) + 8u * (pp & 1);
#pragma unroll
    for (int c = 0; c < 4; ++c) vcq[c] = 64u * ((unsigned)c ^ qa);
    int kcur = 0, vprev = 2, vcur = 0, vnext = 1;
    bool prev_valid = false;
    for (int t = NT - 1; t >= 0; --t) {
        if (t > 0) ATT_STAGE(t - 1, (kcur ^ 1) * 16384, 32768 + vnext * 16384);
        const LAS unsigned char* kb = lds + kcur * 16384;
        const LAS unsigned char* vbp = lds + 32768 + vprev * 16384;
        const int k0 = 64 * t;
        const bool valid = (k0 < qw0 + 31);
        if (valid) {
            if (prev_valid) attn_tile<true>(kb, vbp, qf, o, pa, carry, koff, vbase, vcq, k0, qw0, qabs, hi);
            else            attn_tile<false>(kb, vbp, qf, o, pa, carry, koff, vbase, vcq, k0, qw0, qabs, hi);
        }
        prev_valid = valid;
        asm volatile("s_waitcnt vmcnt(0)" ::: "memory");
        __syncthreads();
        kcur ^= 1; { const int tmp = vprev; vprev = vcur; vcur = vnext; vnext = tmp; }
    }
    { const LAS unsigned char* vbp = lds + 32768 + vprev * 16384;
#pragma unroll
      for (int c = 0; c < 4; ++c)
#pragma unroll
          for (int s = 0; s < 4; ++s) {
              const s16x4 lo = vtr(vbp + 4096 * s + vbase[0] + vcq[c]);
              const s16x4 hh = vtr(vbp + 4096 * s + vbase[1] + vcq[c]);
              const bf16x8 vfr = (bf16x8){lo[0], lo[1], lo[2], lo[3], hh[0], hh[1], hh[2], hh[3]};
              o[c] = __builtin_amdgcn_mfma_f32_32x32x16_bf16(pa[s], vfr, o[c], 0, 0, 0);
          } }
    {
        int lane_e = lane_id(); asm volatile("" : "+v"(lane_e));
        const int r32e = lane_e & 31, hie = lane_e >> 5, rowq = lane_e >> 4, c4 = (lane_e & 15) * 4;
        LAS float* stg = (LAS float*)(lds + 81920 + wid * 8192);
        const size_t gbase = (tok0 + qw0) * DM + h * HD + c4;
        u32x2 zv[2][8];
#pragma unroll
        for (int ps = 0; ps < 2; ++ps)
#pragma unroll
            for (int j = 0; j < 8; ++j) zv[ps][j] = *(const u32x2*)(ZS + gbase + (size_t)(4 * j + rowq) * DM + 64 * ps);
#pragma unroll
        for (int ps = 0; ps < 2; ++ps) {
#pragma unroll
            for (int r = 0; r < 16; ++r) {
                stg[crow(r, hie) * 64 + r32e] = o[2 * ps][r];
                stg[crow(r, hie) * 64 + 32 + r32e] = o[2 * ps + 1][r];
            }
            asm volatile("s_waitcnt lgkmcnt(0)" ::: "memory");
#pragma unroll
            for (int j = 0; j < 8; ++j) {
                const f32x4 ov = *(const LAS f32x4*)(stg + (4 * j + rowq) * 64 + c4);
                const u32x2 z = zv[ps][j];
                u32x2 w; w.x = pk_bf16(ov[0] * bf_lo(z.x), ov[1] * bf_hi(z.x)); w.y = pk_bf16(ov[2] * bf_lo(z.y), ov[3] * bf_hi(z.y));
                *(u32x2*)(OG + gbase + (size_t)(4 * j + rowq) * DM + 64 * ps) = w;
            }
            asm volatile("s_waitcnt lgkmcnt(0)" ::: "memory");
        }
    }
    __syncthreads();
}
__device__ __forceinline__ void attn_phase(LAS unsigned char* lds, const int wid_, int vcu, int G, const bf16_t* Q, const bf16_t* K, const bf16_t* V, const bf16_t* ZS, bf16_t* OG) {
#ifndef NO_ATTN_PRIO
    if (wid_ >= 4) __builtin_amdgcn_s_setprio(1);
#endif
    for (int p = vcu; p < 256; p += G) {
        const int bh = p >> 3, s = p & 7;
#ifdef ATT_ONE_INSTANCE
#pragma unroll 1
        for (int uu = 0; uu < 2; ++uu) attn_unit(lds, wid_, bh >> 4, bh & 15, uu ? 15 - s : s, Q, K, V, ZS, OG);
#else
        attn_unit(lds, wid_, bh >> 4, bh & 15, s, Q, K, V, ZS, OG);
        attn_unit(lds, wid_, bh >> 4, bh & 15, 15 - s, Q, K, V, ZS, OG);
#endif
    }
    __builtin_amdgcn_s_setprio(0);
}

__device__ __forceinline__ void mix_unit(LAS unsigned char* lds, const int wid, int n, int g, const bf16_t* __restrict__ UZ, const bf16_t* __restrict__ V, const float* __restrict__ vss,
                                         const float* __restrict__ w_s, const float* __restrict__ b_s, const float* __restrict__ vg, bf16_t* __restrict__ Y) {
    const int tid = tid_of(wid), lane = tid & 63, r32 = lane & 31, hi = lane >> 5;
    const size_t row0 = (size_t)n * CHUNK;
    LAS float* rstdL = (LAS float*)(lds + 98304);
    const int cc = tid & 31;
    u32x4 uu[8];
#pragma unroll
    for (int i = 0; i < 8; ++i) { const int t = (tid >> 5) + 16 * i; uu[i] = *(const u32x4*)(UZ + (row0 + t) * GW + g * GDIM + cc * 8); }
    {
        u32x4 vr[8];
#pragma unroll
        for (int i = 0; i < 8; ++i) { const int c = tid + 512 * i, s = c >> 5, cc = c & 31;
            vr[i] = *(const u32x4*)(V + (row0 + s) * GW + g * GDIM + cc * 8); }
        if (tid < 128) { const f32x4* vp = (const f32x4*)(vss + (row0 + tid) * 64); f32x4 s4 = vp[0];
#pragma unroll
            for (int i = 1; i < 16; ++i) s4 += vp[i];
            rstdL[tid] = __builtin_amdgcn_rsqf(((s4[0] + s4[1]) + (s4[2] + s4[3])) * (1.0f / GW) + EPS); }
#pragma unroll
        for (int i = 0; i < 8; ++i) { const int c = tid + 512 * i, s = c >> 5, cc = c & 31;
            *(LAS u32x4*)(lds + 32768 + (cc >> 4) * 32768 + off_b(s, cc & 15)) = vr[i]; }
    }
    __syncthreads();
#pragma unroll
    for (int i = 0; i < 4; ++i) { const int c = tid + 512 * i, t = c >> 4, ch = c & 15, s0 = ch * 8;
        const f32x4 w0 = *(const f32x4*)(w_s + ((size_t)g * CHUNK + t) * CHUNK + s0), w1 = *(const f32x4*)(w_s + ((size_t)g * CHUNK + t) * CHUNK + s0 + 4);
        float wv[8] = {w0[0], w0[1], w0[2], w0[3], w1[0], w1[1], w1[2], w1[3]};
#pragma unroll
        for (int j = 0; j < 8; ++j) wv[j] = (s0 + j <= t) ? wv[j] * rstdL[s0 + j] : 0.f;
        u32x4 w; w.x = pk_bf16(wv[0], wv[1]); w.y = pk_bf16(wv[2], wv[3]); w.z = pk_bf16(wv[4], wv[5]); w.w = pk_bf16(wv[6], wv[7]);
        *(LAS u32x4*)(lds + off_b(t, ch)) = w; }
    __syncthreads();
    f32x16 acc[4];
#pragma unroll
    for (int i = 0; i < 4; ++i)
#pragma unroll
        for (int r = 0; r < 16; ++r) acc[i][r] = 0.f;
    {
        const LAS unsigned char* vimg = lds + 32768 + (wid >> 2) * 32768;
        const unsigned cblk = wid & 3, qa = (lane & 15) >> 2, blk = (lane >> 4) & 1, pp = lane & 3;
#pragma unroll
        for (int ks = 0; ks < 8; ++ks) {
            const s16x4 lo = vtr(vimg + off_b(16 * ks + 8 * hi + qa, 4 * cblk + 2 * blk + (pp >> 1)) + 8 * (pp & 1));
            const s16x4 hh = vtr(vimg + off_b(16 * ks + 8 * hi + 4 + qa, 4 * cblk + 2 * blk + (pp >> 1)) + 8 * (pp & 1));
            const bf16x8 vf = (bf16x8){lo[0], lo[1], lo[2], lo[3], hh[0], hh[1], hh[2], hh[3]};
#pragma unroll
            for (int i = 0; i < 4; ++i) if (ks <= 2 * i + 1) {
                const bf16x8 af = *(const LAS bf16x8*)(lds + off_b(32 * i + r32, 2 * ks + hi));
                acc[i] = __builtin_amdgcn_mfma_f32_32x32x16_bf16(af, vf, acc[i], 0, 0, 0);
            }
        }
    }
    __syncthreads();
    {
        LAS float* mx = (LAS float*)lds;
        const int c = 128 * (wid >> 2) + 32 * (wid & 3) + r32;
#pragma unroll
        for (int i = 0; i < 4; ++i)
#pragma unroll
            for (int r = 0; r < 16; ++r) mx[(32 * i + crow(r, hi)) * 256 + c] = acc[i][r];
    }
    __syncthreads();
    {
        const f32x4 g0 = *(const f32x4*)(vg + g * GDIM + cc * 8), g1 = *(const f32x4*)(vg + g * GDIM + cc * 8 + 4);
        float bb[8];
#pragma unroll
        for (int i = 0; i < 8; ++i) bb[i] = b_s[g * CHUNK + (tid >> 5) + 16 * i];
#pragma unroll
        for (int i = 0; i < 8; ++i) { const int t = (tid >> 5) + 16 * i;
            const f32x4 m0 = *(const LAS f32x4*)(lds + (t * 256 + cc * 8) * 4), m1 = *(const LAS f32x4*)(lds + (t * 256 + cc * 8 + 4) * 4);
            float y[8];
            y[0] = bf_lo(uu[i].x) * (m0[0] * g0[0] + bb[i]); y[1] = bf_hi(uu[i].x) * (m0[1] * g0[1] + bb[i]);
            y[2] = bf_lo(uu[i].y) * (m0[2] * g0[2] + bb[i]); y[3] = bf_hi(uu[i].y) * (m0[3] * g0[3] + bb[i]);
            y[4] = bf_lo(uu[i].z) * (m1[0] * g1[0] + bb[i]); y[5] = bf_hi(uu[i].z) * (m1[1] * g1[1] + bb[i]);
            y[6] = bf_lo(uu[i].w) * (m1[2] * g1[2] + bb[i]); y[7] = bf_hi(uu[i].w) * (m1[3] * g1[3] + bb[i]);
            u32x4 w; w.x = pk_bf16(y[0], y[1]); w.y = pk_bf16(y[2], y[3]); w.z = pk_bf16(y[4], y[5]); w.w = pk_bf16(y[6], y[7]);
            *(u32x4*)(Y + (row0 + t) * GW + g * GDIM + cc * 8) = w; }
    }
    __syncthreads();
}

__device__ __forceinline__ float wave_sum(float v) {
#pragma unroll
    for (int o = 1; o < 64; o <<= 1) v += __shfl_xor(v, o);
    return v;
}
__device__ __forceinline__ void tr_load(const float* __restrict__ W, int N, int item, int lane, f32x4 (&wv)[16]) {
    const int nblk = N / 64, k0 = 64 * (item / nblk), n0 = 64 * (item % nblk);
#pragma unroll
    for (int i = 0; i < 16; ++i) wv[i] = __builtin_nontemporal_load((const f32x4*)(W + (size_t)(k0 + 4 * i + (lane >> 4)) * N + n0 + 4 * (lane & 15)));
}
__device__ __forceinline__ void tr_to_lds(LAS float* scr, int lane, const f32x4 (&wv)[16]) {
#pragma unroll
    for (int i = 0; i < 16; ++i) { const int kk = 4 * i + (lane >> 4), nn = 4 * (lane & 15);
        LAS float* s = scr + kk * 65 + nn; s[0] = wv[i][0]; s[1] = wv[i][1]; s[2] = wv[i][2]; s[3] = wv[i][3]; }
    asm volatile("s_waitcnt lgkmcnt(0)" ::: "memory");
}
__device__ __forceinline__ void tr_store(int K, int N, bf16_t* __restrict__ WT, const LAS float* scr, int item, int lane, const float* __restrict__ gk, bool gmlp_perm) {
    const int nblk = N / 64, k0 = 64 * (item / nblk), n0 = 64 * (item % nblk);
    int r0 = n0;
    if (gmlp_perm) {
        if (n0 < GW) { const int cb = n0 >> 7; r0 = 256 * (3 * (cb >> 1) + (cb & 1)) + (n0 & 127); }
        else if (n0 < 2 * GW) { const int mv = n0 - GW; r0 = 256 * (3 * (mv >> 8) + 2) + (mv & 255); }
        else { const int mz = n0 - 2 * GW, cb = mz >> 7; r0 = 256 * (3 * (cb >> 1) + (cb & 1)) + 128 + (mz & 127); }
    }
    const int c = lane & 7;
    f32x4 ga = {1.f, 1.f, 1.f, 1.f}, gb = {1.f, 1.f, 1.f, 1.f};
    if (gk) { ga = *(const f32x4*)(gk + k0 + 8 * c); gb = *(const f32x4*)(gk + k0 + 8 * c + 4); }
#pragma unroll
    for (int j = 0; j < 8; ++j) { const int nn = (lane >> 3) + 8 * j; const LAS float* s = scr + (8 * c) * 65 + nn;
        u32x4 o; o.x = pk_bf16(s[0] * ga[0], s[65] * ga[1]); o.y = pk_bf16(s[2 * 65] * ga[2], s[3 * 65] * ga[3]); o.z = pk_bf16(s[4 * 65] * gb[0], s[5 * 65] * gb[1]); o.w = pk_bf16(s[6 * 65] * gb[2], s[7 * 65] * gb[3]);
        *(u32x4*)(WT + (size_t)(r0 + nn) * K + k0 + 8 * c) = o; }
    asm volatile("s_waitcnt lgkmcnt(0)" ::: "memory");
}
__device__ __forceinline__ void transpose_matrix(const float* __restrict__ W, int K, int N, bf16_t* __restrict__ WT, LAS float* scr, int first, int stride, int nitems, int lane,
                                                 const float* __restrict__ gk = nullptr, bool gmlp_perm = false) {
    f32x4 wv[16], wn[16];
    int it = first;
    if (it < nitems) tr_load(W, N, it, lane, wv);
    while (it < nitems) {
        const int nx = it + stride;
        tr_to_lds(scr, lane, wv);
        if (nx < nitems) tr_load(W, N, nx, lane, wn);
        tr_store(K, N, WT, scr, it, lane, gk, gmlp_perm);
#pragma unroll
        for (int i = 0; i < 16; ++i) wv[i] = wn[i];
        it = nx;
    }
}

#define XB_TMO      128
#define XB_XCNT(j)  (256  + 64 * (j))
#define XB_XSUB(j)  (1280 + 64 * (j))
#define XB_XGEN(j)  (2304 + 64 * (j))
#define XB_TOP      3328
#define XB_TOPGEN   3392
#define XCD_BAR_WORDS 3456
#define XB_SPIN_CAP (1u << 18)

__device__ __forceinline__ unsigned xb_ld(unsigned* p)              { return __hip_atomic_load(p, __ATOMIC_RELAXED, __HIP_MEMORY_SCOPE_AGENT); }
__device__ __forceinline__ unsigned xb_add(unsigned* p, unsigned v) { return __hip_atomic_fetch_add(p, v, __ATOMIC_RELAXED, __HIP_MEMORY_SCOPE_AGENT); }
__device__ __forceinline__ unsigned xb_xcc_id() { return (unsigned)__builtin_amdgcn_s_getreg((3 << 11) | 20) & 0xFu; }
#define XB_SPIN(cond, bar) do { unsigned _sp = 0; while (cond) { __builtin_amdgcn_s_sleep(1); \
    if ((++_sp & 255u) == 0u) { if (xb_ld(&(bar)[XB_TMO])) break; if (_sp > XB_SPIN_CAP) { atomicAdd(&(bar)[XB_TMO], 1u); break; } } } } while (0)

struct XcdBarrier {
    unsigned* bar; unsigned x; int w;
    volatile LAS unsigned* st;
};

__device__ __forceinline__ XcdBarrier xcd_barrier_post(unsigned* bar, volatile LAS unsigned* st, int wave) {
    XcdBarrier b; b.bar = bar; b.x = xb_xcc_id(); b.st = st; b.w = wave;
    if (tid_of(wave) == 0) (void)xb_add(&bar[XB_XCNT(b.x)], 1u);
    return b;
}
__device__ __forceinline__ void xcd_barrier_complete(unsigned* bar, unsigned x, unsigned& nloc, unsigned& nx) {
    const unsigned G = gridDim.x * gridDim.y * gridDim.z;
    unsigned sum, cnt, mine, sp = 0u;
    for (;;) {
        sum = 0u; cnt = 0u; mine = 0u;
#pragma unroll
        for (unsigned j = 0; j < 16; ++j) { const unsigned c = xb_ld(&bar[XB_XCNT(j)]); sum += c; cnt += (c > 0u) ? 1u : 0u; mine = (j == x) ? c : mine; }
        if (sum == G) break;
        __builtin_amdgcn_s_sleep(1);
        if ((++sp & 255u) == 0u) { if (xb_ld(&bar[XB_TMO])) break; if (sp > XB_SPIN_CAP) { atomicAdd(&bar[XB_TMO], 1u); break; } }
    }
    nloc = mine > 0u ? mine : 1u; nx = cnt > 0u ? cnt : 1u;
}

__device__ __forceinline__ void xcd_barrier(const XcdBarrier& b) {
    asm volatile("s_waitcnt vmcnt(0)" ::: "memory");
    __syncthreads();
    if (tid_of(b.w) == 0) {
        unsigned* bar = b.bar;
        __builtin_amdgcn_s_waitcnt(0);
        unsigned nloc = b.st[0], nx = b.st[1];
        if (nloc == 0u) { xcd_barrier_complete(bar, b.x, nloc, nx); b.st[0] = nloc; b.st[1] = nx; }
        const unsigned old = xb_add(&bar[XB_XSUB(b.x)], 1u);
        const unsigned gen = old / nloc;
        if (old + 1u == (gen + 1u) * nloc) {
            __builtin_amdgcn_fence(__ATOMIC_RELEASE, "agent");
            asm volatile("s_waitcnt vmcnt(0)" ::: "memory");
            const unsigned og = xb_add(&bar[XB_TOP], 1u);
            const unsigned tg = og / nx;
            if (og + 1u == (tg + 1u) * nx) xb_add(&bar[XB_TOPGEN], 1u);
            else XB_SPIN(xb_ld(&bar[XB_TOPGEN]) == tg, bar);
            __builtin_amdgcn_fence(__ATOMIC_ACQUIRE, "agent");
            xb_add(&bar[XB_XGEN(b.x)], 1u);
            asm volatile("s_waitcnt vmcnt(0)" ::: "memory");
        } else {
            XB_SPIN(xb_ld(&bar[XB_XGEN(b.x)]) == gen, bar);
            __builtin_amdgcn_fence(__ATOMIC_ACQUIRE, "agent");
            asm volatile("s_waitcnt vmcnt(0)" ::: "memory");
        }
    }
    __syncthreads();
}

constexpr size_t MiB = 1u << 20;
constexpr size_t WS_VSS = 0, WS_HSS1 = 2 * MiB, WS_HSS2 = 3 * MiB, WS_IRS0 = 3 * MiB + 32768, WS_CNT = 3 * MiB + 65536;
constexpr size_t WS_WT1 = 4 * MiB, WS_HN0 = 268 * MiB  , WS_WT2 = 84 * MiB, WS_WT3 = 100 * MiB, WS_WT4 = 132 * MiB;
constexpr size_t WS_U = 140 * MiB, WS_V = 204 * MiB, WS_ZS = 268 * MiB, WS_CTL = 364 * MiB, CTL_ZERO_BYTES = 32768, WS_END = 365 * MiB;
constexpr size_t WS_Y = 4 * MiB;
constexpr size_t WS_H1 = 140 * MiB, WS_H1B = 332 * MiB;
constexpr size_t WS_Q = 204 * MiB, WS_K = 236 * MiB, WS_V2 = 268 * MiB, WS_ZS2 = 300 * MiB, WS_OG = 4 * MiB;

constexpr int NWAVES = 8, LDS_BYTES = 151552;
#ifndef N_LAUNCHES
#define N_LAUNCHES 1
#endif
constexpr int N_PHASES = 7;
#ifndef CONV_TRIGGER
#define CONV_TRIGGER ((bx >> 3) % 6)
#endif
#ifndef GEMM_SP2
#define GEMM_SP2 true
#endif
#ifndef GEMM_ALIGN
#define GEMM_ALIGN true
#endif
#ifndef REPEAT_PHASE
#define REPEAT_PHASE -1
#endif
#define NREP(k) ((REPEAT_PHASE == (k)) ? 2 : 1)

struct Args { const float* in[10]; float* out; unsigned char* ws; int ph_lo, ph_hi, li, pad; };

__global__ void __launch_bounds__(NWAVES * 64, 2) fwd_kernel(Args a) {
    extern __shared__ __attribute__((aligned(16))) unsigned char lds_raw[];
    LAS unsigned char* lds = (LAS unsigned char*)lds_raw;
    cg::grid_group grid = cg::this_grid();
    const int wave = __builtin_amdgcn_readfirstlane(threadIdx.x >> 6);
#define tid tid_of(wave)
#define lane lane_id()
    const int G = gridDim.x, bx = blockIdx.x;
    const int vcu = (G % 8 == 0) ? (bx % 8) * (G / 8) + bx / 8 : bx;
    const float* x = a.in[0]; const float* norm_g = a.in[1]; const float* a_w_in = a.in[2]; const float* a_vg = a.in[3]; const float* a_w_s = a.in[4];
    const float* a_b_s = a.in[5]; const float* a_w_out = a.in[6]; const float* b_w_in = a.in[7]; const float* b_w_out = a.in[8]; const float* final_g = a.in[9];
    unsigned char* ws = a.ws;
    float* VSS = (float*)(ws + WS_VSS); float* HSS1 = (float*)(ws + WS_HSS1); float* HSS2 = (float*)(ws + WS_HSS2); float* IRS0 = (float*)(ws + WS_IRS0); unsigned* CNT = (unsigned*)(ws + WS_CNT);
    bf16_t* WT1 = (bf16_t*)(ws + WS_WT1); bf16_t* WT2 = (bf16_t*)(ws + WS_WT2); bf16_t* WT3 = (bf16_t*)(ws + WS_WT3); bf16_t* WT4 = (bf16_t*)(ws + WS_WT4);
    bf16_t* HN0 = (bf16_t*)(ws + WS_HN0); bf16_t* U = (bf16_t*)(ws + WS_U); bf16_t* V = (bf16_t*)(ws + WS_V); bf16_t* ZS = (bf16_t*)(ws + WS_ZS);
    bf16_t* Y = (bf16_t*)(ws + WS_Y); bf16_t* H1B = (bf16_t*)(ws + WS_H1B);
    bf16_t* Qb = (bf16_t*)(ws + WS_Q); bf16_t* Kb = (bf16_t*)(ws + WS_K); bf16_t* V2 = (bf16_t*)(ws + WS_V2); bf16_t* ZS2 = (bf16_t*)(ws + WS_ZS2); bf16_t* OG = (bf16_t*)(ws + WS_OG);
    const int lo = a.ph_lo, hi = a.ph_hi;
#define IN(k) (lo <= (k) && (k) < hi)
#define SEAM(k) do { if (IN(k) && IN((k) + 1)) xcd_barrier(bar); } while (0)
    volatile LAS unsigned* MISC = (volatile LAS unsigned*)(lds + LDS_BYTES - 64);
    if (tid < 16) MISC[tid] = 0u;
    __syncthreads();
    XcdBarrier bar = xcd_barrier_post((unsigned*)(ws + WS_CTL) + a.li * XCD_BAR_WORDS, MISC + 8, wave);
    if (lo > 1000) grid.sync();
    const int gw = vcu * NWAVES + wave, NGW = G * NWAVES;

    if (IN(0)) for (int rep = 0; rep < NREP(0); ++rep) {
        LAS float* scr = (LAS float*)(lds + wave * 16640);
        constexpr int I1 = (DM / 64) * (3 * GW / 64), I2 = (GW / 64) * (DM / 64), I3 = (DM / 64) * (4 * DM / 64), I4 = (DM / 64) * (DM / 64);
        transpose_matrix(a_w_in, DM, 3 * GW, WT1, scr, gw, NGW, I1, lane, nullptr, true);
        for (int m = bx * (NWAVES * 64) + tid; m < NTOK; m += G * NWAVES * 64) { HSS1[m] = 0.f; HSS2[m] = 0.f; if (m < 2048) CNT[m] = 0u; }
        for (int m = gw; m < NTOK; m += NGW) {
            const f32x4* xr = (const f32x4*)(x + (size_t)m * DM) + lane; const f32x4* gr = (const f32x4*)norm_g + lane;
            f32x4 v[8]; float ss = 0.f;
#pragma unroll
            for (int j = 0; j < 8; ++j) { v[j] = __builtin_nontemporal_load(xr + 64 * j); ss += (v[j][0] * v[j][0] + v[j][1] * v[j][1]) + (v[j][2] * v[j][2] + v[j][3] * v[j][3]); }
            const float ms = wave_sum(ss) * (1.0f / DM) + EPS;
            const float rstd = __builtin_amdgcn_rsqf(ms);
            if (lane == 0) IRS0[m] = __builtin_amdgcn_sqrtf(ms);
            u32x2* o8 = (u32x2*)(HN0 + (size_t)m * DM) + lane;
#pragma unroll
            for (int j = 0; j < 8; ++j) { const f32x4 gg = gr[64 * j]; u32x2 w; w.x = pk_bf16(v[j][0] * rstd * gg[0], v[j][1] * rstd * gg[1]); w.y = pk_bf16(v[j][2] * rstd * gg[2], v[j][3] * rstd * gg[3]); o8[64 * j] = w; }
        }
    }
    SEAM(0);
#ifdef EXTRA_SYNCS
    for (int i = 0; i < EXTRA_SYNCS; ++i) xcd_barrier(bar);
#endif
    if (IN(1)) for (int rep = 0; rep < NREP(1); ++rep) {
        pg8::Gemm g{HN0, WT1, NTOK, 3 * GW, DM}; pg8::ConvOrder S; S.init(NTOK, 3 * GW, G, bx);
        S.w2 = a_w_out; S.w3 = b_w_in; S.w4 = b_w_out; S.g1 = norm_g + DM; S.t2 = WT2; S.t3 = WT3; S.t4 = WT4; S.gw = gw; S.ngw = NGW; S.trigger = (G == 256) ? CONV_TRIGGER : 0; S.ln = lane; S.sw = lds + 131072 + wave * 2048; S.n_done = 0;
        pg8::EpiGmlpIn E{U, V, VSS};
        pg8::gemm_phase<pg8::EpiGmlpIn, pg8::ConvOrder, GEMM_ALIGN, GEMM_SP2>(lds, g, S, E, wave);
    }
    SEAM(1);
    if (IN(2)) for (int rep = 0; rep < NREP(2); ++rep) {
        for (int it = vcu; it < (NTOK / CHUNK) * NGRP; it += G) mix_unit(lds, wave, it >> 4, it & 15, U, V, VSS, a_w_s, a_b_s, a_vg, Y);
    }
    SEAM(2);
    if (IN(3)) for (int rep = 0; rep < NREP(3); ++rep) {
        pg8::Gemm g{Y, WT2, NTOK, DM, GW}; pg8::StaticOrder S; S.init(NTOK, DM, G, bx);
        pg8::EpiRes1 E{HN0, IRS0, norm_g, H1B, HSS1};
        pg8::gemm_phase<pg8::EpiRes1, pg8::StaticOrder, GEMM_ALIGN, GEMM_SP2>(lds, g, S, E, wave);
    }
    SEAM(3);
    if (IN(4)) for (int rep = 0; rep < NREP(4); ++rep) {
        pg8::Gemm g{H1B, WT3, NTOK, 4 * DM, DM}; pg8::StaticOrder S; S.init(NTOK, 4 * DM, G, bx);
        pg8::EpiSbIn E{Qb, (size_t)(WS_K - WS_Q) / 2, HSS1};
        pg8::gemm_phase<pg8::EpiSbIn, pg8::StaticOrder, GEMM_ALIGN, GEMM_SP2>(lds, g, S, E, wave);
    }
    SEAM(4);
    if (IN(5)) for (int rep = 0; rep < NREP(5); ++rep) attn_phase(lds, wave, vcu, G, Qb, Kb, V2, ZS2, OG);
    SEAM(5);
    if (IN(6)) for (int rep = 0; rep < NREP(6); ++rep) {
        pg8::Gemm g{OG, WT4, NTOK, DM, DM}; pg8::StaticOrder S; S.init(NTOK, DM, G, bx);
        pg8::EpiFinal E{H1B, final_g, a.out, HSS2, CNT, G == 256};
        pg8::gemm_phase<pg8::EpiFinal, pg8::StaticOrder, GEMM_ALIGN, GEMM_SP2>(lds, g, S, E, wave);
    }
    if (IN(6) && G != 256) {
        xcd_barrier(bar);
        for (int m = gw; m < NTOK; m += NGW) {
            const float rstd = __builtin_amdgcn_rsqf(HSS2[m] * (1.0f / DM) + EPS);
            f32x4* orow = (f32x4*)(a.out + (size_t)m * DM) + lane; const f32x4* gr = (const f32x4*)final_g + lane;
#pragma unroll
            for (int j = 0; j < 8; ++j) { const f32x4 v = orow[64 * j]; orow[64 * j] = v * rstd * gr[64 * j]; }
        }
    }
#undef IN
#undef SEAM
#undef tid
#undef lane
}

extern "C" void kernel_launch(void* const* d_in, const int* in_sizes, int n_in, void* d_out, int out_size, void* d_ws, size_t ws_size, hipStream_t stream) {
    static int grid = 0;
    if (grid == 0) {
        if (n_in != 10 || out_size != NTOK * DM || ws_size < WS_END) { fprintf(stderr, "kernel_launch: unexpected shapes (n_in %d, out %d, ws %zu)\n", n_in, out_size, ws_size); grid = -1; return; }
        int dev = 0, cus = 0, per_cu = 0;
        (void)hipGetDevice(&dev); (void)hipDeviceGetAttribute(&cus, hipDeviceAttributeMultiprocessorCount, dev);
        if (hipFuncSetAttribute((const void*)fwd_kernel, hipFuncAttributeMaxDynamicSharedMemorySize, LDS_BYTES) != hipSuccess) { fprintf(stderr, "kernel_launch: hipFuncSetAttribute failed\n"); grid = -1; return; }
        if (hipOccupancyMaxActiveBlocksPerMultiprocessor(&per_cu, (const void*)fwd_kernel, NWAVES * 64, LDS_BYTES) != hipSuccess || per_cu < 1) { fprintf(stderr, "kernel_launch: occupancy query says %d\n", per_cu); per_cu = 1; }
        (void)hipGetLastError();
        grid = cus > 0 ? cus : 256;
    }
    if (grid < 0) return;
    if (hipMemsetAsync((char*)d_ws + WS_CTL, 0, CTL_ZERO_BYTES, stream) != hipSuccess) { fprintf(stderr, "kernel_launch: memset failed\n"); return; }
    Args a{};
    for (int i = 0; i < 10; ++i) a.in[i] = (const float*)d_in[i];
    a.out = (float*)d_out; a.ws = (unsigned char*)d_ws;
#ifdef PROBE_SPLIT
    const int nl = 2;
#else
    const int nl = N_LAUNCHES;
#endif
    for (int li = 0; li < nl; ++li) {
        a.ph_lo = (N_LAUNCHES == 1) ? 0 : li; a.ph_hi = (N_LAUNCHES == 1) ? N_PHASES : li + 1;
#ifdef PROBE_SPLIT
        a.ph_lo = li == 0 ? 0 : PROBE_SPLIT; a.ph_hi = li == 0 ? PROBE_SPLIT + 1 : N_PHASES;
#endif
        a.li = li;
        void* args[] = {&a};
        hipError_t e = hipLaunchCooperativeKernel((const void*)fwd_kernel, dim3(grid), dim3(NWAVES * 64), args, LDS_BYTES, stream);
        if (e != hipSuccess) { fprintf(stderr, "kernel_launch: cooperative launch %d failed: %s (grid %d)\n", li, hipGetErrorString(e), grid); break; }
    }
}
```

```cpp
#include <hip/hip_runtime.h>
#include <hip/hip_cooperative_groups.h>
#include <cstdio>
#include <cstdint>
namespace cg = cooperative_groups;
__device__ __forceinline__ int lane_id() { return (int)__builtin_amdgcn_mbcnt_hi(~0u, __builtin_amdgcn_mbcnt_lo(~0u, 0u)); }
__device__ __forceinline__ int tid_of(int wave) { return wave * 64 + lane_id(); }
#ifndef PG8_WGM
#define PG8_WGM 8
#endif
namespace pg8 {
#define PG8_LAS __attribute__((address_space(3)))
typedef unsigned short bf16_t;
typedef short bf16x8 __attribute__((ext_vector_type(8)));
typedef float f32x4 __attribute__((ext_vector_type(4)));
typedef unsigned u32x4 __attribute__((ext_vector_type(4)));
constexpr int BM = 256, BK = 64, HALF = 128, HTB = HALF * BK * 2  , STAGE_BYTES = 8 * HTB, NXCD = 8, WGM = PG8_WGM;

__host__ __device__ __forceinline__ int lds_byte(int r, int c) { const int st = (r >> 4) * 2 + (c >> 5), rr = r & 15, cc = c & 31, ob = rr * 64 + cc * 2; return st * 1024 + (ob ^ (((ob >> 9) & 1) << 5)); }
__host__ __device__ __forceinline__ void stage_rc(int b, int& R, int& C) { const int st = b / 1024, sb = b % 1024, swz = sb ^ (((sb >> 9) & 1) << 5); R = (st >> 1) * 16 + swz / 64; C = (st & 1) * 32 + (swz % 64) / 2; }
__host__ __device__ __forceinline__ int perm32(int rho) { const int n = rho >> 4, i = rho & 15; return 8 * (i >> 2) + 4 * n + (i & 3); }

struct Unit { int pm, pn; };
struct Gemm { const bf16_t* A; const bf16_t* Bt; int M, N, K; };

struct StaticOrder {
    int nM, nN, nwg, G, c;
    __host__ __device__ void init(int M, int N, int G_, int c_) { nM = M / BM; nN = N / BM; nwg = nM * nN; G = G_; c = c_; }
    __host__ __device__ bool next(int i, Unit& u) const {
        const long L = (long)i * G + c; if (L >= nwg) return false;
        int wgid = (int)L; { const int q = nwg / NXCD, r = nwg % NXCD, xcd = wgid % NXCD, off = wgid / NXCD; wgid = (xcd < r ? xcd * (q + 1) : r * (q + 1) + (xcd - r) * q) + off; }
        const int nig = WGM * nN, gid = wgid / nig, fm = gid * WGM, gsz = (nM - fm) < WGM ? (nM - fm) : WGM;
        u.pm = fm + ((wgid % nig) % gsz); u.pn = (wgid % nig) / gsz; return true;
    }
    __device__ __forceinline__ void a_ready(const Unit&) const {}
    __device__ __forceinline__ void done(const Unit&) const {}
};

__device__ __forceinline__ unsigned cvt_pk_bf16(float lo, float hi) { unsigned r; asm volatile("v_cvt_pk_bf16_f32 %0, %1, %2" : "=v"(r) : "v"(lo), "v"(hi)); return r; }
typedef float f32x2 __attribute__((ext_vector_type(2)));
typedef float f32x2 __attribute__((ext_vector_type(2)));
template <class Epi, class Sched, bool ALIGN_EPI = false, bool SP2 = false>
__device__ __forceinline__ void gemm_phase(PG8_LAS unsigned char* lds, const Gemm g, const Sched& S, const Epi& E, const int wave_) {
    const int tid = tid_of(wave_), wid = wave_, lane = tid & 63, wr = wid >> 2, wc = wid & 3, fr = lane & 15, fq = lane >> 4;
    const int K = g.K, nt = K / BK;
    unsigned voffA[2], voffB[2];
#pragma unroll
    for (int i = 0; i < 2; ++i) { int R, C; stage_rc(tid * 16 + i * 8192, R, C); const int Rb = Epi::PERM ? ((R & ~31) + perm32(R & 31)) : R;
        voffA[i] = (unsigned)(R * K + C) * 2u; voffB[i] = (unsigned)(Rb * K + C) * 2u; }
    const size_t kstep = (size_t)(BK * 2);
    const size_t hstep = (size_t)HALF * K * 2;
    const size_t tstep = 2 * hstep;
    const unsigned ldsw = (unsigned)wid * 1024u;
    const int aoff = lds_byte(wr * 64 + fr, fq * 8), boff = lds_byte(wc * 32 + fr, fq * 8);
#define PG8_SA(b, h) (((b) * 2 + (h)) * HTB)
#define PG8_SB(b, h) ((4 + (b) * 2 + (h)) * HTB)
#define PG8_STAGE(bufoff, gbase, voff) do { _Pragma("unroll") for (int _i = 0; _i < 2; ++_i) \
        __builtin_amdgcn_global_load_lds((const unsigned*)((const char*)(gbase) + (voff)[_i]), (PG8_LAS unsigned*)(lds + (bufoff) + ldsw + _i * 8192), 16, 0, 0); } while (0)
#define PG8_LDA(dst, b, h) do { _Pragma("unroll") for (int m = 0; m < 4; ++m) _Pragma("unroll") for (int k = 0; k < 2; ++k) dst[m][k] = *(const PG8_LAS bf16x8*)(lds + PG8_SA(b, h) + aoff + m * 2048 + k * 1024); } while (0)
#define PG8_LDB(dst, b, h) do { _Pragma("unroll") for (int n = 0; n < 2; ++n) _Pragma("unroll") for (int k = 0; k < 2; ++k) dst[n][k] = *(const PG8_LAS bf16x8*)(lds + PG8_SB(b, h) + boff + n * 2048 + k * 1024); } while (0)
#define PG8_MMA(ai, bj, At, Bt) do { __builtin_amdgcn_s_setprio(1); _Pragma("unroll") for (int m = 0; m < 4; ++m) _Pragma("unroll") for (int n = 0; n < 2; ++n) _Pragma("unroll") for (int k = 0; k < 2; ++k) \
        acc[ai][bj][m][n] = __builtin_amdgcn_mfma_f32_16x16x32_bf16(Bt[n][k], At[m][k], acc[ai][bj][m][n], 0, 0, 0); __builtin_amdgcn_s_setprio(0); } while (0)
#define PG8_WAIT_V(n) asm volatile("s_waitcnt vmcnt(" #n ")" ::: "memory")
#define PG8_WAIT_L(n) asm volatile("s_waitcnt lgkmcnt(" #n ")" ::: "memory")
#define PG8_BAR __builtin_amdgcn_s_barrier()
#define PG8_SCHED __builtin_amdgcn_sched_barrier(0)
    Unit cur, nxt; int ui = 0;
    if (!S.next(0, cur)) return;
    f32x4 acc[2][2][4][2];
#pragma unroll
    for (int a = 0; a < 2; ++a)
#pragma unroll
        for (int b = 0; b < 2; ++b)
#pragma unroll
            for (int m = 0; m < 4; ++m)
#pragma unroll
                for (int n = 0; n < 2; ++n) acc[a][b][m][n] = (f32x4){0.f, 0.f, 0.f, 0.f};
    bf16x8 At[4][2], B0[2][2], B1[2][2];
    const char* cA = (const char*)g.A + (size_t)cur.pm * tstep; const char* cB = (const char*)g.Bt + (size_t)cur.pn * tstep;
    S.a_ready(cur);
    if constexpr (SP2) {
        PG8_STAGE(PG8_SB(0, 0), cB, voffB); PG8_STAGE(PG8_SB(0, 1), cB + hstep, voffB); PG8_STAGE(PG8_SA(0, 0), cA, voffA); PG8_STAGE(PG8_SA(0, 1), cA + hstep, voffA);
        if (wr == 1) PG8_BAR;
        PG8_WAIT_V(2); PG8_BAR;
        PG8_STAGE(PG8_SB(1, 0), cB + kstep, voffB); PG8_STAGE(PG8_SA(1, 0), cA + kstep, voffA); PG8_STAGE(PG8_SB(1, 1), cB + hstep + kstep, voffB);
        PG8_WAIT_V(6); PG8_BAR;
    } else {
        PG8_STAGE(PG8_SB(0, 0), cB, voffB); PG8_STAGE(PG8_SA(0, 0), cA, voffA); PG8_STAGE(PG8_SB(0, 1), cB + hstep, voffB); PG8_STAGE(PG8_SA(0, 1), cA + hstep, voffA);
        if (wr == 1) PG8_BAR;
        PG8_WAIT_V(4); PG8_BAR;
        PG8_STAGE(PG8_SB(1, 0), cB + kstep, voffB); PG8_STAGE(PG8_SA(1, 0), cA + kstep, voffA); PG8_STAGE(PG8_SB(1, 1), cB + hstep + kstep, voffB);
        PG8_WAIT_V(6); PG8_BAR;
    }
    for (;;) {
        const bool has_next = S.next(ui + 1, nxt);
        const char* nA = has_next ? (const char*)g.A + (size_t)nxt.pm * tstep : cA; const char* nB = has_next ? (const char*)g.Bt + (size_t)nxt.pn * tstep : cB;
        for (int t = 0; t < nt; t += 2) {
            const bool last = (t == nt - 2);
            const char* a1 = cA + (size_t)(t + 1) * kstep;
            const char* a2 = last ? nA : cA + (size_t)(t + 2) * kstep; const char* b2 = last ? nB : cB + (size_t)(t + 2) * kstep;
            const char* a3 = a2 + kstep; const char* b3 = b2 + kstep;
            if (last && has_next) S.a_ready(nxt);
            if constexpr (SP2) {
            PG8_LDB(B0, 0, 0); PG8_LDB(B1, 0, 1); PG8_SCHED; PG8_LDA(At, 0, 0); PG8_STAGE(PG8_SA(1, 1), a1 + hstep, voffA);
            PG8_WAIT_V(8); PG8_WAIT_L(0); PG8_BAR; PG8_MMA(0, 0, At, B0); PG8_MMA(0, 1, At, B1); PG8_BAR; PG8_SCHED;
            PG8_LDA(At, 0, 1); PG8_STAGE(PG8_SB(0, 0), b2, voffB); PG8_STAGE(PG8_SB(0, 1), b2 + hstep, voffB); PG8_STAGE(PG8_SA(0, 0), a2, voffA);
            PG8_WAIT_V(8); PG8_WAIT_L(0); PG8_BAR; PG8_MMA(1, 0, At, B0); PG8_MMA(1, 1, At, B1); PG8_BAR; PG8_SCHED;
            PG8_LDB(B0, 1, 0); PG8_LDB(B1, 1, 1); PG8_SCHED; PG8_LDA(At, 1, 0); PG8_STAGE(PG8_SA(0, 1), a2 + hstep, voffA);
            PG8_WAIT_V(8); PG8_WAIT_L(0); PG8_BAR; PG8_MMA(0, 0, At, B0); PG8_MMA(0, 1, At, B1); PG8_BAR; PG8_SCHED;
            PG8_LDA(At, 1, 1); PG8_STAGE(PG8_SB(1, 0), b3, voffB); PG8_STAGE(PG8_SB(1, 1), b3 + hstep, voffB); PG8_STAGE(PG8_SA(1, 0), a3, voffA);
            PG8_WAIT_V(8); PG8_WAIT_L(0); PG8_BAR; PG8_MMA(1, 0, At, B0); PG8_MMA(1, 1, At, B1); PG8_BAR; PG8_SCHED;
            } else {
            PG8_LDB(B0, 0, 0); PG8_SCHED; PG8_LDA(At, 0, 0); PG8_STAGE(PG8_SA(1, 1), a1 + hstep, voffA);
            PG8_WAIT_L(8); PG8_BAR; PG8_WAIT_L(0); PG8_MMA(0, 0, At, B0); PG8_BAR; PG8_SCHED;
            PG8_LDB(B1, 0, 1); PG8_STAGE(PG8_SB(0, 0), b2, voffB);
            PG8_BAR; PG8_WAIT_L(0); PG8_MMA(0, 1, At, B1); PG8_BAR;
            PG8_LDA(At, 0, 1); PG8_STAGE(PG8_SA(0, 0), a2, voffA);
            PG8_BAR; PG8_WAIT_L(0); PG8_MMA(1, 0, At, B0); PG8_BAR; PG8_SCHED;
            PG8_STAGE(PG8_SB(0, 1), b2 + hstep, voffB);
            PG8_WAIT_V(6); PG8_BAR; PG8_MMA(1, 1, At, B1); PG8_BAR;
            PG8_LDB(B0, 1, 0); PG8_SCHED; PG8_LDA(At, 1, 0); PG8_STAGE(PG8_SA(0, 1), a2 + hstep, voffA);
            PG8_WAIT_L(8); PG8_BAR; PG8_WAIT_L(0); PG8_MMA(0, 0, At, B0); PG8_BAR; PG8_SCHED;
            PG8_LDB(B1, 1, 1); PG8_STAGE(PG8_SB(1, 0), b3, voffB);
            PG8_BAR; PG8_WAIT_L(0); PG8_MMA(0, 1, At, B1); PG8_BAR;
            PG8_LDA(At, 1, 1); PG8_STAGE(PG8_SA(1, 0), a3, voffA);
            PG8_BAR; PG8_WAIT_L(0); PG8_MMA(1, 0, At, B0); PG8_BAR; PG8_SCHED;
            PG8_STAGE(PG8_SB(1, 1), b3 + hstep, voffB);
            PG8_WAIT_V(6); PG8_BAR; PG8_MMA(1, 1, At, B1); PG8_BAR;
            }
        }
        if constexpr (ALIGN_EPI) { if (wr == 0) PG8_BAR; }
        if constexpr (!Epi::AFTER_DRAIN) { E(acc, cur, wr, wc, fr, fq); S.done(cur); }
        if (!has_next) break;
#pragma unroll
        for (int a = 0; a < 2; ++a)
#pragma unroll
            for (int b = 0; b < 2; ++b)
#pragma unroll
                for (int m = 0; m < 4; ++m)
#pragma unroll
                    for (int n = 0; n < 2; ++n) acc[a][b][m][n] = (f32x4){0.f, 0.f, 0.f, 0.f};
        cur = nxt; cA = nA; cB = nB; ++ui;
        if constexpr (ALIGN_EPI) { if (wr == 1) PG8_BAR; }
    }
    PG8_WAIT_V(0);
    if constexpr (!ALIGN_EPI) { if (wr == 0) PG8_BAR; }
    PG8_BAR;
    if constexpr (Epi::AFTER_DRAIN) { E.fused(acc, cur, wr, wc, fr, fq, lds, wid, lane); S.done(cur); }
#undef PG8_SA
#undef PG8_SB
#undef PG8_STAGE
#undef PG8_LDA
#undef PG8_LDB
#undef PG8_MMA
#undef PG8_WAIT_V
#undef PG8_WAIT_L
#undef PG8_BAR
#undef PG8_SCHED
}
}

constexpr int DM = 2048, NTOK = 8192, SEQ = 4096, GW = 4096, NGRP = 16, GDIM = 256, CHUNK = 128, NHEAD = 16, HD = 128;
constexpr float EPS = 1e-6f;
constexpr float LOG2E = 1.4426950408889634f;
constexpr float QSCALE = 0.08838834764831845f * LOG2E;

constexpr float GELU_C1 = -1.5957691216057308f * LOG2E, GELU_C2 = -0.07135481627260025f * LOG2E;
__device__ __forceinline__ float gelu_tanh(float x) {
    const float e = __builtin_amdgcn_exp2f(x * __builtin_fmaf(x * x, GELU_C2, GELU_C1));
    return x * __builtin_amdgcn_rcpf(1.0f + e);
}
__device__ __forceinline__ float gelu_silu(float u, float z) {
    const float e1 = __builtin_amdgcn_exp2f(u * __builtin_fmaf(u * u, GELU_C2, GELU_C1));
    const float e2 = __builtin_amdgcn_exp2f(z * -LOG2E);
    return (u * z) * __builtin_amdgcn_rcpf((1.0f + e1) * (1.0f + e2));
}
__device__ __forceinline__ float silu_f(float z) { return z * __builtin_amdgcn_rcpf(1.0f + __builtin_amdgcn_exp2f(-LOG2E * z)); }

namespace pg8 {
typedef unsigned u32x2 __attribute__((ext_vector_type(2)));
__device__ __forceinline__ void conv_load4(const float* __restrict__ W, int N, int item, int lane, f32x4 (&x)[16]) {
    const int nblk = N / 64, k0 = 64 * (item / nblk), n0 = 64 * (item % nblk);
#pragma unroll
    for (int i = 0; i < 16; ++i) x[i] = *(const f32x4*)(W + (size_t)(k0 + 4 * i + (lane >> 4)) * N + n0 + 4 * (lane & 15));
}
__device__ __forceinline__ void conv_xpose(f32x4 (&x)[16], int lane) {
    const bool a = (lane >> 4) & 1, b = (lane >> 5) & 1;
#pragma unroll
    for (int i = 0; i < 16; ++i) {
        f32x4 v = x[i];
        {
            const float s0 = a ? v[0] : v[1], s1 = a ? v[2] : v[3];
            const float r0 = __shfl_xor(s0, 16), r1 = __shfl_xor(s1, 16);
            if (a) { v[0] = r0; v[2] = r1; } else { v[1] = r0; v[3] = r1; }
        }
        {
            const float s0 = b ? v[0] : v[2], s1 = b ? v[1] : v[3];
            const float r0 = __shfl_xor(s0, 32), r1 = __shfl_xor(s1, 32);
            if (b) { v[0] = r0; v[1] = r1; } else { v[2] = r0; v[3] = r1; }
        }
        x[i] = v;
    }
}
__device__ __forceinline__ void conv_store4(int K, int N, bf16_t* __restrict__ WT, int item, int lane, const float* __restrict__ gk, const f32x4 (&x)[16]) {
    const int nblk = N / 64, k0 = 64 * (item / nblk), n0 = 64 * (item % nblk);
    const int n = n0 + 4 * (lane & 15) + (lane >> 4);
#pragma unroll
    for (int kc = 0; kc < 8; ++kc) {
        float g[8];
#pragma unroll
        for (int j = 0; j < 8; ++j) g[j] = gk ? gk[k0 + 8 * kc + j] : 1.0f;
        const f32x4 lo = x[2 * kc], hi = x[2 * kc + 1];
        u32x4 o; o.x = cvt_pk_bf16(lo[0] * g[0], lo[1] * g[1]); o.y = cvt_pk_bf16(lo[2] * g[2], lo[3] * g[3]);
        o.z = cvt_pk_bf16(hi[0] * g[4], hi[1] * g[5]); o.w = cvt_pk_bf16(hi[2] * g[6], hi[3] * g[7]);
        *(u32x4*)(WT + (size_t)n * K + k0 + 8 * kc) = o;
    }
}
__device__ __forceinline__ void conv_store4_lds(int K, int N, bf16_t* __restrict__ WT, int item, int lane, const float* __restrict__ gk, const f32x4 (&x)[16], PG8_LAS unsigned char* sw) {
    const int nblk = N / 64, k0 = 64 * (item / nblk), n0 = 64 * (item % nblk);
    const int nq = lane & 15, r = lane >> 4;
    u32x4 o[8];
#pragma unroll
    for (int kc = 0; kc < 8; ++kc) {
        float g[8];
#pragma unroll
        for (int j = 0; j < 8; ++j) g[j] = gk ? gk[k0 + 8 * kc + j] : 1.0f;
        const f32x4 lo = x[2 * kc], hi = x[2 * kc + 1];
        o[kc].x = cvt_pk_bf16(lo[0] * g[0], lo[1] * g[1]); o[kc].y = cvt_pk_bf16(lo[2] * g[2], lo[3] * g[3]);
        o[kc].z = cvt_pk_bf16(hi[0] * g[4], hi[1] * g[5]); o[kc].w = cvt_pk_bf16(hi[2] * g[6], hi[3] * g[7]);
    }
#pragma unroll
    for (int q = 0; q < 4; ++q) {
        if ((nq >> 2) == q) {
            PG8_LAS u32x4* wp = (PG8_LAS u32x4*)(sw + (4 * (nq & 3) + r) * 128);
#pragma unroll
            for (int kc = 0; kc < 8; ++kc) wp[kc] = o[kc];
        }
        asm volatile("s_waitcnt lgkmcnt(0)" ::: "memory");
#pragma unroll
        for (int h = 0; h < 2; ++h) { const int rl = (lane >> 3) + 8 * h;
            const u32x4 v = *(const PG8_LAS u32x4*)(sw + rl * 128 + (lane & 7) * 16);
            *(u32x4*)(WT + (size_t)(n0 + 16 * q + rl) * K + k0 + 8 * (lane & 7)) = v; }
        asm volatile("s_waitcnt lgkmcnt(0)" ::: "memory");
    }
}
struct ConvOrder : StaticOrder {
    const float *w2, *w3, *w4, *g1; bf16_t *t2, *t3, *t4; int gw, ngw, trigger, ln; PG8_LAS unsigned char* sw; mutable int n_done;
    __device__ __forceinline__ void done(const Unit&) const {
        constexpr int I2 = (GW / 64) * (DM / 64), I3 = (DM / 64) * (4 * DM / 64), I4 = (DM / 64) * (DM / 64);
        const int u = n_done++;
#ifdef HOOK_SPREAD
        f32x4 va[16];
        if (u == 0 || u == 1) { for (int it = gw + u * ngw; it < I3; it += 2 * ngw) { conv_load4(w3, 4 * DM, it, ln, va); conv_xpose(va, ln); conv_store4(DM, 4 * DM, t3, it, ln, g1, va); } }
        else if (u == 2) { for (int it = gw; it < I2; it += ngw) { conv_load4(w2, DM, it, ln, va); conv_xpose(va, ln); conv_store4(GW, DM, t2, it, ln, nullptr, va); } }
        else if (u == 3) { for (int it = gw; it < I4; it += ngw) { conv_load4(w4, DM, it, ln, va); conv_xpose(va, ln); conv_store4(DM, DM, t4, it, ln, nullptr, va); } }
#else
        if (u != trigger) return;
        f32x4 va[16], vb[16];
        for (int it = gw; it < I3; it += 2 * ngw) {
            const bool two = it + ngw < I3;
            conv_load4(w3, 4 * DM, it, ln, va); if (two) conv_load4(w3, 4 * DM, it + ngw, ln, vb);
            conv_xpose(va, ln); if (two) conv_xpose(vb, ln);
            conv_store4_lds(DM, 4 * DM, t3, it, ln, g1, va, sw); if (two) conv_store4_lds(DM, 4 * DM, t3, it + ngw, ln, g1, vb, sw);
        }
        for (int it = gw; it < I2; it += ngw) {
            const bool two = it < I4;
            conv_load4(w2, DM, it, ln, va); if (two) conv_load4(w4, DM, it, ln, vb);
            conv_xpose(va, ln); if (two) conv_xpose(vb, ln);
            conv_store4_lds(GW, DM, t2, it, ln, nullptr, va, sw); if (two) conv_store4_lds(DM, DM, t4, it, ln, nullptr, vb, sw);
        }
#endif
    }
};
struct EpiGmlpIn {
    static constexpr bool PERM = true, AFTER_DRAIN = false;
    bf16_t *UZ, *V; float* vss;
    __device__ __forceinline__ void operator()(const f32x4 (&acc)[2][2][4][2], const Unit& u, int wr, int wc, int fr, int fq) const {
        const int row0 = u.pm * BM + wr * 64 + fr;
        const int tq = u.pn / 3, tr = u.pn - 3 * tq;
        if (tr < 2) {
            const int col0 = (2 * tq + tr) * HALF + wc * 32 + 8 * fq;
#pragma unroll
            for (int ai = 0; ai < 2; ++ai)
#pragma unroll
                for (int m = 0; m < 4; ++m) {
                    const int row = row0 + ai * HALF + m * 16;
                    f32x4 v0 = acc[ai][0][m][0], v1 = acc[ai][0][m][1]; const f32x4 z0 = acc[ai][1][m][0], z1 = acc[ai][1][m][1];
#pragma unroll
                    for (int e = 0; e < 4; ++e) { v0[e] = gelu_silu(v0[e], z0[e]); v1[e] = gelu_silu(v1[e], z1[e]); }
                    u32x4 w; w.x = cvt_pk_bf16(v0[0], v0[1]); w.y = cvt_pk_bf16(v0[2], v0[3]); w.z = cvt_pk_bf16(v1[0], v1[1]); w.w = cvt_pk_bf16(v1[2], v1[3]);
                    *(u32x4*)(UZ + (size_t)row * GW + col0) = w;
                }
        } else {
            const int tl = tq, col0 = tl * BM + wc * 32 + 8 * fq;
#pragma unroll
            for (int ai = 0; ai < 2; ++ai)
#pragma unroll
                for (int m = 0; m < 4; ++m) {
                    const int row = row0 + ai * HALF + m * 16;
                    bf16_t* rowp = V + (size_t)row * GW + col0;
                    float ss = 0.f;
#pragma unroll
                    for (int bj = 0; bj < 2; ++bj) {
                        f32x4 v0 = acc[ai][bj][m][0], v1 = acc[ai][bj][m][1];
#pragma unroll
                        for (int e = 0; e < 4; ++e) { v0[e] = gelu_tanh(v0[e]); v1[e] = gelu_tanh(v1[e]); ss += v0[e] * v0[e] + v1[e] * v1[e]; }
                        u32x4 w; w.x = cvt_pk_bf16(v0[0], v0[1]); w.y = cvt_pk_bf16(v0[2], v0[3]); w.z = cvt_pk_bf16(v1[0], v1[1]); w.w = cvt_pk_bf16(v1[2], v1[3]);
                        *(u32x4*)(rowp + bj * HALF) = w;
                    }
                    ss += __shfl_xor(ss, 16); ss += __shfl_xor(ss, 32);
                    if (fq == 0) vss[(size_t)row * 64 + tl * 4 + wc] = ss;
                }
        }
    }
};
struct EpiRes1 {
    static constexpr bool PERM = false, AFTER_DRAIN = false;
    const bf16_t* hn; const float* irs; const float* g0; bf16_t* hb; float* hss;
    __device__ __forceinline__ void operator()(const f32x4 (&acc)[2][2][4][2], const Unit& u, int wr, int wc, int fr, int fq) const {
        const int row0 = u.pm * BM + wr * 64 + fr, col0 = u.pn * BM + wc * 32 + 4 * fq;
        float rs[2][4];
#pragma unroll
        for (int ai = 0; ai < 2; ++ai)
#pragma unroll
            for (int m = 0; m < 4; ++m) rs[ai][m] = irs[row0 + ai * HALF + m * 16];
        f32x4 ig[2][2];
#pragma unroll
        for (int bj = 0; bj < 2; ++bj)
#pragma unroll
            for (int n = 0; n < 2; ++n) { const f32x4 gv = *(const f32x4*)(g0 + col0 + bj * HALF + n * 16);
                ig[bj][n] = (f32x4){__builtin_amdgcn_rcpf(gv[0]), __builtin_amdgcn_rcpf(gv[1]), __builtin_amdgcn_rcpf(gv[2]), __builtin_amdgcn_rcpf(gv[3])}; }
#pragma unroll
        for (int ai = 0; ai < 2; ++ai) {
            u32x2 xv[4][2][2];
#pragma unroll
            for (int m = 0; m < 4; ++m)
#pragma unroll
                for (int bj = 0; bj < 2; ++bj)
#pragma unroll
                    for (int n = 0; n < 2; ++n) xv[m][bj][n] = *(const u32x2*)(hn + (size_t)(row0 + ai * HALF + m * 16) * DM + col0 + bj * HALF + n * 16);
#pragma unroll
            for (int m = 0; m < 4; ++m) {
                const int row = row0 + ai * HALF + m * 16;
                const size_t off = (size_t)row * DM + col0;
                float ss = 0.f;
#pragma unroll
                for (int bj = 0; bj < 2; ++bj)
#pragma unroll
                    for (int n = 0; n < 2; ++n) {
                        const u32x2 w2 = xv[m][bj][n];
                        f32x4 xh; xh[0] = __uint_as_float(w2.x << 16); xh[1] = __uint_as_float(w2.x & 0xffff0000u); xh[2] = __uint_as_float(w2.y << 16); xh[3] = __uint_as_float(w2.y & 0xffff0000u);
                        const f32x4 h = xh * ig[bj][n] * rs[ai][m] + acc[ai][bj][m][n];
                        ss += (h[0] * h[0] + h[1] * h[1]) + (h[2] * h[2] + h[3] * h[3]);
                        const unsigned long long w = (unsigned long long)cvt_pk_bf16(h[0], h[1]) | ((unsigned long long)cvt_pk_bf16(h[2], h[3]) << 32);
                        *(unsigned long long*)(hb + off + bj * HALF + n * 16) = w;
                    }
                ss += __shfl_xor(ss, 16); ss += __shfl_xor(ss, 32);
                if (fq == 0) __hip_atomic_fetch_add(hss + row, ss, __ATOMIC_RELAXED, __HIP_MEMORY_SCOPE_AGENT);
            }
        }
    }
};
struct EpiFinal {
    static constexpr bool PERM = false, AFTER_DRAIN = false;
    const bf16_t* hb; const float* fg; float* out; float* hss; unsigned* cnt; bool fused;
    __device__ __forceinline__ void operator()(f32x4 (&acc)[2][2][4][2], const Unit& u, int wr, int wc, int fr, int fq) const {
        const int row0 = u.pm * BM + wr * 64 + fr, col0 = u.pn * BM + wc * 32 + 4 * fq;
#pragma unroll
        for (int ai = 0; ai < 2; ++ai)
#pragma unroll
            for (int m = 0; m < 4; ++m) {
                const int row = row0 + ai * HALF + m * 16;
                const size_t off = (size_t)row * DM + col0;
                float ss = 0.f;
#pragma unroll
                for (int bj = 0; bj < 2; ++bj)
#pragma unroll
                    for (int n = 0; n < 2; ++n) {
                        const u32x2 w = *(const u32x2*)(hb + off + bj * HALF + n * 16);
                        f32x4 h; h[0] = __uint_as_float(w.x << 16); h[1] = __uint_as_float(w.x & 0xffff0000u); h[2] = __uint_as_float(w.y << 16); h[3] = __uint_as_float(w.y & 0xffff0000u);
                        h += acc[ai][bj][m][n];
                        acc[ai][bj][m][n] = h;
                        ss += (h[0] * h[0] + h[1] * h[1]) + (h[2] * h[2] + h[3] * h[3]);
                    }
                ss += __shfl_xor(ss, 16); ss += __shfl_xor(ss, 32);
                if (fq == 0) __hip_atomic_fetch_add(hss + row, ss, __ATOMIC_RELAXED, __HIP_MEMORY_SCOPE_AGENT);
            }
        if (!fused) {
#pragma unroll
            for (int ai = 0; ai < 2; ++ai)
#pragma unroll
                for (int m = 0; m < 4; ++m)
#pragma unroll
                    for (int bj = 0; bj < 2; ++bj)
#pragma unroll
                        for (int n = 0; n < 2; ++n) *(f32x4*)(out + (size_t)(row0 + ai * HALF + m * 16) * DM + col0 + bj * HALF + n * 16) = acc[ai][bj][m][n];
            return;
        }
        asm volatile("s_waitcnt vmcnt(0)" ::: "memory");
        unsigned* pc = cnt + 64 * u.pm;
        if (lane_id() == 0) __hip_atomic_fetch_add(pc, 1u, __ATOMIC_RELAXED, __HIP_MEMORY_SCOPE_AGENT);
        for (int it = 0; it < (1 << 22); ++it) {
            if (__hip_atomic_load(pc, __ATOMIC_RELAXED, __HIP_MEMORY_SCOPE_AGENT) >= 64u) break;
            __builtin_amdgcn_s_sleep(2);
        }
        asm volatile("" ::: "memory");
        f32x4 gv[2][2];
#pragma unroll
        for (int bj = 0; bj < 2; ++bj)
#pragma unroll
            for (int n = 0; n < 2; ++n) gv[bj][n] = *(const f32x4*)(fg + col0 + bj * HALF + n * 16);
        float ssr[2][4];
#pragma unroll
        for (int ai = 0; ai < 2; ++ai)
#pragma unroll
            for (int m = 0; m < 4; ++m) ssr[ai][m] = __hip_atomic_load(hss + row0 + ai * HALF + m * 16, __ATOMIC_RELAXED, __HIP_MEMORY_SCOPE_AGENT);
#pragma unroll
        for (int ai = 0; ai < 2; ++ai)
#pragma unroll
            for (int m = 0; m < 4; ++m) {
                const int row = row0 + ai * HALF + m * 16;
                const size_t off = (size_t)row * DM + col0;
                const float rstd = __builtin_amdgcn_rsqf(ssr[ai][m] * (1.0f / DM) + EPS);
#pragma unroll
                for (int bj = 0; bj < 2; ++bj)
#pragma unroll
                    for (int n = 0; n < 2; ++n) *(f32x4*)(out + off + bj * HALF + n * 16) = acc[ai][bj][m][n] * rstd * gv[bj][n];
            }
    }
};
struct EpiSbIn {
    static constexpr bool PERM = true, AFTER_DRAIN = false;
    bf16_t* Q; size_t rstride; const float* hss;
    __device__ __forceinline__ void operator()(const f32x4 (&acc)[2][2][4][2], const Unit& u, int wr, int wc, int fr, int fq) const {
        const int region = u.pn >> 3, tl = u.pn & 7;
        bf16_t* base = Q + (size_t)region * rstride;
        const int row0 = u.pm * BM + wr * 64 + fr, col0 = tl * BM + wc * 32 + 8 * fq;
        float ssr[2][4];
#pragma unroll
        for (int ai = 0; ai < 2; ++ai)
#pragma unroll
            for (int m = 0; m < 4; ++m) ssr[ai][m] = hss[row0 + ai * HALF + m * 16];
#pragma unroll
        for (int ai = 0; ai < 2; ++ai)
#pragma unroll
            for (int m = 0; m < 4; ++m) {
                const int row = row0 + ai * HALF + m * 16;
                float sc = __builtin_amdgcn_rsqf(ssr[ai][m] * (1.0f / DM) + EPS);
                if (region == 0) sc *= QSCALE;
                bf16_t* rowp = base + (size_t)row * DM + col0;
#pragma unroll
                for (int bj = 0; bj < 2; ++bj) {
                    f32x4 v0 = acc[ai][bj][m][0] * sc, v1 = acc[ai][bj][m][1] * sc;
                    if (region == 3) {
#pragma unroll
                        for (int e = 0; e < 4; ++e) { v0[e] = silu_f(v0[e]); v1[e] = silu_f(v1[e]); }
                    }
                    u32x4 w; w.x = cvt_pk_bf16(v0[0], v0[1]); w.y = cvt_pk_bf16(v0[2], v0[3]); w.z = cvt_pk_bf16(v1[0], v1[1]); w.w = cvt_pk_bf16(v1[2], v1[3]);
                    *(u32x4*)(rowp + bj * HALF) = w;
                }
            }
    }
};
}

#define LAS __attribute__((address_space(3)))
typedef unsigned short bf16_t;
typedef short bf16x8 __attribute__((ext_vector_type(8)));
typedef short s16x4 __attribute__((ext_vector_type(4)));
typedef float f32x4 __attribute__((ext_vector_type(4)));
typedef float f32x16 __attribute__((ext_vector_type(16)));
typedef unsigned u32x4 __attribute__((ext_vector_type(4)));
typedef unsigned u32x2 __attribute__((ext_vector_type(2)));
__device__ __forceinline__ unsigned off_b(unsigned row, unsigned ch) { return 256u * row + 16u * (ch ^ (((row & 3u) << 2) | ((row >> 2) & 3u))); }
__device__ __forceinline__ s16x4 vtr(const LAS unsigned char* p) { return __builtin_bit_cast(s16x4, __builtin_amdgcn_ds_read_tr16_b64_v4i16((LAS s16x4*)p)); }
__device__ __forceinline__ unsigned pk_bf16(float lo, float hi) { return pg8::cvt_pk_bf16(lo, hi); }
__device__ __forceinline__ float bf_lo(unsigned w) { return __uint_as_float(w << 16); }
__device__ __forceinline__ float bf_hi(unsigned w) { return __uint_as_float(w & 0xffff0000u); }
__device__ __forceinline__ int crow(int r, int hi) { return (r & 3) + 8 * (r >> 2) + 4 * hi; }

#ifdef ATT_NOSB
#define ATT_SB() do {} while (0)
#else
#ifndef ATT_USE_SB
#define ATT_SB() do {} while (0)
#else
#define ATT_SB() __builtin_amdgcn_sched_barrier(0)
#endif
#endif
#define ATT_VLD(f) do { const int c_ = (f) >> 2, s_ = (f) & 3; const s16x4 lo_ = vtr(vbp + 4096 * s_ + vbase[0] + vcq[c_]); const s16x4 hh_ = vtr(vbp + 4096 * s_ + vbase[1] + vcq[c_]); \
        vf[f] = (bf16x8){lo_[0], lo_[1], lo_[2], lo_[3], hh_[0], hh_[1], hh_[2], hh_[3]}; } while (0)
#define ATT_PV(f) do { if (DO_PV) { o[(f) >> 2] = __builtin_amdgcn_mfma_f32_32x32x16_bf16(pa[(f) & 3], vf[f], o[(f) >> 2], 0, 0, 0); if ((f) + 4 < 16) ATT_VLD((f) + 4); } } while (0)
#define ATT_EXP8(i) do { _Pragma("unroll") for (int r_ = 0; r_ < 8; ++r_) p[(i) >> 1][8 * ((i) & 1) + r_] = __builtin_amdgcn_exp2f(fminf(p[(i) >> 1][8 * ((i) & 1) + r_], 30.f)); } while (0)
#define ATT_LBLK(j) do { const int ph_ = 1 - ((j) >> 2), g_ = 3 - ((j) & 3); \
        const float w0_ = 1.0f + p[ph_][4 * g_], w1_ = 1.0f + p[ph_][4 * g_ + 1], w2_ = 1.0f + p[ph_][4 * g_ + 2], w3_ = 1.0f + p[ph_][4 * g_ + 3]; \
        L[j] = __builtin_amdgcn_logf((w0_ * w1_) * (w2_ * w3_)); } while (0)
#define ATT_XCH(j) do { const float own_ = L[j]; const auto rr_ = __builtin_amdgcn_permlane32_swap(__float_as_uint(own_), __float_as_uint(own_), false, false); \
        const float a0_ = __uint_as_float(rr_[0]), a1_ = __uint_as_float(rr_[1]); const float oth_ = (a0_ == own_) ? a1_ : a0_; \
        T[j] = run + (hi ? 0.f : oth_) + own_; run += a0_ + a1_; } while (0)
#define ATT_WGT(j) do { const int ph_ = 1 - ((j) >> 2), g_ = 3 - ((j) & 3); float cf_ = __builtin_amdgcn_exp2f(-T[j]); \
        _Pragma("unroll") for (int e_ = 0; e_ < 4; ++e_) { const float ev_ = p[ph_][4 * g_ + e_]; p[ph_][4 * g_ + e_] = ev_ * cf_; if (e_ < 3) cf_ *= (1.0f + ev_); } } while (0)

template <bool DO_PV>
__device__ __forceinline__ void attn_tile(const LAS unsigned char* kb, const LAS unsigned char* vbp, const bf16x8 (&qf)[8], f32x16 (&o)[4], bf16x8 (&pa)[4], float& carry,
                                          const unsigned (&koff)[8], const unsigned (&vbase)[2], const unsigned (&vcq)[4], int k0, int qw0, int qabs, int hi) {
    f32x16 p[2];
#pragma unroll
    for (int r = 0; r < 16; ++r) { p[0][r] = 0.f; p[1][r] = 0.f; }
    bf16x8 vf[16];
    if (DO_PV) { ATT_VLD(0); ATT_VLD(1); ATT_VLD(2); ATT_VLD(3); }
    {
        bf16x8 ka[8], kc[8];
#pragma unroll
        for (int d0 = 0; d0 < 8; ++d0) { ka[d0] = *(const LAS bf16x8*)(kb + koff[d0]); kc[d0] = *(const LAS bf16x8*)(kb + 8192 + koff[d0]); }
        ATT_SB();
#pragma unroll
        for (int d0 = 0; d0 < 8; ++d0) {
            p[0] = __builtin_amdgcn_mfma_f32_32x32x16_bf16(ka[d0], qf[d0], p[0], 0, 0, 0);
            p[1] = __builtin_amdgcn_mfma_f32_32x32x16_bf16(kc[d0], qf[d0], p[1], 0, 0, 0);
        }
    }
    ATT_SB();
    const bool need_mask = (k0 + 63 >= qw0);
    float L[8], T[8];
    ATT_PV(0); ATT_EXP8(0); ATT_SB();
    ATT_PV(1); ATT_EXP8(1); ATT_SB();
    ATT_PV(2); ATT_EXP8(2); ATT_SB();
    ATT_PV(3); ATT_EXP8(3); ATT_SB();
    if (need_mask) {
#pragma unroll
        for (int ph = 0; ph < 2; ++ph)
#pragma unroll
            for (int r = 0; r < 16; ++r) { const int key = k0 + 32 * ph + crow(r, hi); if (key >= qabs) p[ph][r] = 0.f; }
    }
    ATT_SB();
    ATT_PV(4); ATT_LBLK(0); ATT_LBLK(1); ATT_SB();
    ATT_PV(5); ATT_LBLK(2); ATT_LBLK(3); ATT_SB();
    ATT_PV(6); ATT_LBLK(4); ATT_LBLK(5); ATT_SB();
    ATT_PV(7); ATT_LBLK(6); ATT_LBLK(7); ATT_SB();
    float run = carry;
    ATT_PV(8); ATT_XCH(0); ATT_XCH(1); ATT_SB();
    ATT_PV(9); ATT_XCH(2); ATT_XCH(3); ATT_SB();
    ATT_PV(10); ATT_XCH(4); ATT_XCH(5); ATT_SB();
    ATT_PV(11); ATT_XCH(6); ATT_XCH(7); ATT_SB();
    carry = run;
    ATT_PV(12); ATT_WGT(0); ATT_WGT(1); ATT_SB();
    ATT_PV(13); ATT_WGT(2); ATT_WGT(3); ATT_SB();
    ATT_PV(14); ATT_WGT(4); ATT_WGT(5); ATT_SB();
    ATT_PV(15); ATT_WGT(6); ATT_WGT(7); ATT_SB();
#pragma unroll
    for (int s = 0; s < 4; ++s) { const int ph = s >> 1, rb = 8 * (s & 1);
        u32x4 w; w.x = pk_bf16(p[ph][rb], p[ph][rb + 1]); w.y = pk_bf16(p[ph][rb + 2], p[ph][rb + 3]); w.z = pk_bf16(p[ph][rb + 4], p[ph][rb + 5]); w.w = pk_bf16(p[ph][rb + 6], p[ph][rb + 7]);
        pa[s] = __builtin_bit_cast(bf16x8, w); }
}

__device__ __forceinline__ void attn_unit(LAS unsigned char* lds, const int wid, int b, int h, int qb, const bf16_t* __restrict__ Q, const bf16_t* __restrict__ K,
                                          const bf16_t* __restrict__ V, const bf16_t* __restrict__ ZS, bf16_t* __restrict__ OG) {
    const int tid = tid_of(wid), lane = tid & 63, r32 = lane & 31, hi = lane >> 5;
    const size_t tok0 = (size_t)b * SEQ;
    const int q0 = qb * 256, qw0 = q0 + 32 * wid, qabs = qw0 + r32;
    bf16x8 qf[8];
    { const bf16_t* qp = Q + (tok0 + qabs) * DM + h * HD + 8 * hi;
#pragma unroll
      for (int d0 = 0; d0 < 8; ++d0) qf[d0] = *(const bf16x8*)(qp + 16 * d0); }
    f32x16 o[4];
#pragma unroll
    for (int c = 0; c < 4; ++c)
#pragma unroll
        for (int r = 0; r < 16; ++r) o[c][r] = 0.f;
    bf16x8 pa[4];
#pragma unroll
    for (int s = 0; s < 4; ++s) pa[s] = (bf16x8){0, 0, 0, 0, 0, 0, 0, 0};
    float carry = 0.f;
    const int NT = (q0 + 256) / 64;
    const int srow = tid >> 4, sch = (tid & 15) ^ (((srow & 3) << 2) | ((srow >> 2) & 3));
    const bf16_t* kg = K + (tok0 + srow) * DM + h * HD + sch * 8;
    const bf16_t* vg = V + (tok0 + srow) * DM + h * HD + sch * 8;
    LAS unsigned char* ldsw = lds + wid * 1024;
#define ATT_STAGE(t_, koff_, voff_) do { const size_t go_ = (size_t)(t_) * 64 * DM; \
        __builtin_amdgcn_global_load_lds((const unsigned*)(kg + go_), (LAS unsigned*)(ldsw + (koff_)), 16, 0, 0); \
        __builtin_amdgcn_global_load_lds((const unsigned*)(kg + go_ + 32 * DM), (LAS unsigned*)(ldsw + (koff_) + 8192), 16, 0, 0); \
        __builtin_amdgcn_global_load_lds((const unsigned*)(vg + go_), (LAS unsigned*)(ldsw + (voff_)), 16, 0, 0); \
        __builtin_amdgcn_global_load_lds((const unsigned*)(vg + go_ + 32 * DM), (LAS unsigned*)(ldsw + (voff_) + 8192), 16, 0, 0); } while (0)
    ATT_STAGE(NT - 1, 0, 32768);
    asm volatile("s_waitcnt vmcnt(0)" ::: "memory");
    __syncthreads();
    unsigned koff[8];
#pragma unroll
    for (int d0 = 0; d0 < 8; ++d0) koff[d0] = off_b(r32, 2 * d0 + hi);
    const unsigned qa = (lane & 15) >> 2, blk = (lane >> 4) & 1, pp = lane & 3;
    unsigned vbase[2], vcq[4];
#pragma unroll
    for (int t = 0; t < 2; ++t) vbase[t] = 256u * (8 * t + 4 * hi + qa) + 16u * ((2 * blk + (pp >> 1)) ^ ((2 * t + hi) & 3)) + 8u * (pp & 1);
#pragma unroll
    for (int c = 0; c < 4; ++c) vcq[c] = 64u * ((unsigned)c ^ qa);
    int kcur = 0, vprev = 2, vcur = 0, vnext = 1;
    bool prev_valid = false;
    for (int t = NT - 1; t >= 0; --t) {
        if (t > 0) ATT_STAGE(t - 1, (kcur ^ 1) * 16384, 32768 + vnext * 16384);
        const LAS unsigned char* kb = lds + kcur * 16384;
        const LAS unsigned char* vbp = lds + 32768 + vprev * 16384;
        const int k0 = 64 * t;
        const bool valid = (k0 < qw0 + 31);
        if (valid) {
            if (prev_valid) attn_tile<true>(kb, vbp, qf, o, pa, carry, koff, vbase, vcq, k0, qw0, qabs, hi);
            else            attn_tile<false>(kb, vbp, qf, o, pa, carry, koff, vbase, vcq, k0, qw0, qabs, hi);
        }
        prev_valid = valid;
        asm volatile("s_waitcnt vmcnt(0)" ::: "memory");
        __syncthreads();
        kcur ^= 1; { const int tmp = vprev; vprev = vcur; vcur = vnext; vnext = tmp; }
    }
    { const LAS unsigned char* vbp = lds + 32768 + vprev * 16384;
#pragma unroll
      for (int c = 0; c < 4; ++c)
#pragma unroll
          for (int s = 0; s < 4; ++s) {
              const s16x4 lo = vtr(vbp + 4096 * s + vbase[0] + vcq[c]);
              const s16x4 hh = vtr(vbp + 4096 * s + vbase[1] + vcq[c]);
              const bf16x8 vfr = (bf16x8){lo[0], lo[1], lo[2], lo[3], hh[0], hh[1], hh[2], hh[3]};
              o[c] = __builtin_amdgcn_mfma_f32_32x32x16_bf16(pa[s], vfr, o[c], 0, 0, 0);
          } }
    {
        int lane_e = lane_id(); asm volatile("" : "+v"(lane_e));
        const int r32e = lane_e & 31, hie = lane_e >> 5, rowq = lane_e >> 4, c4 = (lane_e & 15) * 4;
        LAS float* stg = (LAS float*)(lds + 81920 + wid * 8192);
        const size_t gbase = (tok0 + qw0) * DM + h * HD + c4;
        u32x2 zv[2][8];
#pragma unroll
        for (int ps = 0; ps < 2; ++ps)
#pragma unroll
            for (int j = 0; j < 8; ++j) zv[ps][j] = *(const u32x2*)(ZS + gbase + (size_t)(4 * j + rowq) * DM + 64 * ps);
#pragma unroll
        for (int ps = 0; ps < 2; ++ps) {
#pragma unroll
            for (int r = 0; r < 16; ++r) {
                stg[crow(r, hie) * 64 + r32e] = o[2 * ps][r];
                stg[crow(r, hie) * 64 + 32 + r32e] = o[2 * ps + 1][r];
            }
            asm volatile("s_waitcnt lgkmcnt(0)" ::: "memory");
#pragma unroll
            for (int j = 0; j < 8; ++j) {
                const f32x4 ov = *(const LAS f32x4*)(stg + (4 * j + rowq) * 64 + c4);
                const u32x2 z = zv[ps][j];
                u32x2 w; w.x = pk_bf16(ov[0] * bf_lo(z.x), ov[1] * bf_hi(z.x)); w.y = pk_bf16(ov[2] * bf_lo(z.y), ov[3] * bf_hi(z.y));
                *(u32x2*)(OG + gbase + (size_t)(4 * j + rowq) * DM + 64 * ps) = w;
            }
            asm volatile("s_waitcnt lgkmcnt(0)" ::: "memory");
        }
    }
    __syncthreads();
}
__device__ __forceinline__ void attn_phase(LAS unsigned char* lds, const int wid_, int vcu, int G, const bf16_t* Q, const bf16_t* K, const bf16_t* V, const bf16_t* ZS, bf16_t* OG) {
#ifndef NO_ATTN_PRIO
    if (wid_ >= 4) __builtin_amdgcn_s_setprio(1);
#endif
    for (int p = vcu; p < 256; p += G) {
        const int bh = p >> 3, s = p & 7;
#ifdef ATT_ONE_INSTANCE
#pragma unroll 1
        for (int uu = 0; uu < 2; ++uu) attn_unit(lds, wid_, bh >> 4, bh & 15, uu ? 15 - s : s, Q, K, V, ZS, OG);
#else
        attn_unit(lds, wid_, bh >> 4, bh & 15, s, Q, K, V, ZS, OG);
        attn_unit(lds, wid_, bh >> 4, bh & 15, 15 - s, Q, K, V, ZS, OG);
#endif
    }
    __builtin_amdgcn_s_setprio(0);
}

__device__ __forceinline__ void mix_unit(LAS unsigned char* lds, const int wid, int n, int g, const bf16_t* __restrict__ UZ, const bf16_t* __restrict__ V, const float* __restrict__ vss,
                                         const float* __restrict__ w_s, const float* __restrict__ b_s, const float* __restrict__ vg, bf16_t* __restrict__ Y) {
    const int tid = tid_of(wid), lane = tid & 63, r32 = lane & 31, hi = lane >> 5;
    const size_t row0 = (size_t)n * CHUNK;
    LAS float* rstdL = (LAS float*)(lds + 98304);
    const int cc = tid & 31;
    u32x4 uu[8];
#pragma unroll
    for (int i = 0; i < 8; ++i) { const int t = (tid >> 5) + 16 * i; uu[i] = __builtin_nontemporal_load((const u32x4*)(UZ + (row0 + t) * GW + g * GDIM + cc * 8)); }
    {
        u32x4 vr[8];
#pragma unroll
        for (int i = 0; i < 8; ++i) { const int c = tid + 512 * i, s = c >> 5, cc = c & 31;
            vr[i] = __builtin_nontemporal_load((const u32x4*)(V + (row0 + s) * GW + g * GDIM + cc * 8)); }
        if (tid < 128) { const f32x4* vp = (const f32x4*)(vss + (row0 + tid) * 64); f32x4 s4 = vp[0];
#pragma unroll
            for (int i = 1; i < 16; ++i) s4 += vp[i];
            rstdL[tid] = __builtin_amdgcn_rsqf(((s4[0] + s4[1]) + (s4[2] + s4[3])) * (1.0f / GW) + EPS); }
#pragma unroll
        for (int i = 0; i < 8; ++i) { const int c = tid + 512 * i, s = c >> 5, cc = c & 31;
            *(LAS u32x4*)(lds + 32768 + (cc >> 4) * 32768 + off_b(s, cc & 15)) = vr[i]; }
    }
    __syncthreads();
#pragma unroll
    for (int i = 0; i < 4; ++i) { const int c = tid + 512 * i, t = c >> 4, ch = c & 15, s0 = ch * 8;
        const f32x4 w0 = *(const f32x4*)(w_s + ((size_t)g * CHUNK + t) * CHUNK + s0), w1 = *(const f32x4*)(w_s + ((size_t)g * CHUNK + t) * CHUNK + s0 + 4);
        float wv[8] = {w0[0], w0[1], w0[2], w0[3], w1[0], w1[1], w1[2], w1[3]};
#pragma unroll
        for (int j = 0; j < 8; ++j) wv[j] = (s0 + j <= t) ? wv[j] * rstdL[s0 + j] : 0.f;
        u32x4 w; w.x = pk_bf16(wv[0], wv[1]); w.y = pk_bf16(wv[2], wv[3]); w.z = pk_bf16(wv[4], wv[5]); w.w = pk_bf16(wv[6], wv[7]);
        *(LAS u32x4*)(lds + off_b(t, ch)) = w; }
    __syncthreads();
    f32x16 acc[4];
#pragma unroll
    for (int i = 0; i < 4; ++i)
#pragma unroll
        for (int r = 0; r < 16; ++r) acc[i][r] = 0.f;
    {
        const LAS unsigned char* vimg = lds + 32768 + (wid >> 2) * 32768;
        const unsigned cblk = wid & 3, qa = (lane & 15) >> 2, blk = (lane >> 4) & 1, pp = lane & 3;
#pragma unroll
        for (int ks = 0; ks < 8; ++ks) {
            const s16x4 lo = vtr(vimg + off_b(16 * ks + 8 * hi + qa, 4 * cblk + 2 * blk + (pp >> 1)) + 8 * (pp & 1));
            const s16x4 hh = vtr(vimg + off_b(16 * ks + 8 * hi + 4 + qa, 4 * cblk + 2 * blk + (pp >> 1)) + 8 * (pp & 1));
            const bf16x8 vf = (bf16x8){lo[0], lo[1], lo[2], lo[3], hh[0], hh[1], hh[2], hh[3]};
#pragma unroll
            for (int i = 0; i < 4; ++i) if (ks <= 2 * i + 1) {
                const bf16x8 af = *(const LAS bf16x8*)(lds + off_b(32 * i + r32, 2 * ks + hi));
                acc[i] = __builtin_amdgcn_mfma_f32_32x32x16_bf16(af, vf, acc[i], 0, 0, 0);
            }
        }
    }
    __syncthreads();
    {
        LAS float* mx = (LAS float*)lds;
        const int c = 128 * (wid >> 2) + 32 * (wid & 3) + r32;
#pragma unroll
        for (int i = 0; i < 4; ++i)
#pragma unroll
            for (int r = 0; r < 16; ++r) mx[(32 * i + crow(r, hi)) * 256 + c] = acc[i][r];
    }
    __syncthreads();
    {
        const f32x4 g0 = *(const f32x4*)(vg + g * GDIM + cc * 8), g1 = *(const f32x4*)(vg + g * GDIM + cc * 8 + 4);
        float bb[8];
#pragma unroll
        for (int i = 0; i < 8; ++i) bb[i] = b_s[g * CHUNK + (tid >> 5) + 16 * i];
#pragma unroll
        for (int i = 0; i < 8; ++i) { const int t = (tid >> 5) + 16 * i;
            const f32x4 m0 = *(const LAS f32x4*)(lds + (t * 256 + cc * 8) * 4), m1 = *(const LAS f32x4*)(lds + (t * 256 + cc * 8 + 4) * 4);
            float y[8];
            y[0] = bf_lo(uu[i].x) * (m0[0] * g0[0] + bb[i]); y[1] = bf_hi(uu[i].x) * (m0[1] * g0[1] + bb[i]);
            y[2] = bf_lo(uu[i].y) * (m0[2] * g0[2] + bb[i]); y[3] = bf_hi(uu[i].y) * (m0[3] * g0[3] + bb[i]);
            y[4] = bf_lo(uu[i].z) * (m1[0] * g1[0] + bb[i]); y[5] = bf_hi(uu[i].z) * (m1[1] * g1[1] + bb[i]);
            y[6] = bf_lo(uu[i].w) * (m1[2] * g1[2] + bb[i]); y[7] = bf_hi(uu[i].w) * (m1[3] * g1[3] + bb[i]);
            u32x4 w; w.x = pk_bf16(y[0], y[1]); w.y = pk_bf16(y[2], y[3]); w.z = pk_bf16(y[4], y[5]); w.w = pk_bf16(y[6], y[7]);
            *(u32x4*)(Y + (row0 + t) * GW + g * GDIM + cc * 8) = w; }
    }
    __syncthreads();
}

__device__ __forceinline__ float wave_sum(float v) {
#pragma unroll
    for (int o = 1; o < 64; o <<= 1) v += __shfl_xor(v, o);
    return v;
}
__device__ __forceinline__ void tr_load(const float* __restrict__ W, int N, int item, int lane, f32x4 (&wv)[16]) {
    const int nblk = N / 64, k0 = 64 * (item / nblk), n0 = 64 * (item % nblk);
#pragma unroll
    for (int i = 0; i < 16; ++i) wv[i] = __builtin_nontemporal_load((const f32x4*)(W + (size_t)(k0 + 4 * i + (lane >> 4)) * N + n0 + 4 * (lane & 15)));
}
__device__ __forceinline__ void tr_to_lds(LAS float* scr, int lane, const f32x4 (&wv)[16]) {
#pragma unroll
    for (int i = 0; i < 16; ++i) { const int kk = 4 * i + (lane >> 4), nn = 4 * (lane & 15);
        LAS float* s = scr + kk * 65 + nn; s[0] = wv[i][0]; s[1] = wv[i][1]; s[2] = wv[i][2]; s[3] = wv[i][3]; }
    asm volatile("s_waitcnt lgkmcnt(0)" ::: "memory");
}
__device__ __forceinline__ void tr_store(int K, int N, bf16_t* __restrict__ WT, const LAS float* scr, int item, int lane, const float* __restrict__ gk, bool gmlp_perm) {
    const int nblk = N / 64, k0 = 64 * (item / nblk), n0 = 64 * (item % nblk);
    int r0 = n0;
    if (gmlp_perm) {
        if (n0 < GW) { const int cb = n0 >> 7; r0 = 256 * (3 * (cb >> 1) + (cb & 1)) + (n0 & 127); }
        else if (n0 < 2 * GW) { const int mv = n0 - GW; r0 = 256 * (3 * (mv >> 8) + 2) + (mv & 255); }
        else { const int mz = n0 - 2 * GW, cb = mz >> 7; r0 = 256 * (3 * (cb >> 1) + (cb & 1)) + 128 + (mz & 127); }
    }
    const int c = lane & 7;
    f32x4 ga = {1.f, 1.f, 1.f, 1.f}, gb = {1.f, 1.f, 1.f, 1.f};
    if (gk) { ga = *(const f32x4*)(gk + k0 + 8 * c); gb = *(const f32x4*)(gk + k0 + 8 * c + 4); }
#pragma unroll
    for (int j = 0; j < 8; ++j) { const int nn = (lane >> 3) + 8 * j; const LAS float* s = scr + (8 * c) * 65 + nn;
        u32x4 o; o.x = pk_bf16(s[0] * ga[0], s[65] * ga[1]); o.y = pk_bf16(s[2 * 65] * ga[2], s[3 * 65] * ga[3]); o.z = pk_bf16(s[4 * 65] * gb[0], s[5 * 65] * gb[1]); o.w = pk_bf16(s[6 * 65] * gb[2], s[7 * 65] * gb[3]);
        *(u32x4*)(WT + (size_t)(r0 + nn) * K + k0 + 8 * c) = o; }
    asm volatile("s_waitcnt lgkmcnt(0)" ::: "memory");
}
__device__ __forceinline__ void transpose_matrix(const float* __restrict__ W, int K, int N, bf16_t* __restrict__ WT, LAS float* scr, int first, int stride, int nitems, int lane,
                                                 const float* __restrict__ gk = nullptr, bool gmlp_perm = false) {
    f32x4 wv[16], wn[16];
    int it = first;
    if (it < nitems) tr_load(W, N, it, lane, wv);
    while (it < nitems) {
        const int nx = it + stride;
        tr_to_lds(scr, lane, wv);
        if (nx < nitems) tr_load(W, N, nx, lane, wn);
        tr_store(K, N, WT, scr, it, lane, gk, gmlp_perm);
#pragma unroll
        for (int i = 0; i < 16; ++i) wv[i] = wn[i];
        it = nx;
    }
}

#define XB_TMO      128
#define XB_XCNT(j)  (256  + 64 * (j))
#define XB_XSUB(j)  (1280 + 64 * (j))
#define XB_XGEN(j)  (2304 + 64 * (j))
#define XB_TOP      3328
#define XB_TOPGEN   3392
#define XCD_BAR_WORDS 3456
#define XB_SPIN_CAP (1u << 18)

__device__ __forceinline__ unsigned xb_ld(unsigned* p)              { return __hip_atomic_load(p, __ATOMIC_RELAXED, __HIP_MEMORY_SCOPE_AGENT); }
__device__ __forceinline__ unsigned xb_add(unsigned* p, unsigned v) { return __hip_atomic_fetch_add(p, v, __ATOMIC_RELAXED, __HIP_MEMORY_SCOPE_AGENT); }
__device__ __forceinline__ unsigned xb_xcc_id() { return (unsigned)__builtin_amdgcn_s_getreg((3 << 11) | 20) & 0xFu; }
#define XB_SPIN(cond, bar) do { unsigned _sp = 0; while (cond) { __builtin_amdgcn_s_sleep(1); \
    if ((++_sp & 255u) == 0u) { if (xb_ld(&(bar)[XB_TMO])) break; if (_sp > XB_SPIN_CAP) { atomicAdd(&(bar)[XB_TMO], 1u); break; } } } } while (0)

struct XcdBarrier {
    unsigned* bar; unsigned x; int w;
    volatile LAS unsigned* st;
};

__device__ __forceinline__ XcdBarrier xcd_barrier_post(unsigned* bar, volatile LAS unsigned* st, int wave) {
    XcdBarrier b; b.bar = bar; b.x = xb_xcc_id(); b.st = st; b.w = wave;
    if (tid_of(wave) == 0) (void)xb_add(&bar[XB_XCNT(b.x)], 1u);
    return b;
}
__device__ __forceinline__ void xcd_barrier_complete(unsigned* bar, unsigned x, unsigned& nloc, unsigned& nx) {
    const unsigned G = gridDim.x * gridDim.y * gridDim.z;
    unsigned sum, cnt, mine, sp = 0u;
    for (;;) {
        sum = 0u; cnt = 0u; mine = 0u;
#pragma unroll
        for (unsigned j = 0; j < 16; ++j) { const unsigned c = xb_ld(&bar[XB_XCNT(j)]); sum += c; cnt += (c > 0u) ? 1u : 0u; mine = (j == x) ? c : mine; }
        if (sum == G) break;
        __builtin_amdgcn_s_sleep(1);
        if ((++sp & 255u) == 0u) { if (xb_ld(&bar[XB_TMO])) break; if (sp > XB_SPIN_CAP) { atomicAdd(&bar[XB_TMO], 1u); break; } }
    }
    nloc = mine > 0u ? mine : 1u; nx = cnt > 0u ? cnt : 1u;
}

__device__ __forceinline__ void xcd_barrier(const XcdBarrier& b) {
    asm volatile("s_waitcnt vmcnt(0)" ::: "memory");
    __syncthreads();
    if (tid_of(b.w) == 0) {
        unsigned* bar = b.bar;
        __builtin_amdgcn_s_waitcnt(0);
        unsigned nloc = b.st[0], nx = b.st[1];
        if (nloc == 0u) { xcd_barrier_complete(bar, b.x, nloc, nx); b.st[0] = nloc; b.st[1] = nx; }
        const unsigned old = xb_add(&bar[XB_XSUB(b.x)], 1u);
        const unsigned gen = old / nloc;
        if (old + 1u == (gen + 1u) * nloc) {
            __builtin_amdgcn_fence(__ATOMIC_RELEASE, "agent");
            asm volatile("s_waitcnt vmcnt(0)" ::: "memory");
            const unsigned og = xb_add(&bar[XB_TOP], 1u);
            const unsigned tg = og / nx;
            if (og + 1u == (tg + 1u) * nx) xb_add(&bar[XB_TOPGEN], 1u);
            else XB_SPIN(xb_ld(&bar[XB_TOPGEN]) == tg, bar);
            __builtin_amdgcn_fence(__ATOMIC_ACQUIRE, "agent");
            xb_add(&bar[XB_XGEN(b.x)], 1u);
            asm volatile("s_waitcnt vmcnt(0)" ::: "memory");
        } else {
            XB_SPIN(xb_ld(&bar[XB_XGEN(b.x)]) == gen, bar);
            __builtin_amdgcn_fence(__ATOMIC_ACQUIRE, "agent");
            asm volatile("s_waitcnt vmcnt(0)" ::: "memory");
        }
    }
    __syncthreads();
}

constexpr size_t MiB = 1u << 20;
constexpr size_t WS_VSS = 0, WS_HSS1 = 2 * MiB, WS_HSS2 = 3 * MiB, WS_IRS0 = 3 * MiB + 32768, WS_CNT = 3 * MiB + 65536;
constexpr size_t WS_WT1 = 4 * MiB, WS_HN0 = 268 * MiB  , WS_WT2 = 84 * MiB, WS_WT3 = 100 * MiB, WS_WT4 = 132 * MiB;
constexpr size_t WS_U = 140 * MiB, WS_V = 204 * MiB, WS_ZS = 268 * MiB, WS_CTL = 364 * MiB, CTL_ZERO_BYTES = 32768, WS_END = 365 * MiB;
constexpr size_t WS_Y = 4 * MiB;
constexpr size_t WS_H1 = 140 * MiB, WS_H1B = 332 * MiB;
constexpr size_t WS_Q = 204 * MiB, WS_K = 236 * MiB, WS_V2 = 268 * MiB, WS_ZS2 = 300 * MiB, WS_OG = 4 * MiB;

constexpr int NWAVES = 8, LDS_BYTES = 151552;
#ifndef N_LAUNCHES
#define N_LAUNCHES 1
#endif
constexpr int N_PHASES = 7;
#ifndef CONV_TRIGGER
#define CONV_TRIGGER ((bx >> 3) % 6)
#endif
#ifndef GEMM_SP2
#define GEMM_SP2 true
#endif
#ifndef GEMM_ALIGN
#define GEMM_ALIGN true
#endif
#ifndef REPEAT_PHASE
#define REPEAT_PHASE -1
#endif
#define NREP(k) ((REPEAT_PHASE == (k)) ? 2 : 1)

struct Args { const float* in[10]; float* out; unsigned char* ws; int ph_lo, ph_hi, li, pad; };

__global__ void __launch_bounds__(NWAVES * 64, 2) fwd_kernel(Args a) {
    extern __shared__ __attribute__((aligned(16))) unsigned char lds_raw[];
    LAS unsigned char* lds = (LAS unsigned char*)lds_raw;
    cg::grid_group grid = cg::this_grid();
    const int wave = __builtin_amdgcn_readfirstlane(threadIdx.x >> 6);
#define tid tid_of(wave)
#define lane lane_id()
    const int G = gridDim.x, bx = blockIdx.x;
    const int vcu = (G % 8 == 0) ? (bx % 8) * (G / 8) + bx / 8 : bx;
    const float* x = a.in[0]; const float* norm_g = a.in[1]; const float* a_w_in = a.in[2]; const float* a_vg = a.in[3]; const float* a_w_s = a.in[4];
    const float* a_b_s = a.in[5]; const float* a_w_out = a.in[6]; const float* b_w_in = a.in[7]; const float* b_w_out = a.in[8]; const float* final_g = a.in[9];
    unsigned char* ws = a.ws;
    float* VSS = (float*)(ws + WS_VSS); float* HSS1 = (float*)(ws + WS_HSS1); float* HSS2 = (float*)(ws + WS_HSS2); float* IRS0 = (float*)(ws + WS_IRS0); unsigned* CNT = (unsigned*)(ws + WS_CNT);
    bf16_t* WT1 = (bf16_t*)(ws + WS_WT1); bf16_t* WT2 = (bf16_t*)(ws + WS_WT2); bf16_t* WT3 = (bf16_t*)(ws + WS_WT3); bf16_t* WT4 = (bf16_t*)(ws + WS_WT4);
    bf16_t* HN0 = (bf16_t*)(ws + WS_HN0); bf16_t* U = (bf16_t*)(ws + WS_U); bf16_t* V = (bf16_t*)(ws + WS_V); bf16_t* ZS = (bf16_t*)(ws + WS_ZS);
    bf16_t* Y = (bf16_t*)(ws + WS_Y); bf16_t* H1B = (bf16_t*)(ws + WS_H1B);
    bf16_t* Qb = (bf16_t*)(ws + WS_Q); bf16_t* Kb = (bf16_t*)(ws + WS_K); bf16_t* V2 = (bf16_t*)(ws + WS_V2); bf16_t* ZS2 = (bf16_t*)(ws + WS_ZS2); bf16_t* OG = (bf16_t*)(ws + WS_OG);
    const int lo = a.ph_lo, hi = a.ph_hi;
#define IN(k) (lo <= (k) && (k) < hi)
#define SEAM(k) do { if (IN(k) && IN((k) + 1)) xcd_barrier(bar); } while (0)
    volatile LAS unsigned* MISC = (volatile LAS unsigned*)(lds + LDS_BYTES - 64);
    if (tid < 16) MISC[tid] = 0u;
    __syncthreads();
    XcdBarrier bar = xcd_barrier_post((unsigned*)(ws + WS_CTL) + a.li * XCD_BAR_WORDS, MISC + 8, wave);
    if (lo > 1000) grid.sync();
    const int gw = vcu * NWAVES + wave, NGW = G * NWAVES;

    if (IN(0)) for (int rep = 0; rep < NREP(0); ++rep) {
        LAS float* scr = (LAS float*)(lds + wave * 16640);
        constexpr int I1 = (DM / 64) * (3 * GW / 64), I2 = (GW / 64) * (DM / 64), I3 = (DM / 64) * (4 * DM / 64), I4 = (DM / 64) * (DM / 64);
        transpose_matrix(a_w_in, DM, 3 * GW, WT1, scr, gw, NGW, I1, lane, nullptr, true);
        for (int m = bx * (NWAVES * 64) + tid; m < NTOK; m += G * NWAVES * 64) { HSS1[m] = 0.f; HSS2[m] = 0.f; if (m < 2048) CNT[m] = 0u; }
        for (int m = gw; m < NTOK; m += NGW) {
            const f32x4* xr = (const f32x4*)(x + (size_t)m * DM) + lane; const f32x4* gr = (const f32x4*)norm_g + lane;
            f32x4 v[8]; float ss = 0.f;
#pragma unroll
            for (int j = 0; j < 8; ++j) { v[j] = __builtin_nontemporal_load(xr + 64 * j); ss += (v[j][0] * v[j][0] + v[j][1] * v[j][1]) + (v[j][2] * v[j][2] + v[j][3] * v[j][3]); }
            const float ms = wave_sum(ss) * (1.0f / DM) + EPS;
            const float rstd = __builtin_amdgcn_rsqf(ms);
            if (lane == 0) IRS0[m] = __builtin_amdgcn_sqrtf(ms);
            u32x2* o8 = (u32x2*)(HN0 + (size_t)m * DM) + lane;
#pragma unroll
            for (int j = 0; j < 8; ++j) { const f32x4 gg = gr[64 * j]; u32x2 w; w.x = pk_bf16(v[j][0] * rstd * gg[0], v[j][1] * rstd * gg[1]); w.y = pk_bf16(v[j][2] * rstd * gg[2], v[j][3] * rstd * gg[3]); o8[64 * j] = w; }
        }
    }
    SEAM(0);
#ifdef EXTRA_SYNCS
    for (int i = 0; i < EXTRA_SYNCS; ++i) xcd_barrier(bar);
#endif
    if (IN(1)) for (int rep = 0; rep < NREP(1); ++rep) {
        pg8::Gemm g{HN0, WT1, NTOK, 3 * GW, DM}; pg8::ConvOrder S; S.init(NTOK, 3 * GW, G, bx);
        S.w2 = a_w_out; S.w3 = b_w_in; S.w4 = b_w_out; S.g1 = norm_g + DM; S.t2 = WT2; S.t3 = WT3; S.t4 = WT4; S.gw = gw; S.ngw = NGW; S.trigger = (G == 256) ? CONV_TRIGGER : 0; S.ln = lane; S.sw = lds + 131072 + wave * 2048; S.n_done = 0;
        pg8::EpiGmlpIn E{U, V, VSS};
        pg8::gemm_phase<pg8::EpiGmlpIn, pg8::ConvOrder, GEMM_ALIGN, GEMM_SP2>(lds, g, S, E, wave);
    }
    SEAM(1);
    if (IN(2)) for (int rep = 0; rep < NREP(2); ++rep) {
        for (int it = vcu; it < (NTOK / CHUNK) * NGRP; it += G) mix_unit(lds, wave, it >> 4, it & 15, U, V, VSS, a_w_s, a_b_s, a_vg, Y);
    }
    SEAM(2);
    if (IN(3)) for (int rep = 0; rep < NREP(3); ++rep) {
        pg8::Gemm g{Y, WT2, NTOK, DM, GW}; pg8::StaticOrder S; S.init(NTOK, DM, G, bx);
        pg8::EpiRes1 E{HN0, IRS0, norm_g, H1B, HSS1};
        pg8::gemm_phase<pg8::EpiRes1, pg8::StaticOrder, GEMM_ALIGN, GEMM_SP2>(lds, g, S, E, wave);
    }
    SEAM(3);
    if (IN(4)) for (int rep = 0; rep < NREP(4); ++rep) {
        pg8::Gemm g{H1B, WT3, NTOK, 4 * DM, DM}; pg8::StaticOrder S; S.init(NTOK, 4 * DM, G, bx);
        pg8::EpiSbIn E{Qb, (size_t)(WS_K - WS_Q) / 2, HSS1};
        pg8::gemm_phase<pg8::EpiSbIn, pg8::StaticOrder, GEMM_ALIGN, GEMM_SP2>(lds, g, S, E, wave);
    }
    SEAM(4);
    if (IN(5)) for (int rep = 0; rep < NREP(5); ++rep) attn_phase(lds, wave, vcu, G, Qb, Kb, V2, ZS2, OG);
    SEAM(5);
    if (IN(6)) for (int rep = 0; rep < NREP(6); ++rep) {
        pg8::Gemm g{OG, WT4, NTOK, DM, DM}; pg8::StaticOrder S; S.init(NTOK, DM, G, bx);
        pg8::EpiFinal E{H1B, final_g, a.out, HSS2, CNT, G == 256};
        pg8::gemm_phase<pg8::EpiFinal, pg8::StaticOrder, GEMM_ALIGN, GEMM_SP2>(lds, g, S, E, wave);
    }
    if (IN(6) && G != 256) {
        xcd_barrier(bar);
        for (int m = gw; m < NTOK; m += NGW) {
            const float rstd = __builtin_amdgcn_rsqf(HSS2[m] * (1.0f / DM) + EPS);
            f32x4* orow = (f32x4*)(a.out + (size_t)m * DM) + lane; const f32x4* gr = (const f32x4*)final_g + lane;
#pragma unroll
            for (int j = 0; j < 8; ++j) { const f32x4 v = orow[64 * j]; orow[64 * j] = v * rstd * gr[64 * j]; }
        }
    }
#undef IN
#undef SEAM
#undef tid
#undef lane
}

extern "C" void kernel_launch(void* const* d_in, const int* in_sizes, int n_in, void* d_out, int out_size, void* d_ws, size_t ws_size, hipStream_t stream) {
    static int grid = 0;
    if (grid == 0) {
        if (n_in != 10 || out_size != NTOK * DM || ws_size < WS_END) { fprintf(stderr, "kernel_launch: unexpected shapes (n_in %d, out %d, ws %zu)\n", n_in, out_size, ws_size); grid = -1; return; }
        int dev = 0, cus = 0, per_cu = 0;
        (void)hipGetDevice(&dev); (void)hipDeviceGetAttribute(&cus, hipDeviceAttributeMultiprocessorCount, dev);
        if (hipFuncSetAttribute((const void*)fwd_kernel, hipFuncAttributeMaxDynamicSharedMemorySize, LDS_BYTES) != hipSuccess) { fprintf(stderr, "kernel_launch: hipFuncSetAttribute failed\n"); grid = -1; return; }
        if (hipOccupancyMaxActiveBlocksPerMultiprocessor(&per_cu, (const void*)fwd_kernel, NWAVES * 64, LDS_BYTES) != hipSuccess || per_cu < 1) { fprintf(stderr, "kernel_launch: occupancy query says %d\n", per_cu); per_cu = 1; }
        (void)hipGetLastError();
        grid = cus > 0 ? cus : 256;
    }
    if (grid < 0) return;
    if (hipMemsetAsync((char*)d_ws + WS_CTL, 0, CTL_ZERO_BYTES, stream) != hipSuccess) { fprintf(stderr, "kernel_launch: memset failed\n"); return; }
    Args a{};
    for (int i = 0; i < 10; ++i) a.in[i] = (const float*)d_in[i];
    a.out = (float*)d_out; a.ws = (unsigned char*)d_ws;
#ifdef PROBE_SPLIT
    const int nl = 2;
#else
    const int nl = N_LAUNCHES;
#endif
    for (int li = 0; li < nl; ++li) {
        a.ph_lo = (N_LAUNCHES == 1) ? 0 : li; a.ph_hi = (N_LAUNCHES == 1) ? N_PHASES : li + 1;
#ifdef PROBE_SPLIT
        a.ph_lo = li == 0 ? 0 : PROBE_SPLIT; a.ph_hi = li == 0 ? PROBE_SPLIT + 1 : N_PHASES;
#endif
        a.li = li;
        void* args[] = {&a};
        hipError_t e = hipLaunchCooperativeKernel((const void*)fwd_kernel, dim3(grid), dim3(NWAVES * 64), args, LDS_BYTES, stream);
        if (e != hipSuccess) { fprintf(stderr, "kernel_launch: cooperative launch %d failed: %s (grid %d)\n", li, hipGetErrorString(e), grid); break; }
    }
}
```

```cpp
#include <hip/hip_runtime.h>
#include <hip/hip_cooperative_groups.h>
#include <cstdio>
#include <cstdint>
namespace cg = cooperative_groups;
__device__ __forceinline__ int lane_id() { return (int)__builtin_amdgcn_mbcnt_hi(~0u, __builtin_amdgcn_mbcnt_lo(~0u, 0u)); }
__device__ __forceinline__ int tid_of(int wave) { return wave * 64 + lane_id(); }
#ifndef PG8_WGM
#define PG8_WGM 8
#endif
namespace pg8 {
#define PG8_LAS __attribute__((address_space(3)))
typedef unsigned short bf16_t;
typedef short bf16x8 __attribute__((ext_vector_type(8)));
typedef float f32x4 __attribute__((ext_vector_type(4)));
typedef unsigned u32x4 __attribute__((ext_vector_type(4)));
constexpr int BM = 256, BK = 64, HALF = 128, HTB = HALF * BK * 2  , STAGE_BYTES = 8 * HTB, NXCD = 8, WGM = PG8_WGM;

__host__ __device__ __forceinline__ int lds_byte(int r, int c) { const int st = (r >> 4) * 2 + (c >> 5), rr = r & 15, cc = c & 31, ob = rr * 64 + cc * 2; return st * 1024 + (ob ^ (((ob >> 9) & 1) << 5)); }
__host__ __device__ __forceinline__ void stage_rc(int b, int& R, int& C) { const int st = b / 1024, sb = b % 1024, swz = sb ^ (((sb >> 9) & 1) << 5); R = (st >> 1) * 16 + swz / 64; C = (st & 1) * 32 + (swz % 64) / 2; }
__host__ __device__ __forceinline__ int perm32(int rho) { const int n = rho >> 4, i = rho & 15; return 8 * (i >> 2) + 4 * n + (i & 3); }

struct Unit { int pm, pn; };
struct Gemm { const bf16_t* A; const bf16_t* Bt; int M, N, K; };

struct StaticOrder {
    int nM, nN, nwg, G, c;
    __host__ __device__ void init(int M, int N, int G_, int c_) { nM = M / BM; nN = N / BM; nwg = nM * nN; G = G_; c = c_; }
    __host__ __device__ bool next(int i, Unit& u) const {
        const long L = (long)i * G + c; if (L >= nwg) return false;
        int wgid = (int)L; { const int q = nwg / NXCD, r = nwg % NXCD, xcd = wgid % NXCD, off = wgid / NXCD; wgid = (xcd < r ? xcd * (q + 1) : r * (q + 1) + (xcd - r) * q) + off; }
        const int nig = WGM * nN, gid = wgid / nig, fm = gid * WGM, gsz = (nM - fm) < WGM ? (nM - fm) : WGM;
        u.pm = fm + ((wgid % nig) % gsz); u.pn = (wgid % nig) / gsz; return true;
    }
    __device__ __forceinline__ void a_ready(const Unit&) const {}
    __device__ __forceinline__ void done(const Unit&) const {}
};

__device__ __forceinline__ unsigned cvt_pk_bf16(float lo, float hi) { unsigned r; asm volatile("v_cvt_pk_bf16_f32 %0, %1, %2" : "=v"(r) : "v"(lo), "v"(hi)); return r; }
typedef float f32x2 __attribute__((ext_vector_type(2)));
typedef float f32x2 __attribute__((ext_vector_type(2)));
template <class Epi, class Sched, bool ALIGN_EPI = false, bool SP2 = false>
__device__ __forceinline__ void gemm_phase(PG8_LAS unsigned char* lds, const Gemm g, const Sched& S, const Epi& E, const int wave_) {
    const int tid = tid_of(wave_), wid = wave_, lane = tid & 63, wr = wid >> 2, wc = wid & 3, fr = lane & 15, fq = lane >> 4;
    const int K = g.K, nt = K / BK;
    unsigned voffA[2], voffB[2];
#pragma unroll
    for (int i = 0; i < 2; ++i) { int R, C; stage_rc(tid * 16 + i * 8192, R, C); const int Rb = Epi::PERM ? ((R & ~31) + perm32(R & 31)) : R;
        voffA[i] = (unsigned)(R * K + C) * 2u; voffB[i] = (unsigned)(Rb * K + C) * 2u; }
    const size_t kstep = (size_t)(BK * 2);
    const size_t hstep = (size_t)HALF * K * 2;
    const size_t tstep = 2 * hstep;
    const unsigned ldsw = (unsigned)wid * 1024u;
    const int aoff = lds_byte(wr * 64 + fr, fq * 8), boff = lds_byte(wc * 32 + fr, fq * 8);
#define PG8_SA(b, h) (((b) * 2 + (h)) * HTB)
#define PG8_SB(b, h) ((4 + (b) * 2 + (h)) * HTB)
#define PG8_STAGE(bufoff, gbase, voff) do { _Pragma("unroll") for (int _i = 0; _i < 2; ++_i) \
        __builtin_amdgcn_global_load_lds((const unsigned*)((const char*)(gbase) + (voff)[_i]), (PG8_LAS unsigned*)(lds + (bufoff) + ldsw + _i * 8192), 16, 0, 0); } while (0)
#define PG8_LDA(dst, b, h) do { _Pragma("unroll") for (int m = 0; m < 4; ++m) _Pragma("unroll") for (int k = 0; k < 2; ++k) dst[m][k] = *(const PG8_LAS bf16x8*)(lds + PG8_SA(b, h) + aoff + m * 2048 + k * 1024); } while (0)
#define PG8_LDB(dst, b, h) do { _Pragma("unroll") for (int n = 0; n < 2; ++n) _Pragma("unroll") for (int k = 0; k < 2; ++k) dst[n][k] = *(const PG8_LAS bf16x8*)(lds + PG8_SB(b, h) + boff + n * 2048 + k * 1024); } while (0)
#define PG8_MMA(ai, bj, At, Bt) do { __builtin_amdgcn_s_setprio(1); _Pragma("unroll") for (int m = 0; m < 4; ++m) _Pragma("unroll") for (int n = 0; n < 2; ++n) _Pragma("unroll") for (int k = 0; k < 2; ++k) \
        acc[ai][bj][m][n] = __builtin_amdgcn_mfma_f32_16x16x32_bf16(Bt[n][k], At[m][k], acc[ai][bj][m][n], 0, 0, 0); __builtin_amdgcn_s_setprio(0); } while (0)
#define PG8_WAIT_V(n) asm volatile("s_waitcnt vmcnt(" #n ")" ::: "memory")
#define PG8_WAIT_L(n) asm volatile("s_waitcnt lgkmcnt(" #n ")" ::: "memory")
#define PG8_BAR __builtin_amdgcn_s_barrier()
#define PG8_SCHED __builtin_amdgcn_sched_barrier(0)
    Unit cur, nxt; int ui = 0;
    if (!S.next(0, cur)) return;
    f32x4 acc[2][2][4][2];
#pragma unroll
    for (int a = 0; a < 2; ++a)
#pragma unroll
        for (int b = 0; b < 2; ++b)
#pragma unroll
            for (int m = 0; m < 4; ++m)
#pragma unroll
                for (int n = 0; n < 2; ++n) acc[a][b][m][n] = (f32x4){0.f, 0.f, 0.f, 0.f};
    bf16x8 At[4][2], B0[2][2], B1[2][2];
    const char* cA = (const char*)g.A + (size_t)cur.pm * tstep; const char* cB = (const char*)g.Bt + (size_t)cur.pn * tstep;
    S.a_ready(cur);
    if constexpr (SP2) {
        PG8_STAGE(PG8_SB(0, 0), cB, voffB); PG8_STAGE(PG8_SB(0, 1), cB + hstep, voffB); PG8_STAGE(PG8_SA(0, 0), cA, voffA); PG8_STAGE(PG8_SA(0, 1), cA + hstep, voffA);
        if (wr == 1) PG8_BAR;
        PG8_WAIT_V(2); PG8_BAR;
        PG8_STAGE(PG8_SB(1, 0), cB + kstep, voffB); PG8_STAGE(PG8_SA(1, 0), cA + kstep, voffA); PG8_STAGE(PG8_SB(1, 1), cB + hstep + kstep, voffB);
        PG8_WAIT_V(6); PG8_BAR;
    } else {
        PG8_STAGE(PG8_SB(0, 0), cB, voffB); PG8_STAGE(PG8_SA(0, 0), cA, voffA); PG8_STAGE(PG8_SB(0, 1), cB + hstep, voffB); PG8_STAGE(PG8_SA(0, 1), cA + hstep, voffA);
        if (wr == 1) PG8_BAR;
        PG8_WAIT_V(4); PG8_BAR;
        PG8_STAGE(PG8_SB(1, 0), cB + kstep, voffB); PG8_STAGE(PG8_SA(1, 0), cA + kstep, voffA); PG8_STAGE(PG8_SB(1, 1), cB + hstep + kstep, voffB);
        PG8_WAIT_V(6); PG8_BAR;
    }
    for (;;) {
        const bool has_next = S.next(ui + 1, nxt);
        const char* nA = has_next ? (const char*)g.A + (size_t)nxt.pm * tstep : cA; const char* nB = has_next ? (const char*)g.Bt + (size_t)nxt.pn * tstep : cB;
        for (int t = 0; t < nt; t += 2) {
            const bool last = (t == nt - 2);
            const char* a1 = cA + (size_t)(t + 1) * kstep;
            const char* a2 = last ? nA : cA + (size_t)(t + 2) * kstep; const char* b2 = last ? nB : cB + (size_t)(t + 2) * kstep;
            const char* a3 = a2 + kstep; const char* b3 = b2 + kstep;
            if (last && has_next) S.a_ready(nxt);
            if constexpr (SP2) {
            PG8_LDB(B0, 0, 0); PG8_LDB(B1, 0, 1); PG8_SCHED; PG8_LDA(At, 0, 0); PG8_STAGE(PG8_SA(1, 1), a1 + hstep, voffA);
            PG8_WAIT_V(8); PG8_WAIT_L(0); PG8_BAR; PG8_MMA(0, 0, At, B0); PG8_MMA(0, 1, At, B1); PG8_BAR; PG8_SCHED;
            PG8_LDA(At, 0, 1); PG8_STAGE(PG8_SB(0, 0), b2, voffB); PG8_STAGE(PG8_SB(0, 1), b2 + hstep, voffB); PG8_STAGE(PG8_SA(0, 0), a2, voffA);
            PG8_WAIT_V(8); PG8_WAIT_L(0); PG8_BAR; PG8_MMA(1, 0, At, B0); PG8_MMA(1, 1, At, B1); PG8_BAR; PG8_SCHED;
            PG8_LDB(B0, 1, 0); PG8_LDB(B1, 1, 1); PG8_SCHED; PG8_LDA(At, 1, 0); PG8_STAGE(PG8_SA(0, 1), a2 + hstep, voffA);
            PG8_WAIT_V(8); PG8_WAIT_L(0); PG8_BAR; PG8_MMA(0, 0, At, B0); PG8_MMA(0, 1, At, B1); PG8_BAR; PG8_SCHED;
            PG8_LDA(At, 1, 1); PG8_STAGE(PG8_SB(1, 0), b3, voffB); PG8_STAGE(PG8_SB(1, 1), b3 + hstep, voffB); PG8_STAGE(PG8_SA(1, 0), a3, voffA);
            PG8_WAIT_V(8); PG8_WAIT_L(0); PG8_BAR; PG8_MMA(1, 0, At, B0); PG8_MMA(1, 1, At, B1); PG8_BAR; PG8_SCHED;
            } else {
            PG8_LDB(B0, 0, 0); PG8_SCHED; PG8_LDA(At, 0, 0); PG8_STAGE(PG8_SA(1, 1), a1 + hstep, voffA);
            PG8_WAIT_L(8); PG8_BAR; PG8_WAIT_L(0); PG8_MMA(0, 0, At, B0); PG8_BAR; PG8_SCHED;
            PG8_LDB(B1, 0, 1); PG8_STAGE(PG8_SB(0, 0), b2, voffB);
            PG8_BAR; PG8_WAIT_L(0); PG8_MMA(0, 1, At, B1); PG8_BAR;
            PG8_LDA(At, 0, 1); PG8_STAGE(PG8_SA(0, 0), a2, voffA);
            PG8_BAR; PG8_WAIT_L(0); PG8_MMA(1, 0, At, B0); PG8_BAR; PG8_SCHED;
            PG8_STAGE(PG8_SB(0, 1), b2 + hstep, voffB);
            PG8_WAIT_V(6); PG8_BAR; PG8_MMA(1, 1, At, B1); PG8_BAR;
            PG8_LDB(B0, 1, 0); PG8_SCHED; PG8_LDA(At, 1, 0); PG8_STAGE(PG8_SA(0, 1), a2 + hstep, voffA);
            PG8_WAIT_L(8); PG8_BAR; PG8_WAIT_L(0); PG8_MMA(0, 0, At, B0); PG8_BAR; PG8_SCHED;
            PG8_LDB(B1, 1, 1); PG8_STAGE(PG8_SB(1, 0), b3, voffB);
            PG8_BAR; PG8_WAIT_L(0); PG8_MMA(0, 1, At, B1); PG8_BAR;
            PG8_LDA(At, 1, 1); PG8_STAGE(PG8_SA(1, 0), a3, voffA);
            PG8_BAR; PG8_WAIT_L(0); PG8_MMA(1, 0, At, B0); PG8_BAR; PG8_SCHED;
            PG8_STAGE(PG8_SB(1, 1), b3 + hstep, voffB);
            PG8_WAIT_V(6); PG8_BAR; PG8_MMA(1, 1, At, B1); PG8_BAR;
            }
        }
        if constexpr (ALIGN_EPI) { if (wr == 0) PG8_BAR; }
        if constexpr (!Epi::AFTER_DRAIN) { E(acc, cur, wr, wc, fr, fq); S.done(cur); }
        if (!has_next) break;
#pragma unroll
        for (int a = 0; a < 2; ++a)
#pragma unroll
            for (int b = 0; b < 2; ++b)
#pragma unroll
                for (int m = 0; m < 4; ++m)
#pragma unroll
                    for (int n = 0; n < 2; ++n) acc[a][b][m][n] = (f32x4){0.f, 0.f, 0.f, 0.f};
        cur = nxt; cA = nA; cB = nB; ++ui;
        if constexpr (ALIGN_EPI) { if (wr == 1) PG8_BAR; }
    }
    PG8_WAIT_V(0);
    if constexpr (!ALIGN_EPI) { if (wr == 0) PG8_BAR; }
    PG8_BAR;
    if constexpr (Epi::AFTER_DRAIN) { E.fused(acc, cur, wr, wc, fr, fq, lds, wid, lane); S.done(cur); }
#undef PG8_SA
#undef PG8_SB
#undef PG8_STAGE
#undef PG8_LDA
#undef PG8_LDB
#undef PG8_MMA
#undef PG8_WAIT_V
#undef PG8_WAIT_L
#undef PG8_BAR
#undef PG8_SCHED
}
}

constexpr int DM = 2048, NTOK = 8192, SEQ = 4096, GW = 4096, NGRP = 16, GDIM = 256, CHUNK = 128, NHEAD = 16, HD = 128;
constexpr float EPS = 1e-6f;
constexpr float LOG2E = 1.4426950408889634f;
constexpr float QSCALE = 0.08838834764831845f * LOG2E;

constexpr float GELU_C1 = -1.5957691216057308f * LOG2E, GELU_C2 = -0.07135481627260025f * LOG2E;
__device__ __forceinline__ float gelu_tanh(float x) {
    const float e = __builtin_amdgcn_exp2f(x * __builtin_fmaf(x * x, GELU_C2, GELU_C1));
    return x * __builtin_amdgcn_rcpf(1.0f + e);
}
__device__ __forceinline__ float gelu_silu(float u, float z) {
    const float e1 = __builtin_amdgcn_exp2f(u * __builtin_fmaf(u * u, GELU_C2, GELU_C1));
    const float e2 = __builtin_amdgcn_exp2f(z * -LOG2E);
    return (u * z) * __builtin_amdgcn_rcpf((1.0f + e1) * (1.0f + e2));
}
__device__ __forceinline__ float silu_f(float z) { return z * __builtin_amdgcn_rcpf(1.0f + __builtin_amdgcn_exp2f(-LOG2E * z)); }

namespace pg8 {
typedef unsigned u32x2 __attribute__((ext_vector_type(2)));
__device__ __forceinline__ void conv_load4(const float* __restrict__ W, int N, int item, int lane, f32x4 (&x)[16]) {
    const int nblk = N / 64, k0 = 64 * (item / nblk), n0 = 64 * (item % nblk);
#pragma unroll
    for (int i = 0; i < 16; ++i) x[i] = __builtin_nontemporal_load((const f32x4*)(W + (size_t)(k0 + 4 * i + (lane >> 4)) * N + n0 + 4 * (lane & 15)));
}
__device__ __forceinline__ void conv_xpose(f32x4 (&x)[16], int lane) {
    const bool a = (lane >> 4) & 1, b = (lane >> 5) & 1;
#pragma unroll
    for (int i = 0; i < 16; ++i) {
        f32x4 v = x[i];
        {
            const float s0 = a ? v[0] : v[1], s1 = a ? v[2] : v[3];
            const float r0 = __shfl_xor(s0, 16), r1 = __shfl_xor(s1, 16);
            if (a) { v[0] = r0; v[2] = r1; } else { v[1] = r0; v[3] = r1; }
        }
        {
            const float s0 = b ? v[0] : v[2], s1 = b ? v[1] : v[3];
            const float r0 = __shfl_xor(s0, 32), r1 = __shfl_xor(s1, 32);
            if (b) { v[0] = r0; v[1] = r1; } else { v[2] = r0; v[3] = r1; }
        }
        x[i] = v;
    }
}
__device__ __forceinline__ void conv_store4(int K, int N, bf16_t* __restrict__ WT, int item, int lane, const float* __restrict__ gk, const f32x4 (&x)[16]) {
    const int nblk = N / 64, k0 = 64 * (item / nblk), n0 = 64 * (item % nblk);
    const int n = n0 + 4 * (lane & 15) + (lane >> 4);
#pragma unroll
    for (int kc = 0; kc < 8; ++kc) {
        float g[8];
#pragma unroll
        for (int j = 0; j < 8; ++j) g[j] = gk ? gk[k0 + 8 * kc + j] : 1.0f;
        const f32x4 lo = x[2 * kc], hi = x[2 * kc + 1];
        u32x4 o; o.x = cvt_pk_bf16(lo[0] * g[0], lo[1] * g[1]); o.y = cvt_pk_bf16(lo[2] * g[2], lo[3] * g[3]);
        o.z = cvt_pk_bf16(hi[0] * g[4], hi[1] * g[5]); o.w = cvt_pk_bf16(hi[2] * g[6], hi[3] * g[7]);
        *(u32x4*)(WT + (size_t)n * K + k0 + 8 * kc) = o;
    }
}
__device__ __forceinline__ void conv_store4_lds(int K, int N, bf16_t* __restrict__ WT, int item, int lane, const float* __restrict__ gk, const f32x4 (&x)[16], PG8_LAS unsigned char* sw) {
    const int nblk = N / 64, k0 = 64 * (item / nblk), n0 = 64 * (item % nblk);
    const int nq = lane & 15, r = lane >> 4;
    u32x4 o[8];
#pragma unroll
    for (int kc = 0; kc < 8; ++kc) {
        float g[8];
#pragma unroll
        for (int j = 0; j < 8; ++j) g[j] = gk ? gk[k0 + 8 * kc + j] : 1.0f;
        const f32x4 lo = x[2 * kc], hi = x[2 * kc + 1];
        o[kc].x = cvt_pk_bf16(lo[0] * g[0], lo[1] * g[1]); o[kc].y = cvt_pk_bf16(lo[2] * g[2], lo[3] * g[3]);
        o[kc].z = cvt_pk_bf16(hi[0] * g[4], hi[1] * g[5]); o[kc].w = cvt_pk_bf16(hi[2] * g[6], hi[3] * g[7]);
    }
#pragma unroll
    for (int q = 0; q < 4; ++q) {
        if ((nq >> 2) == q) {
            PG8_LAS u32x4* wp = (PG8_LAS u32x4*)(sw + (4 * (nq & 3) + r) * 128);
#pragma unroll
            for (int kc = 0; kc < 8; ++kc) wp[kc] = o[kc];
        }
        asm volatile("s_waitcnt lgkmcnt(0)" ::: "memory");
#pragma unroll
        for (int h = 0; h < 2; ++h) { const int rl = (lane >> 3) + 8 * h;
            const u32x4 v = *(const PG8_LAS u32x4*)(sw + rl * 128 + (lane & 7) * 16);
            *(u32x4*)(WT + (size_t)(n0 + 16 * q + rl) * K + k0 + 8 * (lane & 7)) = v; }
        asm volatile("s_waitcnt lgkmcnt(0)" ::: "memory");
    }
}
struct ConvOrder : StaticOrder {
    const float *w2, *w3, *w4, *g1; bf16_t *t2, *t3, *t4; int gw, ngw, trigger, ln; PG8_LAS unsigned char* sw; mutable int n_done;
    __device__ __forceinline__ void done(const Unit&) const {
        constexpr int I2 = (GW / 64) * (DM / 64), I3 = (DM / 64) * (4 * DM / 64), I4 = (DM / 64) * (DM / 64);
        const int u = n_done++;
#ifdef HOOK_SPREAD
        f32x4 va[16];
        if (u == 0 || u == 1) { for (int it = gw + u * ngw; it < I3; it += 2 * ngw) { conv_load4(w3, 4 * DM, it, ln, va); conv_xpose(va, ln); conv_store4(DM, 4 * DM, t3, it, ln, g1, va); } }
        else if (u == 2) { for (int it = gw; it < I2; it += ngw) { conv_load4(w2, DM, it, ln, va); conv_xpose(va, ln); conv_store4(GW, DM, t2, it, ln, nullptr, va); } }
        else if (u == 3) { for (int it = gw; it < I4; it += ngw) { conv_load4(w4, DM, it, ln, va); conv_xpose(va, ln); conv_store4(DM, DM, t4, it, ln, nullptr, va); } }
#else
        if (u != trigger) return;
        f32x4 va[16], vb[16];
        for (int it = gw; it < I3; it += 2 * ngw) {
            const bool two = it + ngw < I3;
            conv_load4(w3, 4 * DM, it, ln, va); if (two) conv_load4(w3, 4 * DM, it + ngw, ln, vb);
            conv_xpose(va, ln); if (two) conv_xpose(vb, ln);
            conv_store4_lds(DM, 4 * DM, t3, it, ln, g1, va, sw); if (two) conv_store4_lds(DM, 4 * DM, t3, it + ngw, ln, g1, vb, sw);
        }
        for (int it = gw; it < I2; it += ngw) {
            const bool two = it < I4;
            conv_load4(w2, DM, it, ln, va); if (two) conv_load4(w4, DM, it, ln, vb);
            conv_xpose(va, ln); if (two) conv_xpose(vb, ln);
            conv_store4_lds(GW, DM, t2, it, ln, nullptr, va, sw); if (two) conv_store4_lds(DM, DM, t4, it, ln, nullptr, vb, sw);
        }
#endif
    }
};
struct EpiGmlpIn {
    static constexpr bool PERM = true, AFTER_DRAIN = false;
    bf16_t *UZ, *V; float* vss;
    __device__ __forceinline__ void operator()(const f32x4 (&acc)[2][2][4][2], const Unit& u, int wr, int wc, int fr, int fq) const {
        const int row0 = u.pm * BM + wr * 64 + fr;
        const int tq = u.pn / 3, tr = u.pn - 3 * tq;
        if (tr < 2) {
            const int col0 = (2 * tq + tr) * HALF + wc * 32 + 8 * fq;
#pragma unroll
            for (int ai = 0; ai < 2; ++ai)
#pragma unroll
                for (int m = 0; m < 4; ++m) {
                    const int row = row0 + ai * HALF + m * 16;
                    f32x4 v0 = acc[ai][0][m][0], v1 = acc[ai][0][m][1]; const f32x4 z0 = acc[ai][1][m][0], z1 = acc[ai][1][m][1];
#pragma unroll
                    for (int e = 0; e < 4; ++e) { v0[e] = gelu_silu(v0[e], z0[e]); v1[e] = gelu_silu(v1[e], z1[e]); }
                    u32x4 w; w.x = cvt_pk_bf16(v0[0], v0[1]); w.y = cvt_pk_bf16(v0[2], v0[3]); w.z = cvt_pk_bf16(v1[0], v1[1]); w.w = cvt_pk_bf16(v1[2], v1[3]);
                    *(u32x4*)(UZ + (size_t)row * GW + col0) = w;
                }
        } else {
            const int tl = tq, col0 = tl * BM + wc * 32 + 8 * fq;
#pragma unroll
            for (int ai = 0; ai < 2; ++ai)
#pragma unroll
                for (int m = 0; m < 4; ++m) {
                    const int row = row0 + ai * HALF + m * 16;
                    bf16_t* rowp = V + (size_t)row * GW + col0;
                    float ss = 0.f;
#pragma unroll
                    for (int bj = 0; bj < 2; ++bj) {
                        f32x4 v0 = acc[ai][bj][m][0], v1 = acc[ai][bj][m][1];
#pragma unroll
                        for (int e = 0; e < 4; ++e) { v0[e] = gelu_tanh(v0[e]); v1[e] = gelu_tanh(v1[e]); ss += v0[e] * v0[e] + v1[e] * v1[e]; }
                        u32x4 w; w.x = cvt_pk_bf16(v0[0], v0[1]); w.y = cvt_pk_bf16(v0[2], v0[3]); w.z = cvt_pk_bf16(v1[0], v1[1]); w.w = cvt_pk_bf16(v1[2], v1[3]);
                        *(u32x4*)(rowp + bj * HALF) = w;
                    }
                    ss += __shfl_xor(ss, 16); ss += __shfl_xor(ss, 32);
                    if (fq == 0) vss[(size_t)row * 64 + tl * 4 + wc] = ss;
                }
        }
    }
};
struct EpiRes1 {
    static constexpr bool PERM = false, AFTER_DRAIN = false;
    const bf16_t* hn; const float* irs; const float* g0; bf16_t* hb; float* hss;
    __device__ __forceinline__ void operator()(const f32x4 (&acc)[2][2][4][2], const Unit& u, int wr, int wc, int fr, int fq) const {
        const int row0 = u.pm * BM + wr * 64 + fr, col0 = u.pn * BM + wc * 32 + 4 * fq;
        float rs[2][4];
#pragma unroll
        for (int ai = 0; ai < 2; ++ai)
#pragma unroll
            for (int m = 0; m < 4; ++m) rs[ai][m] = irs[row0 + ai * HALF + m * 16];
        f32x4 ig[2][2];
#pragma unroll
        for (int bj = 0; bj < 2; ++bj)
#pragma unroll
            for (int n = 0; n < 2; ++n) { const f32x4 gv = *(const f32x4*)(g0 + col0 + bj * HALF + n * 16);
                ig[bj][n] = (f32x4){__builtin_amdgcn_rcpf(gv[0]), __builtin_amdgcn_rcpf(gv[1]), __builtin_amdgcn_rcpf(gv[2]), __builtin_amdgcn_rcpf(gv[3])}; }
#pragma unroll
        for (int ai = 0; ai < 2; ++ai) {
            u32x2 xv[4][2][2];
#pragma unroll
            for (int m = 0; m < 4; ++m)
#pragma unroll
                for (int bj = 0; bj < 2; ++bj)
#pragma unroll
                    for (int n = 0; n < 2; ++n) xv[m][bj][n] = *(const u32x2*)(hn + (size_t)(row0 + ai * HALF + m * 16) * DM + col0 + bj * HALF + n * 16);
#pragma unroll
            for (int m = 0; m < 4; ++m) {
                const int row = row0 + ai * HALF + m * 16;
                const size_t off = (size_t)row * DM + col0;
                float ss = 0.f;
#pragma unroll
                for (int bj = 0; bj < 2; ++bj)
#pragma unroll
                    for (int n = 0; n < 2; ++n) {
                        const u32x2 w2 = xv[m][bj][n];
                        f32x4 xh; xh[0] = __uint_as_float(w2.x << 16); xh[1] = __uint_as_float(w2.x & 0xffff0000u); xh[2] = __uint_as_float(w2.y << 16); xh[3] = __uint_as_float(w2.y & 0xffff0000u);
                        const f32x4 h = xh * ig[bj][n] * rs[ai][m] + acc[ai][bj][m][n];
                        ss += (h[0] * h[0] + h[1] * h[1]) + (h[2] * h[2] + h[3] * h[3]);
                        const unsigned long long w = (unsigned long long)cvt_pk_bf16(h[0], h[1]) | ((unsigned long long)cvt_pk_bf16(h[2], h[3]) << 32);
                        *(unsigned long long*)(hb + off + bj * HALF + n * 16) = w;
                    }
                ss += __shfl_xor(ss, 16); ss += __shfl_xor(ss, 32);
                if (fq == 0) __hip_atomic_fetch_add(hss + row, ss, __ATOMIC_RELAXED, __HIP_MEMORY_SCOPE_AGENT);
            }
        }
    }
};
struct EpiFinal {
    static constexpr bool PERM = false, AFTER_DRAIN = false;
    const bf16_t* hb; const float* fg; float* out; float* hss; unsigned* cnt; bool fused;
    __device__ __forceinline__ void operator()(f32x4 (&acc)[2][2][4][2], const Unit& u, int wr, int wc, int fr, int fq) const {
        const int row0 = u.pm * BM + wr * 64 + fr, col0 = u.pn * BM + wc * 32 + 4 * fq;
#pragma unroll
        for (int ai = 0; ai < 2; ++ai)
#pragma unroll
            for (int m = 0; m < 4; ++m) {
                const int row = row0 + ai * HALF + m * 16;
                const size_t off = (size_t)row * DM + col0;
                float ss = 0.f;
#pragma unroll
                for (int bj = 0; bj < 2; ++bj)
#pragma unroll
                    for (int n = 0; n < 2; ++n) {
                        const u32x2 w = *(const u32x2*)(hb + off + bj * HALF + n * 16);
                        f32x4 h; h[0] = __uint_as_float(w.x << 16); h[1] = __uint_as_float(w.x & 0xffff0000u); h[2] = __uint_as_float(w.y << 16); h[3] = __uint_as_float(w.y & 0xffff0000u);
                        h += acc[ai][bj][m][n];
                        acc[ai][bj][m][n] = h;
                        ss += (h[0] * h[0] + h[1] * h[1]) + (h[2] * h[2] + h[3] * h[3]);
                    }
                ss += __shfl_xor(ss, 16); ss += __shfl_xor(ss, 32);
                if (fq == 0) __hip_atomic_fetch_add(hss + row, ss, __ATOMIC_RELAXED, __HIP_MEMORY_SCOPE_AGENT);
            }
        if (!fused) {
#pragma unroll
            for (int ai = 0; ai < 2; ++ai)
#pragma unroll
                for (int m = 0; m < 4; ++m)
#pragma unroll
                    for (int bj = 0; bj < 2; ++bj)
#pragma unroll
                        for (int n = 0; n < 2; ++n) *(f32x4*)(out + (size_t)(row0 + ai * HALF + m * 16) * DM + col0 + bj * HALF + n * 16) = acc[ai][bj][m][n];
            return;
        }
        asm volatile("s_waitcnt vmcnt(0)" ::: "memory");
        unsigned* pc = cnt + 64 * u.pm;
        if (lane_id() == 0) __hip_atomic_fetch_add(pc, 1u, __ATOMIC_RELAXED, __HIP_MEMORY_SCOPE_AGENT);
        for (int it = 0; it < (1 << 22); ++it) {
            if (__hip_atomic_load(pc, __ATOMIC_RELAXED, __HIP_MEMORY_SCOPE_AGENT) >= 64u) break;
            __builtin_amdgcn_s_sleep(2);
        }
        asm volatile("" ::: "memory");
        f32x4 gv[2][2];
#pragma unroll
        for (int bj = 0; bj < 2; ++bj)
#pragma unroll
            for (int n = 0; n < 2; ++n) gv[bj][n] = *(const f32x4*)(fg + col0 + bj * HALF + n * 16);
        float ssr[2][4];
#pragma unroll
        for (int ai = 0; ai < 2; ++ai)
#pragma unroll
            for (int m = 0; m < 4; ++m) ssr[ai][m] = __hip_atomic_load(hss + row0 + ai * HALF + m * 16, __ATOMIC_RELAXED, __HIP_MEMORY_SCOPE_AGENT);
#pragma unroll
        for (int ai = 0; ai < 2; ++ai)
#pragma unroll
            for (int m = 0; m < 4; ++m) {
                const int row = row0 + ai * HALF + m * 16;
                const size_t off = (size_t)row * DM + col0;
                const float rstd = __builtin_amdgcn_rsqf(ssr[ai][m] * (1.0f / DM) + EPS);
#pragma unroll
                for (int bj = 0; bj < 2; ++bj)
#pragma unroll
                    for (int n = 0; n < 2; ++n) *(f32x4*)(out + off + bj * HALF + n * 16) = acc[ai][bj][m][n] * rstd * gv[bj][n];
            }
    }
};
struct EpiSbIn {
    static constexpr bool PERM = true, AFTER_DRAIN = false;
    bf16_t* Q; size_t rstride; const float* hss;
    __device__ __forceinline__ void operator()(const f32x4 (&acc)[2][2][4][2], const Unit& u, int wr, int wc, int fr, int fq) const {
        const int region = u.pn >> 3, tl = u.pn & 7;
        bf16_t* base = Q + (size_t)region * rstride;
        const int row0 = u.pm * BM + wr * 64 + fr, col0 = tl * BM + wc * 32 + 8 * fq;
        float ssr[2][4];
#pragma unroll
        for (int ai = 0; ai < 2; ++ai)
#pragma unroll
            for (int m = 0; m < 4; ++m) ssr[ai][m] = hss[row0 + ai * HALF + m * 16];
#pragma unroll
        for (int ai = 0; ai < 2; ++ai)
#pragma unroll
            for (int m = 0; m < 4; ++m) {
                const int row = row0 + ai * HALF + m * 16;
                float sc = __builtin_amdgcn_rsqf(ssr[ai][m] * (1.0f / DM) + EPS);
                if (region == 0) sc *= QSCALE;
                bf16_t* rowp = base + (size_t)row * DM + col0;
#pragma unroll
                for (int bj = 0; bj < 2; ++bj) {
                    f32x4 v0 = acc[ai][bj][m][0] * sc, v1 = acc[ai][bj][m][1] * sc;
                    if (region == 3) {
#pragma unroll
                        for (int e = 0; e < 4; ++e) { v0[e] = silu_f(v0[e]); v1[e] = silu_f(v1[e]); }
                    }
                    u32x4 w; w.x = cvt_pk_bf16(v0[0], v0[1]); w.y = cvt_pk_bf16(v0[2], v0[3]); w.z = cvt_pk_bf16(v1[0], v1[1]); w.w = cvt_pk_bf16(v1[2], v1[3]);
                    *(u32x4*)(rowp + bj * HALF) = w;
                }
            }
    }
};
}

#define LAS __attribute__((address_space(3)))
typedef unsigned short bf16_t;
typedef short bf16x8 __attribute__((ext_vector_type(8)));
typedef short s16x4 __attribute__((ext_vector_type(4)));
typedef float f32x4 __attribute__((ext_vector_type(4)));
typedef float f32x16 __attribute__((ext_vector_type(16)));
typedef unsigned u32x4 __attribute__((ext_vector_type(4)));
typedef unsigned u32x2 __attribute__((ext_vector_type(2)));
__device__ __forceinline__ unsigned off_b(unsigned row, unsigned ch) { return 256u * row + 16u * (ch ^ (((row & 3u) << 2) | ((row >> 2) & 3u))); }
__device__ __forceinline__ s16x4 vtr(const LAS unsigned char* p) { return __builtin_bit_cast(s16x4, __builtin_amdgcn_ds_read_tr16_b64_v4i16((LAS s16x4*)p)); }
__device__ __forceinline__ unsigned pk_bf16(float lo, float hi) { return pg8::cvt_pk_bf16(lo, hi); }
__device__ __forceinline__ float bf_lo(unsigned w) { return __uint_as_float(w << 16); }
__device__ __forceinline__ float bf_hi(unsigned w) { return __uint_as_float(w & 0xffff0000u); }
__device__ __forceinline__ int crow(int r, int hi) { return (r & 3) + 8 * (r >> 2) + 4 * hi; }

#ifdef ATT_NOSB
#define ATT_SB() do {} while (0)
#else
#ifndef ATT_USE_SB
#define ATT_SB() do {} while (0)
#else
#define ATT_SB() __builtin_amdgcn_sched_barrier(0)
#endif
#endif
#define ATT_VLD(f) do { const int c_ = (f) >> 2, s_ = (f) & 3; const s16x4 lo_ = vtr(vbp + 4096 * s_ + vbase[0] + vcq[c_]); const s16x4 hh_ = vtr(vbp + 4096 * s_ + vbase[1] + vcq[c_]); \
        vf[f] = (bf16x8){lo_[0], lo_[1], lo_[2], lo_[3], hh_[0], hh_[1], hh_[2], hh_[3]}; } while (0)
#define ATT_PV(f) do { if (DO_PV) { o[(f) >> 2] = __builtin_amdgcn_mfma_f32_32x32x16_bf16(pa[(f) & 3], vf[f], o[(f) >> 2], 0, 0, 0); if ((f) + 4 < 16) ATT_VLD((f) + 4); } } while (0)
#define ATT_EXP8(i) do { _Pragma("unroll") for (int r_ = 0; r_ < 8; ++r_) p[(i) >> 1][8 * ((i) & 1) + r_] = __builtin_amdgcn_exp2f(fminf(p[(i) >> 1][8 * ((i) & 1) + r_], 30.f)); } while (0)
#define ATT_LBLK(j) do { const int ph_ = 1 - ((j) >> 2), g_ = 3 - ((j) & 3); \
        const float w0_ = 1.0f + p[ph_][4 * g_], w1_ = 1.0f + p[ph_][4 * g_ + 1], w2_ = 1.0f + p[ph_][4 * g_ + 2], w3_ = 1.0f + p[ph_][4 * g_ + 3]; \
        L[j] = __builtin_amdgcn_logf((w0_ * w1_) * (w2_ * w3_)); } while (0)
#define ATT_XCH(j) do { const float own_ = L[j]; const auto rr_ = __builtin_amdgcn_permlane32_swap(__float_as_uint(own_), __float_as_uint(own_), false, false); \
        const float a0_ = __uint_as_float(rr_[0]), a1_ = __uint_as_float(rr_[1]); const float oth_ = (a0_ == own_) ? a1_ : a0_; \
        T[j] = run + (hi ? 0.f : oth_) + own_; run += a0_ + a1_; } while (0)
#define ATT_WGT(j) do { const int ph_ = 1 - ((j) >> 2), g_ = 3 - ((j) & 3); float cf_ = __builtin_amdgcn_exp2f(-T[j]); \
        _Pragma("unroll") for (int e_ = 0; e_ < 4; ++e_) { const float ev_ = p[ph_][4 * g_ + e_]; p[ph_][4 * g_ + e_] = ev_ * cf_; if (e_ < 3) cf_ *= (1.0f + ev_); } } while (0)

template <bool DO_PV>
__device__ __forceinline__ void attn_tile(const LAS unsigned char* kb, const LAS unsigned char* vbp, const bf16x8 (&qf)[8], f32x16 (&o)[4], bf16x8 (&pa)[4], float& carry,
                                          const unsigned (&koff)[8], const unsigned (&vbase)[2], const unsigned (&vcq)[4], int k0, int qw0, int qabs, int hi) {
    f32x16 p[2];
#pragma unroll
    for (int r = 0; r < 16; ++r) { p[0][r] = 0.f; p[1][r] = 0.f; }
    bf16x8 vf[16];
    if (DO_PV) { ATT_VLD(0); ATT_VLD(1); ATT_VLD(2); ATT_VLD(3); }
    {
        bf16x8 ka[8], kc[8];
#pragma unroll
        for (int d0 = 0; d0 < 8; ++d0) { ka[d0] = *(const LAS bf16x8*)(kb + koff[d0]); kc[d0] = *(const LAS bf16x8*)(kb + 8192 + koff[d0]); }
        ATT_SB();
#pragma unroll
        for (int d0 = 0; d0 < 8; ++d0) {
            p[0] = __builtin_amdgcn_mfma_f32_32x32x16_bf16(ka[d0], qf[d0], p[0], 0, 0, 0);
            p[1] = __builtin_amdgcn_mfma_f32_32x32x16_bf16(kc[d0], qf[d0], p[1], 0, 0, 0);
        }
    }
    ATT_SB();
    const bool need_mask = (k0 + 63 >= qw0);
    float L[8], T[8];
    ATT_PV(0); ATT_EXP8(0); ATT_SB();
    ATT_PV(1); ATT_EXP8(1); ATT_SB();
    ATT_PV(2); ATT_EXP8(2); ATT_SB();
    ATT_PV(3); ATT_EXP8(3); ATT_SB();
    if (need_mask) {
#pragma unroll
        for (int ph = 0; ph < 2; ++ph)
#pragma unroll
            for (int r = 0; r < 16; ++r) { const int key = k0 + 32 * ph + crow(r, hi); if (key >= qabs) p[ph][r] = 0.f; }
    }
    ATT_SB();
    ATT_PV(4); ATT_LBLK(0); ATT_LBLK(1); ATT_SB();
    ATT_PV(5); ATT_LBLK(2); ATT_LBLK(3); ATT_SB();
    ATT_PV(6); ATT_LBLK(4); ATT_LBLK(5); ATT_SB();
    ATT_PV(7); ATT_LBLK(6); ATT_LBLK(7); ATT_SB();
    float run = carry;
    ATT_PV(8); ATT_XCH(0); ATT_XCH(1); ATT_SB();
    ATT_PV(9); ATT_XCH(2); ATT_XCH(3); ATT_SB();
    ATT_PV(10); ATT_XCH(4); ATT_XCH(5); ATT_SB();
    ATT_PV(11); ATT_XCH(6); ATT_XCH(7); ATT_SB();
    carry = run;
    ATT_PV(12); ATT_WGT(0); ATT_WGT(1); ATT_SB();
    ATT_PV(13); ATT_WGT(2); ATT_WGT(3); ATT_SB();
    ATT_PV(14); ATT_WGT(4); ATT_WGT(5); ATT_SB();
    ATT_PV(15); ATT_WGT(6); ATT_WGT(7); ATT_SB();
#pragma unroll
    for (int s = 0; s < 4; ++s) { const int ph = s >> 1, rb = 8 * (s & 1);
        u32x4 w; w.x = pk_bf16(p[ph][rb], p[ph][rb + 1]); w.y = pk_bf16(p[ph][rb + 2], p[ph][rb + 3]); w.z = pk_bf16(p[ph][rb + 4], p[ph][rb + 5]); w.w = pk_bf16(p[ph][rb + 6], p[ph][rb + 7]);
        pa[s] = __builtin_bit_cast(bf16x8, w); }
}

__device__ __forceinline__ void attn_unit(LAS unsigned char* lds, const int wid, int b, int h, int qb, const bf16_t* __restrict__ Q, const bf16_t* __restrict__ K,
                                          const bf16_t* __restrict__ V, const bf16_t* __restrict__ ZS, bf16_t* __restrict__ OG) {
    const int tid = tid_of(wid), lane = tid & 63, r32 = lane & 31, hi = lane >> 5;
    const size_t tok0 = (size_t)b * SEQ;
    const int q0 = qb * 256, qw0 = q0 + 32 * wid, qabs = qw0 + r32;
    bf16x8 qf[8];
    { const bf16_t* qp = Q + (tok0 + qabs) * DM + h * HD + 8 * hi;
#pragma unroll
      for (int d0 = 0; d0 < 8; ++d0) qf[d0] = *(const bf16x8*)(qp + 16 * d0); }
    f32x16 o[4];
#pragma unroll
    for (int c = 0; c < 4; ++c)
#pragma unroll
        for (int r = 0; r < 16; ++r) o[c][r] = 0.f;
    bf16x8 pa[4];
#pragma unroll
    for (int s = 0; s < 4; ++s) pa[s] = (bf16x8){0, 0, 0, 0, 0, 0, 0, 0};
    float carry = 0.f;
    const int NT = (q0 + 256) / 64;
    const int srow = tid >> 4, sch = (tid & 15) ^ (((srow & 3) << 2) | ((srow >> 2) & 3));
    const bf16_t* kg = K + (tok0 + srow) * DM + h * HD + sch * 8;
    const bf16_t* vg = V + (tok0 + srow) * DM + h * HD + sch * 8;
    LAS unsigned char* ldsw = lds + wid * 1024;
#define ATT_STAGE(t_, koff_, voff_) do { const size_t go_ = (size_t)(t_) * 64 * DM; \
        __builtin_amdgcn_global_load_lds((const unsigned*)(kg + go_), (LAS unsigned*)(ldsw + (koff_)), 16, 0, 0); \
        __builtin_amdgcn_global_load_lds((const unsigned*)(kg + go_ + 32 * DM), (LAS unsigned*)(ldsw + (koff_) + 8192), 16, 0, 0); \
        __builtin_amdgcn_global_load_lds((const unsigned*)(vg + go_), (LAS unsigned*)(ldsw + (voff_)), 16, 0, 0); \
        __builtin_amdgcn_global_load_lds((const unsigned*)(vg + go_ + 32 * DM), (LAS unsigned*)(ldsw + (voff_) + 8192), 16, 0, 0); } while (0)
    ATT_STAGE(NT - 1, 0, 32768);
    asm volatile("s_waitcnt vmcnt(0)" ::: "memory");
    __syncthreads();
    unsigned koff[8];
#pragma unroll
    for (int d0 = 0; d0 < 8; ++d0) koff[d0] = off_b(r32, 2 * d0 + hi);
    const unsigned qa = (lane & 15) >> 2, blk = (lane >> 4) & 1, pp = lane & 3;
    unsigned vbase[2], vcq[4];
#pragma unroll
    for (int t = 0; t < 2; ++t) vbase[t] = 256u * (8 * t + 4 * hi + qa) + 16u * ((2 * blk + (pp >> 1)) ^ ((2 * t + hi) & 3)) + 8u * (pp & 1);
#pragma unroll
    for (int c = 0; c < 4; ++c) vcq[c] = 64u * ((unsigned)c ^ qa);
    int kcur = 0, vprev = 2, vcur = 0, vnext = 1;
    bool prev_valid = false;
    for (int t = NT - 1; t >= 0; --t) {
        if (t > 0) ATT_STAGE(t - 1, (kcur ^ 1) * 16384, 32768 + vnext * 16384);
        const LAS unsigned char* kb = lds + kcur * 16384;
        const LAS unsigned char* vbp = lds + 32768 + vprev * 16384;
        const int k0 = 64 * t;
        const bool valid = (k0 < qw0 + 31);
        if (valid) {
            if (prev_valid) attn_tile<true>(kb, vbp, qf, o, pa, carry, koff, vbase, vcq, k0, qw0, qabs, hi);
            else            attn_tile<false>(kb, vbp, qf, o, pa, carry, koff, vbase, vcq, k0, qw0, qabs, hi);
        }
        prev_valid = valid;
        asm volatile("s_waitcnt vmcnt(0)" ::: "memory");
        __syncthreads();
        kcur ^= 1; { const int tmp = vprev; vprev = vcur; vcur = vnext; vnext = tmp; }
    }
    { const LAS unsigned char* vbp = lds + 32768 + vprev * 16384;
#pragma unroll
      for (int c = 0; c < 4; ++c)
#pragma unroll
          for (int s = 0; s < 4; ++s) {
              const s16x4 lo = vtr(vbp + 4096 * s + vbase[0] + vcq[c]);
              const s16x4 hh = vtr(vbp + 4096 * s + vbase[1] + vcq[c]);
              const bf16x8 vfr = (bf16x8){lo[0], lo[1], lo[2], lo[3], hh[0], hh[1], hh[2], hh[3]};
              o[c] = __builtin_amdgcn_mfma_f32_32x32x16_bf16(pa[s], vfr, o[c], 0, 0, 0);
          } }
    {
        int lane_e = lane_id(); asm volatile("" : "+v"(lane_e));
        const int r32e = lane_e & 31, hie = lane_e >> 5, rowq = lane_e >> 4, c4 = (lane_e & 15) * 4;
        LAS float* stg = (LAS float*)(lds + 81920 + wid * 8192);
        const size_t gbase = (tok0 + qw0) * DM + h * HD + c4;
        u32x2 zv[2][8];
#pragma unroll
        for (int ps = 0; ps < 2; ++ps)
#pragma unroll
            for (int j = 0; j < 8; ++j) zv[ps][j] = *(const u32x2*)(ZS + gbase + (size_t)(4 * j + rowq) * DM + 64 * ps);
#pragma unroll
        for (int ps = 0; ps < 2; ++ps) {
#pragma unroll
            for (int r = 0; r < 16; ++r) {
                stg[crow(r, hie) * 64 + r32e] = o[2 * ps][r];
                stg[crow(r, hie) * 64 + 32 + r32e] = o[2 * ps + 1][r];
            }
            asm volatile("s_waitcnt lgkmcnt(0)" ::: "memory");
#pragma unroll
            for (int j = 0; j < 8; ++j) {
                const f32x4 ov = *(const LAS f32x4*)(stg + (4 * j + rowq) * 64 + c4);
                const u32x2 z = zv[ps][j];
                u32x2 w; w.x = pk_bf16(ov[0] * bf_lo(z.x), ov[1] * bf_hi(z.x)); w.y = pk_bf16(ov[2] * bf_lo(z.y), ov[3] * bf_hi(z.y));
                *(u32x2*)(OG + gbase + (size_t)(4 * j + rowq) * DM + 64 * ps) = w;
            }
            asm volatile("s_waitcnt lgkmcnt(0)" ::: "memory");
        }
    }
    __syncthreads();
}
__device__ __forceinline__ void attn_phase(LAS unsigned char* lds, const int wid_, int vcu, int G, const bf16_t* Q, const bf16_t* K, const bf16_t* V, const bf16_t* ZS, bf16_t* OG) {
#ifndef NO_ATTN_PRIO
    if (wid_ >= 4) __builtin_amdgcn_s_setprio(1);
#endif
    for (int p = vcu; p < 256; p += G) {
        const int bh = p >> 3, s = p & 7;
#ifdef ATT_ONE_INSTANCE
#pragma unroll 1
        for (int uu = 0; uu < 2; ++uu) attn_unit(lds, wid_, bh >> 4, bh & 15, uu ? 15 - s : s, Q, K, V, ZS, OG);
#else
        attn_unit(lds, wid_, bh >> 4, bh & 15, s, Q, K, V, ZS, OG);
        attn_unit(lds, wid_, bh >> 4, bh & 15, 15 - s, Q, K, V, ZS, OG);
#endif
    }
    __builtin_amdgcn_s_setprio(0);
}

__device__ __forceinline__ void mix_unit(LAS unsigned char* lds, const int wid, int n, int g, const bf16_t* __restrict__ UZ, const bf16_t* __restrict__ V, const float* __restrict__ vss,
                                         const float* __restrict__ w_s, const float* __restrict__ b_s, const float* __restrict__ vg, bf16_t* __restrict__ Y) {
    const int tid = tid_of(wid), lane = tid & 63, r32 = lane & 31, hi = lane >> 5;
    const size_t row0 = (size_t)n * CHUNK;
    LAS float* rstdL = (LAS float*)(lds + 98304);
    const int cc = tid & 31;
    u32x4 uu[8];
#pragma unroll
    for (int i = 0; i < 8; ++i) { const int t = (tid >> 5) + 16 * i; uu[i] = __builtin_nontemporal_load((const u32x4*)(UZ + (row0 + t) * GW + g * GDIM + cc * 8)); }
    {
        u32x4 vr[8];
#pragma unroll
        for (int i = 0; i < 8; ++i) { const int c = tid + 512 * i, s = c >> 5, cc = c & 31;
            vr[i] = __builtin_nontemporal_load((const u32x4*)(V + (row0 + s) * GW + g * GDIM + cc * 8)); }
        if (tid < 128) { const f32x4* vp = (const f32x4*)(vss + (row0 + tid) * 64); f32x4 s4 = vp[0];
#pragma unroll
            for (int i = 1; i < 16; ++i) s4 += vp[i];
            rstdL[tid] = __builtin_amdgcn_rsqf(((s4[0] + s4[1]) + (s4[2] + s4[3])) * (1.0f / GW) + EPS); }
#pragma unroll
        for (int i = 0; i < 8; ++i) { const int c = tid + 512 * i, s = c >> 5, cc = c & 31;
            *(LAS u32x4*)(lds + 32768 + (cc >> 4) * 32768 + off_b(s, cc & 15)) = vr[i]; }
    }
    __syncthreads();
#pragma unroll
    for (int i = 0; i < 4; ++i) { const int c = tid + 512 * i, t = c >> 4, ch = c & 15, s0 = ch * 8;
        const f32x4 w0 = *(const f32x4*)(w_s + ((size_t)g * CHUNK + t) * CHUNK + s0), w1 = *(const f32x4*)(w_s + ((size_t)g * CHUNK + t) * CHUNK + s0 + 4);
        float wv[8] = {w0[0], w0[1], w0[2], w0[3], w1[0], w1[1], w1[2], w1[3]};
#pragma unroll
        for (int j = 0; j < 8; ++j) wv[j] = (s0 + j <= t) ? wv[j] * rstdL[s0 + j] : 0.f;
        u32x4 w; w.x = pk_bf16(wv[0], wv[1]); w.y = pk_bf16(wv[2], wv[3]); w.z = pk_bf16(wv[4], wv[5]); w.w = pk_bf16(wv[6], wv[7]);
        *(LAS u32x4*)(lds + off_b(t, ch)) = w; }
    __syncthreads();
    f32x16 acc[4];
#pragma unroll
    for (int i = 0; i < 4; ++i)
#pragma unroll
        for (int r = 0; r < 16; ++r) acc[i][r] = 0.f;
    {
        const LAS unsigned char* vimg = lds + 32768 + (wid >> 2) * 32768;
        const unsigned cblk = wid & 3, qa = (lane & 15) >> 2, blk = (lane >> 4) & 1, pp = lane & 3;
#pragma unroll
        for (int ks = 0; ks < 8; ++ks) {
            const s16x4 lo = vtr(vimg + off_b(16 * ks + 8 * hi + qa, 4 * cblk + 2 * blk + (pp >> 1)) + 8 * (pp & 1));
            const s16x4 hh = vtr(vimg + off_b(16 * ks + 8 * hi + 4 + qa, 4 * cblk + 2 * blk + (pp >> 1)) + 8 * (pp & 1));
            const bf16x8 vf = (bf16x8){lo[0], lo[1], lo[2], lo[3], hh[0], hh[1], hh[2], hh[3]};
#pragma unroll
            for (int i = 0; i < 4; ++i) if (ks <= 2 * i + 1) {
                const bf16x8 af = *(const LAS bf16x8*)(lds + off_b(32 * i + r32, 2 * ks + hi));
                acc[i] = __builtin_amdgcn_mfma_f32_32x32x16_bf16(af, vf, acc[i], 0, 0, 0);
            }
        }
    }
    __syncthreads();
    {
        LAS float* mx = (LAS float*)lds;
        const int c = 128 * (wid >> 2) + 32 * (wid & 3) + r32;
#pragma unroll
        for (int i = 0; i < 4; ++i)
#pragma unroll
            for (int r = 0; r < 16; ++r) mx[(32 * i + crow(r, hi)) * 256 + c] = acc[i][r];
    }
    __syncthreads();
    {
        const f32x4 g0 = *(const f32x4*)(vg + g * GDIM + cc * 8), g1 = *(const f32x4*)(vg + g * GDIM + cc * 8 + 4);
        float bb[8];
#pragma unroll
        for (int i = 0; i < 8; ++i) bb[i] = b_s[g * CHUNK + (tid >> 5) + 16 * i];
#pragma unroll
        for (int i = 0; i < 8; ++i) { const int t = (tid >> 5) + 16 * i;
            const f32x4 m0 = *(const LAS f32x4*)(lds + (t * 256 + cc * 8) * 4), m1 = *(const LAS f32x4*)(lds + (t * 256 + cc * 8 + 4) * 4);
            float y[8];
            y[0] = bf_lo(uu[i].x) * (m0[0] * g0[0] + bb[i]); y[1] = bf_hi(uu[i].x) * (m0[1] * g0[1] + bb[i]);
            y[2] = bf_lo(uu[i].y) * (m0[2] * g0[2] + bb[i]); y[3] = bf_hi(uu[i].y) * (m0[3] * g0[3] + bb[i]);
            y[4] = bf_lo(uu[i].z) * (m1[0] * g1[0] + bb[i]); y[5] = bf_hi(uu[i].z) * (m1[1] * g1[1] + bb[i]);
            y[6] = bf_lo(uu[i].w) * (m1[2] * g1[2] + bb[i]); y[7] = bf_hi(uu[i].w) * (m1[3] * g1[3] + bb[i]);
            u32x4 w; w.x = pk_bf16(y[0], y[1]); w.y = pk_bf16(y[2], y[3]); w.z = pk_bf16(y[4], y[5]); w.w = pk_bf16(y[6], y[7]);
            *(u32x4*)(Y + (row0 + t) * GW + g * GDIM + cc * 8) = w; }
    }
    __syncthreads();
}

__device__ __forceinline__ float wave_sum(float v) {
#pragma unroll
    for (int o = 1; o < 64; o <<= 1) v += __shfl_xor(v, o);
    return v;
}
__device__ __forceinline__ void tr_load(const float* __restrict__ W, int N, int item, int lane, f32x4 (&wv)[16]) {
    const int nblk = N / 64, k0 = 64 * (item / nblk), n0 = 64 * (item % nblk);
#pragma unroll
    for (int i = 0; i < 16; ++i) wv[i] = __builtin_nontemporal_load((const f32x4*)(W + (size_t)(k0 + 4 * i + (lane >> 4)) * N + n0 + 4 * (lane & 15)));
}
__device__ __forceinline__ void tr_to_lds(LAS float* scr, int lane, const f32x4 (&wv)[16]) {
#pragma unroll
    for (int i = 0; i < 16; ++i) { const int kk = 4 * i + (lane >> 4), nn = 4 * (lane & 15);
        LAS float* s = scr + kk * 65 + nn; s[0] = wv[i][0]; s[1] = wv[i][1]; s[2] = wv[i][2]; s[3] = wv[i][3]; }
    asm volatile("s_waitcnt lgkmcnt(0)" ::: "memory");
}
__device__ __forceinline__ void tr_store(int K, int N, bf16_t* __restrict__ WT, const LAS float* scr, int item, int lane, const float* __restrict__ gk, bool gmlp_perm) {
    const int nblk = N / 64, k0 = 64 * (item / nblk), n0 = 64 * (item % nblk);
    int r0 = n0;
    if (gmlp_perm) {
        if (n0 < GW) { const int cb = n0 >> 7; r0 = 256 * (3 * (cb >> 1) + (cb & 1)) + (n0 & 127); }
        else if (n0 < 2 * GW) { const int mv = n0 - GW; r0 = 256 * (3 * (mv >> 8) + 2) + (mv & 255); }
        else { const int mz = n0 - 2 * GW, cb = mz >> 7; r0 = 256 * (3 * (cb >> 1) + (cb & 1)) + 128 + (mz & 127); }
    }
    const int c = lane & 7;
    f32x4 ga = {1.f, 1.f, 1.f, 1.f}, gb = {1.f, 1.f, 1.f, 1.f};
    if (gk) { ga = *(const f32x4*)(gk + k0 + 8 * c); gb = *(const f32x4*)(gk + k0 + 8 * c + 4); }
#pragma unroll
    for (int j = 0; j < 8; ++j) { const int nn = (lane >> 3) + 8 * j; const LAS float* s = scr + (8 * c) * 65 + nn;
        u32x4 o; o.x = pk_bf16(s[0] * ga[0], s[65] * ga[1]); o.y = pk_bf16(s[2 * 65] * ga[2], s[3 * 65] * ga[3]); o.z = pk_bf16(s[4 * 65] * gb[0], s[5 * 65] * gb[1]); o.w = pk_bf16(s[6 * 65] * gb[2], s[7 * 65] * gb[3]);
        *(u32x4*)(WT + (size_t)(r0 + nn) * K + k0 + 8 * c) = o; }
    asm volatile("s_waitcnt lgkmcnt(0)" ::: "memory");
}
__device__ __forceinline__ void transpose_matrix(const float* __restrict__ W, int K, int N, bf16_t* __restrict__ WT, LAS float* scr, int first, int stride, int nitems, int lane,
                                                 const float* __restrict__ gk = nullptr, bool gmlp_perm = false) {
    f32x4 wv[16], wn[16];
    int it = first;
    if (it < nitems) tr_load(W, N, it, lane, wv);
    while (it < nitems) {
        const int nx = it + stride;
        tr_to_lds(scr, lane, wv);
        if (nx < nitems) tr_load(W, N, nx, lane, wn);
        tr_store(K, N, WT, scr, it, lane, gk, gmlp_perm);
#pragma unroll
        for (int i = 0; i < 16; ++i) wv[i] = wn[i];
        it = nx;
    }
}

#define XB_TMO      128
#define XB_XCNT(j)  (256  + 64 * (j))
#define XB_XSUB(j)  (1280 + 64 * (j))
#define XB_XGEN(j)  (2304 + 64 * (j))
#define XB_TOP      3328
#define XB_TOPGEN   3392
#define XCD_BAR_WORDS 3456
#define XB_SPIN_CAP (1u << 18)

__device__ __forceinline__ unsigned xb_ld(unsigned* p)              { return __hip_atomic_load(p, __ATOMIC_RELAXED, __HIP_MEMORY_SCOPE_AGENT); }
__device__ __forceinline__ unsigned xb_add(unsigned* p, unsigned v) { return __hip_atomic_fetch_add(p, v, __ATOMIC_RELAXED, __HIP_MEMORY_SCOPE_AGENT); }
__device__ __forceinline__ unsigned xb_xcc_id() { return (unsigned)__builtin_amdgcn_s_getreg((3 << 11) | 20) & 0xFu; }
#define XB_SPIN(cond, bar) do { unsigned _sp = 0; while (cond) { __builtin_amdgcn_s_sleep(1); \
    if ((++_sp & 255u) == 0u) { if (xb_ld(&(bar)[XB_TMO])) break; if (_sp > XB_SPIN_CAP) { atomicAdd(&(bar)[XB_TMO], 1u); break; } } } } while (0)

struct XcdBarrier {
    unsigned* bar; unsigned x; int w;
    volatile LAS unsigned* st;
};

__device__ __forceinline__ XcdBarrier xcd_barrier_post(unsigned* bar, volatile LAS unsigned* st, int wave) {
    XcdBarrier b; b.bar = bar; b.x = xb_xcc_id(); b.st = st; b.w = wave;
    if (tid_of(wave) == 0) (void)xb_add(&bar[XB_XCNT(b.x)], 1u);
    return b;
}
__device__ __forceinline__ void xcd_barrier_complete(unsigned* bar, unsigned x, unsigned& nloc, unsigned& nx) {
    const unsigned G = gridDim.x * gridDim.y * gridDim.z;
    unsigned sum, cnt, mine, sp = 0u;
    for (;;) {
        sum = 0u; cnt = 0u; mine = 0u;
#pragma unroll
        for (unsigned j = 0; j < 16; ++j) { const unsigned c = xb_ld(&bar[XB_XCNT(j)]); sum += c; cnt += (c > 0u) ? 1u : 0u; mine = (j == x) ? c : mine; }
        if (sum == G) break;
        __builtin_amdgcn_s_sleep(1);
        if ((++sp & 255u) == 0u) { if (xb_ld(&bar[XB_TMO])) break; if (sp > XB_SPIN_CAP) { atomicAdd(&bar[XB_TMO], 1u); break; } }
    }
    nloc = mine > 0u ? mine : 1u; nx = cnt > 0u ? cnt : 1u;
}

__device__ __forceinline__ void xcd_barrier(const XcdBarrier& b) {
    asm volatile("s_waitcnt vmcnt(0)" ::: "memory");
    __syncthreads();
    if (tid_of(b.w) == 0) {
        unsigned* bar = b.bar;
        __builtin_amdgcn_s_waitcnt(0);
        unsigned nloc = b.st[0], nx = b.st[1];
        if (nloc == 0u) { xcd_barrier_complete(bar, b.x, nloc, nx); b.st[0] = nloc; b.st[1] = nx; }
        const unsigned old = xb_add(&bar[XB_XSUB(b.x)], 1u);
        const unsigned gen = old / nloc;
        if (old + 1u == (gen + 1u) * nloc) {
            __builtin_amdgcn_fence(__ATOMIC_RELEASE, "agent");
            asm volatile("s_waitcnt vmcnt(0)" ::: "memory");
            const unsigned og = xb_add(&bar[XB_TOP], 1u);
            const unsigned tg = og / nx;
            if (og + 1u == (tg + 1u) * nx) xb_add(&bar[XB_TOPGEN], 1u);
            else XB_SPIN(xb_ld(&bar[XB_TOPGEN]) == tg, bar);
            __builtin_amdgcn_fence(__ATOMIC_ACQUIRE, "agent");
            xb_add(&bar[XB_XGEN(b.x)], 1u);
            asm volatile("s_waitcnt vmcnt(0)" ::: "memory");
        } else {
            XB_SPIN(xb_ld(&bar[XB_XGEN(b.x)]) == gen, bar);
            __builtin_amdgcn_fence(__ATOMIC_ACQUIRE, "agent");
            asm volatile("s_waitcnt vmcnt(0)" ::: "memory");
        }
    }
    __syncthreads();
}

constexpr size_t MiB = 1u << 20;
constexpr size_t WS_VSS = 0, WS_HSS1 = 2 * MiB, WS_HSS2 = 3 * MiB, WS_IRS0 = 3 * MiB + 32768, WS_CNT = 3 * MiB + 65536;
constexpr size_t WS_WT1 = 4 * MiB, WS_HN0 = 268 * MiB  , WS_WT2 = 84 * MiB, WS_WT3 = 100 * MiB, WS_WT4 = 132 * MiB;
constexpr size_t WS_U = 140 * MiB, WS_V = 204 * MiB, WS_ZS = 268 * MiB, WS_CTL = 364 * MiB, CTL_ZERO_BYTES = 32768, WS_END = 365 * MiB;
constexpr size_t WS_Y = 4 * MiB;
constexpr size_t WS_H1 = 140 * MiB, WS_H1B = 332 * MiB;
constexpr size_t WS_Q = 204 * MiB, WS_K = 236 * MiB, WS_V2 = 268 * MiB, WS_ZS2 = 300 * MiB, WS_OG = 4 * MiB;

constexpr int NWAVES = 8, LDS_BYTES = 151552;
#ifndef N_LAUNCHES
#define N_LAUNCHES 1
#endif
constexpr int N_PHASES = 7;
#ifndef CONV_TRIGGER
#define CONV_TRIGGER ((bx >> 3) % 6)
#endif
#ifndef GEMM_SP2
#define GEMM_SP2 true
#endif
#ifndef GEMM_ALIGN
#define GEMM_ALIGN true
#endif
#ifndef REPEAT_PHASE
#define REPEAT_PHASE -1
#endif
#define NREP(k) ((REPEAT_PHASE == (k)) ? 2 : 1)

struct Args { const float* in[10]; float* out; unsigned char* ws; int ph_lo, ph_hi, li, pad; };

__global__ void __launch_bounds__(NWAVES * 64, 2) fwd_kernel(Args a) {
    extern __shared__ __attribute__((aligned(16))) unsigned char lds_raw[];
    LAS unsigned char* lds = (LAS unsigned char*)lds_raw;
    cg::grid_group grid = cg::this_grid();
    const int wave = __builtin_amdgcn_readfirstlane(threadIdx.x >> 6);
#define tid tid_of(wave)
#define lane lane_id()
    const int G = gridDim.x, bx = blockIdx.x;
    const int vcu = (G % 8 == 0) ? (bx % 8) * (G / 8) + bx / 8 : bx;
    const float* x = a.in[0]; const float* norm_g = a.in[1]; const float* a_w_in = a.in[2]; const float* a_vg = a.in[3]; const float* a_w_s = a.in[4];
    const float* a_b_s = a.in[5]; const float* a_w_out = a.in[6]; const float* b_w_in = a.in[7]; const float* b_w_out = a.in[8]; const float* final_g = a.in[9];
    unsigned char* ws = a.ws;
    float* VSS = (float*)(ws + WS_VSS); float* HSS1 = (float*)(ws + WS_HSS1); float* HSS2 = (float*)(ws + WS_HSS2); float* IRS0 = (float*)(ws + WS_IRS0); unsigned* CNT = (unsigned*)(ws + WS_CNT);
    bf16_t* WT1 = (bf16_t*)(ws + WS_WT1); bf16_t* WT2 = (bf16_t*)(ws + WS_WT2); bf16_t* WT3 = (bf16_t*)(ws + WS_WT3); bf16_t* WT4 = (bf16_t*)(ws + WS_WT4);
    bf16_t* HN0 = (bf16_t*)(ws + WS_HN0); bf16_t* U = (bf16_t*)(ws + WS_U); bf16_t* V = (bf16_t*)(ws + WS_V); bf16_t* ZS = (bf16_t*)(ws + WS_ZS);
    bf16_t* Y = (bf16_t*)(ws + WS_Y); bf16_t* H1B = (bf16_t*)(ws + WS_H1B);
    bf16_t* Qb = (bf16_t*)(ws + WS_Q); bf16_t* Kb = (bf16_t*)(ws + WS_K); bf16_t* V2 = (bf16_t*)(ws + WS_V2); bf16_t* ZS2 = (bf16_t*)(ws + WS_ZS2); bf16_t* OG = (bf16_t*)(ws + WS_OG);
    const int lo = a.ph_lo, hi = a.ph_hi;
#define IN(k) (lo <= (k) && (k) < hi)
#define SEAM(k) do { if (IN(k) && IN((k) + 1)) xcd_barrier(bar); } while (0)
    volatile LAS unsigned* MISC = (volatile LAS unsigned*)(lds + LDS_BYTES - 64);
    if (tid < 16) MISC[tid] = 0u;
    __syncthreads();
    XcdBarrier bar = xcd_barrier_post((unsigned*)(ws + WS_CTL) + a.li * XCD_BAR_WORDS, MISC + 8, wave);
    if (lo > 1000) grid.sync();
    const int gw = vcu * NWAVES + wave, NGW = G * NWAVES;

    if (IN(0)) for (int rep = 0; rep < NREP(0); ++rep) {
        LAS float* scr = (LAS float*)(lds + wave * 16640);
        constexpr int I1 = (DM / 64) * (3 * GW / 64), I2 = (GW / 64) * (DM / 64), I3 = (DM / 64) * (4 * DM / 64), I4 = (DM / 64) * (DM / 64);
        transpose_matrix(a_w_in, DM, 3 * GW, WT1, scr, gw, NGW, I1, lane, nullptr, true);
        for (int m = bx * (NWAVES * 64) + tid; m < NTOK; m += G * NWAVES * 64) { HSS1[m] = 0.f; HSS2[m] = 0.f; if (m < 2048) CNT[m] = 0u; }
        for (int m = gw; m < NTOK; m += NGW) {
            const f32x4* xr = (const f32x4*)(x + (size_t)m * DM) + lane; const f32x4* gr = (const f32x4*)norm_g + lane;
            f32x4 v[8]; float ss = 0.f;
#pragma unroll
            for (int j = 0; j < 8; ++j) { v[j] = __builtin_nontemporal_load(xr + 64 * j); ss += (v[j][0] * v[j][0] + v[j][1] * v[j][1]) + (v[j][2] * v[j][2] + v[j][3] * v[j][3]); }
            const float ms = wave_sum(ss) * (1.0f / DM) + EPS;
            const float rstd = __builtin_amdgcn_rsqf(ms);
            if (lane == 0) IRS0[m] = __builtin_amdgcn_sqrtf(ms);
            u32x2* o8 = (u32x2*)(HN0 + (size_t)m * DM) + lane;
#pragma unroll
            for (int j = 0; j < 8; ++j) { const f32x4 gg = gr[64 * j]; u32x2 w; w.x = pk_bf16(v[j][0] * rstd * gg[0], v[j][1] * rstd * gg[1]); w.y = pk_bf16(v[j][2] * rstd * gg[2], v[j][3] * rstd * gg[3]); o8[64 * j] = w; }
        }
    }
    SEAM(0);
#ifdef EXTRA_SYNCS
    for (int i = 0; i < EXTRA_SYNCS; ++i) xcd_barrier(bar);
#endif
    if (IN(1)) for (int rep = 0; rep < NREP(1); ++rep) {
        pg8::Gemm g{HN0, WT1, NTOK, 3 * GW, DM}; pg8::ConvOrder S; S.init(NTOK, 3 * GW, G, bx);
        S.w2 = a_w_out; S.w3 = b_w_in; S.w4 = b_w_out; S.g1 = norm_g + DM; S.t2 = WT2; S.t3 = WT3; S.t4 = WT4; S.gw = gw; S.ngw = NGW; S.trigger = (G == 256) ? CONV_TRIGGER : 0; S.ln = lane; S.sw = lds + 131072 + wave * 2048; S.n_done = 0;
        pg8::EpiGmlpIn E{U, V, VSS};
        pg8::gemm_phase<pg8::EpiGmlpIn, pg8::ConvOrder, GEMM_ALIGN, GEMM_SP2>(lds, g, S, E, wave);
    }
    SEAM(1);
    if (IN(2)) for (int rep = 0; rep < NREP(2); ++rep) {
        for (int it = vcu; it < (NTOK / CHUNK) * NGRP; it += G) mix_unit(lds, wave, it >> 4, it & 15, U, V, VSS, a_w_s, a_b_s, a_vg, Y);
    }
    SEAM(2);
    if (IN(3)) for (int rep = 0; rep < NREP(3); ++rep) {
        pg8::Gemm g{Y, WT2, NTOK, DM, GW}; pg8::StaticOrder S; S.init(NTOK, DM, G, bx);
        pg8::EpiRes1 E{HN0, IRS0, norm_g, H1B, HSS1};
        pg8::gemm_phase<pg8::EpiRes1, pg8::StaticOrder, GEMM_ALIGN, GEMM_SP2>(lds, g, S, E, wave);
    }
    SEAM(3);
    if (IN(4)) for (int rep = 0; rep < NREP(4); ++rep) {
        pg8::Gemm g{H1B, WT3, NTOK, 4 * DM, DM}; pg8::StaticOrder S; S.init(NTOK, 4 * DM, G, bx);
        pg8::EpiSbIn E{Qb, (size_t)(WS_K - WS_Q) / 2, HSS1};
        pg8::gemm_phase<pg8::EpiSbIn, pg8::StaticOrder, GEMM_ALIGN, GEMM_SP2>(lds, g, S, E, wave);
    }
    SEAM(4);
    if (IN(5)) for (int rep = 0; rep < NREP(5); ++rep) attn_phase(lds, wave, vcu, G, Qb, Kb, V2, ZS2, OG);
    SEAM(5);
    if (IN(6)) for (int rep = 0; rep < NREP(6); ++rep) {
        pg8::Gemm g{OG, WT4, NTOK, DM, DM}; pg8::StaticOrder S; S.init(NTOK, DM, G, bx);
        pg8::EpiFinal E{H1B, final_g, a.out, HSS2, CNT, G == 256};
        pg8::gemm_phase<pg8::EpiFinal, pg8::StaticOrder, GEMM_ALIGN, GEMM_SP2>(lds, g, S, E, wave);
    }
    if (IN(6) && G != 256) {
        xcd_barrier(bar);
        for (int m = gw; m < NTOK; m += NGW) {
            const float rstd = __builtin_amdgcn_rsqf(HSS2[m] * (1.0f / DM) + EPS);
            f32x4* orow = (f32x4*)(a.out + (size_t)m * DM) + lane; const f32x4* gr = (const f32x4*)final_g + lane;
#pragma unroll
            for (int j = 0; j < 8; ++j) { const f32x4 v = orow[64 * j]; orow[64 * j] = v * rstd * gr[64 * j]; }
        }
    }
#undef IN
#undef SEAM
#undef tid
#undef lane
}

extern "C" void kernel_launch(void* const* d_in, const int* in_sizes, int n_in, void* d_out, int out_size, void* d_ws, size_t ws_size, hipStream_t stream) {
    static int grid = 0;
    if (grid == 0) {
        if (n_in != 10 || out_size != NTOK * DM || ws_size < WS_END) { fprintf(stderr, "kernel_launch: unexpected shapes (n_in %d, out %d, ws %zu)\n", n_in, out_size, ws_size); grid = -1; return; }
        int dev = 0, cus = 0, per_cu = 0;
        (void)hipGetDevice(&dev); (void)hipDeviceGetAttribute(&cus, hipDeviceAttributeMultiprocessorCount, dev);
        if (hipFuncSetAttribute((const void*)fwd_kernel, hipFuncAttributeMaxDynamicSharedMemorySize, LDS_BYTES) != hipSuccess) { fprintf(stderr, "kernel_launch: hipFuncSetAttribute failed\n"); grid = -1; return; }
        if (hipOccupancyMaxActiveBlocksPerMultiprocessor(&per_cu, (const void*)fwd_kernel, NWAVES * 64, LDS_BYTES) != hipSuccess || per_cu < 1) { fprintf(stderr, "kernel_launch: occupancy query says %d\n", per_cu); per_cu = 1; }
        (void)hipGetLastError();
        grid = cus > 0 ? cus : 256;
    }
    if (grid < 0) return;
    if (hipMemsetAsync((char*)d_ws + WS_CTL, 0, CTL_ZERO_BYTES, stream) != hipSuccess) { fprintf(stderr, "kernel_launch: memset failed\n"); return; }
    Args a{};
    for (int i = 0; i < 10; ++i) a.in[i] = (const float*)d_in[i];
    a.out = (float*)d_out; a.ws = (unsigned char*)d_ws;
#ifdef PROBE_SPLIT
    const int nl = 2;
#else
    const int nl = N_LAUNCHES;
#endif
    for (int li = 0; li < nl; ++li) {
        a.ph_lo = (N_LAUNCHES == 1) ? 0 : li; a.ph_hi = (N_LAUNCHES == 1) ? N_PHASES : li + 1;
#ifdef PROBE_SPLIT
        a.ph_lo = li == 0 ? 0 : PROBE_SPLIT; a.ph_hi = li == 0 ? PROBE_SPLIT + 1 : N_PHASES;
#endif
        a.li = li;
        void* args[] = {&a};
        hipError_t e = hipLaunchCooperativeKernel((const void*)fwd_kernel, dim3(grid), dim3(NWAVES * 64), args, LDS_BYTES, stream);
        if (e != hipSuccess) { fprintf(stderr, "kernel_launch: cooperative launch %d failed: %s (grid %d)\n", li, hipGetErrorString(e), grid); break; }
    }
}
```

```cpp
#include <hip/hip_runtime.h>
#include <hip/hip_cooperative_groups.h>
#include <cstdio>
#include <cstdint>
namespace cg = cooperative_groups;
__device__ __forceinline__ int lane_id() { return (int)__builtin_amdgcn_mbcnt_hi(~0u, __builtin_amdgcn_mbcnt_lo(~0u, 0u)); }
__device__ __forceinline__ int tid_of(int wave) { return wave * 64 + lane_id(); }
#ifndef PG8_WGM
#define PG8_WGM 8
#endif
namespace pg8 {
#define PG8_LAS __attribute__((address_space(3)))
typedef unsigned short bf16_t;
typedef short bf16x8 __attribute__((ext_vector_type(8)));
typedef float f32x4 __attribute__((ext_vector_type(4)));
typedef unsigned u32x4 __attribute__((ext_vector_type(4)));
constexpr int BM = 256, BK = 64, HALF = 128, HTB = HALF * BK * 2  , STAGE_BYTES = 8 * HTB, NXCD = 8, WGM = PG8_WGM;

__host__ __device__ __forceinline__ int lds_byte(int r, int c) { const int st = (r >> 4) * 2 + (c >> 5), rr = r & 15, cc = c & 31, ob = rr * 64 + cc * 2; return st * 1024 + (ob ^ (((ob >> 9) & 1) << 5)); }
__host__ __device__ __forceinline__ void stage_rc(int b, int& R, int& C) { const int st = b / 1024, sb = b % 1024, swz = sb ^ (((sb >> 9) & 1) << 5); R = (st >> 1) * 16 + swz / 64; C = (st & 1) * 32 + (swz % 64) / 2; }
__host__ __device__ __forceinline__ int perm32(int rho) { const int n = rho >> 4, i = rho & 15; return 8 * (i >> 2) + 4 * n + (i & 3); }

struct Unit { int pm, pn; };
struct Gemm { const bf16_t* A; const bf16_t* Bt; int M, N, K; };

struct StaticOrder {
    int nM, nN, nwg, G, c;
    __host__ __device__ void init(int M, int N, int G_, int c_) { nM = M / BM; nN = N / BM; nwg = nM * nN; G = G_; c = c_; }
    __host__ __device__ bool next(int i, Unit& u) const {
        const long L = (long)i * G + c; if (L >= nwg) return false;
        int wgid = (int)L; { const int q = nwg / NXCD, r = nwg % NXCD, xcd = wgid % NXCD, off = wgid / NXCD; wgid = (xcd < r ? xcd * (q + 1) : r * (q + 1) + (xcd - r) * q) + off; }
        const int nig = WGM * nN, gid = wgid / nig, fm = gid * WGM, gsz = (nM - fm) < WGM ? (nM - fm) : WGM;
        u.pm = fm + ((wgid % nig) % gsz); u.pn = (wgid % nig) / gsz; return true;
    }
    __device__ __forceinline__ void a_ready(const Unit&) const {}
    __device__ __forceinline__ void done(const Unit&) const {}
};

__device__ __forceinline__ unsigned cvt_pk_bf16(float lo, float hi) { unsigned r; asm volatile("v_cvt_pk_bf16_f32 %0, %1, %2" : "=v"(r) : "v"(lo), "v"(hi)); return r; }
typedef float f32x2 __attribute__((ext_vector_type(2)));
typedef float f32x2 __attribute__((ext_vector_type(2)));
template <class Epi, class Sched, bool ALIGN_EPI = false, bool SP2 = false>
__device__ __forceinline__ void gemm_phase(PG8_LAS unsigned char* lds, const Gemm g, const Sched& S, const Epi& E, const int wave_) {
    const int tid = tid_of(wave_), wid = wave_, lane = tid & 63, wr = wid >> 2, wc = wid & 3, fr = lane & 15, fq = lane >> 4;
    const int K = g.K, nt = K / BK;
    unsigned voffA[2], voffB[2];
#pragma unroll
    for (int i = 0; i < 2; ++i) { int R, C; stage_rc(tid * 16 + i * 8192, R, C); const int Rb = Epi::PERM ? ((R & ~31) + perm32(R & 31)) : R;
        voffA[i] = (unsigned)(R * K + C) * 2u; voffB[i] = (unsigned)(Rb * K + C) * 2u; }
    const size_t kstep = (size_t)(BK * 2);
    const size_t hstep = (size_t)HALF * K * 2;
    const size_t tstep = 2 * hstep;
    const unsigned ldsw = (unsigned)wid * 1024u;
    const int aoff = lds_byte(wr * 64 + fr, fq * 8), boff = lds_byte(wc * 32 + fr, fq * 8);
#define PG8_SA(b, h) (((b) * 2 + (h)) * HTB)
#define PG8_SB(b, h) ((4 + (b) * 2 + (h)) * HTB)
#define PG8_STAGE(bufoff, gbase, voff) do { _Pragma("unroll") for (int _i = 0; _i < 2; ++_i) \
        __builtin_amdgcn_global_load_lds((const unsigned*)((const char*)(gbase) + (voff)[_i]), (PG8_LAS unsigned*)(lds + (bufoff) + ldsw + _i * 8192), 16, 0, 0); } while (0)
#define PG8_LDA(dst, b, h) do { _Pragma("unroll") for (int m = 0; m < 4; ++m) _Pragma("unroll") for (int k = 0; k < 2; ++k) dst[m][k] = *(const PG8_LAS bf16x8*)(lds + PG8_SA(b, h) + aoff + m * 2048 + k * 1024); } while (0)
#define PG8_LDB(dst, b, h) do { _Pragma("unroll") for (int n = 0; n < 2; ++n) _Pragma("unroll") for (int k = 0; k < 2; ++k) dst[n][k] = *(const PG8_LAS bf16x8*)(lds + PG8_SB(b, h) + boff + n * 2048 + k * 1024); } while (0)
#define PG8_MMA(ai, bj, At, Bt) do { __builtin_amdgcn_s_setprio(1); _Pragma("unroll") for (int m = 0; m < 4; ++m) _Pragma("unroll") for (int n = 0; n < 2; ++n) _Pragma("unroll") for (int k = 0; k < 2; ++k) \
        acc[ai][bj][m][n] = __builtin_amdgcn_mfma_f32_16x16x32_bf16(Bt[n][k], At[m][k], acc[ai][bj][m][n], 0, 0, 0); __builtin_amdgcn_s_setprio(0); } while (0)
#define PG8_WAIT_V(n) asm volatile("s_waitcnt vmcnt(" #n ")" ::: "memory")
#define PG8_WAIT_L(n) asm volatile("s_waitcnt lgkmcnt(" #n ")" ::: "memory")
#define PG8_BAR __builtin_amdgcn_s_barrier()
#define PG8_SCHED __builtin_amdgcn_sched_barrier(0)
    Unit cur, nxt; int ui = 0;
    if (!S.next(0, cur)) return;
    f32x4 acc[2][2][4][2];
#pragma unroll
    for (int a = 0; a < 2; ++a)
#pragma unroll
        for (int b = 0; b < 2; ++b)
#pragma unroll
            for (int m = 0; m < 4; ++m)
#pragma unroll
                for (int n = 0; n < 2; ++n) acc[a][b][m][n] = (f32x4){0.f, 0.f, 0.f, 0.f};
    bf16x8 At[4][2], B0[2][2], B1[2][2];
    const char* cA = (const char*)g.A + (size_t)cur.pm * tstep; const char* cB = (const char*)g.Bt + (size_t)cur.pn * tstep;
    S.a_ready(cur);
    if constexpr (SP2) {
        PG8_STAGE(PG8_SB(0, 0), cB, voffB); PG8_STAGE(PG8_SB(0, 1), cB + hstep, voffB); PG8_STAGE(PG8_SA(0, 0), cA, voffA); PG8_STAGE(PG8_SA(0, 1), cA + hstep, voffA);
        if (wr == 1) PG8_BAR;
        PG8_WAIT_V(2); PG8_BAR;
        PG8_STAGE(PG8_SB(1, 0), cB + kstep, voffB); PG8_STAGE(PG8_SA(1, 0), cA + kstep, voffA); PG8_STAGE(PG8_SB(1, 1), cB + hstep + kstep, voffB);
        PG8_WAIT_V(6); PG8_BAR;
    } else {
        PG8_STAGE(PG8_SB(0, 0), cB, voffB); PG8_STAGE(PG8_SA(0, 0), cA, voffA); PG8_STAGE(PG8_SB(0, 1), cB + hstep, voffB); PG8_STAGE(PG8_SA(0, 1), cA + hstep, voffA);
        if (wr == 1) PG8_BAR;
        PG8_WAIT_V(4); PG8_BAR;
        PG8_STAGE(PG8_SB(1, 0), cB + kstep, voffB); PG8_STAGE(PG8_SA(1, 0), cA + kstep, voffA); PG8_STAGE(PG8_SB(1, 1), cB + hstep + kstep, voffB);
        PG8_WAIT_V(6); PG8_BAR;
    }
    for (;;) {
        const bool has_next = S.next(ui + 1, nxt);
        const char* nA = has_next ? (const char*)g.A + (size_t)nxt.pm * tstep : cA; const char* nB = has_next ? (const char*)g.Bt + (size_t)nxt.pn * tstep : cB;
        for (int t = 0; t < nt; t += 2) {
            const bool last = (t == nt - 2);
            const char* a1 = cA + (size_t)(t + 1) * kstep;
            const char* a2 = last ? nA : cA + (size_t)(t + 2) * kstep; const char* b2 = last ? nB : cB + (size_t)(t + 2) * kstep;
            const char* a3 = a2 + kstep; const char* b3 = b2 + kstep;
            if (last && has_next) S.a_ready(nxt);
            if constexpr (SP2) {
            PG8_LDB(B0, 0, 0); PG8_LDB(B1, 0, 1); PG8_SCHED; PG8_LDA(At, 0, 0); PG8_STAGE(PG8_SA(1, 1), a1 + hstep, voffA);
            PG8_WAIT_V(8); PG8_WAIT_L(0); PG8_BAR; PG8_MMA(0, 0, At, B0); PG8_MMA(0, 1, At, B1); PG8_BAR; PG8_SCHED;
            PG8_LDA(At, 0, 1); PG8_STAGE(PG8_SB(0, 0), b2, voffB); PG8_STAGE(PG8_SB(0, 1), b2 + hstep, voffB); PG8_STAGE(PG8_SA(0, 0), a2, voffA);
            PG8_WAIT_V(8); PG8_WAIT_L(0); PG8_BAR; PG8_MMA(1, 0, At, B0); PG8_MMA(1, 1, At, B1); PG8_BAR; PG8_SCHED;
            PG8_LDB(B0, 1, 0); PG8_LDB(B1, 1, 1); PG8_SCHED; PG8_LDA(At, 1, 0); PG8_STAGE(PG8_SA(0, 1), a2 + hstep, voffA);
            PG8_WAIT_V(8); PG8_WAIT_L(0); PG8_BAR; PG8_MMA(0, 0, At, B0); PG8_MMA(0, 1, At, B1); PG8_BAR; PG8_SCHED;
            PG8_LDA(At, 1, 1); PG8_STAGE(PG8_SB(1, 0), b3, voffB); PG8_STAGE(PG8_SB(1, 1), b3 + hstep, voffB); PG8_STAGE(PG8_SA(1, 0), a3, voffA);
            PG8_WAIT_V(8); PG8_WAIT_L(0); PG8_BAR; PG8_MMA(1, 0, At, B0); PG8_MMA(1, 1, At, B1); PG8_BAR; PG8_SCHED;
            } else {
            PG8_LDB(B0, 0, 0); PG8_SCHED; PG8_LDA(At, 0, 0); PG8_STAGE(PG8_SA(1, 1), a1 + hstep, voffA);
            PG8_WAIT_L(8); PG8_BAR; PG8_WAIT_L(0); PG8_MMA(0, 0, At, B0); PG8_BAR; PG8_SCHED;
            PG8_LDB(B1, 0, 1); PG8_STAGE(PG8_SB(0, 0), b2, voffB);
            PG8_BAR; PG8_WAIT_L(0); PG8_MMA(0, 1, At, B1); PG8_BAR;
            PG8_LDA(At, 0, 1); PG8_STAGE(PG8_SA(0, 0), a2, voffA);
            PG8_BAR; PG8_WAIT_L(0); PG8_MMA(1, 0, At, B0); PG8_BAR; PG8_SCHED;
            PG8_STAGE(PG8_SB(0, 1), b2 + hstep, voffB);
            PG8_WAIT_V(6); PG8_BAR; PG8_MMA(1, 1, At, B1); PG8_BAR;
            PG8_LDB(B0, 1, 0); PG8_SCHED; PG8_LDA(At, 1, 0); PG8_STAGE(PG8_SA(0, 1), a2 + hstep, voffA);
            PG8_WAIT_L(8); PG8_BAR; PG8_WAIT_L(0); PG8_MMA(0, 0, At, B0); PG8_BAR; PG8_SCHED;
            PG8_LDB(B1, 1, 1); PG8_STAGE(PG8_SB(1, 0), b3, voffB);
            PG8_BAR; PG8_WAIT_L(0); PG8_MMA(0, 1, At, B1); PG8_BAR;
            PG8_LDA(At, 1, 1); PG8_STAGE(PG8_SA(1, 0), a3, voffA);
            PG8_BAR; PG8_WAIT_L(0); PG8_MMA(1, 0, At, B0); PG8_BAR; PG8_SCHED;
            PG8_STAGE(PG8_SB(1, 1), b3 + hstep, voffB);
            PG8_WAIT_V(6); PG8_BAR; PG8_MMA(1, 1, At, B1); PG8_BAR;
            }
        }
        if constexpr (ALIGN_EPI) { if (wr == 0) PG8_BAR; }
        if constexpr (!Epi::AFTER_DRAIN) { E(acc, cur, wr, wc, fr, fq); S.done(cur); }
        if (!has_next) break;
#pragma unroll
        for (int a = 0; a < 2; ++a)
#pragma unroll
            for (int b = 0; b < 2; ++b)
#pragma unroll
                for (int m = 0; m < 4; ++m)
#pragma unroll
                    for (int n = 0; n < 2; ++n) acc[a][b][m][n] = (f32x4){0.f, 0.f, 0.f, 0.f};
        cur = nxt; cA = nA; cB = nB; ++ui;
        if constexpr (ALIGN_EPI) { if (wr == 1) PG8_BAR; }
    }
    PG8_WAIT_V(0);
    if constexpr (!ALIGN_EPI) { if (wr == 0) PG8_BAR; }
    PG8_BAR;
    if constexpr (Epi::AFTER_DRAIN) { E.fused(acc, cur, wr, wc, fr, fq, lds, wid, lane); S.done(cur); }
#undef PG8_SA
#undef PG8_SB
#undef PG8_STAGE
#undef PG8_LDA
#undef PG8_LDB
#undef PG8_MMA
#undef PG8_WAIT_V
#undef PG8_WAIT_L
#undef PG8_BAR
#undef PG8_SCHED
}
}

constexpr int DM = 2048, NTOK = 8192, SEQ = 4096, GW = 4096, NGRP = 16, GDIM = 256, CHUNK = 128, NHEAD = 16, HD = 128;
constexpr float EPS = 1e-6f;
constexpr float LOG2E = 1.4426950408889634f;
constexpr float QSCALE = 0.08838834764831845f * LOG2E;

constexpr float GELU_C1 = -1.5957691216057308f * LOG2E, GELU_C2 = -0.07135481627260025f * LOG2E;
__device__ __forceinline__ float gelu_tanh(float x) {
    const float e = __builtin_amdgcn_exp2f(x * __builtin_fmaf(x * x, GELU_C2, GELU_C1));
    return x * __builtin_amdgcn_rcpf(1.0f + e);
}
__device__ __forceinline__ float gelu_silu(float u, float z) {
    const float e1 = __builtin_amdgcn_exp2f(u * __builtin_fmaf(u * u, GELU_C2, GELU_C1));
    const float e2 = __builtin_amdgcn_exp2f(z * -LOG2E);
    return (u * z) * __builtin_amdgcn_rcpf((1.0f + e1) * (1.0f + e2));
}
__device__ __forceinline__ float silu_f(float z) { return z * __builtin_amdgcn_rcpf(1.0f + __builtin_amdgcn_exp2f(-LOG2E * z)); }

namespace pg8 {
typedef unsigned u32x2 __attribute__((ext_vector_type(2)));
__device__ __forceinline__ void conv_load4(const float* __restrict__ W, int N, int item, int lane, f32x4 (&x)[16]) {
    const int nblk = N / 64, k0 = 64 * (item / nblk), n0 = 64 * (item % nblk);
#pragma unroll
    for (int i = 0; i < 16; ++i) x[i] = __builtin_nontemporal_load((const f32x4*)(W + (size_t)(k0 + 4 * i + (lane >> 4)) * N + n0 + 4 * (lane & 15)));
}
__device__ __forceinline__ void conv_xpose(f32x4 (&x)[16], int lane) {
    const bool a = (lane >> 4) & 1, b = (lane >> 5) & 1;
#pragma unroll
    for (int i = 0; i < 16; ++i) {
        f32x4 v = x[i];
        {
            const float s0 = a ? v[0] : v[1], s1 = a ? v[2] : v[3];
            const float r0 = __shfl_xor(s0, 16), r1 = __shfl_xor(s1, 16);
            if (a) { v[0] = r0; v[2] = r1; } else { v[1] = r0; v[3] = r1; }
        }
        {
            const float s0 = b ? v[0] : v[2], s1 = b ? v[1] : v[3];
            const float r0 = __shfl_xor(s0, 32), r1 = __shfl_xor(s1, 32);
            if (b) { v[0] = r0; v[1] = r1; } else { v[2] = r0; v[3] = r1; }
        }
        x[i] = v;
    }
}
__device__ __forceinline__ void conv_store4(int K, int N, bf16_t* __restrict__ WT, int item, int lane, const float* __restrict__ gk, const f32x4 (&x)[16]) {
    const int nblk = N / 64, k0 = 64 * (item / nblk), n0 = 64 * (item % nblk);
    const int n = n0 + 4 * (lane & 15) + (lane >> 4);
#pragma unroll
    for (int kc = 0; kc < 8; ++kc) {
        float g[8];
#pragma unroll
        for (int j = 0; j < 8; ++j) g[j] = gk ? gk[k0 + 8 * kc + j] : 1.0f;
        const f32x4 lo = x[2 * kc], hi = x[2 * kc + 1];
        u32x4 o; o.x = cvt_pk_bf16(lo[0] * g[0], lo[1] * g[1]); o.y = cvt_pk_bf16(lo[2] * g[2], lo[3] * g[3]);
        o.z = cvt_pk_bf16(hi[0] * g[4], hi[1] * g[5]); o.w = cvt_pk_bf16(hi[2] * g[6], hi[3] * g[7]);
        *(u32x4*)(WT + (size_t)n * K + k0 + 8 * kc) = o;
    }
}
__device__ __forceinline__ void conv_store4_lds(int K, int N, bf16_t* __restrict__ WT, int item, int lane, const float* __restrict__ gk, const f32x4 (&x)[16], PG8_LAS unsigned char* sw) {
    const int nblk = N / 64, k0 = 64 * (item / nblk), n0 = 64 * (item % nblk);
    const int nq = lane & 15, r = lane >> 4;
    u32x4 o[8];
#pragma unroll
    for (int kc = 0; kc < 8; ++kc) {
        float g[8];
#pragma unroll
        for (int j = 0; j < 8; ++j) g[j] = gk ? gk[k0 + 8 * kc + j] : 1.0f;
        const f32x4 lo = x[2 * kc], hi = x[2 * kc + 1];
        o[kc].x = cvt_pk_bf16(lo[0] * g[0], lo[1] * g[1]); o[kc].y = cvt_pk_bf16(lo[2] * g[2], lo[3] * g[3]);
        o[kc].z = cvt_pk_bf16(hi[0] * g[4], hi[1] * g[5]); o[kc].w = cvt_pk_bf16(hi[2] * g[6], hi[3] * g[7]);
    }
#pragma unroll
    for (int q = 0; q < 4; ++q) {
        if ((nq >> 2) == q) {
            PG8_LAS u32x4* wp = (PG8_LAS u32x4*)(sw + (4 * (nq & 3) + r) * 128);
#pragma unroll
            for (int kc = 0; kc < 8; ++kc) wp[kc] = o[kc];
        }
        asm volatile("s_waitcnt lgkmcnt(0)" ::: "memory");
#pragma unroll
        for (int h = 0; h < 2; ++h) { const int rl = (lane >> 3) + 8 * h;
            const u32x4 v = *(const PG8_LAS u32x4*)(sw + rl * 128 + (lane & 7) * 16);
            *(u32x4*)(WT + (size_t)(n0 + 16 * q + rl) * K + k0 + 8 * (lane & 7)) = v; }
        asm volatile("s_waitcnt lgkmcnt(0)" ::: "memory");
    }
}
struct ConvOrder : StaticOrder {
    const float *w2, *w3, *w4, *g1; bf16_t *t2, *t3, *t4; int gw, ngw, trigger, ln; PG8_LAS unsigned char* sw; mutable int n_done;
    __device__ __forceinline__ void done(const Unit&) const {
        constexpr int I2 = (GW / 64) * (DM / 64), I3 = (DM / 64) * (4 * DM / 64), I4 = (DM / 64) * (DM / 64);
        const int u = n_done++;
#ifdef HOOK_SPREAD
        f32x4 va[16];
        if (u == 0 || u == 1) { for (int it = gw + u * ngw; it < I3; it += 2 * ngw) { conv_load4(w3, 4 * DM, it, ln, va); conv_xpose(va, ln); conv_store4(DM, 4 * DM, t3, it, ln, g1, va); } }
        else if (u == 2) { for (int it = gw; it < I2; it += ngw) { conv_load4(w2, DM, it, ln, va); conv_xpose(va, ln); conv_store4(GW, DM, t2, it, ln, nullptr, va); } }
        else if (u == 3) { for (int it = gw; it < I4; it += ngw) { conv_load4(w4, DM, it, ln, va); conv_xpose(va, ln); conv_store4(DM, DM, t4, it, ln, nullptr, va); } }
#else
        if (u != trigger) return;
        f32x4 va[16], vb[16];
        for (int it = gw; it < I3; it += 2 * ngw) {
            const bool two = it + ngw < I3;
            conv_load4(w3, 4 * DM, it, ln, va); if (two) conv_load4(w3, 4 * DM, it + ngw, ln, vb);
            conv_xpose(va, ln); if (two) conv_xpose(vb, ln);
            conv_store4_lds(DM, 4 * DM, t3, it, ln, g1, va, sw); if (two) conv_store4_lds(DM, 4 * DM, t3, it + ngw, ln, g1, vb, sw);
        }
        for (int it = gw; it < I2; it += ngw) {
            const bool two = it < I4;
            conv_load4(w2, DM, it, ln, va); if (two) conv_load4(w4, DM, it, ln, vb);
            conv_xpose(va, ln); if (two) conv_xpose(vb, ln);
            conv_store4_lds(GW, DM, t2, it, ln, nullptr, va, sw); if (two) conv_store4_lds(DM, DM, t4, it, ln, nullptr, vb, sw);
        }
#endif
    }
};
struct EpiGmlpIn {
    static constexpr bool PERM = true, AFTER_DRAIN = false;
    bf16_t *UZ, *V; float* vss;
    __device__ __forceinline__ void operator()(const f32x4 (&acc)[2][2][4][2], const Unit& u, int wr, int wc, int fr, int fq) const {
        const int row0 = u.pm * BM + wr * 64 + fr;
        const int tq = u.pn / 3, tr = u.pn - 3 * tq;
        if (tr < 2) {
            const int col0 = (2 * tq + tr) * HALF + wc * 32 + 8 * fq;
#pragma unroll
            for (int ai = 0; ai < 2; ++ai)
#pragma unroll
                for (int m = 0; m < 4; ++m) {
                    const int row = row0 + ai * HALF + m * 16;
                    f32x4 v0 = acc[ai][0][m][0], v1 = acc[ai][0][m][1]; const f32x4 z0 = acc[ai][1][m][0], z1 = acc[ai][1][m][1];
#pragma unroll
                    for (int e = 0; e < 4; ++e) { v0[e] = gelu_silu(v0[e], z0[e]); v1[e] = gelu_silu(v1[e], z1[e]); }
                    u32x4 w; w.x = cvt_pk_bf16(v0[0], v0[1]); w.y = cvt_pk_bf16(v0[2], v0[3]); w.z = cvt_pk_bf16(v1[0], v1[1]); w.w = cvt_pk_bf16(v1[2], v1[3]);
                    *(u32x4*)(UZ + (size_t)row * GW + col0) = w;
                }
        } else {
            const int tl = tq, col0 = tl * BM + wc * 32 + 8 * fq;
#pragma unroll
            for (int ai = 0; ai < 2; ++ai)
#pragma unroll
                for (int m = 0; m < 4; ++m) {
                    const int row = row0 + ai * HALF + m * 16;
                    bf16_t* rowp = V + (size_t)row * GW + col0;
                    float ss = 0.f;
#pragma unroll
                    for (int bj = 0; bj < 2; ++bj) {
                        f32x4 v0 = acc[ai][bj][m][0], v1 = acc[ai][bj][m][1];
#pragma unroll
                        for (int e = 0; e < 4; ++e) { v0[e] = gelu_tanh(v0[e]); v1[e] = gelu_tanh(v1[e]); ss += v0[e] * v0[e] + v1[e] * v1[e]; }
                        u32x4 w; w.x = cvt_pk_bf16(v0[0], v0[1]); w.y = cvt_pk_bf16(v0[2], v0[3]); w.z = cvt_pk_bf16(v1[0], v1[1]); w.w = cvt_pk_bf16(v1[2], v1[3]);
                        *(u32x4*)(rowp + bj * HALF) = w;
                    }
                    ss += __shfl_xor(ss, 16); ss += __shfl_xor(ss, 32);
                    if (fq == 0) vss[(size_t)row * 64 + tl * 4 + wc] = ss;
                }
        }
    }
};
struct EpiRes1 {
    static constexpr bool PERM = false, AFTER_DRAIN = false;
    const bf16_t* hn; const float* irs; const float* g0; bf16_t* hb; float* hss;
    __device__ __forceinline__ void operator()(const f32x4 (&acc)[2][2][4][2], const Unit& u, int wr, int wc, int fr, int fq) const {
        const int row0 = u.pm * BM + wr * 64 + fr, col0 = u.pn * BM + wc * 32 + 4 * fq;
        float rs[2][4];
#pragma unroll
        for (int ai = 0; ai < 2; ++ai)
#pragma unroll
            for (int m = 0; m < 4; ++m) rs[ai][m] = irs[row0 + ai * HALF + m * 16];
        f32x4 ig[2][2];
#pragma unroll
        for (int bj = 0; bj < 2; ++bj)
#pragma unroll
            for (int n = 0; n < 2; ++n) { const f32x4 gv = *(const f32x4*)(g0 + col0 + bj * HALF + n * 16);
                ig[bj][n] = (f32x4){__builtin_amdgcn_rcpf(gv[0]), __builtin_amdgcn_rcpf(gv[1]), __builtin_amdgcn_rcpf(gv[2]), __builtin_amdgcn_rcpf(gv[3])}; }
#pragma unroll
        for (int ai = 0; ai < 2; ++ai) {
            u32x2 xv[4][2][2];
#pragma unroll
            for (int m = 0; m < 4; ++m)
#pragma unroll
                for (int bj = 0; bj < 2; ++bj)
#pragma unroll
                    for (int n = 0; n < 2; ++n) xv[m][bj][n] = *(const u32x2*)(hn + (size_t)(row0 + ai * HALF + m * 16) * DM + col0 + bj * HALF + n * 16);
#pragma unroll
            for (int m = 0; m < 4; ++m) {
                const int row = row0 + ai * HALF + m * 16;
                const size_t off = (size_t)row * DM + col0;
                float ss = 0.f;
#pragma unroll
                for (int bj = 0; bj < 2; ++bj)
#pragma unroll
                    for (int n = 0; n < 2; ++n) {
                        const u32x2 w2 = xv[m][bj][n];
                        f32x4 xh; xh[0] = __uint_as_float(w2.x << 16); xh[1] = __uint_as_float(w2.x & 0xffff0000u); xh[2] = __uint_as_float(w2.y << 16); xh[3] = __uint_as_float(w2.y & 0xffff0000u);
                        const f32x4 h = xh * ig[bj][n] * rs[ai][m] + acc[ai][bj][m][n];
                        ss += (h[0] * h[0] + h[1] * h[1]) + (h[2] * h[2] + h[3] * h[3]);
                        const unsigned long long w = (unsigned long long)cvt_pk_bf16(h[0], h[1]) | ((unsigned long long)cvt_pk_bf16(h[2], h[3]) << 32);
                        *(unsigned long long*)(hb + off + bj * HALF + n * 16) = w;
                    }
                ss += __shfl_xor(ss, 16); ss += __shfl_xor(ss, 32);
                if (fq == 0) __hip_atomic_fetch_add(hss + row, ss, __ATOMIC_RELAXED, __HIP_MEMORY_SCOPE_AGENT);
            }
        }
    }
};
struct EpiFinal {
    static constexpr bool PERM = false, AFTER_DRAIN = false;
    const bf16_t* hb; const float* fg; float* out; float* hss; unsigned* cnt; bool fused;
    __device__ __forceinline__ void operator()(f32x4 (&acc)[2][2][4][2], const Unit& u, int wr, int wc, int fr, int fq) const {
        const int row0 = u.pm * BM + wr * 64 + fr, col0 = u.pn * BM + wc * 32 + 4 * fq;
#pragma unroll
        for (int ai = 0; ai < 2; ++ai)
#pragma unroll
            for (int m = 0; m < 4; ++m) {
                const int row = row0 + ai * HALF + m * 16;
                const size_t off = (size_t)row * DM + col0;
                float ss = 0.f;
#pragma unroll
                for (int bj = 0; bj < 2; ++bj)
#pragma unroll
                    for (int n = 0; n < 2; ++n) {
                        const u32x2 w = *(const u32x2*)(hb + off + bj * HALF + n * 16);
                        f32x4 h; h[0] = __uint_as_float(w.x << 16); h[1] = __uint_as_float(w.x & 0xffff0000u); h[2] = __uint_as_float(w.y << 16); h[3] = __uint_as_float(w.y & 0xffff0000u);
                        h += acc[ai][bj][m][n];
                        acc[ai][bj][m][n] = h;
                        ss += (h[0] * h[0] + h[1] * h[1]) + (h[2] * h[2] + h[3] * h[3]);
                    }
                ss += __shfl_xor(ss, 16); ss += __shfl_xor(ss, 32);
                if (fq == 0) __hip_atomic_fetch_add(hss + row, ss, __ATOMIC_RELAXED, __HIP_MEMORY_SCOPE_AGENT);
            }
        if (!fused) {
#pragma unroll
            for (int ai = 0; ai < 2; ++ai)
#pragma unroll
                for (int m = 0; m < 4; ++m)
#pragma unroll
                    for (int bj = 0; bj < 2; ++bj)
#pragma unroll
                        for (int n = 0; n < 2; ++n) *(f32x4*)(out + (size_t)(row0 + ai * HALF + m * 16) * DM + col0 + bj * HALF + n * 16) = acc[ai][bj][m][n];
            return;
        }
        asm volatile("s_waitcnt vmcnt(0)" ::: "memory");
        unsigned* pc = cnt + 64 * u.pm;
        if (lane_id() == 0) __hip_atomic_fetch_add(pc, 1u, __ATOMIC_RELAXED, __HIP_MEMORY_SCOPE_AGENT);
        for (int it = 0; it < (1 << 22); ++it) {
            if (__hip_atomic_load(pc, __ATOMIC_RELAXED, __HIP_MEMORY_SCOPE_AGENT) >= 64u) break;
            __builtin_amdgcn_s_sleep(2);
        }
        asm volatile("" ::: "memory");
        f32x4 gv[2][2];
#pragma unroll
        for (int bj = 0; bj < 2; ++bj)
#pragma unroll
            for (int n = 0; n < 2; ++n) gv[bj][n] = *(const f32x4*)(fg + col0 + bj * HALF + n * 16);
        float ssr[2][4];
#pragma unroll
        for (int ai = 0; ai < 2; ++ai)
#pragma unroll
            for (int m = 0; m < 4; ++m) ssr[ai][m] = __hip_atomic_load(hss + row0 + ai * HALF + m * 16, __ATOMIC_RELAXED, __HIP_MEMORY_SCOPE_AGENT);
#pragma unroll
        for (int ai = 0; ai < 2; ++ai)
#pragma unroll
            for (int m = 0; m < 4; ++m) {
                const int row = row0 + ai * HALF + m * 16;
                const size_t off = (size_t)row * DM + col0;
                const float rstd = __builtin_amdgcn_rsqf(ssr[ai][m] * (1.0f / DM) + EPS);
#pragma unroll
                for (int bj = 0; bj < 2; ++bj)
#pragma unroll
                    for (int n = 0; n < 2; ++n) *(f32x4*)(out + off + bj * HALF + n * 16) = acc[ai][bj][m][n] * rstd * gv[bj][n];
            }
    }
};
struct EpiSbIn {
    static constexpr bool PERM = true, AFTER_DRAIN = false;
    bf16_t* Q; size_t rstride; const float* hss;
    __device__ __forceinline__ void operator()(const f32x4 (&acc)[2][2][4][2], const Unit& u, int wr, int wc, int fr, int fq) const {
        const int region = u.pn >> 3, tl = u.pn & 7;
        bf16_t* base = Q + (size_t)region * rstride;
        const int row0 = u.pm * BM + wr * 64 + fr, col0 = tl * BM + wc * 32 + 8 * fq;
        float ssr[2][4];
#pragma unroll
        for (int ai = 0; ai < 2; ++ai)
#pragma unroll
            for (int m = 0; m < 4; ++m) ssr[ai][m] = hss[row0 + ai * HALF + m * 16];
#pragma unroll
        for (int ai = 0; ai < 2; ++ai)
#pragma unroll
            for (int m = 0; m < 4; ++m) {
                const int row = row0 + ai * HALF + m * 16;
                float sc = __builtin_amdgcn_rsqf(ssr[ai][m] * (1.0f / DM) + EPS);
                if (region == 0) sc *= QSCALE;
                bf16_t* rowp = base + (size_t)row * DM + col0;
#pragma unroll
                for (int bj = 0; bj < 2; ++bj) {
                    f32x4 v0 = acc[ai][bj][m][0] * sc, v1 = acc[ai][bj][m][1] * sc;
                    if (region == 3) {
#pragma unroll
                        for (int e = 0; e < 4; ++e) { v0[e] = silu_f(v0[e]); v1[e] = silu_f(v1[e]); }
                    }
                    u32x4 w; w.x = cvt_pk_bf16(v0[0], v0[1]); w.y = cvt_pk_bf16(v0[2], v0[3]); w.z = cvt_pk_bf16(v1[0], v1[1]); w.w = cvt_pk_bf16(v1[2], v1[3]);
                    *(u32x4*)(rowp + bj * HALF) = w;
                }
            }
    }
};
}

#define LAS __attribute__((address_space(3)))
typedef unsigned short bf16_t;
typedef short bf16x8 __attribute__((ext_vector_type(8)));
typedef short s16x4 __attribute__((ext_vector_type(4)));
typedef float f32x4 __attribute__((ext_vector_type(4)));
typedef float f32x16 __attribute__((ext_vector_type(16)));
typedef unsigned u32x4 __attribute__((ext_vector_type(4)));
typedef unsigned u32x2 __attribute__((ext_vector_type(2)));
__device__ __forceinline__ unsigned off_b(unsigned row, unsigned ch) { return 256u * row + 16u * (ch ^ (((row & 3u) << 2) | ((row >> 2) & 3u))); }
__device__ __forceinline__ s16x4 vtr(const LAS unsigned char* p) { return __builtin_bit_cast(s16x4, __builtin_amdgcn_ds_read_tr16_b64_v4i16((LAS s16x4*)p)); }
__device__ __forceinline__ unsigned pk_bf16(float lo, float hi) { return pg8::cvt_pk_bf16(lo, hi); }
__device__ __forceinline__ float bf_lo(unsigned w) { return __uint_as_float(w << 16); }
__device__ __forceinline__ float bf_hi(unsigned w) { return __uint_as_float(w & 0xffff0000u); }
__device__ __forceinline__ int crow(int r, int hi) { return (r & 3) + 8 * (r >> 2) + 4 * hi; }

#ifdef ATT_NOSB
#define ATT_SB() do {} while (0)
#else
#ifndef ATT_USE_SB
#define ATT_SB() do {} while (0)
#else
#define ATT_SB() __builtin_amdgcn_sched_barrier(0)
#endif
#endif
#define ATT_VLD(f) do { const int c_ = (f) >> 2, s_ = (f) & 3; const s16x4 lo_ = vtr(vbp + 4096 * s_ + vbase[0] + vcq[c_]); const s16x4 hh_ = vtr(vbp + 4096 * s_ + vbase[1] + vcq[c_]); \
        vf[f] = (bf16x8){lo_[0], lo_[1], lo_[2], lo_[3], hh_[0], hh_[1], hh_[2], hh_[3]}; } while (0)
#define ATT_PV(f) do { if (DO_PV) { o[(f) >> 2] = __builtin_amdgcn_mfma_f32_32x32x16_bf16(pa[(f) & 3], vf[f], o[(f) >> 2], 0, 0, 0); if ((f) + 4 < 16) ATT_VLD((f) + 4); } } while (0)
#define ATT_EXP8(i) do { _Pragma("unroll") for (int r_ = 0; r_ < 8; ++r_) p[(i) >> 1][8 * ((i) & 1) + r_] = __builtin_amdgcn_exp2f(fminf(p[(i) >> 1][8 * ((i) & 1) + r_], 30.f)); } while (0)
#define ATT_LBLK(j) do { const int ph_ = 1 - ((j) >> 2), g_ = 3 - ((j) & 3); \
        const float w0_ = 1.0f + p[ph_][4 * g_], w1_ = 1.0f + p[ph_][4 * g_ + 1], w2_ = 1.0f + p[ph_][4 * g_ + 2], w3_ = 1.0f + p[ph_][4 * g_ + 3]; \
        L[j] = __builtin_amdgcn_logf((w0_ * w1_) * (w2_ * w3_)); } while (0)
#define ATT_XCH(j) do { const float own_ = L[j]; const auto rr_ = __builtin_amdgcn_permlane32_swap(__float_as_uint(own_), __float_as_uint(own_), false, false); \
        const float a0_ = __uint_as_float(rr_[0]), a1_ = __uint_as_float(rr_[1]); const float oth_ = (a0_ == own_) ? a1_ : a0_; \
        T[j] = run + (hi ? 0.f : oth_) + own_; run += a0_ + a1_; } while (0)
#define ATT_WGT(j) do { const int ph_ = 1 - ((j) >> 2), g_ = 3 - ((j) & 3); float cf_ = __builtin_amdgcn_exp2f(-T[j]); \
        _Pragma("unroll") for (int e_ = 0; e_ < 4; ++e_) { const float ev_ = p[ph_][4 * g_ + e_]; p[ph_][4 * g_ + e_] = ev_ * cf_; if (e_ < 3) cf_ *= (1.0f + ev_); } } while (0)

template <bool DO_PV>
__device__ __forceinline__ void attn_tile(const LAS unsigned char* kb, const LAS unsigned char* vbp, const bf16x8 (&qf)[8], f32x16 (&o)[4], bf16x8 (&pa)[4], float& carry,
                                          const unsigned (&koff)[8], const unsigned (&vbase)[2], const unsigned (&vcq)[4], int k0, int qw0, int qabs, int hi) {
    f32x16 p[2];
#pragma unroll
    for (int r = 0; r < 16; ++r) { p[0][r] = 0.f; p[1][r] = 0.f; }
    bf16x8 vf[16];
    if (DO_PV) { ATT_VLD(0); ATT_VLD(1); ATT_VLD(2); ATT_VLD(3); }
    {
        bf16x8 ka[8], kc[8];
#pragma unroll
        for (int d0 = 0; d0 < 8; ++d0) { ka[d0] = *(const LAS bf16x8*)(kb + koff[d0]); kc[d0] = *(const LAS bf16x8*)(kb + 8192 + koff[d0]); }
        ATT_SB();
#pragma unroll
        for (int d0 = 0; d0 < 8; ++d0) {
            p[0] = __builtin_amdgcn_mfma_f32_32x32x16_bf16(ka[d0], qf[d0], p[0], 0, 0, 0);
            p[1] = __builtin_amdgcn_mfma_f32_32x32x16_bf16(kc[d0], qf[d0], p[1], 0, 0, 0);
        }
    }
    ATT_SB();
    const bool need_mask = (k0 + 63 >= qw0);
    float L[8], T[8];
    ATT_PV(0); ATT_EXP8(0); ATT_SB();
    ATT_PV(1); ATT_EXP8(1); ATT_SB();
    ATT_PV(2); ATT_EXP8(2); ATT_SB();
    ATT_PV(3); ATT_EXP8(3); ATT_SB();
    if (need_mask) {
#pragma unroll
        for (int ph = 0; ph < 2; ++ph)
#pragma unroll
            for (int r = 0; r < 16; ++r) { const int key = k0 + 32 * ph + crow(r, hi); if (key >= qabs) p[ph][r] = 0.f; }
    }
    ATT_SB();
    ATT_PV(4); ATT_LBLK(0); ATT_LBLK(1); ATT_SB();
    ATT_PV(5); ATT_LBLK(2); ATT_LBLK(3); ATT_SB();
    ATT_PV(6); ATT_LBLK(4); ATT_LBLK(5); ATT_SB();
    ATT_PV(7); ATT_LBLK(6); ATT_LBLK(7); ATT_SB();
    float run = carry;
    ATT_PV(8); ATT_XCH(0); ATT_XCH(1); ATT_SB();
    ATT_PV(9); ATT_XCH(2); ATT_XCH(3); ATT_SB();
    ATT_PV(10); ATT_XCH(4); ATT_XCH(5); ATT_SB();
    ATT_PV(11); ATT_XCH(6); ATT_XCH(7); ATT_SB();
    carry = run;
    ATT_PV(12); ATT_WGT(0); ATT_WGT(1); ATT_SB();
    ATT_PV(13); ATT_WGT(2); ATT_WGT(3); ATT_SB();
    ATT_PV(14); ATT_WGT(4); ATT_WGT(5); ATT_SB();
    ATT_PV(15); ATT_WGT(6); ATT_WGT(7); ATT_SB();
#pragma unroll
    for (int s = 0; s < 4; ++s) { const int ph = s >> 1, rb = 8 * (s & 1);
        u32x4 w; w.x = pk_bf16(p[ph][rb], p[ph][rb + 1]); w.y = pk_bf16(p[ph][rb + 2], p[ph][rb + 3]); w.z = pk_bf16(p[ph][rb + 4], p[ph][rb + 5]); w.w = pk_bf16(p[ph][rb + 6], p[ph][rb + 7]);
        pa[s] = __builtin_bit_cast(bf16x8, w); }
}

__device__ __forceinline__ void attn_unit(LAS unsigned char* lds, const int wid, int b, int h, int qb, const bf16_t* __restrict__ Q, const bf16_t* __restrict__ K,
                                          const bf16_t* __restrict__ V, const bf16_t* __restrict__ ZS, bf16_t* __restrict__ OG) {
    const int tid = tid_of(wid), lane = tid & 63, r32 = lane & 31, hi = lane >> 5;
    const size_t tok0 = (size_t)b * SEQ;
    const int q0 = qb * 256, qw0 = q0 + 32 * wid, qabs = qw0 + r32;
    bf16x8 qf[8];
    { const bf16_t* qp = Q + (tok0 + qabs) * DM + h * HD + 8 * hi;
#pragma unroll
      for (int d0 = 0; d0 < 8; ++d0) qf[d0] = *(const bf16x8*)(qp + 16 * d0); }
    f32x16 o[4];
#pragma unroll
    for (int c = 0; c < 4; ++c)
#pragma unroll
        for (int r = 0; r < 16; ++r) o[c][r] = 0.f;
    bf16x8 pa[4];
#pragma unroll
    for (int s = 0; s < 4; ++s) pa[s] = (bf16x8){0, 0, 0, 0, 0, 0, 0, 0};
    float carry = 0.f;
    const int NT = (q0 + 256) / 64;
    const int srow = tid >> 4, sch = (tid & 15) ^ (((srow & 3) << 2) | ((srow >> 2) & 3));
    const bf16_t* kg = K + (tok0 + srow) * DM + h * HD + sch * 8;
    const bf16_t* vg = V + (tok0 + srow) * DM + h * HD + sch * 8;
    LAS unsigned char* ldsw = lds + wid * 1024;
#define ATT_STAGE(t_, koff_, voff_) do { const size_t go_ = (size_t)(t_) * 64 * DM; \
        __builtin_amdgcn_global_load_lds((const unsigned*)(kg + go_), (LAS unsigned*)(ldsw + (koff_)), 16, 0, 0); \
        __builtin_amdgcn_global_load_lds((const unsigned*)(kg + go_ + 32 * DM), (LAS unsigned*)(ldsw + (koff_) + 8192), 16, 0, 0); \
        __builtin_amdgcn_global_load_lds((const unsigned*)(vg + go_), (LAS unsigned*)(ldsw + (voff_)), 16, 0, 0); \
        __builtin_amdgcn_global_load_lds((const unsigned*)(vg + go_ + 32 * DM), (LAS unsigned*)(ldsw + (voff_) + 8192), 16, 0, 0); } while (0)
    ATT_STAGE(NT - 1, 0, 32768);
    asm volatile("s_waitcnt vmcnt(0)" ::: "memory");
    __syncthreads();
    unsigned koff[8];
#pragma unroll
    for (int d0 = 0; d0 < 8; ++d0) koff[d0] = off_b(r32, 2 * d0 + hi);
    const unsigned qa = (lane & 15) >> 2, blk = (lane >> 4) & 1, pp = lane & 3;
    unsigned vbase[2], vcq[4];
#pragma unroll
    for (int t = 0; t < 2; ++t) vbase[t] = 256u * (8 * t + 4 * hi + qa) + 16u * ((2 * blk + (pp >> 1)) ^ ((2 * t + hi) & 3)) + 8u * (pp & 1);
#pragma unroll
    for (int c = 0; c < 4; ++c) vcq[c] = 64u * ((unsigned)c ^ qa);
    int kcur = 0, vprev = 2, vcur = 0, vnext = 1;
    bool prev_valid = false;
    for (int t = NT - 1; t >= 0; --t) {
        if (t > 0) ATT_STAGE(t - 1, (kcur ^ 1) * 16384, 32768 + vnext * 16384);
        const LAS unsigned char* kb = lds + kcur * 16384;
        const LAS unsigned char* vbp = lds + 32768 + vprev * 16384;
        const int k0 = 64 * t;
        const bool valid = (k0 < qw0 + 31);
        if (valid) {
            if (prev_valid) attn_tile<true>(kb, vbp, qf, o, pa, carry, koff, vbase, vcq, k0, qw0, qabs, hi);
            else            attn_tile<false>(kb, vbp, qf, o, pa, carry, koff, vbase, vcq, k0, qw0, qabs, hi);
        }
        prev_valid = valid;
        asm volatile("s_waitcnt vmcnt(0)" ::: "memory");
        __syncthreads();
        kcur ^= 1; { const int tmp = vprev; vprev = vcur; vcur = vnext; vnext = tmp; }
    }
    { const LAS unsigned char* vbp = lds + 32768 + vprev * 16384;
#pragma unroll
      for (int c = 0; c < 4; ++c)
#pragma unroll
          for (int s = 0; s < 4; ++s) {
              const s16x4 lo = vtr(vbp + 4096 * s + vbase[0] + vcq[c]);
              const s16x4 hh = vtr(vbp + 4096 * s + vbase[1] + vcq[c]);
              const bf16x8 vfr = (bf16x8){lo[0], lo[1], lo[2], lo[3], hh[0], hh[1], hh[2], hh[3]};
              o[c] = __builtin_amdgcn_mfma_f32_32x32x16_bf16(pa[s], vfr, o[c], 0, 0, 0);
          } }
    {
        int lane_e = lane_id(); asm volatile("" : "+v"(lane_e));
        const int r32e = lane_e & 31, hie = lane_e >> 5, rowq = lane_e >> 4, c4 = (lane_e & 15) * 4;
        LAS float* stg = (LAS float*)(lds + 81920 + wid * 8192);
        const size_t gbase = (tok0 + qw0) * DM + h * HD + c4;
        u32x2 zv[2][8];
#pragma unroll
        for (int ps = 0; ps < 2; ++ps)
#pragma unroll
            for (int j = 0; j < 8; ++j) zv[ps][j] = *(const u32x2*)(ZS + gbase + (size_t)(4 * j + rowq) * DM + 64 * ps);
#pragma unroll
        for (int ps = 0; ps < 2; ++ps) {
#pragma unroll
            for (int r = 0; r < 16; ++r) {
                stg[crow(r, hie) * 64 + r32e] = o[2 * ps][r];
                stg[crow(r, hie) * 64 + 32 + r32e] = o[2 * ps + 1][r];
            }
            asm volatile("s_waitcnt lgkmcnt(0)" ::: "memory");
#pragma unroll
            for (int j = 0; j < 8; ++j) {
                const f32x4 ov = *(const LAS f32x4*)(stg + (4 * j + rowq) * 64 + c4);
                const u32x2 z = zv[ps][j];
                u32x2 w; w.x = pk_bf16(ov[0] * bf_lo(z.x), ov[1] * bf_hi(z.x)); w.y = pk_bf16(ov[2] * bf_lo(z.y), ov[3] * bf_hi(z.y));
                *(u32x2*)(OG + gbase + (size_t)(4 * j + rowq) * DM + 64 * ps) = w;
            }
            asm volatile("s_waitcnt lgkmcnt(0)" ::: "memory");
        }
    }
    __syncthreads();
}
__device__ __forceinline__ void attn_phase(LAS unsigned char* lds, const int wid_, int vcu, int G, const bf16_t* Q, const bf16_t* K, const bf16_t* V, const bf16_t* ZS, bf16_t* OG) {
#ifndef NO_ATTN_PRIO
    if (wid_ >= 4) __builtin_amdgcn_s_setprio(1);
#endif
    for (int p = vcu; p < 256; p += G) {
        const int bh = p >> 3, s = p & 7;
#ifdef ATT_ONE_INSTANCE
#pragma unroll 1
        for (int uu = 0; uu < 2; ++uu) attn_unit(lds, wid_, bh >> 4, bh & 15, uu ? 15 - s : s, Q, K, V, ZS, OG);
#else
        attn_unit(lds, wid_, bh >> 4, bh & 15, s, Q, K, V, ZS, OG);
        attn_unit(lds, wid_, bh >> 4, bh & 15, 15 - s, Q, K, V, ZS, OG);
#endif
    }
    __builtin_amdgcn_s_setprio(0);
}

__device__ __forceinline__ void mix_unit(LAS unsigned char* lds, const int wid, int n, int g, const bf16_t* __restrict__ UZ, const bf16_t* __restrict__ V, const float* __restrict__ vss,
                                         const float* __restrict__ w_s, const float* __restrict__ b_s, const float* __restrict__ vg, bf16_t* __restrict__ Y) {
    const int tid = tid_of(wid), lane = tid & 63, r32 = lane & 31, hi = lane >> 5;
    const size_t row0 = (size_t)n * CHUNK;
    LAS float* rstdL = (LAS float*)(lds + 98304);
    const int cc = tid & 31;
    u32x4 uu[8];
#pragma unroll
    for (int i = 0; i < 8; ++i) { const int t = (tid >> 5) + 16 * i; uu[i] = __builtin_nontemporal_load((const u32x4*)(UZ + (row0 + t) * GW + g * GDIM + cc * 8)); }
    {
        u32x4 vr[8];
#pragma unroll
        for (int i = 0; i < 8; ++i) { const int c = tid + 512 * i, s = c >> 5, cc = c & 31;
            vr[i] = __builtin_nontemporal_load((const u32x4*)(V + (row0 + s) * GW + g * GDIM + cc * 8)); }
        if (tid < 128) { const f32x4* vp = (const f32x4*)(vss + (row0 + tid) * 64); f32x4 s4 = vp[0];
#pragma unroll
            for (int i = 1; i < 16; ++i) s4 += vp[i];
            rstdL[tid] = __builtin_amdgcn_rsqf(((s4[0] + s4[1]) + (s4[2] + s4[3])) * (1.0f / GW) + EPS); }
#pragma unroll
        for (int i = 0; i < 8; ++i) { const int c = tid + 512 * i, s = c >> 5, cc = c & 31;
            *(LAS u32x4*)(lds + 32768 + (cc >> 4) * 32768 + off_b(s, cc & 15)) = vr[i]; }
    }
    __syncthreads();
#pragma unroll
    for (int i = 0; i < 4; ++i) { const int c = tid + 512 * i, t = c >> 4, ch = c & 15, s0 = ch * 8;
        const f32x4 w0 = *(const f32x4*)(w_s + ((size_t)g * CHUNK + t) * CHUNK + s0), w1 = *(const f32x4*)(w_s + ((size_t)g * CHUNK + t) * CHUNK + s0 + 4);
        float wv[8] = {w0[0], w0[1], w0[2], w0[3], w1[0], w1[1], w1[2], w1[3]};
#pragma unroll
        for (int j = 0; j < 8; ++j) wv[j] = (s0 + j <= t) ? wv[j] * rstdL[s0 + j] : 0.f;
        u32x4 w; w.x = pk_bf16(wv[0], wv[1]); w.y = pk_bf16(wv[2], wv[3]); w.z = pk_bf16(wv[4], wv[5]); w.w = pk_bf16(wv[6], wv[7]);
        *(LAS u32x4*)(lds + off_b(t, ch)) = w; }
    __syncthreads();
    f32x16 acc[4];
#pragma unroll
    for (int i = 0; i < 4; ++i)
#pragma unroll
        for (int r = 0; r < 16; ++r) acc[i][r] = 0.f;
    {
        const LAS unsigned char* vimg = lds + 32768 + (wid >> 2) * 32768;
        const unsigned cblk = wid & 3, qa = (lane & 15) >> 2, blk = (lane >> 4) & 1, pp = lane & 3;
#pragma unroll
        for (int ks = 0; ks < 8; ++ks) {
            const s16x4 lo = vtr(vimg + off_b(16 * ks + 8 * hi + qa, 4 * cblk + 2 * blk + (pp >> 1)) + 8 * (pp & 1));
            const s16x4 hh = vtr(vimg + off_b(16 * ks + 8 * hi + 4 + qa, 4 * cblk + 2 * blk + (pp >> 1)) + 8 * (pp & 1));
            const bf16x8 vf = (bf16x8){lo[0], lo[1], lo[2], lo[3], hh[0], hh[1], hh[2], hh[3]};
#pragma unroll
            for (int i = 0; i < 4; ++i) if (ks <= 2 * i + 1) {
                const bf16x8 af = *(const LAS bf16x8*)(lds + off_b(32 * i + r32, 2 * ks + hi));
                acc[i] = __builtin_amdgcn_mfma_f32_32x32x16_bf16(af, vf, acc[i], 0, 0, 0);
            }
        }
    }
    __syncthreads();
    {
        LAS float* mx = (LAS float*)lds;
        const int c = 128 * (wid >> 2) + 32 * (wid & 3) + r32;
#pragma unroll
        for (int i = 0; i < 4; ++i)
#pragma unroll
            for (int r = 0; r < 16; ++r) mx[(32 * i + crow(r, hi)) * 256 + c] = acc[i][r];
    }
    __syncthreads();
    {
        const f32x4 g0 = *(const f32x4*)(vg + g * GDIM + cc * 8), g1 = *(const f32x4*)(vg + g * GDIM + cc * 8 + 4);
        float bb[8];
#pragma unroll
        for (int i = 0; i < 8; ++i) bb[i] = b_s[g * CHUNK + (tid >> 5) + 16 * i];
#pragma unroll
        for (int i = 0; i < 8; ++i) { const int t = (tid >> 5) + 16 * i;
            const f32x4 m0 = *(const LAS f32x4*)(lds + (t * 256 + cc * 8) * 4), m1 = *(const LAS f32x4*)(lds + (t * 256 + cc * 8 + 4) * 4);
            float y[8];
            y[0] = bf_lo(uu[i].x) * (m0[0] * g0[0] + bb[i]); y[1] = bf_hi(uu[i].x) * (m0[1] * g0[1] + bb[i]);
            y[2] = bf_lo(uu[i].y) * (m0[2] * g0[2] + bb[i]); y[3] = bf_hi(uu[i].y) * (m0[3] * g0[3] + bb[i]);
            y[4] = bf_lo(uu[i].z) * (m1[0] * g1[0] + bb[i]); y[5] = bf_hi(uu[i].z) * (m1[1] * g1[1] + bb[i]);
            y[6] = bf_lo(uu[i].w) * (m1[2] * g1[2] + bb[i]); y[7] = bf_hi(uu[i].w) * (m1[3] * g1[3] + bb[i]);
            u32x4 w; w.x = pk_bf16(y[0], y[1]); w.y = pk_bf16(y[2], y[3]); w.z = pk_bf16(y[4], y[5]); w.w = pk_bf16(y[6], y[7]);
            *(u32x4*)(Y + (row0 + t) * GW + g * GDIM + cc * 8) = w; }
    }
    __syncthreads();
}

__device__ __forceinline__ float wave_sum(float v) {
#pragma unroll
    for (int o = 1; o < 64; o <<= 1) v += __shfl_xor(v, o);
    return v;
}
__device__ __forceinline__ void tr_load(const float* __restrict__ W, int N, int item, int lane, f32x4 (&wv)[16]) {
    const int nblk = N / 64, k0 = 64 * (item / nblk), n0 = 64 * (item % nblk);
#pragma unroll
    for (int i = 0; i < 16; ++i) wv[i] = __builtin_nontemporal_load((const f32x4*)(W + (size_t)(k0 + 4 * i + (lane >> 4)) * N + n0 + 4 * (lane & 15)));
}
__device__ __forceinline__ void tr_to_lds(LAS float* scr, int lane, const f32x4 (&wv)[16]) {
#pragma unroll
    for (int i = 0; i < 16; ++i) { const int kk = 4 * i + (lane >> 4), nn = 4 * (lane & 15);
        LAS float* s = scr + kk * 65 + nn; s[0] = wv[i][0]; s[1] = wv[i][1]; s[2] = wv[i][2]; s[3] = wv[i][3]; }
    asm volatile("s_waitcnt lgkmcnt(0)" ::: "memory");
}
__device__ __forceinline__ void tr_store(int K, int N, bf16_t* __restrict__ WT, const LAS float* scr, int item, int lane, const float* __restrict__ gk, bool gmlp_perm) {
    const int nblk = N / 64, k0 = 64 * (item / nblk), n0 = 64 * (item % nblk);
    int r0 = n0;
    if (gmlp_perm) {
        if (n0 < GW) { const int cb = n0 >> 7; r0 = 256 * (3 * (cb >> 1) + (cb & 1)) + (n0 & 127); }
        else if (n0 < 2 * GW) { const int mv = n0 - GW; r0 = 256 * (3 * (mv >> 8) + 2) + (mv & 255); }
        else { const int mz = n0 - 2 * GW, cb = mz >> 7; r0 = 256 * (3 * (cb >> 1) + (cb & 1)) + 128 + (mz & 127); }
    }
    const int c = lane & 7;
    f32x4 ga = {1.f, 1.f, 1.f, 1.f}, gb = {1.f, 1.f, 1.f, 1.f};
    if (gk) { ga = *(const f32x4*)(gk + k0 + 8 * c); gb = *(const f32x4*)(gk + k0 + 8 * c + 4); }
#pragma unroll
    for (int j = 0; j < 8; ++j) { const int nn = (lane >> 3) + 8 * j; const LAS float* s = scr + (8 * c) * 65 + nn;
        u32x4 o; o.x = pk_bf16(s[0] * ga[0], s[65] * ga[1]); o.y = pk_bf16(s[2 * 65] * ga[2], s[3 * 65] * ga[3]); o.z = pk_bf16(s[4 * 65] * gb[0], s[5 * 65] * gb[1]); o.w = pk_bf16(s[6 * 65] * gb[2], s[7 * 65] * gb[3]);
        *(u32x4*)(WT + (size_t)(r0 + nn) * K + k0 + 8 * c) = o; }
    asm volatile("s_waitcnt lgkmcnt(0)" ::: "memory");
}
__device__ __forceinline__ void transpose_matrix(const float* __restrict__ W, int K, int N, bf16_t* __restrict__ WT, LAS float* scr, int first, int stride, int nitems, int lane,
                                                 const float* __restrict__ gk = nullptr, bool gmlp_perm = false) {
    f32x4 wv[16], wn[16];
    int it = first;
    if (it < nitems) tr_load(W, N, it, lane, wv);
    while (it < nitems) {
        const int nx = it + stride;
        tr_to_lds(scr, lane, wv);
        if (nx < nitems) tr_load(W, N, nx, lane, wn);
        tr_store(K, N, WT, scr, it, lane, gk, gmlp_perm);
#pragma unroll
        for (int i = 0; i < 16; ++i) wv[i] = wn[i];
        it = nx;
    }
}

#define XB_TMO      128
#define XB_XCNT(j)  (256  + 64 * (j))
#define XB_XSUB(j)  (1280 + 64 * (j))
#define XB_XGEN(j)  (2304 + 64 * (j))
#define XB_TOP      3328
#define XB_TOPGEN   3392
#define XCD_BAR_WORDS 3456
#define XB_SPIN_CAP (1u << 18)

__device__ __forceinline__ unsigned xb_ld(unsigned* p)              { return __hip_atomic_load(p, __ATOMIC_RELAXED, __HIP_MEMORY_SCOPE_AGENT); }
__device__ __forceinline__ unsigned xb_add(unsigned* p, unsigned v) { return __hip_atomic_fetch_add(p, v, __ATOMIC_RELAXED, __HIP_MEMORY_SCOPE_AGENT); }
__device__ __forceinline__ unsigned xb_xcc_id() { return (unsigned)__builtin_amdgcn_s_getreg((3 << 11) | 20) & 0xFu; }
#define XB_SPIN(cond, bar) do { unsigned _sp = 0; while (cond) { __builtin_amdgcn_s_sleep(1); \
    if ((++_sp & 255u) == 0u) { if (xb_ld(&(bar)[XB_TMO])) break; if (_sp > XB_SPIN_CAP) { atomicAdd(&(bar)[XB_TMO], 1u); break; } } } } while (0)

struct XcdBarrier {
    unsigned* bar; unsigned x; int w;
    volatile LAS unsigned* st;
};

__device__ __forceinline__ XcdBarrier xcd_barrier_post(unsigned* bar, volatile LAS unsigned* st, int wave) {
    XcdBarrier b; b.bar = bar; b.x = xb_xcc_id(); b.st = st; b.w = wave;
    if (tid_of(wave) == 0) (void)xb_add(&bar[XB_XCNT(b.x)], 1u);
    return b;
}
__device__ __forceinline__ void xcd_barrier_complete(unsigned* bar, unsigned x, unsigned& nloc, unsigned& nx) {
    const unsigned G = gridDim.x * gridDim.y * gridDim.z;
    unsigned sum, cnt, mine, sp = 0u;
    for (;;) {
        sum = 0u; cnt = 0u; mine = 0u;
#pragma unroll
        for (unsigned j = 0; j < 16; ++j) { const unsigned c = xb_ld(&bar[XB_XCNT(j)]); sum += c; cnt += (c > 0u) ? 1u : 0u; mine = (j == x) ? c : mine; }
        if (sum == G) break;
        __builtin_amdgcn_s_sleep(1);
        if ((++sp & 255u) == 0u) { if (xb_ld(&bar[XB_TMO])) break; if (sp > XB_SPIN_CAP) { atomicAdd(&bar[XB_TMO], 1u); break; } }
    }
    nloc = mine > 0u ? mine : 1u; nx = cnt > 0u ? cnt : 1u;
}

__device__ __forceinline__ void xcd_barrier(const XcdBarrier& b) {
    asm volatile("s_waitcnt vmcnt(0)" ::: "memory");
    __syncthreads();
    if (tid_of(b.w) == 0) {
        unsigned* bar = b.bar;
        __builtin_amdgcn_s_waitcnt(0);
        unsigned nloc = b.st[0], nx = b.st[1];
        if (nloc == 0u) { xcd_barrier_complete(bar, b.x, nloc, nx); b.st[0] = nloc; b.st[1] = nx; }
        const unsigned old = xb_add(&bar[XB_XSUB(b.x)], 1u);
        const unsigned gen = old / nloc;
        if (old + 1u == (gen + 1u) * nloc) {
            __builtin_amdgcn_fence(__ATOMIC_RELEASE, "agent");
            asm volatile("s_waitcnt vmcnt(0)" ::: "memory");
            const unsigned og = xb_add(&bar[XB_TOP], 1u);
            const unsigned tg = og / nx;
            if (og + 1u == (tg + 1u) * nx) xb_add(&bar[XB_TOPGEN], 1u);
            else XB_SPIN(xb_ld(&bar[XB_TOPGEN]) == tg, bar);
            __builtin_amdgcn_fence(__ATOMIC_ACQUIRE, "agent");
            xb_add(&bar[XB_XGEN(b.x)], 1u);
            asm volatile("s_waitcnt vmcnt(0)" ::: "memory");
        } else {
            XB_SPIN(xb_ld(&bar[XB_XGEN(b.x)]) == gen, bar);
            __builtin_amdgcn_fence(__ATOMIC_ACQUIRE, "agent");
            asm volatile("s_waitcnt vmcnt(0)" ::: "memory");
        }
    }
    __syncthreads();
}

constexpr size_t MiB = 1u << 20;
constexpr size_t WS_VSS = 0, WS_HSS1 = 2 * MiB, WS_HSS2 = 3 * MiB, WS_IRS0 = 3 * MiB + 32768, WS_CNT = 3 * MiB + 65536;
constexpr size_t WS_WT1 = 4 * MiB, WS_HN0 = 268 * MiB  , WS_WT2 = 84 * MiB, WS_WT3 = 100 * MiB, WS_WT4 = 132 * MiB;
constexpr size_t WS_U = 140 * MiB, WS_V = 204 * MiB, WS_ZS = 268 * MiB, WS_CTL = 364 * MiB, CTL_ZERO_BYTES = 32768, WS_END = 365 * MiB;
constexpr size_t WS_Y = 4 * MiB;
constexpr size_t WS_H1 = 140 * MiB, WS_H1B = 332 * MiB;
constexpr size_t WS_Q = 204 * MiB, WS_K = 236 * MiB, WS_V2 = 268 * MiB, WS_ZS2 = 300 * MiB, WS_OG = 4 * MiB;

constexpr int NWAVES = 8, LDS_BYTES = 151552;
#ifndef N_LAUNCHES
#define N_LAUNCHES 1
#endif
constexpr int N_PHASES = 7;
#ifndef CONV_TRIGGER
#define CONV_TRIGGER ((bx >> 3) % 6)
#endif
#ifndef GEMM_SP2
#define GEMM_SP2 true
#endif
#ifndef GEMM_ALIGN
#define GEMM_ALIGN true
#endif
#ifndef REPEAT_PHASE
#define REPEAT_PHASE -1
#endif
#define NREP(k) ((REPEAT_PHASE == (k)) ? 2 : 1)

struct Args { const float* in[10]; float* out; unsigned char* ws; int ph_lo, ph_hi, li, pad; };

__global__ void __launch_bounds__(NWAVES * 64, 2) fwd_kernel(Args a) {
    extern __shared__ __attribute__((aligned(16))) unsigned char lds_raw[];
    LAS unsigned char* lds = (LAS unsigned char*)lds_raw;
    cg::grid_group grid = cg::this_grid();
    const int wave = __builtin_amdgcn_readfirstlane(threadIdx.x >> 6);
#define tid tid_of(wave)
#define lane lane_id()
    const int G = gridDim.x, bx = blockIdx.x;
    const int vcu = (G % 8 == 0) ? (bx % 8) * (G / 8) + bx / 8 : bx;
    const float* x = a.in[0]; const float* norm_g = a.in[1]; const float* a_w_in = a.in[2]; const float* a_vg = a.in[3]; const float* a_w_s = a.in[4];
    const float* a_b_s = a.in[5]; const float* a_w_out = a.in[6]; const float* b_w_in = a.in[7]; const float* b_w_out = a.in[8]; const float* final_g = a.in[9];
    unsigned char* ws = a.ws;
    float* VSS = (float*)(ws + WS_VSS); float* HSS1 = (float*)(ws + WS_HSS1); float* HSS2 = (float*)(ws + WS_HSS2); float* IRS0 = (float*)(ws + WS_IRS0); unsigned* CNT = (unsigned*)(ws + WS_CNT);
    bf16_t* WT1 = (bf16_t*)(ws + WS_WT1); bf16_t* WT2 = (bf16_t*)(ws + WS_WT2); bf16_t* WT3 = (bf16_t*)(ws + WS_WT3); bf16_t* WT4 = (bf16_t*)(ws + WS_WT4);
    bf16_t* HN0 = (bf16_t*)(ws + WS_HN0); bf16_t* U = (bf16_t*)(ws + WS_U); bf16_t* V = (bf16_t*)(ws + WS_V); bf16_t* ZS = (bf16_t*)(ws + WS_ZS);
    bf16_t* Y = (bf16_t*)(ws + WS_Y); bf16_t* H1B = (bf16_t*)(ws + WS_H1B);
    bf16_t* Qb = (bf16_t*)(ws + WS_Q); bf16_t* Kb = (bf16_t*)(ws + WS_K); bf16_t* V2 = (bf16_t*)(ws + WS_V2); bf16_t* ZS2 = (bf16_t*)(ws + WS_ZS2); bf16_t* OG = (bf16_t*)(ws + WS_OG);
    const int lo = a.ph_lo, hi = a.ph_hi;
#define IN(k) (lo <= (k) && (k) < hi)
#define SEAM(k) do { if (IN(k) && IN((k) + 1)) xcd_barrier(bar); } while (0)
    volatile LAS unsigned* MISC = (volatile LAS unsigned*)(lds + LDS_BYTES - 64);
    if (tid < 16) MISC[tid] = 0u;
    __syncthreads();
    XcdBarrier bar = xcd_barrier_post((unsigned*)(ws + WS_CTL) + a.li * XCD_BAR_WORDS, MISC + 8, wave);
    if (lo > 1000) grid.sync();
    const int gw = vcu * NWAVES + wave, NGW = G * NWAVES;

    if (IN(0)) for (int rep = 0; rep < NREP(0); ++rep) {
        LAS float* scr = (LAS float*)(lds + wave * 16640);
        constexpr int I1 = (DM / 64) * (3 * GW / 64), I2 = (GW / 64) * (DM / 64), I3 = (DM / 64) * (4 * DM / 64), I4 = (DM / 64) * (DM / 64);
        transpose_matrix(a_w_in, DM, 3 * GW, WT1, scr, gw, NGW, I1, lane, nullptr, true);
        for (int m = bx * (NWAVES * 64) + tid; m < NTOK; m += G * NWAVES * 64) { HSS1[m] = 0.f; HSS2[m] = 0.f; if (m < 2048) CNT[m] = 0u; }
        for (int m = gw; m < NTOK; m += 2 * NGW) {
            const int m2 = m + NGW; const bool two = m2 < NTOK;
            const f32x4* xr = (const f32x4*)(x + (size_t)m * DM) + lane; const f32x4* xr2 = (const f32x4*)(x + (size_t)(two ? m2 : m) * DM) + lane; const f32x4* gr = (const f32x4*)norm_g + lane;
            f32x4 v[8], v2[8]; float ss = 0.f, ss2 = 0.f;
#pragma unroll
            for (int j = 0; j < 8; ++j) { v[j] = __builtin_nontemporal_load(xr + 64 * j); v2[j] = __builtin_nontemporal_load(xr2 + 64 * j); }
#pragma unroll
            for (int j = 0; j < 8; ++j) { ss += (v[j][0] * v[j][0] + v[j][1] * v[j][1]) + (v[j][2] * v[j][2] + v[j][3] * v[j][3]); ss2 += (v2[j][0] * v2[j][0] + v2[j][1] * v2[j][1]) + (v2[j][2] * v2[j][2] + v2[j][3] * v2[j][3]); }
            const float ms = wave_sum(ss) * (1.0f / DM) + EPS, ms2 = wave_sum(ss2) * (1.0f / DM) + EPS;
            const float rstd = __builtin_amdgcn_rsqf(ms), rstd2 = __builtin_amdgcn_rsqf(ms2);
            if (lane == 0) { IRS0[m] = __builtin_amdgcn_sqrtf(ms); if (two) IRS0[m2] = __builtin_amdgcn_sqrtf(ms2); }
            u32x2* o8 = (u32x2*)(HN0 + (size_t)m * DM) + lane; u32x2* o82 = (u32x2*)(HN0 + (size_t)m2 * DM) + lane;
#pragma unroll
            for (int j = 0; j < 8; ++j) { const f32x4 gg = gr[64 * j];
                u32x2 w; w.x = pk_bf16(v[j][0] * rstd * gg[0], v[j][1] * rstd * gg[1]); w.y = pk_bf16(v[j][2] * rstd * gg[2], v[j][3] * rstd * gg[3]); o8[64 * j] = w;
                if (two) { u32x2 w2; w2.x = pk_bf16(v2[j][0] * rstd2 * gg[0], v2[j][1] * rstd2 * gg[1]); w2.y = pk_bf16(v2[j][2] * rstd2 * gg[2], v2[j][3] * rstd2 * gg[3]); o82[64 * j] = w2; } }
        }
    }
    SEAM(0);
#ifdef EXTRA_SYNCS
    for (int i = 0; i < EXTRA_SYNCS; ++i) xcd_barrier(bar);
#endif
    if (IN(1)) for (int rep = 0; rep < NREP(1); ++rep) {
        pg8::Gemm g{HN0, WT1, NTOK, 3 * GW, DM}; pg8::ConvOrder S; S.init(NTOK, 3 * GW, G, bx);
        S.w2 = a_w_out; S.w3 = b_w_in; S.w4 = b_w_out; S.g1 = norm_g + DM; S.t2 = WT2; S.t3 = WT3; S.t4 = WT4; S.gw = gw; S.ngw = NGW; S.trigger = (G == 256) ? CONV_TRIGGER : 0; S.ln = lane; S.sw = lds + 131072 + wave * 2048; S.n_done = 0;
        pg8::EpiGmlpIn E{U, V, VSS};
        pg8::gemm_phase<pg8::EpiGmlpIn, pg8::ConvOrder, GEMM_ALIGN, GEMM_SP2>(lds, g, S, E, wave);
    }
    SEAM(1);
    if (IN(2)) for (int rep = 0; rep < NREP(2); ++rep) {
        for (int it = vcu; it < (NTOK / CHUNK) * NGRP; it += G) mix_unit(lds, wave, it >> 4, it & 15, U, V, VSS, a_w_s, a_b_s, a_vg, Y);
    }
    SEAM(2);
    if (IN(3)) for (int rep = 0; rep < NREP(3); ++rep) {
        pg8::Gemm g{Y, WT2, NTOK, DM, GW}; pg8::StaticOrder S; S.init(NTOK, DM, G, bx);
        pg8::EpiRes1 E{HN0, IRS0, norm_g, H1B, HSS1};
        pg8::gemm_phase<pg8::EpiRes1, pg8::StaticOrder, GEMM_ALIGN, GEMM_SP2>(lds, g, S, E, wave);
    }
    SEAM(3);
    if (IN(4)) for (int rep = 0; rep < NREP(4); ++rep) {
        pg8::Gemm g{H1B, WT3, NTOK, 4 * DM, DM}; pg8::StaticOrder S; S.init(NTOK, 4 * DM, G, bx);
        pg8::EpiSbIn E{Qb, (size_t)(WS_K - WS_Q) / 2, HSS1};
        pg8::gemm_phase<pg8::EpiSbIn, pg8::StaticOrder, GEMM_ALIGN, GEMM_SP2>(lds, g, S, E, wave);
    }
    SEAM(4);
    if (IN(5)) for (int rep = 0; rep < NREP(5); ++rep) attn_phase(lds, wave, vcu, G, Qb, Kb, V2, ZS2, OG);
    SEAM(5);
    if (IN(6)) for (int rep = 0; rep < NREP(6); ++rep) {
        pg8::Gemm g{OG, WT4, NTOK, DM, DM}; pg8::StaticOrder S; S.init(NTOK, DM, G, bx);
        pg8::EpiFinal E{H1B, final_g, a.out, HSS2, CNT, G == 256};
        pg8::gemm_phase<pg8::EpiFinal, pg8::StaticOrder, GEMM_ALIGN, GEMM_SP2>(lds, g, S, E, wave);
    }
    if (IN(6) && G != 256) {
        xcd_barrier(bar);
        for (int m = gw; m < NTOK; m += NGW) {
            const float rstd = __builtin_amdgcn_rsqf(HSS2[m] * (1.0f / DM) + EPS);
            f32x4* orow = (f32x4*)(a.out + (size_t)m * DM) + lane; const f32x4* gr = (const f32x4*)final_g + lane;
#pragma unroll
            for (int j = 0; j < 8; ++j) { const f32x4 v = orow[64 * j]; orow[64 * j] = v * rstd * gr[64 * j]; }
        }
    }
#undef IN
#undef SEAM
#undef tid
#undef lane
}

extern "C" void kernel_launch(void* const* d_in, const int* in_sizes, int n_in, void* d_out, int out_size, void* d_ws, size_t ws_size, hipStream_t stream) {
    static int grid = 0;
    if (grid == 0) {
        if (n_in != 10 || out_size != NTOK * DM || ws_size < WS_END) { fprintf(stderr, "kernel_launch: unexpected shapes (n_in %d, out %d, ws %zu)\n", n_in, out_size, ws_size); grid = -1; return; }
        int dev = 0, cus = 0, per_cu = 0;
        (void)hipGetDevice(&dev); (void)hipDeviceGetAttribute(&cus, hipDeviceAttributeMultiprocessorCount, dev);
        if (hipFuncSetAttribute((const void*)fwd_kernel, hipFuncAttributeMaxDynamicSharedMemorySize, LDS_BYTES) != hipSuccess) { fprintf(stderr, "kernel_launch: hipFuncSetAttribute failed\n"); grid = -1; return; }
        if (hipOccupancyMaxActiveBlocksPerMultiprocessor(&per_cu, (const void*)fwd_kernel, NWAVES * 64, LDS_BYTES) != hipSuccess || per_cu < 1) { fprintf(stderr, "kernel_launch: occupancy query says %d\n", per_cu); per_cu = 1; }
        (void)hipGetLastError();
        grid = cus > 0 ? cus : 256;
    }
    if (grid < 0) return;
    if (hipMemsetAsync((char*)d_ws + WS_CTL, 0, CTL_ZERO_BYTES, stream) != hipSuccess) { fprintf(stderr, "kernel_launch: memset failed\n"); return; }
    Args a{};
    for (int i = 0; i < 10; ++i) a.in[i] = (const float*)d_in[i];
    a.out = (float*)d_out; a.ws = (unsigned char*)d_ws;
#ifdef PROBE_SPLIT
    const int nl = 2;
#else
    const int nl = N_LAUNCHES;
#endif
    for (int li = 0; li < nl; ++li) {
        a.ph_lo = (N_LAUNCHES == 1) ? 0 : li; a.ph_hi = (N_LAUNCHES == 1) ? N_PHASES : li + 1;
#ifdef PROBE_SPLIT
        a.ph_lo = li == 0 ? 0 : PROBE_SPLIT; a.ph_hi = li == 0 ? PROBE_SPLIT + 1 : N_PHASES;
#endif
        a.li = li;
        void* args[] = {&a};
        hipError_t e = hipLaunchCooperativeKernel((const void*)fwd_kernel, dim3(grid), dim3(NWAVES * 64), args, LDS_BYTES, stream);
        if (e != hipSuccess) { fprintf(stderr, "kernel_launch: cooperative launch %d failed: %s (grid %d)\n", li, hipGetErrorString(e), grid); break; }
    }
}
```

```cpp
#include <hip/hip_runtime.h>
#include <hip/hip_cooperative_groups.h>
#include <cstdio>
#include <cstdint>
namespace cg = cooperative_groups;
__device__ __forceinline__ int lane_id() { return (int)__builtin_amdgcn_mbcnt_hi(~0u, __builtin_amdgcn_mbcnt_lo(~0u, 0u)); }
__device__ __forceinline__ int tid_of(int wave) { return wave * 64 + lane_id(); }
#ifndef PG8_WGM
#define PG8_WGM 8
#endif
namespace pg8 {
#define PG8_LAS __attribute__((address_space(3)))
typedef unsigned short bf16_t;
typedef short bf16x8 __attribute__((ext_vector_type(8)));
typedef float f32x4 __attribute__((ext_vector_type(4)));
typedef unsigned u32x4 __attribute__((ext_vector_type(4)));
constexpr int BM = 256, BK = 64, HALF = 128, HTB = HALF * BK * 2  , STAGE_BYTES = 8 * HTB, NXCD = 8, WGM = PG8_WGM;

__host__ __device__ __forceinline__ int lds_byte(int r, int c) { const int st = (r >> 4) * 2 + (c >> 5), rr = r & 15, cc = c & 31, ob = rr * 64 + cc * 2; return st * 1024 + (ob ^ (((ob >> 9) & 1) << 5)); }
__host__ __device__ __forceinline__ void stage_rc(int b, int& R, int& C) { const int st = b / 1024, sb = b % 1024, swz = sb ^ (((sb >> 9) & 1) << 5); R = (st >> 1) * 16 + swz / 64; C = (st & 1) * 32 + (swz % 64) / 2; }
__host__ __device__ __forceinline__ int perm32(int rho) { const int n = rho >> 4, i = rho & 15; return 8 * (i >> 2) + 4 * n + (i & 3); }

struct Unit { int pm, pn; };
struct Gemm { const bf16_t* A; const bf16_t* Bt; int M, N, K; };

struct StaticOrder {
    int nM, nN, nwg, G, c;
    __host__ __device__ void init(int M, int N, int G_, int c_) { nM = M / BM; nN = N / BM; nwg = nM * nN; G = G_; c = c_; }
    __host__ __device__ bool next(int i, Unit& u) const {
        const long L = (long)i * G + c; if (L >= nwg) return false;
        int wgid = (int)L; { const int q = nwg / NXCD, r = nwg % NXCD, xcd = wgid % NXCD, off = wgid / NXCD; wgid = (xcd < r ? xcd * (q + 1) : r * (q + 1) + (xcd - r) * q) + off; }
        const int nig = WGM * nN, gid = wgid / nig, fm = gid * WGM, gsz = (nM - fm) < WGM ? (nM - fm) : WGM;
        u.pm = fm + ((wgid % nig) % gsz); u.pn = (wgid % nig) / gsz; return true;
    }
    __device__ __forceinline__ void a_ready(const Unit&) const {}
    __device__ __forceinline__ void done(const Unit&) const {}
};

__device__ __forceinline__ unsigned cvt_pk_bf16(float lo, float hi) { unsigned r; asm volatile("v_cvt_pk_bf16_f32 %0, %1, %2" : "=v"(r) : "v"(lo), "v"(hi)); return r; }
typedef float f32x2 __attribute__((ext_vector_type(2)));
typedef float f32x2 __attribute__((ext_vector_type(2)));
template <class Epi, class Sched, bool ALIGN_EPI = false, bool SP2 = false>
__device__ __forceinline__ void gemm_phase(PG8_LAS unsigned char* lds, const Gemm g, const Sched& S, const Epi& E, const int wave_) {
    const int tid = tid_of(wave_), wid = wave_, lane = tid & 63, wr = wid >> 2, wc = wid & 3, fr = lane & 15, fq = lane >> 4;
    const int K = g.K, nt = K / BK;
    unsigned voffA[2], voffB[2];
#pragma unroll
    for (int i = 0; i < 2; ++i) { int R, C; stage_rc(tid * 16 + i * 8192, R, C); const int Rb = Epi::PERM ? ((R & ~31) + perm32(R & 31)) : R;
        voffA[i] = (unsigned)(R * K + C) * 2u; voffB[i] = (unsigned)(Rb * K + C) * 2u; }
    const size_t kstep = (size_t)(BK * 2);
    const size_t hstep = (size_t)HALF * K * 2;
    const size_t tstep = 2 * hstep;
    const unsigned ldsw = (unsigned)wid * 1024u;
    const int aoff = lds_byte(wr * 64 + fr, fq * 8), boff = lds_byte(wc * 32 + fr, fq * 8);
#define PG8_SA(b, h) (((b) * 2 + (h)) * HTB)
#define PG8_SB(b, h) ((4 + (b) * 2 + (h)) * HTB)
#define PG8_STAGE(bufoff, gbase, voff) do { _Pragma("unroll") for (int _i = 0; _i < 2; ++_i) \
        __builtin_amdgcn_global_load_lds((const unsigned*)((const char*)(gbase) + (voff)[_i]), (PG8_LAS unsigned*)(lds + (bufoff) + ldsw + _i * 8192), 16, 0, 0); } while (0)
#define PG8_LDA(dst, b, h) do { _Pragma("unroll") for (int m = 0; m < 4; ++m) _Pragma("unroll") for (int k = 0; k < 2; ++k) dst[m][k] = *(const PG8_LAS bf16x8*)(lds + PG8_SA(b, h) + aoff + m * 2048 + k * 1024); } while (0)
#define PG8_LDB(dst, b, h) do { _Pragma("unroll") for (int n = 0; n < 2; ++n) _Pragma("unroll") for (int k = 0; k < 2; ++k) dst[n][k] = *(const PG8_LAS bf16x8*)(lds + PG8_SB(b, h) + boff + n * 2048 + k * 1024); } while (0)
#define PG8_MMA(ai, bj, At, Bt) do { __builtin_amdgcn_s_setprio(1); _Pragma("unroll") for (int m = 0; m < 4; ++m) _Pragma("unroll") for (int n = 0; n < 2; ++n) _Pragma("unroll") for (int k = 0; k < 2; ++k) \
        acc[ai][bj][m][n] = __builtin_amdgcn_mfma_f32_16x16x32_bf16(Bt[n][k], At[m][k], acc[ai][bj][m][n], 0, 0, 0); __builtin_amdgcn_s_setprio(0); } while (0)
#define PG8_WAIT_V(n) asm volatile("s_waitcnt vmcnt(" #n ")" ::: "memory")
#define PG8_WAIT_L(n) asm volatile("s_waitcnt lgkmcnt(" #n ")" ::: "memory")
#define PG8_BAR __builtin_amdgcn_s_barrier()
#define PG8_SCHED __builtin_amdgcn_sched_barrier(0)
    Unit cur, nxt; int ui = 0;
    if (!S.next(0, cur)) return;
    f32x4 acc[2][2][4][2];
#pragma unroll
    for (int a = 0; a < 2; ++a)
#pragma unroll
        for (int b = 0; b < 2; ++b)
#pragma unroll
            for (int m = 0; m < 4; ++m)
#pragma unroll
                for (int n = 0; n < 2; ++n) acc[a][b][m][n] = (f32x4){0.f, 0.f, 0.f, 0.f};
    bf16x8 At[4][2], B0[2][2], B1[2][2];
    const char* cA = (const char*)g.A + (size_t)cur.pm * tstep; const char* cB = (const char*)g.Bt + (size_t)cur.pn * tstep;
    S.a_ready(cur);
    if constexpr (SP2) {
        PG8_STAGE(PG8_SB(0, 0), cB, voffB); PG8_STAGE(PG8_SB(0, 1), cB + hstep, voffB); PG8_STAGE(PG8_SA(0, 0), cA, voffA); PG8_STAGE(PG8_SA(0, 1), cA + hstep, voffA);
        if (wr == 1) PG8_BAR;
        PG8_WAIT_V(2); PG8_BAR;
        PG8_STAGE(PG8_SB(1, 0), cB + kstep, voffB); PG8_STAGE(PG8_SA(1, 0), cA + kstep, voffA); PG8_STAGE(PG8_SB(1, 1), cB + hstep + kstep, voffB);
        PG8_WAIT_V(6); PG8_BAR;
    } else {
        PG8_STAGE(PG8_SB(0, 0), cB, voffB); PG8_STAGE(PG8_SA(0, 0), cA, voffA); PG8_STAGE(PG8_SB(0, 1), cB + hstep, voffB); PG8_STAGE(PG8_SA(0, 1), cA + hstep, voffA);
        if (wr == 1) PG8_BAR;
        PG8_WAIT_V(4); PG8_BAR;
        PG8_STAGE(PG8_SB(1, 0), cB + kstep, voffB); PG8_STAGE(PG8_SA(1, 0), cA + kstep, voffA); PG8_STAGE(PG8_SB(1, 1), cB + hstep + kstep, voffB);
        PG8_WAIT_V(6); PG8_BAR;
    }
    for (;;) {
        const bool has_next = S.next(ui + 1, nxt);
        const char* nA = has_next ? (const char*)g.A + (size_t)nxt.pm * tstep : cA; const char* nB = has_next ? (const char*)g.Bt + (size_t)nxt.pn * tstep : cB;
        for (int t = 0; t < nt; t += 2) {
            const bool last = (t == nt - 2);
            const char* a1 = cA + (size_t)(t + 1) * kstep;
            const char* a2 = last ? nA : cA + (size_t)(t + 2) * kstep; const char* b2 = last ? nB : cB + (size_t)(t + 2) * kstep;
            const char* a3 = a2 + kstep; const char* b3 = b2 + kstep;
            if (last && has_next) S.a_ready(nxt);
            if constexpr (SP2) {
            PG8_LDB(B0, 0, 0); PG8_LDB(B1, 0, 1); PG8_SCHED; PG8_LDA(At, 0, 0); PG8_STAGE(PG8_SA(1, 1), a1 + hstep, voffA);
            PG8_WAIT_V(8); PG8_WAIT_L(0); PG8_BAR; PG8_MMA(0, 0, At, B0); PG8_MMA(0, 1, At, B1); PG8_BAR; PG8_SCHED;
            PG8_LDA(At, 0, 1); PG8_STAGE(PG8_SB(0, 0), b2, voffB); PG8_STAGE(PG8_SB(0, 1), b2 + hstep, voffB); PG8_STAGE(PG8_SA(0, 0), a2, voffA);
            PG8_WAIT_V(8); PG8_WAIT_L(0); PG8_BAR; PG8_MMA(1, 0, At, B0); PG8_MMA(1, 1, At, B1); PG8_BAR; PG8_SCHED;
            PG8_LDB(B0, 1, 0); PG8_LDB(B1, 1, 1); PG8_SCHED; PG8_LDA(At, 1, 0); PG8_STAGE(PG8_SA(0, 1), a2 + hstep, voffA);
            PG8_WAIT_V(8); PG8_WAIT_L(0); PG8_BAR; PG8_MMA(0, 0, At, B0); PG8_MMA(0, 1, At, B1); PG8_BAR; PG8_SCHED;
            PG8_LDA(At, 1, 1); PG8_STAGE(PG8_SB(1, 0), b3, voffB); PG8_STAGE(PG8_SB(1, 1), b3 + hstep, voffB); PG8_STAGE(PG8_SA(1, 0), a3, voffA);
            PG8_WAIT_V(8); PG8_WAIT_L(0); PG8_BAR; PG8_MMA(1, 0, At, B0); PG8_MMA(1, 1, At, B1); PG8_BAR; PG8_SCHED;
            } else {
            PG8_LDB(B0, 0, 0); PG8_SCHED; PG8_LDA(At, 0, 0); PG8_STAGE(PG8_SA(1, 1), a1 + hstep, voffA);
            PG8_WAIT_L(8); PG8_BAR; PG8_WAIT_L(0); PG8_MMA(0, 0, At, B0); PG8_BAR; PG8_SCHED;
            PG8_LDB(B1, 0, 1); PG8_STAGE(PG8_SB(0, 0), b2, voffB);
            PG8_BAR; PG8_WAIT_L(0); PG8_MMA(0, 1, At, B1); PG8_BAR;
            PG8_LDA(At, 0, 1); PG8_STAGE(PG8_SA(0, 0), a2, voffA);
            PG8_BAR; PG8_WAIT_L(0); PG8_MMA(1, 0, At, B0); PG8_BAR; PG8_SCHED;
            PG8_STAGE(PG8_SB(0, 1), b2 + hstep, voffB);
            PG8_WAIT_V(6); PG8_BAR; PG8_MMA(1, 1, At, B1); PG8_BAR;
            PG8_LDB(B0, 1, 0); PG8_SCHED; PG8_LDA(At, 1, 0); PG8_STAGE(PG8_SA(0, 1), a2 + hstep, voffA);
            PG8_WAIT_L(8); PG8_BAR; PG8_WAIT_L(0); PG8_MMA(0, 0, At, B0); PG8_BAR; PG8_SCHED;
            PG8_LDB(B1, 1, 1); PG8_STAGE(PG8_SB(1, 0), b3, voffB);
            PG8_BAR; PG8_WAIT_L(0); PG8_MMA(0, 1, At, B1); PG8_BAR;
            PG8_LDA(At, 1, 1); PG8_STAGE(PG8_SA(1, 0), a3, voffA);
            PG8_BAR; PG8_WAIT_L(0); PG8_MMA(1, 0, At, B0); PG8_BAR; PG8_SCHED;
            PG8_STAGE(PG8_SB(1, 1), b3 + hstep, voffB);
            PG8_WAIT_V(6); PG8_BAR; PG8_MMA(1, 1, At, B1); PG8_BAR;
            }
        }
        if constexpr (ALIGN_EPI) { if (wr == 0) PG8_BAR; }
        if constexpr (!Epi::AFTER_DRAIN) { E(acc, cur, wr, wc, fr, fq); S.done(cur); }
        if (!has_next) break;
#pragma unroll
        for (int a = 0; a < 2; ++a)
#pragma unroll
            for (int b = 0; b < 2; ++b)
#pragma unroll
                for (int m = 0; m < 4; ++m)
#pragma unroll
                    for (int n = 0; n < 2; ++n) acc[a][b][m][n] = (f32x4){0.f, 0.f, 0.f, 0.f};
        cur = nxt; cA = nA; cB = nB; ++ui;
        if constexpr (ALIGN_EPI) { if (wr == 1) PG8_BAR; }
    }
    PG8_WAIT_V(0);
    if constexpr (!ALIGN_EPI) { if (wr == 0) PG8_BAR; }
    PG8_BAR;
    if constexpr (Epi::AFTER_DRAIN) { E.fused(acc, cur, wr, wc, fr, fq, lds, wid, lane); S.done(cur); }
#undef PG8_SA
#undef PG8_SB
#undef PG8_STAGE
#undef PG8_LDA
#undef PG8_LDB
#undef PG8_MMA
#undef PG8_WAIT_V
#undef PG8_WAIT_L
#undef PG8_BAR
#undef PG8_SCHED
}
}

constexpr int DM = 2048, NTOK = 8192, SEQ = 4096, GW = 4096, NGRP = 16, GDIM = 256, CHUNK = 128, NHEAD = 16, HD = 128;
constexpr float EPS = 1e-6f;
constexpr float LOG2E = 1.4426950408889634f;
constexpr float QSCALE = 0.08838834764831845f * LOG2E;

constexpr float GELU_C1 = -1.5957691216057308f * LOG2E, GELU_C2 = -0.07135481627260025f * LOG2E;
__device__ __forceinline__ float gelu_tanh(float x) {
    const float e = __builtin_amdgcn_exp2f(x * __builtin_fmaf(x * x, GELU_C2, GELU_C1));
    return x * __builtin_amdgcn_rcpf(1.0f + e);
}
__device__ __forceinline__ float gelu_silu(float u, float z) {
    const float e1 = __builtin_amdgcn_exp2f(u * __builtin_fmaf(u * u, GELU_C2, GELU_C1));
    const float e2 = __builtin_amdgcn_exp2f(z * -LOG2E);
    return (u * z) * __builtin_amdgcn_rcpf((1.0f + e1) * (1.0f + e2));
}
__device__ __forceinline__ float silu_f(float z) { return z * __builtin_amdgcn_rcpf(1.0f + __builtin_amdgcn_exp2f(-LOG2E * z)); }

namespace pg8 {
typedef unsigned u32x2 __attribute__((ext_vector_type(2)));
__device__ __forceinline__ void conv_load4(const float* __restrict__ W, int N, int item, int lane, f32x4 (&x)[16]) {
    const int nblk = N / 64, k0 = 64 * (item / nblk), n0 = 64 * (item % nblk);
#pragma unroll
    for (int i = 0; i < 16; ++i) x[i] = __builtin_nontemporal_load((const f32x4*)(W + (size_t)(k0 + 4 * i + (lane >> 4)) * N + n0 + 4 * (lane & 15)));
}
__device__ __forceinline__ void conv_xpose(f32x4 (&x)[16], int lane) {
    const bool a = (lane >> 4) & 1, b = (lane >> 5) & 1;
#pragma unroll
    for (int i = 0; i < 16; ++i) {
        f32x4 v = x[i];
        {
            const float s0 = a ? v[0] : v[1], s1 = a ? v[2] : v[3];
            const float r0 = __shfl_xor(s0, 16), r1 = __shfl_xor(s1, 16);
            if (a) { v[0] = r0; v[2] = r1; } else { v[1] = r0; v[3] = r1; }
        }
        {
            const float s0 = b ? v[0] : v[2], s1 = b ? v[1] : v[3];
            const float r0 = __shfl_xor(s0, 32), r1 = __shfl_xor(s1, 32);
            if (b) { v[0] = r0; v[1] = r1; } else { v[2] = r0; v[3] = r1; }
        }
        x[i] = v;
    }
}
__device__ __forceinline__ void conv_store4(int K, int N, bf16_t* __restrict__ WT, int item, int lane, const float* __restrict__ gk, const f32x4 (&x)[16]) {
    const int nblk = N / 64, k0 = 64 * (item / nblk), n0 = 64 * (item % nblk);
    const int n = n0 + 4 * (lane & 15) + (lane >> 4);
#pragma unroll
    for (int kc = 0; kc < 8; ++kc) {
        float g[8];
#pragma unroll
        for (int j = 0; j < 8; ++j) g[j] = gk ? gk[k0 + 8 * kc + j] : 1.0f;
        const f32x4 lo = x[2 * kc], hi = x[2 * kc + 1];
        u32x4 o; o.x = cvt_pk_bf16(lo[0] * g[0], lo[1] * g[1]); o.y = cvt_pk_bf16(lo[2] * g[2], lo[3] * g[3]);
        o.z = cvt_pk_bf16(hi[0] * g[4], hi[1] * g[5]); o.w = cvt_pk_bf16(hi[2] * g[6], hi[3] * g[7]);
        *(u32x4*)(WT + (size_t)n * K + k0 + 8 * kc) = o;
    }
}
__device__ __forceinline__ void conv_store4_lds(int K, int N, bf16_t* __restrict__ WT, int item, int lane, const float* __restrict__ gk, const f32x4 (&x)[16], PG8_LAS unsigned char* sw) {
    const int nblk = N / 64, k0 = 64 * (item / nblk), n0 = 64 * (item % nblk);
    const int nq = lane & 15, r = lane >> 4;
    u32x4 o[8];
#pragma unroll
    for (int kc = 0; kc < 8; ++kc) {
        float g[8];
#pragma unroll
        for (int j = 0; j < 8; ++j) g[j] = gk ? gk[k0 + 8 * kc + j] : 1.0f;
        const f32x4 lo = x[2 * kc], hi = x[2 * kc + 1];
        o[kc].x = cvt_pk_bf16(lo[0] * g[0], lo[1] * g[1]); o[kc].y = cvt_pk_bf16(lo[2] * g[2], lo[3] * g[3]);
        o[kc].z = cvt_pk_bf16(hi[0] * g[4], hi[1] * g[5]); o[kc].w = cvt_pk_bf16(hi[2] * g[6], hi[3] * g[7]);
    }
#pragma unroll
    for (int q = 0; q < 4; ++q) {
        if ((nq >> 2) == q) {
            PG8_LAS u32x4* wp = (PG8_LAS u32x4*)(sw + (4 * (nq & 3) + r) * 128);
#pragma unroll
            for (int kc = 0; kc < 8; ++kc) wp[kc] = o[kc];
        }
        asm volatile("s_waitcnt lgkmcnt(0)" ::: "memory");
#pragma unroll
        for (int h = 0; h < 2; ++h) { const int rl = (lane >> 3) + 8 * h;
            const u32x4 v = *(const PG8_LAS u32x4*)(sw + rl * 128 + (lane & 7) * 16);
            __builtin_nontemporal_store(v, (u32x4*)(WT + (size_t)(n0 + 16 * q + rl) * K + k0 + 8 * (lane & 7))); }
        asm volatile("s_waitcnt lgkmcnt(0)" ::: "memory");
    }
}
struct ConvOrder : StaticOrder {
    const float *w2, *w3, *w4, *g1; bf16_t *t2, *t3, *t4; int gw, ngw, trigger, ln; PG8_LAS unsigned char* sw; mutable int n_done;
    __device__ __forceinline__ void done(const Unit&) const {
        constexpr int I2 = (GW / 64) * (DM / 64), I3 = (DM / 64) * (4 * DM / 64), I4 = (DM / 64) * (DM / 64);
        const int u = n_done++;
#ifdef HOOK_SPREAD
        f32x4 va[16];
        if (u == 0 || u == 1) { for (int it = gw + u * ngw; it < I3; it += 2 * ngw) { conv_load4(w3, 4 * DM, it, ln, va); conv_xpose(va, ln); conv_store4(DM, 4 * DM, t3, it, ln, g1, va); } }
        else if (u == 2) { for (int it = gw; it < I2; it += ngw) { conv_load4(w2, DM, it, ln, va); conv_xpose(va, ln); conv_store4(GW, DM, t2, it, ln, nullptr, va); } }
        else if (u == 3) { for (int it = gw; it < I4; it += ngw) { conv_load4(w4, DM, it, ln, va); conv_xpose(va, ln); conv_store4(DM, DM, t4, it, ln, nullptr, va); } }
#else
        if (u != trigger) return;
        f32x4 va[16], vb[16];
        for (int it = gw; it < I3; it += 2 * ngw) {
            const bool two = it + ngw < I3;
            conv_load4(w3, 4 * DM, it, ln, va); if (two) conv_load4(w3, 4 * DM, it + ngw, ln, vb);
            conv_xpose(va, ln); if (two) conv_xpose(vb, ln);
            conv_store4_lds(DM, 4 * DM, t3, it, ln, g1, va, sw); if (two) conv_store4_lds(DM, 4 * DM, t3, it + ngw, ln, g1, vb, sw);
        }
        for (int it = gw; it < I2; it += ngw) {
            const bool two = it < I4;
            conv_load4(w2, DM, it, ln, va); if (two) conv_load4(w4, DM, it, ln, vb);
            conv_xpose(va, ln); if (two) conv_xpose(vb, ln);
            conv_store4_lds(GW, DM, t2, it, ln, nullptr, va, sw); if (two) conv_store4_lds(DM, DM, t4, it, ln, nullptr, vb, sw);
        }
#endif
    }
};
struct EpiGmlpIn {
    static constexpr bool PERM = true, AFTER_DRAIN = false;
    bf16_t *UZ, *V; float* vss;
    __device__ __forceinline__ void operator()(const f32x4 (&acc)[2][2][4][2], const Unit& u, int wr, int wc, int fr, int fq) const {
        const int row0 = u.pm * BM + wr * 64 + fr;
        const int tq = u.pn / 3, tr = u.pn - 3 * tq;
        if (tr < 2) {
            const int col0 = (2 * tq + tr) * HALF + wc * 32 + 8 * fq;
#pragma unroll
            for (int ai = 0; ai < 2; ++ai)
#pragma unroll
                for (int m = 0; m < 4; ++m) {
                    const int row = row0 + ai * HALF + m * 16;
                    f32x4 v0 = acc[ai][0][m][0], v1 = acc[ai][0][m][1]; const f32x4 z0 = acc[ai][1][m][0], z1 = acc[ai][1][m][1];
#pragma unroll
                    for (int e = 0; e < 4; ++e) { v0[e] = gelu_silu(v0[e], z0[e]); v1[e] = gelu_silu(v1[e], z1[e]); }
                    u32x4 w; w.x = cvt_pk_bf16(v0[0], v0[1]); w.y = cvt_pk_bf16(v0[2], v0[3]); w.z = cvt_pk_bf16(v1[0], v1[1]); w.w = cvt_pk_bf16(v1[2], v1[3]);
                    *(u32x4*)(UZ + (size_t)row * GW + col0) = w;
                }
        } else {
            const int tl = tq, col0 = tl * BM + wc * 32 + 8 * fq;
#pragma unroll
            for (int ai = 0; ai < 2; ++ai)
#pragma unroll
                for (int m = 0; m < 4; ++m) {
                    const int row = row0 + ai * HALF + m * 16;
                    bf16_t* rowp = V + (size_t)row * GW + col0;
                    float ss = 0.f;
#pragma unroll
                    for (int bj = 0; bj < 2; ++bj) {
                        f32x4 v0 = acc[ai][bj][m][0], v1 = acc[ai][bj][m][1];
#pragma unroll
                        for (int e = 0; e < 4; ++e) { v0[e] = gelu_tanh(v0[e]); v1[e] = gelu_tanh(v1[e]); ss += v0[e] * v0[e] + v1[e] * v1[e]; }
                        u32x4 w; w.x = cvt_pk_bf16(v0[0], v0[1]); w.y = cvt_pk_bf16(v0[2], v0[3]); w.z = cvt_pk_bf16(v1[0], v1[1]); w.w = cvt_pk_bf16(v1[2], v1[3]);
                        *(u32x4*)(rowp + bj * HALF) = w;
                    }
                    ss += __shfl_xor(ss, 16); ss += __shfl_xor(ss, 32);
                    if (fq == 0) vss[(size_t)row * 64 + tl * 4 + wc] = ss;
                }
        }
    }
};
struct EpiRes1 {
    static constexpr bool PERM = false, AFTER_DRAIN = false;
    const bf16_t* hn; const float* irs; const float* g0; bf16_t* hb; float* hss;
    __device__ __forceinline__ void operator()(const f32x4 (&acc)[2][2][4][2], const Unit& u, int wr, int wc, int fr, int fq) const {
        const int row0 = u.pm * BM + wr * 64 + fr, col0 = u.pn * BM + wc * 32 + 4 * fq;
        float rs[2][4];
#pragma unroll
        for (int ai = 0; ai < 2; ++ai)
#pragma unroll
            for (int m = 0; m < 4; ++m) rs[ai][m] = irs[row0 + ai * HALF + m * 16];
        f32x4 ig[2][2];
#pragma unroll
        for (int bj = 0; bj < 2; ++bj)
#pragma unroll
            for (int n = 0; n < 2; ++n) { const f32x4 gv = *(const f32x4*)(g0 + col0 + bj * HALF + n * 16);
                ig[bj][n] = (f32x4){__builtin_amdgcn_rcpf(gv[0]), __builtin_amdgcn_rcpf(gv[1]), __builtin_amdgcn_rcpf(gv[2]), __builtin_amdgcn_rcpf(gv[3])}; }
#pragma unroll
        for (int ai = 0; ai < 2; ++ai) {
            u32x2 xv[4][2][2];
#pragma unroll
            for (int m = 0; m < 4; ++m)
#pragma unroll
                for (int bj = 0; bj < 2; ++bj)
#pragma unroll
                    for (int n = 0; n < 2; ++n) xv[m][bj][n] = *(const u32x2*)(hn + (size_t)(row0 + ai * HALF + m * 16) * DM + col0 + bj * HALF + n * 16);
#pragma unroll
            for (int m = 0; m < 4; ++m) {
                const int row = row0 + ai * HALF + m * 16;
                const size_t off = (size_t)row * DM + col0;
                float ss = 0.f;
#pragma unroll
                for (int bj = 0; bj < 2; ++bj)
#pragma unroll
                    for (int n = 0; n < 2; ++n) {
                        const u32x2 w2 = xv[m][bj][n];
                        f32x4 xh; xh[0] = __uint_as_float(w2.x << 16); xh[1] = __uint_as_float(w2.x & 0xffff0000u); xh[2] = __uint_as_float(w2.y << 16); xh[3] = __uint_as_float(w2.y & 0xffff0000u);
                        const f32x4 h = xh * ig[bj][n] * rs[ai][m] + acc[ai][bj][m][n];
                        ss += (h[0] * h[0] + h[1] * h[1]) + (h[2] * h[2] + h[3] * h[3]);
                        const unsigned long long w = (unsigned long long)cvt_pk_bf16(h[0], h[1]) | ((unsigned long long)cvt_pk_bf16(h[2], h[3]) << 32);
                        *(unsigned long long*)(hb + off + bj * HALF + n * 16) = w;
                    }
                ss += __shfl_xor(ss, 16); ss += __shfl_xor(ss, 32);
                if (fq == 0) __hip_atomic_fetch_add(hss + row, ss, __ATOMIC_RELAXED, __HIP_MEMORY_SCOPE_AGENT);
            }
        }
    }
};
struct EpiFinal {
    static constexpr bool PERM = false, AFTER_DRAIN = false;
    const bf16_t* hb; const float* fg; float* out; float* hss; unsigned* cnt; bool fused;
    __device__ __forceinline__ void operator()(f32x4 (&acc)[2][2][4][2], const Unit& u, int wr, int wc, int fr, int fq) const {
        const int row0 = u.pm * BM + wr * 64 + fr, col0 = u.pn * BM + wc * 32 + 4 * fq;
#pragma unroll
        for (int ai = 0; ai < 2; ++ai)
#pragma unroll
            for (int m = 0; m < 4; ++m) {
                const int row = row0 + ai * HALF + m * 16;
                const size_t off = (size_t)row * DM + col0;
                float ss = 0.f;
#pragma unroll
                for (int bj = 0; bj < 2; ++bj)
#pragma unroll
                    for (int n = 0; n < 2; ++n) {
                        const u32x2 w = *(const u32x2*)(hb + off + bj * HALF + n * 16);
                        f32x4 h; h[0] = __uint_as_float(w.x << 16); h[1] = __uint_as_float(w.x & 0xffff0000u); h[2] = __uint_as_float(w.y << 16); h[3] = __uint_as_float(w.y & 0xffff0000u);
                        h += acc[ai][bj][m][n];
                        acc[ai][bj][m][n] = h;
                        ss += (h[0] * h[0] + h[1] * h[1]) + (h[2] * h[2] + h[3] * h[3]);
                    }
                ss += __shfl_xor(ss, 16); ss += __shfl_xor(ss, 32);
                if (fq == 0) __hip_atomic_fetch_add(hss + row, ss, __ATOMIC_RELAXED, __HIP_MEMORY_SCOPE_AGENT);
            }
        if (!fused) {
#pragma unroll
            for (int ai = 0; ai < 2; ++ai)
#pragma unroll
                for (int m = 0; m < 4; ++m)
#pragma unroll
                    for (int bj = 0; bj < 2; ++bj)
#pragma unroll
                        for (int n = 0; n < 2; ++n) *(f32x4*)(out + (size_t)(row0 + ai * HALF + m * 16) * DM + col0 + bj * HALF + n * 16) = acc[ai][bj][m][n];
            return;
        }
        asm volatile("s_waitcnt vmcnt(0)" ::: "memory");
        unsigned* pc = cnt + 64 * u.pm;
        if (lane_id() == 0) __hip_atomic_fetch_add(pc, 1u, __ATOMIC_RELAXED, __HIP_MEMORY_SCOPE_AGENT);
        for (int it = 0; it < (1 << 22); ++it) {
            if (__hip_atomic_load(pc, __ATOMIC_RELAXED, __HIP_MEMORY_SCOPE_AGENT) >= 64u) break;
            __builtin_amdgcn_s_sleep(2);
        }
        asm volatile("" ::: "memory");
        f32x4 gv[2][2];
#pragma unroll
        for (int bj = 0; bj < 2; ++bj)
#pragma unroll
            for (int n = 0; n < 2; ++n) gv[bj][n] = *(const f32x4*)(fg + col0 + bj * HALF + n * 16);
        float ssr[2][4];
#pragma unroll
        for (int ai = 0; ai < 2; ++ai)
#pragma unroll
            for (int m = 0; m < 4; ++m) ssr[ai][m] = __hip_atomic_load(hss + row0 + ai * HALF + m * 16, __ATOMIC_RELAXED, __HIP_MEMORY_SCOPE_AGENT);
#pragma unroll
        for (int ai = 0; ai < 2; ++ai)
#pragma unroll
            for (int m = 0; m < 4; ++m) {
                const int row = row0 + ai * HALF + m * 16;
                const size_t off = (size_t)row * DM + col0;
                const float rstd = __builtin_amdgcn_rsqf(ssr[ai][m] * (1.0f / DM) + EPS);
#pragma unroll
                for (int bj = 0; bj < 2; ++bj)
#pragma unroll
                    for (int n = 0; n < 2; ++n) *(f32x4*)(out + off + bj * HALF + n * 16) = acc[ai][bj][m][n] * rstd * gv[bj][n];
            }
    }
};
struct EpiSbIn {
    static constexpr bool PERM = true, AFTER_DRAIN = false;
    bf16_t* Q; size_t rstride; const float* hss;
    __device__ __forceinline__ void operator()(const f32x4 (&acc)[2][2][4][2], const Unit& u, int wr, int wc, int fr, int fq) const {
        const int region = u.pn >> 3, tl = u.pn & 7;
        bf16_t* base = Q + (size_t)region * rstride;
        const int row0 = u.pm * BM + wr * 64 + fr, col0 = tl * BM + wc * 32 + 8 * fq;
        float ssr[2][4];
#pragma unroll
        for (int ai = 0; ai < 2; ++ai)
#pragma unroll
            for (int m = 0; m < 4; ++m) ssr[ai][m] = hss[row0 + ai * HALF + m * 16];
#pragma unroll
        for (int ai = 0; ai < 2; ++ai)
#pragma unroll
            for (int m = 0; m < 4; ++m) {
                const int row = row0 + ai * HALF + m * 16;
                float sc = __builtin_amdgcn_rsqf(ssr[ai][m] * (1.0f / DM) + EPS);
                if (region == 0) sc *= QSCALE;
                bf16_t* rowp = base + (size_t)row * DM + col0;
#pragma unroll
                for (int bj = 0; bj < 2; ++bj) {
                    f32x4 v0 = acc[ai][bj][m][0] * sc, v1 = acc[ai][bj][m][1] * sc;
                    if (region == 3) {
#pragma unroll
                        for (int e = 0; e < 4; ++e) { v0[e] = silu_f(v0[e]); v1[e] = silu_f(v1[e]); }
                    }
                    u32x4 w; w.x = cvt_pk_bf16(v0[0], v0[1]); w.y = cvt_pk_bf16(v0[2], v0[3]); w.z = cvt_pk_bf16(v1[0], v1[1]); w.w = cvt_pk_bf16(v1[2], v1[3]);
                    *(u32x4*)(rowp + bj * HALF) = w;
                }
            }
    }
};
}

#define LAS __attribute__((address_space(3)))
typedef unsigned short bf16_t;
typedef short bf16x8 __attribute__((ext_vector_type(8)));
typedef short s16x4 __attribute__((ext_vector_type(4)));
typedef float f32x4 __attribute__((ext_vector_type(4)));
typedef float f32x16 __attribute__((ext_vector_type(16)));
typedef unsigned u32x4 __attribute__((ext_vector_type(4)));
typedef unsigned u32x2 __attribute__((ext_vector_type(2)));
__device__ __forceinline__ unsigned off_b(unsigned row, unsigned ch) { return 256u * row + 16u * (ch ^ (((row & 3u) << 2) | ((row >> 2) & 3u))); }
__device__ __forceinline__ s16x4 vtr(const LAS unsigned char* p) { return __builtin_bit_cast(s16x4, __builtin_amdgcn_ds_read_tr16_b64_v4i16((LAS s16x4*)p)); }
__device__ __forceinline__ unsigned pk_bf16(float lo, float hi) { return pg8::cvt_pk_bf16(lo, hi); }
__device__ __forceinline__ float bf_lo(unsigned w) { return __uint_as_float(w << 16); }
__device__ __forceinline__ float bf_hi(unsigned w) { return __uint_as_float(w & 0xffff0000u); }
__device__ __forceinline__ int crow(int r, int hi) { return (r & 3) + 8 * (r >> 2) + 4 * hi; }

#ifdef ATT_NOSB
#define ATT_SB() do {} while (0)
#else
#ifndef ATT_USE_SB
#define ATT_SB() do {} while (0)
#else
#define ATT_SB() __builtin_amdgcn_sched_barrier(0)
#endif
#endif
#define ATT_VLD(f) do { const int c_ = (f) >> 2, s_ = (f) & 3; const s16x4 lo_ = vtr(vbp + 4096 * s_ + vbase[0] + vcq[c_]); const s16x4 hh_ = vtr(vbp + 4096 * s_ + vbase[1] + vcq[c_]); \
        vf[f] = (bf16x8){lo_[0], lo_[1], lo_[2], lo_[3], hh_[0], hh_[1], hh_[2], hh_[3]}; } while (0)
#define ATT_PV(f) do { if (DO_PV) { o[(f) >> 2] = __builtin_amdgcn_mfma_f32_32x32x16_bf16(pa[(f) & 3], vf[f], o[(f) >> 2], 0, 0, 0); if ((f) + 4 < 16) ATT_VLD((f) + 4); } } while (0)
#define ATT_EXP8(i) do { _Pragma("unroll") for (int r_ = 0; r_ < 8; ++r_) p[(i) >> 1][8 * ((i) & 1) + r_] = __builtin_amdgcn_exp2f(fminf(p[(i) >> 1][8 * ((i) & 1) + r_], 30.f)); } while (0)
#define ATT_LBLK(j) do { const int ph_ = 1 - ((j) >> 2), g_ = 3 - ((j) & 3); \
        const float w0_ = 1.0f + p[ph_][4 * g_], w1_ = 1.0f + p[ph_][4 * g_ + 1], w2_ = 1.0f + p[ph_][4 * g_ + 2], w3_ = 1.0f + p[ph_][4 * g_ + 3]; \
        L[j] = __builtin_amdgcn_logf((w0_ * w1_) * (w2_ * w3_)); } while (0)
#define ATT_XCH(j) do { const float own_ = L[j]; const auto rr_ = __builtin_amdgcn_permlane32_swap(__float_as_uint(own_), __float_as_uint(own_), false, false); \
        const float a0_ = __uint_as_float(rr_[0]), a1_ = __uint_as_float(rr_[1]); const float oth_ = (a0_ == own_) ? a1_ : a0_; \
        T[j] = run + (hi ? 0.f : oth_) + own_; run += a0_ + a1_; } while (0)
#define ATT_WGT(j) do { const int ph_ = 1 - ((j) >> 2), g_ = 3 - ((j) & 3); float cf_ = __builtin_amdgcn_exp2f(-T[j]); \
        _Pragma("unroll") for (int e_ = 0; e_ < 4; ++e_) { const float ev_ = p[ph_][4 * g_ + e_]; p[ph_][4 * g_ + e_] = ev_ * cf_; if (e_ < 3) cf_ *= (1.0f + ev_); } } while (0)

template <bool DO_PV>
__device__ __forceinline__ void attn_tile(const LAS unsigned char* kb, const LAS unsigned char* vbp, const bf16x8 (&qf)[8], f32x16 (&o)[4], bf16x8 (&pa)[4], float& carry,
                                          const unsigned (&koff)[8], const unsigned (&vbase)[2], const unsigned (&vcq)[4], int k0, int qw0, int qabs, int hi) {
    f32x16 p[2];
#pragma unroll
    for (int r = 0; r < 16; ++r) { p[0][r] = 0.f; p[1][r] = 0.f; }
    bf16x8 vf[16];
    if (DO_PV) { ATT_VLD(0); ATT_VLD(1); ATT_VLD(2); ATT_VLD(3); }
    {
        bf16x8 ka[8], kc[8];
#pragma unroll
        for (int d0 = 0; d0 < 8; ++d0) { ka[d0] = *(const LAS bf16x8*)(kb + koff[d0]); kc[d0] = *(const LAS bf16x8*)(kb + 8192 + koff[d0]); }
        ATT_SB();
#pragma unroll
        for (int d0 = 0; d0 < 8; ++d0) {
            p[0] = __builtin_amdgcn_mfma_f32_32x32x16_bf16(ka[d0], qf[d0], p[0], 0, 0, 0);
            p[1] = __builtin_amdgcn_mfma_f32_32x32x16_bf16(kc[d0], qf[d0], p[1], 0, 0, 0);
        }
    }
    ATT_SB();
    const bool need_mask = (k0 + 63 >= qw0);
    float L[8], T[8];
    ATT_PV(0); ATT_EXP8(0); ATT_SB();
    ATT_PV(1); ATT_EXP8(1); ATT_SB();
    ATT_PV(2); ATT_EXP8(2); ATT_SB();
    ATT_PV(3); ATT_EXP8(3); ATT_SB();
    if (need_mask) {
#pragma unroll
        for (int ph = 0; ph < 2; ++ph)
#pragma unroll
            for (int r = 0; r < 16; ++r) { const int key = k0 + 32 * ph + crow(r, hi); if (key >= qabs) p[ph][r] = 0.f; }
    }
    ATT_SB();
    ATT_PV(4); ATT_LBLK(0); ATT_LBLK(1); ATT_SB();
    ATT_PV(5); ATT_LBLK(2); ATT_LBLK(3); ATT_SB();
    ATT_PV(6); ATT_LBLK(4); ATT_LBLK(5); ATT_SB();
    ATT_PV(7); ATT_LBLK(6); ATT_LBLK(7); ATT_SB();
    float run = carry;
    ATT_PV(8); ATT_XCH(0); ATT_XCH(1); ATT_SB();
    ATT_PV(9); ATT_XCH(2); ATT_XCH(3); ATT_SB();
    ATT_PV(10); ATT_XCH(4); ATT_XCH(5); ATT_SB();
    ATT_PV(11); ATT_XCH(6); ATT_XCH(7); ATT_SB();
    carry = run;
    ATT_PV(12); ATT_WGT(0); ATT_WGT(1); ATT_SB();
    ATT_PV(13); ATT_WGT(2); ATT_WGT(3); ATT_SB();
    ATT_PV(14); ATT_WGT(4); ATT_WGT(5); ATT_SB();
    ATT_PV(15); ATT_WGT(6); ATT_WGT(7); ATT_SB();
#pragma unroll
    for (int s = 0; s < 4; ++s) { const int ph = s >> 1, rb = 8 * (s & 1);
        u32x4 w; w.x = pk_bf16(p[ph][rb], p[ph][rb + 1]); w.y = pk_bf16(p[ph][rb + 2], p[ph][rb + 3]); w.z = pk_bf16(p[ph][rb + 4], p[ph][rb + 5]); w.w = pk_bf16(p[ph][rb + 6], p[ph][rb + 7]);
        pa[s] = __builtin_bit_cast(bf16x8, w); }
}

__device__ __forceinline__ void attn_unit(LAS unsigned char* lds, const int wid, int b, int h, int qb, const bf16_t* __restrict__ Q, const bf16_t* __restrict__ K,
                                          const bf16_t* __restrict__ V, const bf16_t* __restrict__ ZS, bf16_t* __restrict__ OG) {
    const int tid = tid_of(wid), lane = tid & 63, r32 = lane & 31, hi = lane >> 5;
    const size_t tok0 = (size_t)b * SEQ;
    const int q0 = qb * 256, qw0 = q0 + 32 * wid, qabs = qw0 + r32;
    bf16x8 qf[8];
    { const bf16_t* qp = Q + (tok0 + qabs) * DM + h * HD + 8 * hi;
#pragma unroll
      for (int d0 = 0; d0 < 8; ++d0) qf[d0] = *(const bf16x8*)(qp + 16 * d0); }
    f32x16 o[4];
#pragma unroll
    for (int c = 0; c < 4; ++c)
#pragma unroll
        for (int r = 0; r < 16; ++r) o[c][r] = 0.f;
    bf16x8 pa[4];
#pragma unroll
    for (int s = 0; s < 4; ++s) pa[s] = (bf16x8){0, 0, 0, 0, 0, 0, 0, 0};
    float carry = 0.f;
    const int NT = (q0 + 256) / 64;
    const int srow = tid >> 4, sch = (tid & 15) ^ (((srow & 3) << 2) | ((srow >> 2) & 3));
    const bf16_t* kg = K + (tok0 + srow) * DM + h * HD + sch * 8;
    const bf16_t* vg = V + (tok0 + srow) * DM + h * HD + sch * 8;
    LAS unsigned char* ldsw = lds + wid * 1024;
#define ATT_STAGE(t_, koff_, voff_) do { const size_t go_ = (size_t)(t_) * 64 * DM; \
        __builtin_amdgcn_global_load_lds((const unsigned*)(kg + go_), (LAS unsigned*)(ldsw + (koff_)), 16, 0, 0); \
        __builtin_amdgcn_global_load_lds((const unsigned*)(kg + go_ + 32 * DM), (LAS unsigned*)(ldsw + (koff_) + 8192), 16, 0, 0); \
        __builtin_amdgcn_global_load_lds((const unsigned*)(vg + go_), (LAS unsigned*)(ldsw + (voff_)), 16, 0, 0); \
        __builtin_amdgcn_global_load_lds((const unsigned*)(vg + go_ + 32 * DM), (LAS unsigned*)(ldsw + (voff_) + 8192), 16, 0, 0); } while (0)
    ATT_STAGE(NT - 1, 0, 32768);
    asm volatile("s_waitcnt vmcnt(0)" ::: "memory");
    __syncthreads();
    unsigned koff[8];
#pragma unroll
    for (int d0 = 0; d0 < 8; ++d0) koff[d0] = off_b(r32, 2 * d0 + hi);
    const unsigned qa = (lane & 15) >> 2, blk = (lane >> 4) & 1, pp = lane & 3;
    unsigned vbase[2], vcq[4];
#pragma unroll
    for (int t = 0; t < 2; ++t) vbase[t] = 256u * (8 * t + 4 * hi + qa) + 16u * ((2 * blk + (pp >> 1)) ^ ((2 * t + hi) & 3)) + 8u * (pp & 1);
#pragma unroll
    for (int c = 0; c < 4; ++c) vcq[c] = 64u * ((unsigned)c ^ qa);
    int kcur = 0, vprev = 2, vcur = 0, vnext = 1;
    bool prev_valid = false;
    for (int t = NT - 1; t >= 0; --t) {
        if (t > 0) ATT_STAGE(t - 1, (kcur ^ 1) * 16384, 32768 + vnext * 16384);
        const LAS unsigned char* kb = lds + kcur * 16384;
        const LAS unsigned char* vbp = lds + 32768 + vprev * 16384;
        const int k0 = 64 * t;
        const bool valid = (k0 < qw0 + 31);
        if (valid) {
            if (prev_valid) attn_tile<true>(kb, vbp, qf, o, pa, carry, koff, vbase, vcq, k0, qw0, qabs, hi);
            else            attn_tile<false>(kb, vbp, qf, o, pa, carry, koff, vbase, vcq, k0, qw0, qabs, hi);
        }
        prev_valid = valid;
        asm volatile("s_waitcnt vmcnt(0)" ::: "memory");
        __syncthreads();
        kcur ^= 1; { const int tmp = vprev; vprev = vcur; vcur = vnext; vnext = tmp; }
    }
    { const LAS unsigned char* vbp = lds + 32768 + vprev * 16384;
#pragma unroll
      for (int c = 0; c < 4; ++c)
#pragma unroll
          for (int s = 0; s < 4; ++s) {
              const s16x4 lo = vtr(vbp + 4096 * s + vbase[0] + vcq[c]);
              const s16x4 hh = vtr(vbp + 4096 * s + vbase[1] + vcq[c]);
              const bf16x8 vfr = (bf16x8){lo[0], lo[1], lo[2], lo[3], hh[0], hh[1], hh[2], hh[3]};
              o[c] = __builtin_amdgcn_mfma_f32_32x32x16_bf16(pa[s], vfr, o[c], 0, 0, 0);
          } }
    {
        int lane_e = lane_id(); asm volatile("" : "+v"(lane_e));
        const int r32e = lane_e & 31, hie = lane_e >> 5, rowq = lane_e >> 4, c4 = (lane_e & 15) * 4;
        LAS float* stg = (LAS float*)(lds + 81920 + wid * 8192);
        const size_t gbase = (tok0 + qw0) * DM + h * HD + c4;
        u32x2 zv[2][8];
#pragma unroll
        for (int ps = 0; ps < 2; ++ps)
#pragma unroll
            for (int j = 0; j < 8; ++j) zv[ps][j] = *(const u32x2*)(ZS + gbase + (size_t)(4 * j + rowq) * DM + 64 * ps);
#pragma unroll
        for (int ps = 0; ps < 2; ++ps) {
#pragma unroll
            for (int r = 0; r < 16; ++r) {
                stg[crow(r, hie) * 64 + r32e] = o[2 * ps][r];
                stg[crow(r, hie) * 64 + 32 + r32e] = o[2 * ps + 1][r];
            }
            asm volatile("s_waitcnt lgkmcnt(0)" ::: "memory");
#pragma unroll
            for (int j = 0; j < 8; ++j) {
                const f32x4 ov = *(const LAS f32x4*)(stg + (4 * j + rowq) * 64 + c4);
                const u32x2 z = zv[ps][j];
                u32x2 w; w.x = pk_bf16(ov[0] * bf_lo(z.x), ov[1] * bf_hi(z.x)); w.y = pk_bf16(ov[2] * bf_lo(z.y), ov[3] * bf_hi(z.y));
                *(u32x2*)(OG + gbase + (size_t)(4 * j + rowq) * DM + 64 * ps) = w;
            }
            asm volatile("s_waitcnt lgkmcnt(0)" ::: "memory");
        }
    }
    __syncthreads();
}
__device__ __forceinline__ void attn_phase(LAS unsigned char* lds, const int wid_, int vcu, int G, const bf16_t* Q, const bf16_t* K, const bf16_t* V, const bf16_t* ZS, bf16_t* OG) {
#ifndef NO_ATTN_PRIO
    if (wid_ >= 4) __builtin_amdgcn_s_setprio(1);
#endif
    for (int p = vcu; p < 256; p += G) {
        const int bh = p >> 3, s = p & 7;
#ifdef ATT_ONE_INSTANCE
#pragma unroll 1
        for (int uu = 0; uu < 2; ++uu) attn_unit(lds, wid_, bh >> 4, bh & 15, uu ? 15 - s : s, Q, K, V, ZS, OG);
#else
        attn_unit(lds, wid_, bh >> 4, bh & 15, s, Q, K, V, ZS, OG);
        attn_unit(lds, wid_, bh >> 4, bh & 15, 15 - s, Q, K, V, ZS, OG);
#endif
    }
    __builtin_amdgcn_s_setprio(0);
}

__device__ __forceinline__ void mix_unit(LAS unsigned char* lds, const int wid, int n, int g, const bf16_t* __restrict__ UZ, const bf16_t* __restrict__ V, const float* __restrict__ vss,
                                         const float* __restrict__ w_s, const float* __restrict__ b_s, const float* __restrict__ vg, bf16_t* __restrict__ Y) {
    const int tid = tid_of(wid), lane = tid & 63, r32 = lane & 31, hi = lane >> 5;
    const size_t row0 = (size_t)n * CHUNK;
    LAS float* rstdL = (LAS float*)(lds + 98304);
    const int cc = tid & 31;
    u32x4 uu[8];
#pragma unroll
    for (int i = 0; i < 8; ++i) { const int t = (tid >> 5) + 16 * i; uu[i] = __builtin_nontemporal_load((const u32x4*)(UZ + (row0 + t) * GW + g * GDIM + cc * 8)); }
    {
        u32x4 vr[8];
#pragma unroll
        for (int i = 0; i < 8; ++i) { const int c = tid + 512 * i, s = c >> 5, cc = c & 31;
            vr[i] = __builtin_nontemporal_load((const u32x4*)(V + (row0 + s) * GW + g * GDIM + cc * 8)); }
        if (tid < 128) { const f32x4* vp = (const f32x4*)(vss + (row0 + tid) * 64); f32x4 s4 = vp[0];
#pragma unroll
            for (int i = 1; i < 16; ++i) s4 += vp[i];
            rstdL[tid] = __builtin_amdgcn_rsqf(((s4[0] + s4[1]) + (s4[2] + s4[3])) * (1.0f / GW) + EPS); }
#pragma unroll
        for (int i = 0; i < 8; ++i) { const int c = tid + 512 * i, s = c >> 5, cc = c & 31;
            *(LAS u32x4*)(lds + 32768 + (cc >> 4) * 32768 + off_b(s, cc & 15)) = vr[i]; }
    }
    __syncthreads();
#pragma unroll
    for (int i = 0; i < 4; ++i) { const int c = tid + 512 * i, t = c >> 4, ch = c & 15, s0 = ch * 8;
        const f32x4 w0 = *(const f32x4*)(w_s + ((size_t)g * CHUNK + t) * CHUNK + s0), w1 = *(const f32x4*)(w_s + ((size_t)g * CHUNK + t) * CHUNK + s0 + 4);
        float wv[8] = {w0[0], w0[1], w0[2], w0[3], w1[0], w1[1], w1[2], w1[3]};
#pragma unroll
        for (int j = 0; j < 8; ++j) wv[j] = (s0 + j <= t) ? wv[j] * rstdL[s0 + j] : 0.f;
        u32x4 w; w.x = pk_bf16(wv[0], wv[1]); w.y = pk_bf16(wv[2], wv[3]); w.z = pk_bf16(wv[4], wv[5]); w.w = pk_bf16(wv[6], wv[7]);
        *(LAS u32x4*)(lds + off_b(t, ch)) = w; }
    __syncthreads();
    f32x16 acc[4];
#pragma unroll
    for (int i = 0; i < 4; ++i)
#pragma unroll
        for (int r = 0; r < 16; ++r) acc[i][r] = 0.f;
    {
        const LAS unsigned char* vimg = lds + 32768 + (wid >> 2) * 32768;
        const unsigned cblk = wid & 3, qa = (lane & 15) >> 2, blk = (lane >> 4) & 1, pp = lane & 3;
#pragma unroll
        for (int ks = 0; ks < 8; ++ks) {
            const s16x4 lo = vtr(vimg + off_b(16 * ks + 8 * hi + qa, 4 * cblk + 2 * blk + (pp >> 1)) + 8 * (pp & 1));
            const s16x4 hh = vtr(vimg + off_b(16 * ks + 8 * hi + 4 + qa, 4 * cblk + 2 * blk + (pp >> 1)) + 8 * (pp & 1));
            const bf16x8 vf = (bf16x8){lo[0], lo[1], lo[2], lo[3], hh[0], hh[1], hh[2], hh[3]};
#pragma unroll
            for (int i = 0; i < 4; ++i) if (ks <= 2 * i + 1) {
                const bf16x8 af = *(const LAS bf16x8*)(lds + off_b(32 * i + r32, 2 * ks + hi));
                acc[i] = __builtin_amdgcn_mfma_f32_32x32x16_bf16(af, vf, acc[i], 0, 0, 0);
            }
        }
    }
    __syncthreads();
    {
        LAS float* mx = (LAS float*)lds;
        const int c = 128 * (wid >> 2) + 32 * (wid & 3) + r32;
#pragma unroll
        for (int i = 0; i < 4; ++i)
#pragma unroll
            for (int r = 0; r < 16; ++r) mx[(32 * i + crow(r, hi)) * 256 + c] = acc[i][r];
    }
    __syncthreads();
    {
        const f32x4 g0 = *(const f32x4*)(vg + g * GDIM + cc * 8), g1 = *(const f32x4*)(vg + g * GDIM + cc * 8 + 4);
        float bb[8];
#pragma unroll
        for (int i = 0; i < 8; ++i) bb[i] = b_s[g * CHUNK + (tid >> 5) + 16 * i];
#pragma unroll
        for (int i = 0; i < 8; ++i) { const int t = (tid >> 5) + 16 * i;
            const f32x4 m0 = *(const LAS f32x4*)(lds + (t * 256 + cc * 8) * 4), m1 = *(const LAS f32x4*)(lds + (t * 256 + cc * 8 + 4) * 4);
            float y[8];
            y[0] = bf_lo(uu[i].x) * (m0[0] * g0[0] + bb[i]); y[1] = bf_hi(uu[i].x) * (m0[1] * g0[1] + bb[i]);
            y[2] = bf_lo(uu[i].y) * (m0[2] * g0[2] + bb[i]); y[3] = bf_hi(uu[i].y) * (m0[3] * g0[3] + bb[i]);
            y[4] = bf_lo(uu[i].z) * (m1[0] * g1[0] + bb[i]); y[5] = bf_hi(uu[i].z) * (m1[1] * g1[1] + bb[i]);
            y[6] = bf_lo(uu[i].w) * (m1[2] * g1[2] + bb[i]); y[7] = bf_hi(uu[i].w) * (m1[3] * g1[3] + bb[i]);
            u32x4 w; w.x = pk_bf16(y[0], y[1]); w.y = pk_bf16(y[2], y[3]); w.z = pk_bf16(y[4], y[5]); w.w = pk_bf16(y[6], y[7]);
            *(u32x4*)(Y + (row0 + t) * GW + g * GDIM + cc * 8) = w; }
    }
    __syncthreads();
}

__device__ __forceinline__ float wave_sum(float v) {
#pragma unroll
    for (int o = 1; o < 64; o <<= 1) v += __shfl_xor(v, o);
    return v;
}
__device__ __forceinline__ void tr_load(const float* __restrict__ W, int N, int item, int lane, f32x4 (&wv)[16]) {
    const int nblk = N / 64, k0 = 64 * (item / nblk), n0 = 64 * (item % nblk);
#pragma unroll
    for (int i = 0; i < 16; ++i) wv[i] = __builtin_nontemporal_load((const f32x4*)(W + (size_t)(k0 + 4 * i + (lane >> 4)) * N + n0 + 4 * (lane & 15)));
}
__device__ __forceinline__ void tr_to_lds(LAS float* scr, int lane, const f32x4 (&wv)[16]) {
#pragma unroll
    for (int i = 0; i < 16; ++i) { const int kk = 4 * i + (lane >> 4), nn = 4 * (lane & 15);
        LAS float* s = scr + kk * 65 + nn; s[0] = wv[i][0]; s[1] = wv[i][1]; s[2] = wv[i][2]; s[3] = wv[i][3]; }
    asm volatile("s_waitcnt lgkmcnt(0)" ::: "memory");
}
__device__ __forceinline__ void tr_store(int K, int N, bf16_t* __restrict__ WT, const LAS float* scr, int item, int lane, const float* __restrict__ gk, bool gmlp_perm) {
    const int nblk = N / 64, k0 = 64 * (item / nblk), n0 = 64 * (item % nblk);
    int r0 = n0;
    if (gmlp_perm) {
        if (n0 < GW) { const int cb = n0 >> 7; r0 = 256 * (3 * (cb >> 1) + (cb & 1)) + (n0 & 127); }
        else if (n0 < 2 * GW) { const int mv = n0 - GW; r0 = 256 * (3 * (mv >> 8) + 2) + (mv & 255); }
        else { const int mz = n0 - 2 * GW, cb = mz >> 7; r0 = 256 * (3 * (cb >> 1) + (cb & 1)) + 128 + (mz & 127); }
    }
    const int c = lane & 7;
    f32x4 ga = {1.f, 1.f, 1.f, 1.f}, gb = {1.f, 1.f, 1.f, 1.f};
    if (gk) { ga = *(const f32x4*)(gk + k0 + 8 * c); gb = *(const f32x4*)(gk + k0 + 8 * c + 4); }
#pragma unroll
    for (int j = 0; j < 8; ++j) { const int nn = (lane >> 3) + 8 * j; const LAS float* s = scr + (8 * c) * 65 + nn;
        u32x4 o; o.x = pk_bf16(s[0] * ga[0], s[65] * ga[1]); o.y = pk_bf16(s[2 * 65] * ga[2], s[3 * 65] * ga[3]); o.z = pk_bf16(s[4 * 65] * gb[0], s[5 * 65] * gb[1]); o.w = pk_bf16(s[6 * 65] * gb[2], s[7 * 65] * gb[3]);
        *(u32x4*)(WT + (size_t)(r0 + nn) * K + k0 + 8 * c) = o; }
    asm volatile("s_waitcnt lgkmcnt(0)" ::: "memory");
}
__device__ __forceinline__ void transpose_matrix(const float* __restrict__ W, int K, int N, bf16_t* __restrict__ WT, LAS float* scr, int first, int stride, int nitems, int lane,
                                                 const float* __restrict__ gk = nullptr, bool gmlp_perm = false) {
    f32x4 wv[16], wn[16];
    int it = first;
    if (it < nitems) tr_load(W, N, it, lane, wv);
    while (it < nitems) {
        const int nx = it + stride;
        tr_to_lds(scr, lane, wv);
        if (nx < nitems) tr_load(W, N, nx, lane, wn);
        tr_store(K, N, WT, scr, it, lane, gk, gmlp_perm);
#pragma unroll
        for (int i = 0; i < 16; ++i) wv[i] = wn[i];
        it = nx;
    }
}

#define XB_TMO      128
#define XB_XCNT(j)  (256  + 64 * (j))
#define XB_XSUB(j)  (1280 + 64 * (j))
#define XB_XGEN(j)  (2304 + 64 * (j))
#define XB_TOP      3328
#define XB_TOPGEN   3392
#define XCD_BAR_WORDS 3456
#define XB_SPIN_CAP (1u << 18)

__device__ __forceinline__ unsigned xb_ld(unsigned* p)              { return __hip_atomic_load(p, __ATOMIC_RELAXED, __HIP_MEMORY_SCOPE_AGENT); }
__device__ __forceinline__ unsigned xb_add(unsigned* p, unsigned v) { return __hip_atomic_fetch_add(p, v, __ATOMIC_RELAXED, __HIP_MEMORY_SCOPE_AGENT); }
__device__ __forceinline__ unsigned xb_xcc_id() { return (unsigned)__builtin_amdgcn_s_getreg((3 << 11) | 20) & 0xFu; }
#define XB_SPIN(cond, bar) do { unsigned _sp = 0; while (cond) { __builtin_amdgcn_s_sleep(1); \
    if ((++_sp & 255u) == 0u) { if (xb_ld(&(bar)[XB_TMO])) break; if (_sp > XB_SPIN_CAP) { atomicAdd(&(bar)[XB_TMO], 1u); break; } } } } while (0)

struct XcdBarrier {
    unsigned* bar; unsigned x; int w;
    volatile LAS unsigned* st;
};

__device__ __forceinline__ XcdBarrier xcd_barrier_post(unsigned* bar, volatile LAS unsigned* st, int wave) {
    XcdBarrier b; b.bar = bar; b.x = xb_xcc_id(); b.st = st; b.w = wave;
    if (tid_of(wave) == 0) (void)xb_add(&bar[XB_XCNT(b.x)], 1u);
    return b;
}
__device__ __forceinline__ void xcd_barrier_complete(unsigned* bar, unsigned x, unsigned& nloc, unsigned& nx) {
    const unsigned G = gridDim.x * gridDim.y * gridDim.z;
    unsigned sum, cnt, mine, sp = 0u;
    for (;;) {
        sum = 0u; cnt = 0u; mine = 0u;
#pragma unroll
        for (unsigned j = 0; j < 16; ++j) { const unsigned c = xb_ld(&bar[XB_XCNT(j)]); sum += c; cnt += (c > 0u) ? 1u : 0u; mine = (j == x) ? c : mine; }
        if (sum == G) break;
        __builtin_amdgcn_s_sleep(1);
        if ((++sp & 255u) == 0u) { if (xb_ld(&bar[XB_TMO])) break; if (sp > XB_SPIN_CAP) { atomicAdd(&bar[XB_TMO], 1u); break; } }
    }
    nloc = mine > 0u ? mine : 1u; nx = cnt > 0u ? cnt : 1u;
}

__device__ __forceinline__ void xcd_barrier(const XcdBarrier& b) {
    asm volatile("s_waitcnt vmcnt(0)" ::: "memory");
    __syncthreads();
    if (tid_of(b.w) == 0) {
        unsigned* bar = b.bar;
        __builtin_amdgcn_s_waitcnt(0);
        unsigned nloc = b.st[0], nx = b.st[1];
        if (nloc == 0u) { xcd_barrier_complete(bar, b.x, nloc, nx); b.st[0] = nloc; b.st[1] = nx; }
        const unsigned old = xb_add(&bar[XB_XSUB(b.x)], 1u);
        const unsigned gen = old / nloc;
        if (old + 1u == (gen + 1u) * nloc) {
            __builtin_amdgcn_fence(__ATOMIC_RELEASE, "agent");
            asm volatile("s_waitcnt vmcnt(0)" ::: "memory");
            const unsigned og = xb_add(&bar[XB_TOP], 1u);
            const unsigned tg = og / nx;
            if (og + 1u == (tg + 1u) * nx) xb_add(&bar[XB_TOPGEN], 1u);
            else XB_SPIN(xb_ld(&bar[XB_TOPGEN]) == tg, bar);
            __builtin_amdgcn_fence(__ATOMIC_ACQUIRE, "agent");
            xb_add(&bar[XB_XGEN(b.x)], 1u);
            asm volatile("s_waitcnt vmcnt(0)" ::: "memory");
        } else {
            XB_SPIN(xb_ld(&bar[XB_XGEN(b.x)]) == gen, bar);
            __builtin_amdgcn_fence(__ATOMIC_ACQUIRE, "agent");
            asm volatile("s_waitcnt vmcnt(0)" ::: "memory");
        }
    }
    __syncthreads();
}

constexpr size_t MiB = 1u << 20;
constexpr size_t WS_VSS = 0, WS_HSS1 = 2 * MiB, WS_HSS2 = 3 * MiB, WS_IRS0 = 3 * MiB + 32768, WS_CNT = 3 * MiB + 65536;
constexpr size_t WS_WT1 = 4 * MiB, WS_HN0 = 268 * MiB  , WS_WT2 = 84 * MiB, WS_WT3 = 100 * MiB, WS_WT4 = 132 * MiB;
constexpr size_t WS_U = 140 * MiB, WS_V = 204 * MiB, WS_ZS = 268 * MiB, WS_CTL = 364 * MiB, CTL_ZERO_BYTES = 32768, WS_END = 365 * MiB;
constexpr size_t WS_Y = 4 * MiB;
constexpr size_t WS_H1 = 140 * MiB, WS_H1B = 332 * MiB;
constexpr size_t WS_Q = 204 * MiB, WS_K = 236 * MiB, WS_V2 = 268 * MiB, WS_ZS2 = 300 * MiB, WS_OG = 4 * MiB;

constexpr int NWAVES = 8, LDS_BYTES = 151552;
#ifndef N_LAUNCHES
#define N_LAUNCHES 1
#endif
constexpr int N_PHASES = 7;
#ifndef CONV_TRIGGER
#define CONV_TRIGGER ((bx >> 3) % 6)
#endif
#ifndef GEMM_SP2
#define GEMM_SP2 true
#endif
#ifndef GEMM_ALIGN
#define GEMM_ALIGN true
#endif
#ifndef REPEAT_PHASE
#define REPEAT_PHASE -1
#endif
#define NREP(k) ((REPEAT_PHASE == (k)) ? 2 : 1)

struct Args { const float* in[10]; float* out; unsigned char* ws; int ph_lo, ph_hi, li, pad; };

__global__ void __launch_bounds__(NWAVES * 64, 2) fwd_kernel(Args a) {
    extern __shared__ __attribute__((aligned(16))) unsigned char lds_raw[];
    LAS unsigned char* lds = (LAS unsigned char*)lds_raw;
    cg::grid_group grid = cg::this_grid();
    const int wave = __builtin_amdgcn_readfirstlane(threadIdx.x >> 6);
#define tid tid_of(wave)
#define lane lane_id()
    const int G = gridDim.x, bx = blockIdx.x;
    const int vcu = (G % 8 == 0) ? (bx % 8) * (G / 8) + bx / 8 : bx;
    const float* x = a.in[0]; const float* norm_g = a.in[1]; const float* a_w_in = a.in[2]; const float* a_vg = a.in[3]; const float* a_w_s = a.in[4];
    const float* a_b_s = a.in[5]; const float* a_w_out = a.in[6]; const float* b_w_in = a.in[7]; const float* b_w_out = a.in[8]; const float* final_g = a.in[9];
    unsigned char* ws = a.ws;
    float* VSS = (float*)(ws + WS_VSS); float* HSS1 = (float*)(ws + WS_HSS1); float* HSS2 = (float*)(ws + WS_HSS2); float* IRS0 = (float*)(ws + WS_IRS0); unsigned* CNT = (unsigned*)(ws + WS_CNT);
    bf16_t* WT1 = (bf16_t*)(ws + WS_WT1); bf16_t* WT2 = (bf16_t*)(ws + WS_WT2); bf16_t* WT3 = (bf16_t*)(ws + WS_WT3); bf16_t* WT4 = (bf16_t*)(ws + WS_WT4);
    bf16_t* HN0 = (bf16_t*)(ws + WS_HN0); bf16_t* U = (bf16_t*)(ws + WS_U); bf16_t* V = (bf16_t*)(ws + WS_V); bf16_t* ZS = (bf16_t*)(ws + WS_ZS);
    bf16_t* Y = (bf16_t*)(ws + WS_Y); bf16_t* H1B = (bf16_t*)(ws + WS_H1B);
    bf16_t* Qb = (bf16_t*)(ws + WS_Q); bf16_t* Kb = (bf16_t*)(ws + WS_K); bf16_t* V2 = (bf16_t*)(ws + WS_V2); bf16_t* ZS2 = (bf16_t*)(ws + WS_ZS2); bf16_t* OG = (bf16_t*)(ws + WS_OG);
    const int lo = a.ph_lo, hi = a.ph_hi;
#define IN(k) (lo <= (k) && (k) < hi)
#define SEAM(k) do { if (IN(k) && IN((k) + 1)) xcd_barrier(bar); } while (0)
    volatile LAS unsigned* MISC = (volatile LAS unsigned*)(lds + LDS_BYTES - 64);
    if (tid < 16) MISC[tid] = 0u;
    __syncthreads();
    XcdBarrier bar = xcd_barrier_post((unsigned*)(ws + WS_CTL) + a.li * XCD_BAR_WORDS, MISC + 8, wave);
    if (lo > 1000) grid.sync();
    const int gw = vcu * NWAVES + wave, NGW = G * NWAVES;

    if (IN(0)) for (int rep = 0; rep < NREP(0); ++rep) {
        LAS float* scr = (LAS float*)(lds + wave * 16640);
        constexpr int I1 = (DM / 64) * (3 * GW / 64), I2 = (GW / 64) * (DM / 64), I3 = (DM / 64) * (4 * DM / 64), I4 = (DM / 64) * (DM / 64);
        transpose_matrix(a_w_in, DM, 3 * GW, WT1, scr, gw, NGW, I1, lane, nullptr, true);
        for (int m = bx * (NWAVES * 64) + tid; m < NTOK; m += G * NWAVES * 64) { HSS1[m] = 0.f; HSS2[m] = 0.f; if (m < 2048) CNT[m] = 0u; }
        for (int m = gw; m < NTOK; m += 2 * NGW) {
            const int m2 = m + NGW; const bool two = m2 < NTOK;
            const f32x4* xr = (const f32x4*)(x + (size_t)m * DM) + lane; const f32x4* xr2 = (const f32x4*)(x + (size_t)(two ? m2 : m) * DM) + lane; const f32x4* gr = (const f32x4*)norm_g + lane;
            f32x4 v[8], v2[8]; float ss = 0.f, ss2 = 0.f;
#pragma unroll
            for (int j = 0; j < 8; ++j) { v[j] = __builtin_nontemporal_load(xr + 64 * j); v2[j] = __builtin_nontemporal_load(xr2 + 64 * j); }
#pragma unroll
            for (int j = 0; j < 8; ++j) { ss += (v[j][0] * v[j][0] + v[j][1] * v[j][1]) + (v[j][2] * v[j][2] + v[j][3] * v[j][3]); ss2 += (v2[j][0] * v2[j][0] + v2[j][1] * v2[j][1]) + (v2[j][2] * v2[j][2] + v2[j][3] * v2[j][3]); }
            const float ms = wave_sum(ss) * (1.0f / DM) + EPS, ms2 = wave_sum(ss2) * (1.0f / DM) + EPS;
            const float rstd = __builtin_amdgcn_rsqf(ms), rstd2 = __builtin_amdgcn_rsqf(ms2);
            if (lane == 0) { IRS0[m] = __builtin_amdgcn_sqrtf(ms); if (two) IRS0[m2] = __builtin_amdgcn_sqrtf(ms2); }
            u32x2* o8 = (u32x2*)(HN0 + (size_t)m * DM) + lane; u32x2* o82 = (u32x2*)(HN0 + (size_t)m2 * DM) + lane;
#pragma unroll
            for (int j = 0; j < 8; ++j) { const f32x4 gg = gr[64 * j];
                u32x2 w; w.x = pk_bf16(v[j][0] * rstd * gg[0], v[j][1] * rstd * gg[1]); w.y = pk_bf16(v[j][2] * rstd * gg[2], v[j][3] * rstd * gg[3]); o8[64 * j] = w;
                if (two) { u32x2 w2; w2.x = pk_bf16(v2[j][0] * rstd2 * gg[0], v2[j][1] * rstd2 * gg[1]); w2.y = pk_bf16(v2[j][2] * rstd2 * gg[2], v2[j][3] * rstd2 * gg[3]); o82[64 * j] = w2; } }
        }
    }
    SEAM(0);
#ifdef EXTRA_SYNCS
    for (int i = 0; i < EXTRA_SYNCS; ++i) xcd_barrier(bar);
#endif
    if (IN(1)) for (int rep = 0; rep < NREP(1); ++rep) {
        pg8::Gemm g{HN0, WT1, NTOK, 3 * GW, DM}; pg8::ConvOrder S; S.init(NTOK, 3 * GW, G, bx);
        S.w2 = a_w_out; S.w3 = b_w_in; S.w4 = b_w_out; S.g1 = norm_g + DM; S.t2 = WT2; S.t3 = WT3; S.t4 = WT4; S.gw = gw; S.ngw = NGW; S.trigger = (G == 256) ? CONV_TRIGGER : 0; S.ln = lane; S.sw = lds + 131072 + wave * 2048; S.n_done = 0;
        pg8::EpiGmlpIn E{U, V, VSS};
        pg8::gemm_phase<pg8::EpiGmlpIn, pg8::ConvOrder, GEMM_ALIGN, GEMM_SP2>(lds, g, S, E, wave);
    }
    SEAM(1);
    if (IN(2)) for (int rep = 0; rep < NREP(2); ++rep) {
        for (int it = vcu; it < (NTOK / CHUNK) * NGRP; it += G) mix_unit(lds, wave, it >> 4, it & 15, U, V, VSS, a_w_s, a_b_s, a_vg, Y);
    }
    SEAM(2);
    if (IN(3)) for (int rep = 0; rep < NREP(3); ++rep) {
        pg8::Gemm g{Y, WT2, NTOK, DM, GW}; pg8::StaticOrder S; S.init(NTOK, DM, G, bx);
        pg8::EpiRes1 E{HN0, IRS0, norm_g, H1B, HSS1};
        pg8::gemm_phase<pg8::EpiRes1, pg8::StaticOrder, GEMM_ALIGN, GEMM_SP2>(lds, g, S, E, wave);
    }
    SEAM(3);
    if (IN(4)) for (int rep = 0; rep < NREP(4); ++rep) {
        pg8::Gemm g{H1B, WT3, NTOK, 4 * DM, DM}; pg8::StaticOrder S; S.init(NTOK, 4 * DM, G, bx);
        pg8::EpiSbIn E{Qb, (size_t)(WS_K - WS_Q) / 2, HSS1};
        pg8::gemm_phase<pg8::EpiSbIn, pg8::StaticOrder, GEMM_ALIGN, GEMM_SP2>(lds, g, S, E, wave);
    }
    SEAM(4);
    if (IN(5)) for (int rep = 0; rep < NREP(5); ++rep) attn_phase(lds, wave, vcu, G, Qb, Kb, V2, ZS2, OG);
    SEAM(5);
    if (IN(6)) for (int rep = 0; rep < NREP(6); ++rep) {
        pg8::Gemm g{OG, WT4, NTOK, DM, DM}; pg8::StaticOrder S; S.init(NTOK, DM, G, bx);
        pg8::EpiFinal E{H1B, final_g, a.out, HSS2, CNT, G == 256};
        pg8::gemm_phase<pg8::EpiFinal, pg8::StaticOrder, GEMM_ALIGN, GEMM_SP2>(lds, g, S, E, wave);
    }
    if (IN(6) && G != 256) {
        xcd_barrier(bar);
        for (int m = gw; m < NTOK; m += NGW) {
            const float rstd = __builtin_amdgcn_rsqf(HSS2[m] * (1.0f / DM) + EPS);
            f32x4* orow = (f32x4*)(a.out + (size_t)m * DM) + lane; const f32x4* gr = (const f32x4*)final_g + lane;
#pragma unroll
            for (int j = 0; j < 8; ++j) { const f32x4 v = orow[64 * j]; orow[64 * j] = v * rstd * gr[64 * j]; }
        }
    }
#undef IN
#undef SEAM
#undef tid
#undef lane
}

extern "C" void kernel_launch(void* const* d_in, const int* in_sizes, int n_in, void* d_out, int out_size, void* d_ws, size_t ws_size, hipStream_t stream) {
    static int grid = 0;
    if (grid == 0) {
        if (n_in != 10 || out_size != NTOK * DM || ws_size < WS_END) { fprintf(stderr, "kernel_launch: unexpected shapes (n_in %d, out %d, ws %zu)\n", n_in, out_size, ws_size); grid = -1; return; }
        int dev = 0, cus = 0, per_cu = 0;
        (void)hipGetDevice(&dev); (void)hipDeviceGetAttribute(&cus, hipDeviceAttributeMultiprocessorCount, dev);
        if (hipFuncSetAttribute((const void*)fwd_kernel, hipFuncAttributeMaxDynamicSharedMemorySize, LDS_BYTES) != hipSuccess) { fprintf(stderr, "kernel_launch: hipFuncSetAttribute failed\n"); grid = -1; return; }
        if (hipOccupancyMaxActiveBlocksPerMultiprocessor(&per_cu, (const void*)fwd_kernel, NWAVES * 64, LDS_BYTES) != hipSuccess || per_cu < 1) { fprintf(stderr, "kernel_launch: occupancy query says %d\n", per_cu); per_cu = 1; }
        (void)hipGetLastError();
        grid = cus > 0 ? cus : 256;
    }
    if (grid < 0) return;
    if (hipMemsetAsync((char*)d_ws + WS_CTL, 0, CTL_ZERO_BYTES, stream) != hipSuccess) { fprintf(stderr, "kernel_launch: memset failed\n"); return; }
    Args a{};
    for (int i = 0; i < 10; ++i) a.in[i] = (const float*)d_in[i];
    a.out = (float*)d_out; a.ws = (unsigned char*)d_ws;
#ifdef PROBE_SPLIT
    const int nl = 2;
#else
    const int nl = N_LAUNCHES;
#endif
    for (int li = 0; li < nl; ++li) {
        a.ph_lo = (N_LAUNCHES == 1) ? 0 : li; a.ph_hi = (N_LAUNCHES == 1) ? N_PHASES : li + 1;
#ifdef PROBE_SPLIT
        a.ph_lo = li == 0 ? 0 : PROBE_SPLIT; a.ph_hi = li == 0 ? PROBE_SPLIT + 1 : N_PHASES;
#endif
        a.li = li;
        void* args[] = {&a};
        hipError_t e = hipLaunchCooperativeKernel((const void*)fwd_kernel, dim3(grid), dim3(NWAVES * 64), args, LDS_BYTES, stream);
        if (e != hipSuccess) { fprintf(stderr, "kernel_launch: cooperative launch %d failed: %s (grid %d)\n", li, hipGetErrorString(e), grid); break; }
    }
}
```

```cpp
#include <hip/hip_runtime.h>
#include <hip/hip_cooperative_groups.h>
#include <cstdio>
#include <cstdint>
namespace cg = cooperative_groups;
__device__ __forceinline__ int lane_id() { return (int)__builtin_amdgcn_mbcnt_hi(~0u, __builtin_amdgcn_mbcnt_lo(~0u, 0u)); }
__device__ __forceinline__ int tid_of(int wave) { return wave * 64 + lane_id(); }
#ifndef PG8_WGM
#define PG8_WGM 8
#endif
namespace pg8 {
#define PG8_LAS __attribute__((address_space(3)))
typedef unsigned short bf16_t;
typedef short bf16x8 __attribute__((ext_vector_type(8)));
typedef float f32x4 __attribute__((ext_vector_type(4)));
typedef unsigned u32x4 __attribute__((ext_vector_type(4)));
constexpr int BM = 256, BK = 64, HALF = 128, HTB = HALF * BK * 2  , STAGE_BYTES = 8 * HTB, NXCD = 8, WGM = PG8_WGM;

__host__ __device__ __forceinline__ int lds_byte(int r, int c) { const int st = (r >> 4) * 2 + (c >> 5), rr = r & 15, cc = c & 31, ob = rr * 64 + cc * 2; return st * 1024 + (ob ^ (((ob >> 9) & 1) << 5)); }
__host__ __device__ __forceinline__ void stage_rc(int b, int& R, int& C) { const int st = b / 1024, sb = b % 1024, swz = sb ^ (((sb >> 9) & 1) << 5); R = (st >> 1) * 16 + swz / 64; C = (st & 1) * 32 + (swz % 64) / 2; }
__host__ __device__ __forceinline__ int perm32(int rho) { const int n = rho >> 4, i = rho & 15; return 8 * (i >> 2) + 4 * n + (i & 3); }

struct Unit { int pm, pn; };
struct Gemm { const bf16_t* A; const bf16_t* Bt; int M, N, K; };

struct StaticOrder {
    int nM, nN, nwg, G, c;
    __host__ __device__ void init(int M, int N, int G_, int c_) { nM = M / BM; nN = N / BM; nwg = nM * nN; G = G_; c = c_; }
    __host__ __device__ bool next(int i, Unit& u) const {
        const long L = (long)i * G + c; if (L >= nwg) return false;
        int wgid = (int)L; { const int q = nwg / NXCD, r = nwg % NXCD, xcd = wgid % NXCD, off = wgid / NXCD; wgid = (xcd < r ? xcd * (q + 1) : r * (q + 1) + (xcd - r) * q) + off; }
        const int nig = WGM * nN, gid = wgid / nig, fm = gid * WGM, gsz = (nM - fm) < WGM ? (nM - fm) : WGM;
        u.pm = fm + ((wgid % nig) % gsz); u.pn = (wgid % nig) / gsz; return true;
    }
    __device__ __forceinline__ void a_ready(const Unit&) const {}
    __device__ __forceinline__ void done(const Unit&) const {}
};

__device__ __forceinline__ unsigned cvt_pk_bf16(float lo, float hi) { unsigned r; asm volatile("v_cvt_pk_bf16_f32 %0, %1, %2" : "=v"(r) : "v"(lo), "v"(hi)); return r; }
typedef float f32x2 __attribute__((ext_vector_type(2)));
typedef float f32x2 __attribute__((ext_vector_type(2)));
template <class Epi, class Sched, bool ALIGN_EPI = false, bool SP2 = false>
__device__ __forceinline__ void gemm_phase(PG8_LAS unsigned char* lds, const Gemm g, const Sched& S, const Epi& E, const int wave_) {
    const int tid = tid_of(wave_), wid = wave_, lane = tid & 63, wr = wid >> 2, wc = wid & 3, fr = lane & 15, fq = lane >> 4;
    const int K = g.K, nt = K / BK;
    unsigned voffA[2], voffB[2];
#pragma unroll
    for (int i = 0; i < 2; ++i) { int R, C; stage_rc(tid * 16 + i * 8192, R, C); const int Rb = Epi::PERM ? ((R & ~31) + perm32(R & 31)) : R;
        voffA[i] = (unsigned)(R * K + C) * 2u; voffB[i] = (unsigned)(Rb * K + C) * 2u; }
    const size_t kstep = (size_t)(BK * 2);
    const size_t hstep = (size_t)HALF * K * 2;
    const size_t tstep = 2 * hstep;
    const unsigned ldsw = (unsigned)wid * 1024u;
    const int aoff = lds_byte(wr * 64 + fr, fq * 8), boff = lds_byte(wc * 32 + fr, fq * 8);
#define PG8_SA(b, h) (((b) * 2 + (h)) * HTB)
#define PG8_SB(b, h) ((4 + (b) * 2 + (h)) * HTB)
#define PG8_STAGE(bufoff, gbase, voff) do { _Pragma("unroll") for (int _i = 0; _i < 2; ++_i) \
        __builtin_amdgcn_global_load_lds((const unsigned*)((const char*)(gbase) + (voff)[_i]), (PG8_LAS unsigned*)(lds + (bufoff) + ldsw + _i * 8192), 16, 0, 0); } while (0)
#define PG8_LDA(dst, b, h) do { _Pragma("unroll") for (int m = 0; m < 4; ++m) _Pragma("unroll") for (int k = 0; k < 2; ++k) dst[m][k] = *(const PG8_LAS bf16x8*)(lds + PG8_SA(b, h) + aoff + m * 2048 + k * 1024); } while (0)
#define PG8_LDB(dst, b, h) do { _Pragma("unroll") for (int n = 0; n < 2; ++n) _Pragma("unroll") for (int k = 0; k < 2; ++k) dst[n][k] = *(const PG8_LAS bf16x8*)(lds + PG8_SB(b, h) + boff + n * 2048 + k * 1024); } while (0)
#define PG8_MMA(ai, bj, At, Bt) do { __builtin_amdgcn_s_setprio(1); _Pragma("unroll") for (int m = 0; m < 4; ++m) _Pragma("unroll") for (int n = 0; n < 2; ++n) _Pragma("unroll") for (int k = 0; k < 2; ++k) \
        acc[ai][bj][m][n] = __builtin_amdgcn_mfma_f32_16x16x32_bf16(Bt[n][k], At[m][k], acc[ai][bj][m][n], 0, 0, 0); __builtin_amdgcn_s_setprio(0); } while (0)
#define PG8_WAIT_V(n) asm volatile("s_waitcnt vmcnt(" #n ")" ::: "memory")
#define PG8_WAIT_L(n) asm volatile("s_waitcnt lgkmcnt(" #n ")" ::: "memory")
#define PG8_BAR __builtin_amdgcn_s_barrier()
#define PG8_SCHED __builtin_amdgcn_sched_barrier(0)
    Unit cur, nxt; int ui = 0;
    if (!S.next(0, cur)) return;
    f32x4 acc[2][2][4][2];
#pragma unroll
    for (int a = 0; a < 2; ++a)
#pragma unroll
        for (int b = 0; b < 2; ++b)
#pragma unroll
            for (int m = 0; m < 4; ++m)
#pragma unroll
                for (int n = 0; n < 2; ++n) acc[a][b][m][n] = (f32x4){0.f, 0.f, 0.f, 0.f};
    bf16x8 At[4][2], B0[2][2], B1[2][2];
    const char* cA = (const char*)g.A + (size_t)cur.pm * tstep; const char* cB = (const char*)g.Bt + (size_t)cur.pn * tstep;
    S.a_ready(cur);
    if constexpr (SP2) {
        PG8_STAGE(PG8_SB(0, 0), cB, voffB); PG8_STAGE(PG8_SB(0, 1), cB + hstep, voffB); PG8_STAGE(PG8_SA(0, 0), cA, voffA); PG8_STAGE(PG8_SA(0, 1), cA + hstep, voffA);
        if (wr == 1) PG8_BAR;
        PG8_WAIT_V(2); PG8_BAR;
        PG8_STAGE(PG8_SB(1, 0), cB + kstep, voffB); PG8_STAGE(PG8_SA(1, 0), cA + kstep, voffA); PG8_STAGE(PG8_SB(1, 1), cB + hstep + kstep, voffB);
        PG8_WAIT_V(6); PG8_BAR;
    } else {
        PG8_STAGE(PG8_SB(0, 0), cB, voffB); PG8_STAGE(PG8_SA(0, 0), cA, voffA); PG8_STAGE(PG8_SB(0, 1), cB + hstep, voffB); PG8_STAGE(PG8_SA(0, 1), cA + hstep, voffA);
        if (wr == 1) PG8_BAR;
        PG8_WAIT_V(4); PG8_BAR;
        PG8_STAGE(PG8_SB(1, 0), cB + kstep, voffB); PG8_STAGE(PG8_SA(1, 0), cA + kstep, voffA); PG8_STAGE(PG8_SB(1, 1), cB + hstep + kstep, voffB);
        PG8_WAIT_V(6); PG8_BAR;
    }
    for (;;) {
        const bool has_next = S.next(ui + 1, nxt);
        const char* nA = has_next ? (const char*)g.A + (size_t)nxt.pm * tstep : cA; const char* nB = has_next ? (const char*)g.Bt + (size_t)nxt.pn * tstep : cB;
        for (int t = 0; t < nt; t += 2) {
            const bool last = (t == nt - 2);
            const char* a1 = cA + (size_t)(t + 1) * kstep;
            const char* a2 = last ? nA : cA + (size_t)(t + 2) * kstep; const char* b2 = last ? nB : cB + (size_t)(t + 2) * kstep;
            const char* a3 = a2 + kstep; const char* b3 = b2 + kstep;
            if (last && has_next) S.a_ready(nxt);
            if constexpr (SP2) {
            PG8_LDB(B0, 0, 0); PG8_LDB(B1, 0, 1); PG8_SCHED; PG8_LDA(At, 0, 0); PG8_STAGE(PG8_SA(1, 1), a1 + hstep, voffA);
            PG8_WAIT_V(8); PG8_WAIT_L(0); PG8_BAR; PG8_MMA(0, 0, At, B0); PG8_MMA(0, 1, At, B1); PG8_BAR; PG8_SCHED;
            PG8_LDA(At, 0, 1); PG8_STAGE(PG8_SB(0, 0), b2, voffB); PG8_STAGE(PG8_SB(0, 1), b2 + hstep, voffB); PG8_STAGE(PG8_SA(0, 0), a2, voffA);
            PG8_WAIT_V(8); PG8_WAIT_L(0); PG8_BAR; PG8_MMA(1, 0, At, B0); PG8_MMA(1, 1, At, B1); PG8_BAR; PG8_SCHED;
            PG8_LDB(B0, 1, 0); PG8_LDB(B1, 1, 1); PG8_SCHED; PG8_LDA(At, 1, 0); PG8_STAGE(PG8_SA(0, 1), a2 + hstep, voffA);
            PG8_WAIT_V(8); PG8_WAIT_L(0); PG8_BAR; PG8_MMA(0, 0, At, B0); PG8_MMA(0, 1, At, B1); PG8_BAR; PG8_SCHED;
            PG8_LDA(At, 1, 1); PG8_STAGE(PG8_SB(1, 0), b3, voffB); PG8_STAGE(PG8_SB(1, 1), b3 + hstep, voffB); PG8_STAGE(PG8_SA(1, 0), a3, voffA);
            PG8_WAIT_V(8); PG8_WAIT_L(0); PG8_BAR; PG8_MMA(1, 0, At, B0); PG8_MMA(1, 1, At, B1); PG8_BAR; PG8_SCHED;
            } else {
            PG8_LDB(B0, 0, 0); PG8_SCHED; PG8_LDA(At, 0, 0); PG8_STAGE(PG8_SA(1, 1), a1 + hstep, voffA);
            PG8_WAIT_L(8); PG8_BAR; PG8_WAIT_L(0); PG8_MMA(0, 0, At, B0); PG8_BAR; PG8_SCHED;
            PG8_LDB(B1, 0, 1); PG8_STAGE(PG8_SB(0, 0), b2, voffB);
            PG8_BAR; PG8_WAIT_L(0); PG8_MMA(0, 1, At, B1); PG8_BAR;
            PG8_LDA(At, 0, 1); PG8_STAGE(PG8_SA(0, 0), a2, voffA);
            PG8_BAR; PG8_WAIT_L(0); PG8_MMA(1, 0, At, B0); PG8_BAR; PG8_SCHED;
            PG8_STAGE(PG8_SB(0, 1), b2 + hstep, voffB);
            PG8_WAIT_V(6); PG8_BAR; PG8_MMA(1, 1, At, B1); PG8_BAR;
            PG8_LDB(B0, 1, 0); PG8_SCHED; PG8_LDA(At, 1, 0); PG8_STAGE(PG8_SA(0, 1), a2 + hstep, voffA);
            PG8_WAIT_L(8); PG8_BAR; PG8_WAIT_L(0); PG8_MMA(0, 0, At, B0); PG8_BAR; PG8_SCHED;
            PG8_LDB(B1, 1, 1); PG8_STAGE(PG8_SB(1, 0), b3, voffB);
            PG8_BAR; PG8_WAIT_L(0); PG8_MMA(0, 1, At, B1); PG8_BAR;
            PG8_LDA(At, 1, 1); PG8_STAGE(PG8_SA(1, 0), a3, voffA);
            PG8_BAR; PG8_WAIT_L(0); PG8_MMA(1, 0, At, B0); PG8_BAR; PG8_SCHED;
            PG8_STAGE(PG8_SB(1, 1), b3 + hstep, voffB);
            PG8_WAIT_V(6); PG8_BAR; PG8_MMA(1, 1, At, B1); PG8_BAR;
            }
        }
        if constexpr (ALIGN_EPI) { if (wr == 0) PG8_BAR; }
        if constexpr (!Epi::AFTER_DRAIN) { E(acc, cur, wr, wc, fr, fq); S.done(cur); }
        if (!has_next) break;
#pragma unroll
        for (int a = 0; a < 2; ++a)
#pragma unroll
            for (int b = 0; b < 2; ++b)
#pragma unroll
                for (int m = 0; m < 4; ++m)
#pragma unroll
                    for (int n = 0; n < 2; ++n) acc[a][b][m][n] = (f32x4){0.f, 0.f, 0.f, 0.f};
        cur = nxt; cA = nA; cB = nB; ++ui;
        if constexpr (ALIGN_EPI) { if (wr == 1) PG8_BAR; }
    }
    PG8_WAIT_V(0);
    if constexpr (!ALIGN_EPI) { if (wr == 0) PG8_BAR; }
    PG8_BAR;
    if constexpr (Epi::AFTER_DRAIN) { E.fused(acc, cur, wr, wc, fr, fq, lds, wid, lane); S.done(cur); }
#undef PG8_SA
#undef PG8_SB
#undef PG8_STAGE
#undef PG8_LDA
#undef PG8_LDB
#undef PG8_MMA
#undef PG8_WAIT_V
#undef PG8_WAIT_L
#undef PG8_BAR
#undef PG8_SCHED
}
}

constexpr int DM = 2048, NTOK = 8192, SEQ = 4096, GW = 4096, NGRP = 16, GDIM = 256, CHUNK = 128, NHEAD = 16, HD = 128;
constexpr float EPS = 1e-6f;
constexpr float LOG2E = 1.4426950408889634f;
constexpr float QSCALE = 0.08838834764831845f * LOG2E;

constexpr float GELU_C1 = -1.5957691216057308f * LOG2E, GELU_C2 = -0.07135481627260025f * LOG2E;
__device__ __forceinline__ float gelu_tanh(float x) {
    const float e = __builtin_amdgcn_exp2f(x * __builtin_fmaf(x * x, GELU_C2, GELU_C1));
    return x * __builtin_amdgcn_rcpf(1.0f + e);
}
__device__ __forceinline__ float gelu_silu(float u, float z) {
    const float e1 = __builtin_amdgcn_exp2f(u * __builtin_fmaf(u * u, GELU_C2, GELU_C1));
    const float e2 = __builtin_amdgcn_exp2f(z * -LOG2E);
    return (u * z) * __builtin_amdgcn_rcpf((1.0f + e1) * (1.0f + e2));
}
__device__ __forceinline__ float silu_f(float z) { return z * __builtin_amdgcn_rcpf(1.0f + __builtin_amdgcn_exp2f(-LOG2E * z)); }

namespace pg8 {
typedef unsigned u32x2 __attribute__((ext_vector_type(2)));
__device__ __forceinline__ void conv_load4(const float* __restrict__ W, int N, int item, int lane, f32x4 (&x)[16]) {
    const int nblk = N / 64, k0 = 64 * (item / nblk), n0 = 64 * (item % nblk);
#pragma unroll
    for (int i = 0; i < 16; ++i) x[i] = __builtin_nontemporal_load((const f32x4*)(W + (size_t)(k0 + 4 * i + (lane >> 4)) * N + n0 + 4 * (lane & 15)));
}
__device__ __forceinline__ void conv_xpose(f32x4 (&x)[16], int lane) {
    const bool a = (lane >> 4) & 1, b = (lane >> 5) & 1;
#pragma unroll
    for (int i = 0; i < 16; ++i) {
        f32x4 v = x[i];
        {
            const float s0 = a ? v[0] : v[1], s1 = a ? v[2] : v[3];
            const float r0 = __shfl_xor(s0, 16), r1 = __shfl_xor(s1, 16);
            if (a) { v[0] = r0; v[2] = r1; } else { v[1] = r0; v[3] = r1; }
        }
        {
            const float s0 = b ? v[0] : v[2], s1 = b ? v[1] : v[3];
            const float r0 = __shfl_xor(s0, 32), r1 = __shfl_xor(s1, 32);
            if (b) { v[0] = r0; v[1] = r1; } else { v[2] = r0; v[3] = r1; }
        }
        x[i] = v;
    }
}
__device__ __forceinline__ void conv_store4(int K, int N, bf16_t* __restrict__ WT, int item, int lane, const float* __restrict__ gk, const f32x4 (&x)[16]) {
    const int nblk = N / 64, k0 = 64 * (item / nblk), n0 = 64 * (item % nblk);
    const int n = n0 + 4 * (lane & 15) + (lane >> 4);
#pragma unroll
    for (int kc = 0; kc < 8; ++kc) {
        float g[8];
#pragma unroll
        for (int j = 0; j < 8; ++j) g[j] = gk ? gk[k0 + 8 * kc + j] : 1.0f;
        const f32x4 lo = x[2 * kc], hi = x[2 * kc + 1];
        u32x4 o; o.x = cvt_pk_bf16(lo[0] * g[0], lo[1] * g[1]); o.y = cvt_pk_bf16(lo[2] * g[2], lo[3] * g[3]);
        o.z = cvt_pk_bf16(hi[0] * g[4], hi[1] * g[5]); o.w = cvt_pk_bf16(hi[2] * g[6], hi[3] * g[7]);
        *(u32x4*)(WT + (size_t)n * K + k0 + 8 * kc) = o;
    }
}
__device__ __forceinline__ void conv_store4_lds(int K, int N, bf16_t* __restrict__ WT, int item, int lane, const float* __restrict__ gk, const f32x4 (&x)[16], PG8_LAS unsigned char* sw) {
    const int nblk = N / 64, k0 = 64 * (item / nblk), n0 = 64 * (item % nblk);
    const int nq = lane & 15, r = lane >> 4;
    u32x4 o[8];
#pragma unroll
    for (int kc = 0; kc < 8; ++kc) {
        float g[8];
#pragma unroll
        for (int j = 0; j < 8; ++j) g[j] = gk ? gk[k0 + 8 * kc + j] : 1.0f;
        const f32x4 lo = x[2 * kc], hi = x[2 * kc + 1];
        o[kc].x = cvt_pk_bf16(lo[0] * g[0], lo[1] * g[1]); o[kc].y = cvt_pk_bf16(lo[2] * g[2], lo[3] * g[3]);
        o[kc].z = cvt_pk_bf16(hi[0] * g[4], hi[1] * g[5]); o[kc].w = cvt_pk_bf16(hi[2] * g[6], hi[3] * g[7]);
    }
#pragma unroll
    for (int q = 0; q < 4; ++q) {
        if ((nq >> 2) == q) {
            PG8_LAS u32x4* wp = (PG8_LAS u32x4*)(sw + (4 * (nq & 3) + r) * 128);
#pragma unroll
            for (int kc = 0; kc < 8; ++kc) wp[kc] = o[kc];
        }
        asm volatile("s_waitcnt lgkmcnt(0)" ::: "memory");
#pragma unroll
        for (int h = 0; h < 2; ++h) { const int rl = (lane >> 3) + 8 * h;
            const u32x4 v = *(const PG8_LAS u32x4*)(sw + rl * 128 + (lane & 7) * 16);
            __builtin_nontemporal_store(v, (u32x4*)(WT + (size_t)(n0 + 16 * q + rl) * K + k0 + 8 * (lane & 7))); }
        asm volatile("s_waitcnt lgkmcnt(0)" ::: "memory");
    }
}
struct ConvOrder : StaticOrder {
    const float *w2, *w3, *w4, *g1; bf16_t *t2, *t3, *t4; int gw, ngw, trigger, ln; PG8_LAS unsigned char* sw; mutable int n_done;
    __device__ __forceinline__ void done(const Unit&) const {
        constexpr int I2 = (GW / 64) * (DM / 64), I3 = (DM / 64) * (4 * DM / 64), I4 = (DM / 64) * (DM / 64);
        const int u = n_done++;
#ifdef HOOK_SPREAD
        f32x4 va[16];
        if (u == 0 || u == 1) { for (int it = gw + u * ngw; it < I3; it += 2 * ngw) { conv_load4(w3, 4 * DM, it, ln, va); conv_xpose(va, ln); conv_store4(DM, 4 * DM, t3, it, ln, g1, va); } }
        else if (u == 2) { for (int it = gw; it < I2; it += ngw) { conv_load4(w2, DM, it, ln, va); conv_xpose(va, ln); conv_store4(GW, DM, t2, it, ln, nullptr, va); } }
        else if (u == 3) { for (int it = gw; it < I4; it += ngw) { conv_load4(w4, DM, it, ln, va); conv_xpose(va, ln); conv_store4(DM, DM, t4, it, ln, nullptr, va); } }
#else
        if (u != trigger) return;
        f32x4 va[16], vb[16];
        for (int it = gw; it < I3; it += 2 * ngw) {
            const bool two = it + ngw < I3;
            conv_load4(w3, 4 * DM, it, ln, va); if (two) conv_load4(w3, 4 * DM, it + ngw, ln, vb);
            conv_xpose(va, ln); if (two) conv_xpose(vb, ln);
            conv_store4_lds(DM, 4 * DM, t3, it, ln, g1, va, sw); if (two) conv_store4_lds(DM, 4 * DM, t3, it + ngw, ln, g1, vb, sw);
        }
        for (int it = gw; it < I2; it += ngw) {
            const bool two = it < I4;
            conv_load4(w2, DM, it, ln, va); if (two) conv_load4(w4, DM, it, ln, vb);
            conv_xpose(va, ln); if (two) conv_xpose(vb, ln);
            conv_store4_lds(GW, DM, t2, it, ln, nullptr, va, sw); if (two) conv_store4_lds(DM, DM, t4, it, ln, nullptr, vb, sw);
        }
#endif
    }
};
struct EpiGmlpIn {
    static constexpr bool PERM = true, AFTER_DRAIN = false;
    bf16_t *UZ, *V; float* vss;
    __device__ __forceinline__ void operator()(const f32x4 (&acc)[2][2][4][2], const Unit& u, int wr, int wc, int fr, int fq) const {
        const int row0 = u.pm * BM + wr * 64 + fr;
        const int tq = u.pn / 3, tr = u.pn - 3 * tq;
        if (tr < 2) {
            const int col0 = (2 * tq + tr) * HALF + wc * 32 + 8 * fq;
#pragma unroll
            for (int ai = 0; ai < 2; ++ai)
#pragma unroll
                for (int m = 0; m < 4; ++m) {
                    const int row = row0 + ai * HALF + m * 16;
                    f32x4 v0 = acc[ai][0][m][0], v1 = acc[ai][0][m][1]; const f32x4 z0 = acc[ai][1][m][0], z1 = acc[ai][1][m][1];
#pragma unroll
                    for (int e = 0; e < 4; ++e) { v0[e] = gelu_silu(v0[e], z0[e]); v1[e] = gelu_silu(v1[e], z1[e]); }
                    u32x4 w; w.x = cvt_pk_bf16(v0[0], v0[1]); w.y = cvt_pk_bf16(v0[2], v0[3]); w.z = cvt_pk_bf16(v1[0], v1[1]); w.w = cvt_pk_bf16(v1[2], v1[3]);
                    *(u32x4*)(UZ + (size_t)row * GW + col0) = w;
                }
        } else {
            const int tl = tq, col0 = tl * BM + wc * 32 + 8 * fq;
#pragma unroll
            for (int ai = 0; ai < 2; ++ai)
#pragma unroll
                for (int m = 0; m < 4; ++m) {
                    const int row = row0 + ai * HALF + m * 16;
                    bf16_t* rowp = V + (size_t)row * GW + col0;
                    float ss = 0.f;
#pragma unroll
                    for (int bj = 0; bj < 2; ++bj) {
                        f32x4 v0 = acc[ai][bj][m][0], v1 = acc[ai][bj][m][1];
#pragma unroll
                        for (int e = 0; e < 4; ++e) { v0[e] = gelu_tanh(v0[e]); v1[e] = gelu_tanh(v1[e]); ss += v0[e] * v0[e] + v1[e] * v1[e]; }
                        u32x4 w; w.x = cvt_pk_bf16(v0[0], v0[1]); w.y = cvt_pk_bf16(v0[2], v0[3]); w.z = cvt_pk_bf16(v1[0], v1[1]); w.w = cvt_pk_bf16(v1[2], v1[3]);
                        *(u32x4*)(rowp + bj * HALF) = w;
                    }
                    ss += __shfl_xor(ss, 16); ss += __shfl_xor(ss, 32);
                    if (fq == 0) vss[(size_t)row * 64 + tl * 4 + wc] = ss;
                }
        }
    }
};
struct EpiRes1 {
    static constexpr bool PERM = false, AFTER_DRAIN = false;
    const bf16_t* hn; const float* irs; bf16_t* hb; float* hss;
    __device__ __forceinline__ void operator()(const f32x4 (&acc)[2][2][4][2], const Unit& u, int wr, int wc, int fr, int fq) const {
        const int row0 = u.pm * BM + wr * 64 + fr, col0 = u.pn * BM + wc * 32 + 4 * fq;
        float rs[2][4];
#pragma unroll
        for (int ai = 0; ai < 2; ++ai)
#pragma unroll
            for (int m = 0; m < 4; ++m) rs[ai][m] = irs[row0 + ai * HALF + m * 16];
#pragma unroll
        for (int ai = 0; ai < 2; ++ai) {
            u32x2 xv[4][2][2];
#pragma unroll
            for (int m = 0; m < 4; ++m)
#pragma unroll
                for (int bj = 0; bj < 2; ++bj)
#pragma unroll
                    for (int n = 0; n < 2; ++n) xv[m][bj][n] = *(const u32x2*)(hn + (size_t)(row0 + ai * HALF + m * 16) * DM + col0 + bj * HALF + n * 16);
#pragma unroll
            for (int m = 0; m < 4; ++m) {
                const int row = row0 + ai * HALF + m * 16;
                const size_t off = (size_t)row * DM + col0;
                float ss = 0.f;
#pragma unroll
                for (int bj = 0; bj < 2; ++bj)
#pragma unroll
                    for (int n = 0; n < 2; ++n) {
                        const u32x2 w2 = xv[m][bj][n];
                        f32x4 xh; xh[0] = __uint_as_float(w2.x << 16); xh[1] = __uint_as_float(w2.x & 0xffff0000u); xh[2] = __uint_as_float(w2.y << 16); xh[3] = __uint_as_float(w2.y & 0xffff0000u);
                        const f32x4 h = xh * rs[ai][m] + acc[ai][bj][m][n];
                        ss += (h[0] * h[0] + h[1] * h[1]) + (h[2] * h[2] + h[3] * h[3]);
                        const unsigned long long w = (unsigned long long)cvt_pk_bf16(h[0], h[1]) | ((unsigned long long)cvt_pk_bf16(h[2], h[3]) << 32);
                        *(unsigned long long*)(hb + off + bj * HALF + n * 16) = w;
                    }
                ss += __shfl_xor(ss, 16); ss += __shfl_xor(ss, 32);
                if (fq == 0) __hip_atomic_fetch_add(hss + row, ss, __ATOMIC_RELAXED, __HIP_MEMORY_SCOPE_AGENT);
            }
        }
    }
};
struct EpiFinal {
    static constexpr bool PERM = false, AFTER_DRAIN = false;
    const bf16_t* hb; const float* fg; float* out; float* hss; unsigned* cnt; bool fused;
    __device__ __forceinline__ void operator()(f32x4 (&acc)[2][2][4][2], const Unit& u, int wr, int wc, int fr, int fq) const {
        const int row0 = u.pm * BM + wr * 64 + fr, col0 = u.pn * BM + wc * 32 + 4 * fq;
#pragma unroll
        for (int ai = 0; ai < 2; ++ai)
#pragma unroll
            for (int m = 0; m < 4; ++m) {
                const int row = row0 + ai * HALF + m * 16;
                const size_t off = (size_t)row * DM + col0;
                float ss = 0.f;
#pragma unroll
                for (int bj = 0; bj < 2; ++bj)
#pragma unroll
                    for (int n = 0; n < 2; ++n) {
                        const u32x2 w = *(const u32x2*)(hb + off + bj * HALF + n * 16);
                        f32x4 h; h[0] = __uint_as_float(w.x << 16); h[1] = __uint_as_float(w.x & 0xffff0000u); h[2] = __uint_as_float(w.y << 16); h[3] = __uint_as_float(w.y & 0xffff0000u);
                        h += acc[ai][bj][m][n];
                        acc[ai][bj][m][n] = h;
                        ss += (h[0] * h[0] + h[1] * h[1]) + (h[2] * h[2] + h[3] * h[3]);
                    }
                ss += __shfl_xor(ss, 16); ss += __shfl_xor(ss, 32);
                if (fq == 0) __hip_atomic_fetch_add(hss + row, ss, __ATOMIC_RELAXED, __HIP_MEMORY_SCOPE_AGENT);
            }
        if (!fused) {
#pragma unroll
            for (int ai = 0; ai < 2; ++ai)
#pragma unroll
                for (int m = 0; m < 4; ++m)
#pragma unroll
                    for (int bj = 0; bj < 2; ++bj)
#pragma unroll
                        for (int n = 0; n < 2; ++n) *(f32x4*)(out + (size_t)(row0 + ai * HALF + m * 16) * DM + col0 + bj * HALF + n * 16) = acc[ai][bj][m][n];
            return;
        }
        asm volatile("s_waitcnt vmcnt(0)" ::: "memory");
        unsigned* pc = cnt + 64 * u.pm;
        if (lane_id() == 0) __hip_atomic_fetch_add(pc, 1u, __ATOMIC_RELAXED, __HIP_MEMORY_SCOPE_AGENT);
        for (int it = 0; it < (1 << 22); ++it) {
            if (__hip_atomic_load(pc, __ATOMIC_RELAXED, __HIP_MEMORY_SCOPE_AGENT) >= 64u) break;
            __builtin_amdgcn_s_sleep(2);
        }
        asm volatile("" ::: "memory");
        f32x4 gv[2][2];
#pragma unroll
        for (int bj = 0; bj < 2; ++bj)
#pragma unroll
            for (int n = 0; n < 2; ++n) gv[bj][n] = *(const f32x4*)(fg + col0 + bj * HALF + n * 16);
        float ssr[2][4];
#pragma unroll
        for (int ai = 0; ai < 2; ++ai)
#pragma unroll
            for (int m = 0; m < 4; ++m) ssr[ai][m] = __hip_atomic_load(hss + row0 + ai * HALF + m * 16, __ATOMIC_RELAXED, __HIP_MEMORY_SCOPE_AGENT);
#pragma unroll
        for (int ai = 0; ai < 2; ++ai)
#pragma unroll
            for (int m = 0; m < 4; ++m) {
                const int row = row0 + ai * HALF + m * 16;
                const size_t off = (size_t)row * DM + col0;
                const float rstd = __builtin_amdgcn_rsqf(ssr[ai][m] * (1.0f / DM) + EPS);
#pragma unroll
                for (int bj = 0; bj < 2; ++bj)
#pragma unroll
                    for (int n = 0; n < 2; ++n) *(f32x4*)(out + off + bj * HALF + n * 16) = acc[ai][bj][m][n] * rstd * gv[bj][n];
            }
    }
};
struct EpiSbIn {
    static constexpr bool PERM = true, AFTER_DRAIN = false;
    bf16_t* Q; size_t rstride; const float* hss;
    __device__ __forceinline__ void operator()(const f32x4 (&acc)[2][2][4][2], const Unit& u, int wr, int wc, int fr, int fq) const {
        const int region = u.pn >> 3, tl = u.pn & 7;
        bf16_t* base = Q + (size_t)region * rstride;
        const int row0 = u.pm * BM + wr * 64 + fr, col0 = tl * BM + wc * 32 + 8 * fq;
        float ssr[2][4];
#pragma unroll
        for (int ai = 0; ai < 2; ++ai)
#pragma unroll
            for (int m = 0; m < 4; ++m) ssr[ai][m] = hss[row0 + ai * HALF + m * 16];
#pragma unroll
        for (int ai = 0; ai < 2; ++ai)
#pragma unroll
            for (int m = 0; m < 4; ++m) {
                const int row = row0 + ai * HALF + m * 16;
                float sc = __builtin_amdgcn_rsqf(ssr[ai][m] * (1.0f / DM) + EPS);
                if (region == 0) sc *= QSCALE;
                bf16_t* rowp = base + (size_t)row * DM + col0;
#pragma unroll
                for (int bj = 0; bj < 2; ++bj) {
                    f32x4 v0 = acc[ai][bj][m][0] * sc, v1 = acc[ai][bj][m][1] * sc;
                    if (region == 3) {
#pragma unroll
                        for (int e = 0; e < 4; ++e) { v0[e] = silu_f(v0[e]); v1[e] = silu_f(v1[e]); }
                    }
                    u32x4 w; w.x = cvt_pk_bf16(v0[0], v0[1]); w.y = cvt_pk_bf16(v0[2], v0[3]); w.z = cvt_pk_bf16(v1[0], v1[1]); w.w = cvt_pk_bf16(v1[2], v1[3]);
                    *(u32x4*)(rowp + bj * HALF) = w;
                }
            }
    }
};
}

#define LAS __attribute__((address_space(3)))
typedef unsigned short bf16_t;
typedef short bf16x8 __attribute__((ext_vector_type(8)));
typedef short s16x4 __attribute__((ext_vector_type(4)));
typedef float f32x4 __attribute__((ext_vector_type(4)));
typedef float f32x16 __attribute__((ext_vector_type(16)));
typedef unsigned u32x4 __attribute__((ext_vector_type(4)));
typedef unsigned u32x2 __attribute__((ext_vector_type(2)));
__device__ __forceinline__ unsigned off_b(unsigned row, unsigned ch) { return 256u * row + 16u * (ch ^ (((row & 3u) << 2) | ((row >> 2) & 3u))); }
__device__ __forceinline__ s16x4 vtr(const LAS unsigned char* p) { return __builtin_bit_cast(s16x4, __builtin_amdgcn_ds_read_tr16_b64_v4i16((LAS s16x4*)p)); }
__device__ __forceinline__ unsigned pk_bf16(float lo, float hi) { return pg8::cvt_pk_bf16(lo, hi); }
__device__ __forceinline__ float bf_lo(unsigned w) { return __uint_as_float(w << 16); }
__device__ __forceinline__ float bf_hi(unsigned w) { return __uint_as_float(w & 0xffff0000u); }
__device__ __forceinline__ int crow(int r, int hi) { return (r & 3) + 8 * (r >> 2) + 4 * hi; }

#ifdef ATT_NOSB
#define ATT_SB() do {} while (0)
#else
#ifndef ATT_USE_SB
#define ATT_SB() do {} while (0)
#else
#define ATT_SB() __builtin_amdgcn_sched_barrier(0)
#endif
#endif
#define ATT_VLD(f) do { const int c_ = (f) >> 2, s_ = (f) & 3; const s16x4 lo_ = vtr(vbp + 4096 * s_ + vbase[0] + vcq[c_]); const s16x4 hh_ = vtr(vbp + 4096 * s_ + vbase[1] + vcq[c_]); \
        vf[f] = (bf16x8){lo_[0], lo_[1], lo_[2], lo_[3], hh_[0], hh_[1], hh_[2], hh_[3]}; } while (0)
#define ATT_PV(f) do { if (DO_PV) { o[(f) >> 2] = __builtin_amdgcn_mfma_f32_32x32x16_bf16(pa[(f) & 3], vf[f], o[(f) >> 2], 0, 0, 0); if ((f) + 4 < 16) ATT_VLD((f) + 4); } } while (0)
#define ATT_EXP8(i) do { _Pragma("unroll") for (int r_ = 0; r_ < 8; ++r_) p[(i) >> 1][8 * ((i) & 1) + r_] = __builtin_amdgcn_exp2f(fminf(p[(i) >> 1][8 * ((i) & 1) + r_], 30.f)); } while (0)
#define ATT_LBLK(j) do { const int ph_ = 1 - ((j) >> 2), g_ = 3 - ((j) & 3); \
        const float w0_ = 1.0f + p[ph_][4 * g_], w1_ = 1.0f + p[ph_][4 * g_ + 1], w2_ = 1.0f + p[ph_][4 * g_ + 2], w3_ = 1.0f + p[ph_][4 * g_ + 3]; \
        L[j] = __builtin_amdgcn_logf((w0_ * w1_) * (w2_ * w3_)); } while (0)
#define ATT_XCH(j) do { const float own_ = L[j]; const auto rr_ = __builtin_amdgcn_permlane32_swap(__float_as_uint(own_), __float_as_uint(own_), false, false); \
        const float a0_ = __uint_as_float(rr_[0]), a1_ = __uint_as_float(rr_[1]); const float oth_ = (a0_ == own_) ? a1_ : a0_; \
        T[j] = run + (hi ? 0.f : oth_) + own_; run += a0_ + a1_; } while (0)
#define ATT_WGT(j) do { const int ph_ = 1 - ((j) >> 2), g_ = 3 - ((j) & 3); float cf_ = __builtin_amdgcn_exp2f(-T[j]); \
        _Pragma("unroll") for (int e_ = 0; e_ < 4; ++e_) { const float ev_ = p[ph_][4 * g_ + e_]; p[ph_][4 * g_ + e_] = ev_ * cf_; if (e_ < 3) cf_ *= (1.0f + ev_); } } while (0)

template <bool DO_PV>
__device__ __forceinline__ void attn_tile(const LAS unsigned char* kb, const LAS unsigned char* vbp, const bf16x8 (&qf)[8], f32x16 (&o)[4], bf16x8 (&pa)[4], float& carry,
                                          const unsigned (&koff)[8], const unsigned (&vbase)[2], const unsigned (&vcq)[4], int k0, int qw0, int qabs, int hi) {
    f32x16 p[2];
#pragma unroll
    for (int r = 0; r < 16; ++r) { p[0][r] = 0.f; p[1][r] = 0.f; }
    bf16x8 vf[16];
    if (DO_PV) { ATT_VLD(0); ATT_VLD(1); ATT_VLD(2); ATT_VLD(3); }
    {
        bf16x8 ka[8], kc[8];
#pragma unroll
        for (int d0 = 0; d0 < 8; ++d0) { ka[d0] = *(const LAS bf16x8*)(kb + koff[d0]); kc[d0] = *(const LAS bf16x8*)(kb + 8192 + koff[d0]); }
        ATT_SB();
#pragma unroll
        for (int d0 = 0; d0 < 8; ++d0) {
            p[0] = __builtin_amdgcn_mfma_f32_32x32x16_bf16(ka[d0], qf[d0], p[0], 0, 0, 0);
            p[1] = __builtin_amdgcn_mfma_f32_32x32x16_bf16(kc[d0], qf[d0], p[1], 0, 0, 0);
        }
    }
    ATT_SB();
    const bool need_mask = (k0 + 63 >= qw0);
    float L[8], T[8];
    ATT_PV(0); ATT_EXP8(0); ATT_SB();
    ATT_PV(1); ATT_EXP8(1); ATT_SB();
    ATT_PV(2); ATT_EXP8(2); ATT_SB();
    ATT_PV(3); ATT_EXP8(3); ATT_SB();
    if (need_mask) {
#pragma unroll
        for (int ph = 0; ph < 2; ++ph)
#pragma unroll
            for (int r = 0; r < 16; ++r) { const int key = k0 + 32 * ph + crow(r, hi); if (key >= qabs) p[ph][r] = 0.f; }
    }
    ATT_SB();
    ATT_PV(4); ATT_LBLK(0); ATT_LBLK(1); ATT_SB();
    ATT_PV(5); ATT_LBLK(2); ATT_LBLK(3); ATT_SB();
    ATT_PV(6); ATT_LBLK(4); ATT_LBLK(5); ATT_SB();
    ATT_PV(7); ATT_LBLK(6); ATT_LBLK(7); ATT_SB();
    float run = carry;
    ATT_PV(8); ATT_XCH(0); ATT_XCH(1); ATT_SB();
    ATT_PV(9); ATT_XCH(2); ATT_XCH(3); ATT_SB();
    ATT_PV(10); ATT_XCH(4); ATT_XCH(5); ATT_SB();
    ATT_PV(11); ATT_XCH(6); ATT_XCH(7); ATT_SB();
    carry = run;
    ATT_PV(12); ATT_WGT(0); ATT_WGT(1); ATT_SB();
    ATT_PV(13); ATT_WGT(2); ATT_WGT(3); ATT_SB();
    ATT_PV(14); ATT_WGT(4); ATT_WGT(5); ATT_SB();
    ATT_PV(15); ATT_WGT(6); ATT_WGT(7); ATT_SB();
#pragma unroll
    for (int s = 0; s < 4; ++s) { const int ph = s >> 1, rb = 8 * (s & 1);
        u32x4 w; w.x = pk_bf16(p[ph][rb], p[ph][rb + 1]); w.y = pk_bf16(p[ph][rb + 2], p[ph][rb + 3]); w.z = pk_bf16(p[ph][rb + 4], p[ph][rb + 5]); w.w = pk_bf16(p[ph][rb + 6], p[ph][rb + 7]);
        pa[s] = __builtin_bit_cast(bf16x8, w); }
}

__device__ __forceinline__ void attn_unit(LAS unsigned char* lds, const int wid, int b, int h, int qb, const bf16_t* __restrict__ Q, const bf16_t* __restrict__ K,
                                          const bf16_t* __restrict__ V, const bf16_t* __restrict__ ZS, bf16_t* __restrict__ OG) {
    const int tid = tid_of(wid), lane = tid & 63, r32 = lane & 31, hi = lane >> 5;
    const size_t tok0 = (size_t)b * SEQ;
    const int q0 = qb * 256, qw0 = q0 + 32 * wid, qabs = qw0 + r32;
    bf16x8 qf[8];
    { const bf16_t* qp = Q + (tok0 + qabs) * DM + h * HD + 8 * hi;
#pragma unroll
      for (int d0 = 0; d0 < 8; ++d0) qf[d0] = *(const bf16x8*)(qp + 16 * d0); }
    f32x16 o[4];
#pragma unroll
    for (int c = 0; c < 4; ++c)
#pragma unroll
        for (int r = 0; r < 16; ++r) o[c][r] = 0.f;
    bf16x8 pa[4];
#pragma unroll
    for (int s = 0; s < 4; ++s) pa[s] = (bf16x8){0, 0, 0, 0, 0, 0, 0, 0};
    float carry = 0.f;
    const int NT = (q0 + 256) / 64;
    const int srow = tid >> 4, sch = (tid & 15) ^ (((srow & 3) << 2) | ((srow >> 2) & 3));
    const bf16_t* kg = K + (tok0 + srow) * DM + h * HD + sch * 8;
    const bf16_t* vg = V + (tok0 + srow) * DM + h * HD + sch * 8;
    LAS unsigned char* ldsw = lds + wid * 1024;
#define ATT_STAGE(t_, koff_, voff_) do { const size_t go_ = (size_t)(t_) * 64 * DM; \
        __builtin_amdgcn_global_load_lds((const unsigned*)(kg + go_), (LAS unsigned*)(ldsw + (koff_)), 16, 0, 0); \
        __builtin_amdgcn_global_load_lds((const unsigned*)(kg + go_ + 32 * DM), (LAS unsigned*)(ldsw + (koff_) + 8192), 16, 0, 0); \
        __builtin_amdgcn_global_load_lds((const unsigned*)(vg + go_), (LAS unsigned*)(ldsw + (voff_)), 16, 0, 0); \
        __builtin_amdgcn_global_load_lds((const unsigned*)(vg + go_ + 32 * DM), (LAS unsigned*)(ldsw + (voff_) + 8192), 16, 0, 0); } while (0)
    ATT_STAGE(NT - 1, 0, 32768);
    asm volatile("s_waitcnt vmcnt(0)" ::: "memory");
    __syncthreads();
    unsigned koff[8];
#pragma unroll
    for (int d0 = 0; d0 < 8; ++d0) koff[d0] = off_b(r32, 2 * d0 + hi);
    const unsigned qa = (lane & 15) >> 2, blk = (lane >> 4) & 1, pp = lane & 3;
    unsigned vbase[2], vcq[4];
#pragma unroll
    for (int t = 0; t < 2; ++t) vbase[t] = 256u * (8 * t + 4 * hi + qa) + 16u * ((2 * blk + (pp >> 1)) ^ ((2 * t + hi) & 3)) + 8u * (pp & 1);
#pragma unroll
    for (int c = 0; c < 4; ++c) vcq[c] = 64u * ((unsigned)c ^ qa);
    int kcur = 0, vprev = 2, vcur = 0, vnext = 1;
    bool prev_valid = false;
    for (int t = NT - 1; t >= 0; --t) {
        if (t > 0) ATT_STAGE(t - 1, (kcur ^ 1) * 16384, 32768 + vnext * 16384);
        const LAS unsigned char* kb = lds + kcur * 16384;
        const LAS unsigned char* vbp = lds + 32768 + vprev * 16384;
        const int k0 = 64 * t;
        const bool valid = (k0 < qw0 + 31);
        if (valid) {
            if (prev_valid) attn_tile<true>(kb, vbp, qf, o, pa, carry, koff, vbase, vcq, k0, qw0, qabs, hi);
            else            attn_tile<false>(kb, vbp, qf, o, pa, carry, koff, vbase, vcq, k0, qw0, qabs, hi);
        }
        prev_valid = valid;
        asm volatile("s_waitcnt vmcnt(0)" ::: "memory");
        __syncthreads();
        kcur ^= 1; { const int tmp = vprev; vprev = vcur; vcur = vnext; vnext = tmp; }
    }
    { const LAS unsigned char* vbp = lds + 32768 + vprev * 16384;
#pragma unroll
      for (int c = 0; c < 4; ++c)
#pragma unroll
          for (int s = 0; s < 4; ++s) {
              const s16x4 lo = vtr(vbp + 4096 * s + vbase[0] + vcq[c]);
              const s16x4 hh = vtr(vbp + 4096 * s + vbase[1] + vcq[c]);
              const bf16x8 vfr = (bf16x8){lo[0], lo[1], lo[2], lo[3], hh[0], hh[1], hh[2], hh[3]};
              o[c] = __builtin_amdgcn_mfma_f32_32x32x16_bf16(pa[s], vfr, o[c], 0, 0, 0);
          } }
    {
        int lane_e = lane_id(); asm volatile("" : "+v"(lane_e));
        const int r32e = lane_e & 31, hie = lane_e >> 5, rowq = lane_e >> 4, c4 = (lane_e & 15) * 4;
        LAS float* stg = (LAS float*)(lds + 81920 + wid * 8192);
        const size_t gbase = (tok0 + qw0) * DM + h * HD + c4;
        u32x2 zv[2][8];
#pragma unroll
        for (int ps = 0; ps < 2; ++ps)
#pragma unroll
            for (int j = 0; j < 8; ++j) zv[ps][j] = *(const u32x2*)(ZS + gbase + (size_t)(4 * j + rowq) * DM + 64 * ps);
#pragma unroll
        for (int ps = 0; ps < 2; ++ps) {
#pragma unroll
            for (int r = 0; r < 16; ++r) {
                stg[crow(r, hie) * 64 + r32e] = o[2 * ps][r];
                stg[crow(r, hie) * 64 + 32 + r32e] = o[2 * ps + 1][r];
            }
            asm volatile("s_waitcnt lgkmcnt(0)" ::: "memory");
#pragma unroll
            for (int j = 0; j < 8; ++j) {
                const f32x4 ov = *(const LAS f32x4*)(stg + (4 * j + rowq) * 64 + c4);
                const u32x2 z = zv[ps][j];
                u32x2 w; w.x = pk_bf16(ov[0] * bf_lo(z.x), ov[1] * bf_hi(z.x)); w.y = pk_bf16(ov[2] * bf_lo(z.y), ov[3] * bf_hi(z.y));
                *(u32x2*)(OG + gbase + (size_t)(4 * j + rowq) * DM + 64 * ps) = w;
            }
            asm volatile("s_waitcnt lgkmcnt(0)" ::: "memory");
        }
    }
    __syncthreads();
}
__device__ __forceinline__ void attn_phase(LAS unsigned char* lds, const int wid_, int vcu, int G, const bf16_t* Q, const bf16_t* K, const bf16_t* V, const bf16_t* ZS, bf16_t* OG) {
#ifndef NO_ATTN_PRIO
    if (wid_ >= 4) __builtin_amdgcn_s_setprio(1);
#endif
    for (int p = vcu; p < 256; p += G) {
        const int bh = p >> 3, s = p & 7;
#ifdef ATT_ONE_INSTANCE
#pragma unroll 1
        for (int uu = 0; uu < 2; ++uu) attn_unit(lds, wid_, bh >> 4, bh & 15, uu ? 15 - s : s, Q, K, V, ZS, OG);
#else
        attn_unit(lds, wid_, bh >> 4, bh & 15, s, Q, K, V, ZS, OG);
        attn_unit(lds, wid_, bh >> 4, bh & 15, 15 - s, Q, K, V, ZS, OG);
#endif
    }
    __builtin_amdgcn_s_setprio(0);
}

__device__ __forceinline__ void mix_unit(LAS unsigned char* lds, const int wid, int n, int g, const bf16_t* __restrict__ UZ, const bf16_t* __restrict__ V, const float* __restrict__ vss,
                                         const float* __restrict__ w_s, const float* __restrict__ b_s, const float* __restrict__ vg, bf16_t* __restrict__ Y) {
    const int tid = tid_of(wid), lane = tid & 63, r32 = lane & 31, hi = lane >> 5;
    const size_t row0 = (size_t)n * CHUNK;
    LAS float* rstdL = (LAS float*)(lds + 98304);
    const int cc = tid & 31;
    u32x4 uu[8];
#pragma unroll
    for (int i = 0; i < 8; ++i) { const int t = (tid >> 5) + 16 * i; uu[i] = __builtin_nontemporal_load((const u32x4*)(UZ + (row0 + t) * GW + g * GDIM + cc * 8)); }
    {
        u32x4 vr[8];
#pragma unroll
        for (int i = 0; i < 8; ++i) { const int c = tid + 512 * i, s = c >> 5, cc = c & 31;
            vr[i] = __builtin_nontemporal_load((const u32x4*)(V + (row0 + s) * GW + g * GDIM + cc * 8)); }
        if (tid < 128) { const f32x4* vp = (const f32x4*)(vss + (row0 + tid) * 64); f32x4 s4 = vp[0];
#pragma unroll
            for (int i = 1; i < 16; ++i) s4 += vp[i];
            rstdL[tid] = __builtin_amdgcn_rsqf(((s4[0] + s4[1]) + (s4[2] + s4[3])) * (1.0f / GW) + EPS); }
#pragma unroll
        for (int i = 0; i < 8; ++i) { const int c = tid + 512 * i, s = c >> 5, cc = c & 31;
            *(LAS u32x4*)(lds + 32768 + (cc >> 4) * 32768 + off_b(s, cc & 15)) = vr[i]; }
    }
    __syncthreads();
#pragma unroll
    for (int i = 0; i < 4; ++i) { const int c = tid + 512 * i, t = c >> 4, ch = c & 15, s0 = ch * 8;
        const f32x4 w0 = *(const f32x4*)(w_s + ((size_t)g * CHUNK + t) * CHUNK + s0), w1 = *(const f32x4*)(w_s + ((size_t)g * CHUNK + t) * CHUNK + s0 + 4);
        float wv[8] = {w0[0], w0[1], w0[2], w0[3], w1[0], w1[1], w1[2], w1[3]};
#pragma unroll
        for (int j = 0; j < 8; ++j) wv[j] = (s0 + j <= t) ? wv[j] * rstdL[s0 + j] : 0.f;
        u32x4 w; w.x = pk_bf16(wv[0], wv[1]); w.y = pk_bf16(wv[2], wv[3]); w.z = pk_bf16(wv[4], wv[5]); w.w = pk_bf16(wv[6], wv[7]);
        *(LAS u32x4*)(lds + off_b(t, ch)) = w; }
    __syncthreads();
    f32x16 acc[4];
#pragma unroll
    for (int i = 0; i < 4; ++i)
#pragma unroll
        for (int r = 0; r < 16; ++r) acc[i][r] = 0.f;
    {
        const LAS unsigned char* vimg = lds + 32768 + (wid >> 2) * 32768;
        const unsigned cblk = wid & 3, qa = (lane & 15) >> 2, blk = (lane >> 4) & 1, pp = lane & 3;
#pragma unroll
        for (int ks = 0; ks < 8; ++ks) {
            const s16x4 lo = vtr(vimg + off_b(16 * ks + 8 * hi + qa, 4 * cblk + 2 * blk + (pp >> 1)) + 8 * (pp & 1));
            const s16x4 hh = vtr(vimg + off_b(16 * ks + 8 * hi + 4 + qa, 4 * cblk + 2 * blk + (pp >> 1)) + 8 * (pp & 1));
            const bf16x8 vf = (bf16x8){lo[0], lo[1], lo[2], lo[3], hh[0], hh[1], hh[2], hh[3]};
#pragma unroll
            for (int i = 0; i < 4; ++i) if (ks <= 2 * i + 1) {
                const bf16x8 af = *(const LAS bf16x8*)(lds + off_b(32 * i + r32, 2 * ks + hi));
                acc[i] = __builtin_amdgcn_mfma_f32_32x32x16_bf16(af, vf, acc[i], 0, 0, 0);
            }
        }
    }
    __syncthreads();
    {
        LAS float* mx = (LAS float*)lds;
        const int c = 128 * (wid >> 2) + 32 * (wid & 3) + r32;
#pragma unroll
        for (int i = 0; i < 4; ++i)
#pragma unroll
            for (int r = 0; r < 16; ++r) mx[(32 * i + crow(r, hi)) * 256 + c] = acc[i][r];
    }
    __syncthreads();
    {
        const f32x4 g0 = *(const f32x4*)(vg + g * GDIM + cc * 8), g1 = *(const f32x4*)(vg + g * GDIM + cc * 8 + 4);
        float bb[8];
#pragma unroll
        for (int i = 0; i < 8; ++i) bb[i] = b_s[g * CHUNK + (tid >> 5) + 16 * i];
#pragma unroll
        for (int i = 0; i < 8; ++i) { const int t = (tid >> 5) + 16 * i;
            const f32x4 m0 = *(const LAS f32x4*)(lds + (t * 256 + cc * 8) * 4), m1 = *(const LAS f32x4*)(lds + (t * 256 + cc * 8 + 4) * 4);
            float y[8];
            y[0] = bf_lo(uu[i].x) * (m0[0] * g0[0] + bb[i]); y[1] = bf_hi(uu[i].x) * (m0[1] * g0[1] + bb[i]);
            y[2] = bf_lo(uu[i].y) * (m0[2] * g0[2] + bb[i]); y[3] = bf_hi(uu[i].y) * (m0[3] * g0[3] + bb[i]);
            y[4] = bf_lo(uu[i].z) * (m1[0] * g1[0] + bb[i]); y[5] = bf_hi(uu[i].z) * (m1[1] * g1[1] + bb[i]);
            y[6] = bf_lo(uu[i].w) * (m1[2] * g1[2] + bb[i]); y[7] = bf_hi(uu[i].w) * (m1[3] * g1[3] + bb[i]);
            u32x4 w; w.x = pk_bf16(y[0], y[1]); w.y = pk_bf16(y[2], y[3]); w.z = pk_bf16(y[4], y[5]); w.w = pk_bf16(y[6], y[7]);
            *(u32x4*)(Y + (row0 + t) * GW + g * GDIM + cc * 8) = w; }
    }
    __syncthreads();
}

__device__ __forceinline__ float wave_sum(float v) {
#pragma unroll
    for (int o = 1; o < 64; o <<= 1) v += __shfl_xor(v, o);
    return v;
}
__device__ __forceinline__ void tr_load(const float* __restrict__ W, int N, int item, int lane, f32x4 (&wv)[16]) {
    const int nblk = N / 64, k0 = 64 * (item / nblk), n0 = 64 * (item % nblk);
#pragma unroll
    for (int i = 0; i < 16; ++i) wv[i] = __builtin_nontemporal_load((const f32x4*)(W + (size_t)(k0 + 4 * i + (lane >> 4)) * N + n0 + 4 * (lane & 15)));
}
__device__ __forceinline__ void tr_to_lds(LAS float* scr, int lane, const f32x4 (&wv)[16]) {
#pragma unroll
    for (int i = 0; i < 16; ++i) { const int kk = 4 * i + (lane >> 4), nn = 4 * (lane & 15);
        LAS float* s = scr + kk * 65 + nn; s[0] = wv[i][0]; s[1] = wv[i][1]; s[2] = wv[i][2]; s[3] = wv[i][3]; }
    asm volatile("s_waitcnt lgkmcnt(0)" ::: "memory");
}
__device__ __forceinline__ void tr_store(int K, int N, bf16_t* __restrict__ WT, const LAS float* scr, int item, int lane, const float* __restrict__ gk, bool gmlp_perm) {
    const int nblk = N / 64, k0 = 64 * (item / nblk), n0 = 64 * (item % nblk);
    int r0 = n0;
    if (gmlp_perm) {
        if (n0 < GW) { const int cb = n0 >> 7; r0 = 256 * (3 * (cb >> 1) + (cb & 1)) + (n0 & 127); }
        else if (n0 < 2 * GW) { const int mv = n0 - GW; r0 = 256 * (3 * (mv >> 8) + 2) + (mv & 255); }
        else { const int mz = n0 - 2 * GW, cb = mz >> 7; r0 = 256 * (3 * (cb >> 1) + (cb & 1)) + 128 + (mz & 127); }
    }
    const int c = lane & 7;
    f32x4 ga = {1.f, 1.f, 1.f, 1.f}, gb = {1.f, 1.f, 1.f, 1.f};
    if (gk) { ga = *(const f32x4*)(gk + k0 + 8 * c); gb = *(const f32x4*)(gk + k0 + 8 * c + 4); }
#pragma unroll
    for (int j = 0; j < 8; ++j) { const int nn = (lane >> 3) + 8 * j; const LAS float* s = scr + (8 * c) * 65 + nn;
        u32x4 o; o.x = pk_bf16(s[0] * ga[0], s[65] * ga[1]); o.y = pk_bf16(s[2 * 65] * ga[2], s[3 * 65] * ga[3]); o.z = pk_bf16(s[4 * 65] * gb[0], s[5 * 65] * gb[1]); o.w = pk_bf16(s[6 * 65] * gb[2], s[7 * 65] * gb[3]);
        *(u32x4*)(WT + (size_t)(r0 + nn) * K + k0 + 8 * c) = o; }
    asm volatile("s_waitcnt lgkmcnt(0)" ::: "memory");
}
__device__ __forceinline__ void transpose_matrix(const float* __restrict__ W, int K, int N, bf16_t* __restrict__ WT, LAS float* scr, int first, int stride, int nitems, int lane,
                                                 const float* __restrict__ gk = nullptr, bool gmlp_perm = false) {
    f32x4 wv[16], wn[16];
    int it = first;
    if (it < nitems) tr_load(W, N, it, lane, wv);
    while (it < nitems) {
        const int nx = it + stride;
        tr_to_lds(scr, lane, wv);
        if (nx < nitems) tr_load(W, N, nx, lane, wn);
        tr_store(K, N, WT, scr, it, lane, gk, gmlp_perm);
#pragma unroll
        for (int i = 0; i < 16; ++i) wv[i] = wn[i];
        it = nx;
    }
}

#define XB_TMO      128
#define XB_XCNT(j)  (256  + 64 * (j))
#define XB_XSUB(j)  (1280 + 64 * (j))
#define XB_XGEN(j)  (2304 + 64 * (j))
#define XB_TOP      3328
#define XB_TOPGEN   3392
#define XCD_BAR_WORDS 3456
#define XB_SPIN_CAP (1u << 18)

__device__ __forceinline__ unsigned xb_ld(unsigned* p)              { return __hip_atomic_load(p, __ATOMIC_RELAXED, __HIP_MEMORY_SCOPE_AGENT); }
__device__ __forceinline__ unsigned xb_add(unsigned* p, unsigned v) { return __hip_atomic_fetch_add(p, v, __ATOMIC_RELAXED, __HIP_MEMORY_SCOPE_AGENT); }
__device__ __forceinline__ unsigned xb_xcc_id() { return (unsigned)__builtin_amdgcn_s_getreg((3 << 11) | 20) & 0xFu; }
#define XB_SPIN(cond, bar) do { unsigned _sp = 0; while (cond) { __builtin_amdgcn_s_sleep(1); \
    if ((++_sp & 255u) == 0u) { if (xb_ld(&(bar)[XB_TMO])) break; if (_sp > XB_SPIN_CAP) { atomicAdd(&(bar)[XB_TMO], 1u); break; } } } } while (0)

struct XcdBarrier {
    unsigned* bar; unsigned x; int w;
    volatile LAS unsigned* st;
};

__device__ __forceinline__ XcdBarrier xcd_barrier_post(unsigned* bar, volatile LAS unsigned* st, int wave) {
    XcdBarrier b; b.bar = bar; b.x = xb_xcc_id(); b.st = st; b.w = wave;
    if (tid_of(wave) == 0) (void)xb_add(&bar[XB_XCNT(b.x)], 1u);
    return b;
}
__device__ __forceinline__ void xcd_barrier_complete(unsigned* bar, unsigned x, unsigned& nloc, unsigned& nx) {
    const unsigned G = gridDim.x * gridDim.y * gridDim.z;
    unsigned sum, cnt, mine, sp = 0u;
    for (;;) {
        sum = 0u; cnt = 0u; mine = 0u;
#pragma unroll
        for (unsigned j = 0; j < 16; ++j) { const unsigned c = xb_ld(&bar[XB_XCNT(j)]); sum += c; cnt += (c > 0u) ? 1u : 0u; mine = (j == x) ? c : mine; }
        if (sum == G) break;
        __builtin_amdgcn_s_sleep(1);
        if ((++sp & 255u) == 0u) { if (xb_ld(&bar[XB_TMO])) break; if (sp > XB_SPIN_CAP) { atomicAdd(&bar[XB_TMO], 1u); break; } }
    }
    nloc = mine > 0u ? mine : 1u; nx = cnt > 0u ? cnt : 1u;
}

__device__ __forceinline__ void xcd_barrier(const XcdBarrier& b) {
    asm volatile("s_waitcnt vmcnt(0)" ::: "memory");
    __syncthreads();
    if (tid_of(b.w) == 0) {
        unsigned* bar = b.bar;
        __builtin_amdgcn_s_waitcnt(0);
        unsigned nloc = b.st[0], nx = b.st[1];
        if (nloc == 0u) { xcd_barrier_complete(bar, b.x, nloc, nx); b.st[0] = nloc; b.st[1] = nx; }
        const unsigned old = xb_add(&bar[XB_XSUB(b.x)], 1u);
        const unsigned gen = old / nloc;
        if (old + 1u == (gen + 1u) * nloc) {
            __builtin_amdgcn_fence(__ATOMIC_RELEASE, "agent");
            asm volatile("s_waitcnt vmcnt(0)" ::: "memory");
            const unsigned og = xb_add(&bar[XB_TOP], 1u);
            const unsigned tg = og / nx;
            if (og + 1u == (tg + 1u) * nx) xb_add(&bar[XB_TOPGEN], 1u);
            else XB_SPIN(xb_ld(&bar[XB_TOPGEN]) == tg, bar);
            __builtin_amdgcn_fence(__ATOMIC_ACQUIRE, "agent");
            xb_add(&bar[XB_XGEN(b.x)], 1u);
            asm volatile("s_waitcnt vmcnt(0)" ::: "memory");
        } else {
            XB_SPIN(xb_ld(&bar[XB_XGEN(b.x)]) == gen, bar);
            __builtin_amdgcn_fence(__ATOMIC_ACQUIRE, "agent");
            asm volatile("s_waitcnt vmcnt(0)" ::: "memory");
        }
    }
    __syncthreads();
}

constexpr size_t MiB = 1u << 20;
constexpr size_t WS_VSS = 0, WS_HSS1 = 2 * MiB, WS_HSS2 = 3 * MiB, WS_IRS0 = 3 * MiB + 32768, WS_CNT = 3 * MiB + 65536;
constexpr size_t WS_WT1 = 4 * MiB, WS_HN0 = 268 * MiB  , WS_WT2 = 84 * MiB, WS_WT3 = 100 * MiB, WS_WT4 = 132 * MiB;
constexpr size_t WS_U = 140 * MiB, WS_V = 204 * MiB, WS_ZS = 268 * MiB, WS_CTL = 364 * MiB, CTL_ZERO_BYTES = 32768, WS_END = 365 * MiB;
constexpr size_t WS_Y = 4 * MiB;
constexpr size_t WS_H1 = 140 * MiB, WS_H1B = 332 * MiB;
constexpr size_t WS_Q = 204 * MiB, WS_K = 236 * MiB, WS_V2 = 268 * MiB, WS_ZS2 = 300 * MiB, WS_OG = 4 * MiB;

constexpr int NWAVES = 8, LDS_BYTES = 151552;
#ifndef N_LAUNCHES
#define N_LAUNCHES 1
#endif
constexpr int N_PHASES = 7;
#ifndef CONV_TRIGGER
#define CONV_TRIGGER ((bx >> 3) % 6)
#endif
#ifndef GEMM_SP2
#define GEMM_SP2 true
#endif
#ifndef GEMM_ALIGN
#define GEMM_ALIGN true
#endif
#ifndef REPEAT_PHASE
#define REPEAT_PHASE -1
#endif
#define NREP(k) ((REPEAT_PHASE == (k)) ? 2 : 1)

struct Args { const float* in[10]; float* out; unsigned char* ws; int ph_lo, ph_hi, li, pad; };

__global__ void __launch_bounds__(NWAVES * 64, 2) fwd_kernel(Args a) {
    extern __shared__ __attribute__((aligned(16))) unsigned char lds_raw[];
    LAS unsigned char* lds = (LAS unsigned char*)lds_raw;
    cg::grid_group grid = cg::this_grid();
    const int wave = __builtin_amdgcn_readfirstlane(threadIdx.x >> 6);
#define tid tid_of(wave)
#define lane lane_id()
    const int G = gridDim.x, bx = blockIdx.x;
    const int vcu = (G % 8 == 0) ? (bx % 8) * (G / 8) + bx / 8 : bx;
    const float* x = a.in[0]; const float* norm_g = a.in[1]; const float* a_w_in = a.in[2]; const float* a_vg = a.in[3]; const float* a_w_s = a.in[4];
    const float* a_b_s = a.in[5]; const float* a_w_out = a.in[6]; const float* b_w_in = a.in[7]; const float* b_w_out = a.in[8]; const float* final_g = a.in[9];
    unsigned char* ws = a.ws;
    float* VSS = (float*)(ws + WS_VSS); float* HSS1 = (float*)(ws + WS_HSS1); float* HSS2 = (float*)(ws + WS_HSS2); float* IRS0 = (float*)(ws + WS_IRS0); unsigned* CNT = (unsigned*)(ws + WS_CNT);
    bf16_t* WT1 = (bf16_t*)(ws + WS_WT1); bf16_t* WT2 = (bf16_t*)(ws + WS_WT2); bf16_t* WT3 = (bf16_t*)(ws + WS_WT3); bf16_t* WT4 = (bf16_t*)(ws + WS_WT4);
    bf16_t* HN0 = (bf16_t*)(ws + WS_HN0); bf16_t* U = (bf16_t*)(ws + WS_U); bf16_t* V = (bf16_t*)(ws + WS_V); bf16_t* ZS = (bf16_t*)(ws + WS_ZS);
    bf16_t* Y = (bf16_t*)(ws + WS_Y); bf16_t* H1B = (bf16_t*)(ws + WS_H1B);
    bf16_t* Qb = (bf16_t*)(ws + WS_Q); bf16_t* Kb = (bf16_t*)(ws + WS_K); bf16_t* V2 = (bf16_t*)(ws + WS_V2); bf16_t* ZS2 = (bf16_t*)(ws + WS_ZS2); bf16_t* OG = (bf16_t*)(ws + WS_OG);
    const int lo = a.ph_lo, hi = a.ph_hi;
#define IN(k) (lo <= (k) && (k) < hi)
#define SEAM(k) do { if (IN(k) && IN((k) + 1)) xcd_barrier(bar); } while (0)
    volatile LAS unsigned* MISC = (volatile LAS unsigned*)(lds + LDS_BYTES - 64);
    if (tid < 16) MISC[tid] = 0u;
    __syncthreads();
    XcdBarrier bar = xcd_barrier_post((unsigned*)(ws + WS_CTL) + a.li * XCD_BAR_WORDS, MISC + 8, wave);
    if (lo > 1000) grid.sync();
    const int gw = vcu * NWAVES + wave, NGW = G * NWAVES;

    if (IN(0)) for (int rep = 0; rep < NREP(0); ++rep) {
        LAS float* scr = (LAS float*)(lds + wave * 16640);
        constexpr int I1 = (DM / 64) * (3 * GW / 64), I2 = (GW / 64) * (DM / 64), I3 = (DM / 64) * (4 * DM / 64), I4 = (DM / 64) * (DM / 64);
        transpose_matrix(a_w_in, DM, 3 * GW, WT1, scr, gw, NGW, I1, lane, norm_g, true);
        for (int m = bx * (NWAVES * 64) + tid; m < NTOK; m += G * NWAVES * 64) { HSS1[m] = 0.f; HSS2[m] = 0.f; if (m < 2048) CNT[m] = 0u; }
        for (int m = gw; m < NTOK; m += 2 * NGW) {
            const int m2 = m + NGW; const bool two = m2 < NTOK;
            const f32x4* xr = (const f32x4*)(x + (size_t)m * DM) + lane; const f32x4* xr2 = (const f32x4*)(x + (size_t)(two ? m2 : m) * DM) + lane;
            f32x4 v[8], v2[8]; float ss = 0.f, ss2 = 0.f;
#pragma unroll
            for (int j = 0; j < 8; ++j) { v[j] = __builtin_nontemporal_load(xr + 64 * j); v2[j] = __builtin_nontemporal_load(xr2 + 64 * j); }
#pragma unroll
            for (int j = 0; j < 8; ++j) { ss += (v[j][0] * v[j][0] + v[j][1] * v[j][1]) + (v[j][2] * v[j][2] + v[j][3] * v[j][3]); ss2 += (v2[j][0] * v2[j][0] + v2[j][1] * v2[j][1]) + (v2[j][2] * v2[j][2] + v2[j][3] * v2[j][3]); }
            const float ms = wave_sum(ss) * (1.0f / DM) + EPS, ms2 = wave_sum(ss2) * (1.0f / DM) + EPS;
            const float rstd = __builtin_amdgcn_rsqf(ms), rstd2 = __builtin_amdgcn_rsqf(ms2);
            if (lane == 0) { IRS0[m] = __builtin_amdgcn_sqrtf(ms); if (two) IRS0[m2] = __builtin_amdgcn_sqrtf(ms2); }
            u32x2* o8 = (u32x2*)(HN0 + (size_t)m * DM) + lane; u32x2* o82 = (u32x2*)(HN0 + (size_t)m2 * DM) + lane;
#pragma unroll
            for (int j = 0; j < 8; ++j) {
                u32x2 w; w.x = pk_bf16(v[j][0] * rstd, v[j][1] * rstd); w.y = pk_bf16(v[j][2] * rstd, v[j][3] * rstd); o8[64 * j] = w;
                if (two) { u32x2 w2; w2.x = pk_bf16(v2[j][0] * rstd2, v2[j][1] * rstd2); w2.y = pk_bf16(v2[j][2] * rstd2, v2[j][3] * rstd2); o82[64 * j] = w2; } }
        }
    }
    SEAM(0);
#ifdef EXTRA_SYNCS
    for (int i = 0; i < EXTRA_SYNCS; ++i) xcd_barrier(bar);
#endif
    if (IN(1)) for (int rep = 0; rep < NREP(1); ++rep) {
        pg8::Gemm g{HN0, WT1, NTOK, 3 * GW, DM}; pg8::ConvOrder S; S.init(NTOK, 3 * GW, G, bx);
        S.w2 = a_w_out; S.w3 = b_w_in; S.w4 = b_w_out; S.g1 = norm_g + DM; S.t2 = WT2; S.t3 = WT3; S.t4 = WT4; S.gw = gw; S.ngw = NGW; S.trigger = (G == 256) ? CONV_TRIGGER : 0; S.ln = lane; S.sw = lds + 131072 + wave * 2048; S.n_done = 0;
        pg8::EpiGmlpIn E{U, V, VSS};
        pg8::gemm_phase<pg8::EpiGmlpIn, pg8::ConvOrder, GEMM_ALIGN, GEMM_SP2>(lds, g, S, E, wave);
    }
    SEAM(1);
    if (IN(2)) for (int rep = 0; rep < NREP(2); ++rep) {
        for (int it = vcu; it < (NTOK / CHUNK) * NGRP; it += G) mix_unit(lds, wave, it >> 4, it & 15, U, V, VSS, a_w_s, a_b_s, a_vg, Y);
    }
    SEAM(2);
    if (IN(3)) for (int rep = 0; rep < NREP(3); ++rep) {
        pg8::Gemm g{Y, WT2, NTOK, DM, GW}; pg8::StaticOrder S; S.init(NTOK, DM, G, bx);
        pg8::EpiRes1 E{HN0, IRS0, H1B, HSS1};
        pg8::gemm_phase<pg8::EpiRes1, pg8::StaticOrder, GEMM_ALIGN, GEMM_SP2>(lds, g, S, E, wave);
    }
    SEAM(3);
    if (IN(4)) for (int rep = 0; rep < NREP(4); ++rep) {
        pg8::Gemm g{H1B, WT3, NTOK, 4 * DM, DM}; pg8::StaticOrder S; S.init(NTOK, 4 * DM, G, bx);
        pg8::EpiSbIn E{Qb, (size_t)(WS_K - WS_Q) / 2, HSS1};
        pg8::gemm_phase<pg8::EpiSbIn, pg8::StaticOrder, GEMM_ALIGN, GEMM_SP2>(lds, g, S, E, wave);
    }
    SEAM(4);
    if (IN(5)) for (int rep = 0; rep < NREP(5); ++rep) attn_phase(lds, wave, vcu, G, Qb, Kb, V2, ZS2, OG);
    SEAM(5);
    if (IN(6)) for (int rep = 0; rep < NREP(6); ++rep) {
        pg8::Gemm g{OG, WT4, NTOK, DM, DM}; pg8::StaticOrder S; S.init(NTOK, DM, G, bx);
        pg8::EpiFinal E{H1B, final_g, a.out, HSS2, CNT, G == 256};
        pg8::gemm_phase<pg8::EpiFinal, pg8::StaticOrder, GEMM_ALIGN, GEMM_SP2>(lds, g, S, E, wave);
    }
    if (IN(6) && G != 256) {
        xcd_barrier(bar);
        for (int m = gw; m < NTOK; m += NGW) {
            const float rstd = __builtin_amdgcn_rsqf(HSS2[m] * (1.0f / DM) + EPS);
            f32x4* orow = (f32x4*)(a.out + (size_t)m * DM) + lane; const f32x4* gr = (const f32x4*)final_g + lane;
#pragma unroll
            for (int j = 0; j < 8; ++j) { const f32x4 v = orow[64 * j]; orow[64 * j] = v * rstd * gr[64 * j]; }
        }
    }
#undef IN
#undef SEAM
#undef tid
#undef lane
}

extern "C" void kernel_launch(void* const* d_in, const int* in_sizes, int n_in, void* d_out, int out_size, void* d_ws, size_t ws_size, hipStream_t stream) {
    static int grid = 0;
    if (grid == 0) {
        if (n_in != 10 || out_size != NTOK * DM || ws_size < WS_END) { fprintf(stderr, "kernel_launch: unexpected shapes (n_in %d, out %d, ws %zu)\n", n_in, out_size, ws_size); grid = -1; return; }
        int dev = 0, cus = 0, per_cu = 0;
        (void)hipGetDevice(&dev); (void)hipDeviceGetAttribute(&cus, hipDeviceAttributeMultiprocessorCount, dev);
        if (hipFuncSetAttribute((const void*)fwd_kernel, hipFuncAttributeMaxDynamicSharedMemorySize, LDS_BYTES) != hipSuccess) { fprintf(stderr, "kernel_launch: hipFuncSetAttribute failed\n"); grid = -1; return; }
        if (hipOccupancyMaxActiveBlocksPerMultiprocessor(&per_cu, (const void*)fwd_kernel, NWAVES * 64, LDS_BYTES) != hipSuccess || per_cu < 1) { fprintf(stderr, "kernel_launch: occupancy query says %d\n", per_cu); per_cu = 1; }
        (void)hipGetLastError();
        grid = cus > 0 ? cus : 256;
    }
    if (grid < 0) return;
    if (hipMemsetAsync((char*)d_ws + WS_CTL, 0, CTL_ZERO_BYTES, stream) != hipSuccess) { fprintf(stderr, "kernel_launch: memset failed\n"); return; }
    Args a{};
    for (int i = 0; i < 10; ++i) a.in[i] = (const float*)d_in[i];
    a.out = (float*)d_out; a.ws = (unsigned char*)d_ws;
#ifdef PROBE_SPLIT
    const int nl = 2;
#else
    const int nl = N_LAUNCHES;
#endif
    for (int li = 0; li < nl; ++li) {
        a.ph_lo = (N_LAUNCHES == 1) ? 0 : li; a.ph_hi = (N_LAUNCHES == 1) ? N_PHASES : li + 1;
#ifdef PROBE_SPLIT
        a.ph_lo = li == 0 ? 0 : PROBE_SPLIT; a.ph_hi = li == 0 ? PROBE_SPLIT + 1 : N_PHASES;
#endif
        a.li = li;
        void* args[] = {&a};
        hipError_t e = hipLaunchCooperativeKernel((const void*)fwd_kernel, dim3(grid), dim3(NWAVES * 64), args, LDS_BYTES, stream);
        if (e != hipSuccess) { fprintf(stderr, "kernel_launch: cooperative launch %d failed: %s (grid %d)\n", li, hipGetErrorString(e), grid); break; }
    }
}
```

```cpp
#include <hip/hip_runtime.h>
#include <hip/hip_cooperative_groups.h>
#include <cstdio>
#include <cstdint>
namespace cg = cooperative_groups;
__device__ __forceinline__ int lane_id() { return (int)__builtin_amdgcn_mbcnt_hi(~0u, __builtin_amdgcn_mbcnt_lo(~0u, 0u)); }
__device__ __forceinline__ int tid_of(int wave) { return wave * 64 + lane_id(); }
#ifndef PG8_WGM
#define PG8_WGM 8
#endif
namespace pg8 {
#define PG8_LAS __attribute__((address_space(3)))
typedef unsigned short bf16_t;
typedef short bf16x8 __attribute__((ext_vector_type(8)));
typedef float f32x4 __attribute__((ext_vector_type(4)));
typedef unsigned u32x4 __attribute__((ext_vector_type(4)));
constexpr int BM = 256, BK = 64, HALF = 128, HTB = HALF * BK * 2  , STAGE_BYTES = 8 * HTB, NXCD = 8, WGM = PG8_WGM;

__host__ __device__ __forceinline__ int lds_byte(int r, int c) { const int st = (r >> 4) * 2 + (c >> 5), rr = r & 15, cc = c & 31, ob = rr * 64 + cc * 2; return st * 1024 + (ob ^ (((ob >> 9) & 1) << 5)); }
__host__ __device__ __forceinline__ void stage_rc(int b, int& R, int& C) { const int st = b / 1024, sb = b % 1024, swz = sb ^ (((sb >> 9) & 1) << 5); R = (st >> 1) * 16 + swz / 64; C = (st & 1) * 32 + (swz % 64) / 2; }
__host__ __device__ __forceinline__ int perm32(int rho) { const int n = rho >> 4, i = rho & 15; return 8 * (i >> 2) + 4 * n + (i & 3); }

struct Unit { int pm, pn; };
struct Gemm { const bf16_t* A; const bf16_t* Bt; int M, N, K; };

struct StaticOrder {
    int nM, nN, nwg, G, c;
    __host__ __device__ void init(int M, int N, int G_, int c_) { nM = M / BM; nN = N / BM; nwg = nM * nN; G = G_; c = c_; }
    __host__ __device__ bool next(int i, Unit& u) const {
        const long L = (long)i * G + c; if (L >= nwg) return false;
        int wgid = (int)L; { const int q = nwg / NXCD, r = nwg % NXCD, xcd = wgid % NXCD, off = wgid / NXCD; wgid = (xcd < r ? xcd * (q + 1) : r * (q + 1) + (xcd - r) * q) + off; }
        const int nig = WGM * nN, gid = wgid / nig, fm = gid * WGM, gsz = (nM - fm) < WGM ? (nM - fm) : WGM;
        u.pm = fm + ((wgid % nig) % gsz); u.pn = (wgid % nig) / gsz; return true;
    }
    __device__ __forceinline__ void a_ready(const Unit&) const {}
    __device__ __forceinline__ void done(const Unit&) const {}
};

__device__ __forceinline__ unsigned cvt_pk_bf16(float lo, float hi) { unsigned r; asm volatile("v_cvt_pk_bf16_f32 %0, %1, %2" : "=v"(r) : "v"(lo), "v"(hi)); return r; }
typedef float f32x2 __attribute__((ext_vector_type(2)));
typedef float f32x2 __attribute__((ext_vector_type(2)));
template <class Epi, class Sched, bool ALIGN_EPI = false, bool SP2 = false>
__device__ __forceinline__ void gemm_phase(PG8_LAS unsigned char* lds, const Gemm g, const Sched& S, const Epi& E, const int wave_) {
    const int tid = tid_of(wave_), wid = wave_, lane = tid & 63, wr = wid >> 2, wc = wid & 3, fr = lane & 15, fq = lane >> 4;
    const int K = g.K, nt = K / BK;
    unsigned voffA[2], voffB[2];
#pragma unroll
    for (int i = 0; i < 2; ++i) { int R, C; stage_rc(tid * 16 + i * 8192, R, C); const int Rb = Epi::PERM ? ((R & ~31) + perm32(R & 31)) : R;
        voffA[i] = (unsigned)(R * K + C) * 2u; voffB[i] = (unsigned)(Rb * K + C) * 2u; }
    const size_t kstep = (size_t)(BK * 2);
    const size_t hstep = (size_t)HALF * K * 2;
    const size_t tstep = 2 * hstep;
    const unsigned ldsw = (unsigned)wid * 1024u;
    const int aoff = lds_byte(wr * 64 + fr, fq * 8), boff = lds_byte(wc * 32 + fr, fq * 8);
#define PG8_SA(b, h) (((b) * 2 + (h)) * HTB)
#define PG8_SB(b, h) ((4 + (b) * 2 + (h)) * HTB)
#define PG8_STAGE(bufoff, gbase, voff) do { _Pragma("unroll") for (int _i = 0; _i < 2; ++_i) \
        __builtin_amdgcn_global_load_lds((const unsigned*)((const char*)(gbase) + (voff)[_i]), (PG8_LAS unsigned*)(lds + (bufoff) + ldsw + _i * 8192), 16, 0, 0); } while (0)
#define PG8_LDA(dst, b, h) do { _Pragma("unroll") for (int m = 0; m < 4; ++m) _Pragma("unroll") for (int k = 0; k < 2; ++k) dst[m][k] = *(const PG8_LAS bf16x8*)(lds + PG8_SA(b, h) + aoff + m * 2048 + k * 1024); } while (0)
#define PG8_LDB(dst, b, h) do { _Pragma("unroll") for (int n = 0; n < 2; ++n) _Pragma("unroll") for (int k = 0; k < 2; ++k) dst[n][k] = *(const PG8_LAS bf16x8*)(lds + PG8_SB(b, h) + boff + n * 2048 + k * 1024); } while (0)
#define PG8_MMA(ai, bj, At, Bt) do { __builtin_amdgcn_s_setprio(1); _Pragma("unroll") for (int m = 0; m < 4; ++m) _Pragma("unroll") for (int n = 0; n < 2; ++n) _Pragma("unroll") for (int k = 0; k < 2; ++k) \
        acc[ai][bj][m][n] = __builtin_amdgcn_mfma_f32_16x16x32_bf16(Bt[n][k], At[m][k], acc[ai][bj][m][n], 0, 0, 0); __builtin_amdgcn_s_setprio(0); } while (0)
#define PG8_WAIT_V(n) asm volatile("s_waitcnt vmcnt(" #n ")" ::: "memory")
#define PG8_WAIT_L(n) asm volatile("s_waitcnt lgkmcnt(" #n ")" ::: "memory")
#define PG8_BAR __builtin_amdgcn_s_barrier()
#define PG8_SCHED __builtin_amdgcn_sched_barrier(0)
    Unit cur, nxt; int ui = 0;
    if (!S.next(0, cur)) return;
    f32x4 acc[2][2][4][2];
#pragma unroll
    for (int a = 0; a < 2; ++a)
#pragma unroll
        for (int b = 0; b < 2; ++b)
#pragma unroll
            for (int m = 0; m < 4; ++m)
#pragma unroll
                for (int n = 0; n < 2; ++n) acc[a][b][m][n] = (f32x4){0.f, 0.f, 0.f, 0.f};
    bf16x8 At[4][2], B0[2][2], B1[2][2];
    const char* cA = (const char*)g.A + (size_t)cur.pm * tstep; const char* cB = (const char*)g.Bt + (size_t)cur.pn * tstep;
    S.a_ready(cur);
    if constexpr (SP2) {
        PG8_STAGE(PG8_SB(0, 0), cB, voffB); PG8_STAGE(PG8_SB(0, 1), cB + hstep, voffB); PG8_STAGE(PG8_SA(0, 0), cA, voffA); PG8_STAGE(PG8_SA(0, 1), cA + hstep, voffA);
        if (wr == 1) PG8_BAR;
        PG8_WAIT_V(2); PG8_BAR;
        PG8_STAGE(PG8_SB(1, 0), cB + kstep, voffB); PG8_STAGE(PG8_SA(1, 0), cA + kstep, voffA); PG8_STAGE(PG8_SB(1, 1), cB + hstep + kstep, voffB);
        PG8_WAIT_V(6); PG8_BAR;
    } else {
        PG8_STAGE(PG8_SB(0, 0), cB, voffB); PG8_STAGE(PG8_SA(0, 0), cA, voffA); PG8_STAGE(PG8_SB(0, 1), cB + hstep, voffB); PG8_STAGE(PG8_SA(0, 1), cA + hstep, voffA);
        if (wr == 1) PG8_BAR;
        PG8_WAIT_V(4); PG8_BAR;
        PG8_STAGE(PG8_SB(1, 0), cB + kstep, voffB); PG8_STAGE(PG8_SA(1, 0), cA + kstep, voffA); PG8_STAGE(PG8_SB(1, 1), cB + hstep + kstep, voffB);
        PG8_WAIT_V(6); PG8_BAR;
    }
    for (;;) {
        const bool has_next = S.next(ui + 1, nxt);
        const char* nA = has_next ? (const char*)g.A + (size_t)nxt.pm * tstep : cA; const char* nB = has_next ? (const char*)g.Bt + (size_t)nxt.pn * tstep : cB;
        for (int t = 0; t < nt; t += 2) {
            const bool last = (t == nt - 2);
            const char* a1 = cA + (size_t)(t + 1) * kstep;
            const char* a2 = last ? nA : cA + (size_t)(t + 2) * kstep; const char* b2 = last ? nB : cB + (size_t)(t + 2) * kstep;
            const char* a3 = a2 + kstep; const char* b3 = b2 + kstep;
            if (last && has_next) S.a_ready(nxt);
            if constexpr (SP2) {
            PG8_LDB(B0, 0, 0); PG8_LDB(B1, 0, 1); PG8_SCHED; PG8_LDA(At, 0, 0); PG8_STAGE(PG8_SA(1, 1), a1 + hstep, voffA);
            PG8_WAIT_V(8); PG8_WAIT_L(0); PG8_BAR; PG8_MMA(0, 0, At, B0); PG8_MMA(0, 1, At, B1); PG8_BAR; PG8_SCHED;
            PG8_LDA(At, 0, 1); PG8_STAGE(PG8_SB(0, 0), b2, voffB); PG8_STAGE(PG8_SB(0, 1), b2 + hstep, voffB); PG8_STAGE(PG8_SA(0, 0), a2, voffA);
            PG8_WAIT_V(8); PG8_WAIT_L(0); PG8_BAR; PG8_MMA(1, 0, At, B0); PG8_MMA(1, 1, At, B1); PG8_BAR; PG8_SCHED;
            PG8_LDB(B0, 1, 0); PG8_LDB(B1, 1, 1); PG8_SCHED; PG8_LDA(At, 1, 0); PG8_STAGE(PG8_SA(0, 1), a2 + hstep, voffA);
            PG8_WAIT_V(8); PG8_WAIT_L(0); PG8_BAR; PG8_MMA(0, 0, At, B0); PG8_MMA(0, 1, At, B1); PG8_BAR; PG8_SCHED;
            PG8_LDA(At, 1, 1); PG8_STAGE(PG8_SB(1, 0), b3, voffB); PG8_STAGE(PG8_SB(1, 1), b3 + hstep, voffB); PG8_STAGE(PG8_SA(1, 0), a3, voffA);
            PG8_WAIT_V(8); PG8_WAIT_L(0); PG8_BAR; PG8_MMA(1, 0, At, B0); PG8_MMA(1, 1, At, B1); PG8_BAR; PG8_SCHED;
            } else {
            PG8_LDB(B0, 0, 0); PG8_SCHED; PG8_LDA(At, 0, 0); PG8_STAGE(PG8_SA(1, 1), a1 + hstep, voffA);
            PG8_WAIT_L(8); PG8_BAR; PG8_WAIT_L(0); PG8_MMA(0, 0, At, B0); PG8_BAR; PG8_SCHED;
            PG8_LDB(B1, 0, 1); PG8_STAGE(PG8_SB(0, 0), b2, voffB);
            PG8_BAR; PG8_WAIT_L(0); PG8_MMA(0, 1, At, B1); PG8_BAR;
            PG8_LDA(At, 0, 1); PG8_STAGE(PG8_SA(0, 0), a2, voffA);
            PG8_BAR; PG8_WAIT_L(0); PG8_MMA(1, 0, At, B0); PG8_BAR; PG8_SCHED;
            PG8_STAGE(PG8_SB(0, 1), b2 + hstep, voffB);
            PG8_WAIT_V(6); PG8_BAR; PG8_MMA(1, 1, At, B1); PG8_BAR;
            PG8_LDB(B0, 1, 0); PG8_SCHED; PG8_LDA(At, 1, 0); PG8_STAGE(PG8_SA(0, 1), a2 + hstep, voffA);
            PG8_WAIT_L(8); PG8_BAR; PG8_WAIT_L(0); PG8_MMA(0, 0, At, B0); PG8_BAR; PG8_SCHED;
            PG8_LDB(B1, 1, 1); PG8_STAGE(PG8_SB(1, 0), b3, voffB);
            PG8_BAR; PG8_WAIT_L(0); PG8_MMA(0, 1, At, B1); PG8_BAR;
            PG8_LDA(At, 1, 1); PG8_STAGE(PG8_SA(1, 0), a3, voffA);
            PG8_BAR; PG8_WAIT_L(0); PG8_MMA(1, 0, At, B0); PG8_BAR; PG8_SCHED;
            PG8_STAGE(PG8_SB(1, 1), b3 + hstep, voffB);
            PG8_WAIT_V(6); PG8_BAR; PG8_MMA(1, 1, At, B1); PG8_BAR;
            }
        }
        if constexpr (ALIGN_EPI) { if (wr == 0) PG8_BAR; }
        if constexpr (!Epi::AFTER_DRAIN) { E(acc, cur, wr, wc, fr, fq); S.done(cur); }
        if (!has_next) break;
#pragma unroll
        for (int a = 0; a < 2; ++a)
#pragma unroll
            for (int b = 0; b < 2; ++b)
#pragma unroll
                for (int m = 0; m < 4; ++m)
#pragma unroll
                    for (int n = 0; n < 2; ++n) acc[a][b][m][n] = (f32x4){0.f, 0.f, 0.f, 0.f};
        cur = nxt; cA = nA; cB = nB; ++ui;
        if constexpr (ALIGN_EPI) { if (wr == 1) PG8_BAR; }
    }
    PG8_WAIT_V(0);
    if constexpr (!ALIGN_EPI) { if (wr == 0) PG8_BAR; }
    PG8_BAR;
    if constexpr (Epi::AFTER_DRAIN) { E.fused(acc, cur, wr, wc, fr, fq, lds, wid, lane); S.done(cur); }
#undef PG8_SA
#undef PG8_SB
#undef PG8_STAGE
#undef PG8_LDA
#undef PG8_LDB
#undef PG8_MMA
#undef PG8_WAIT_V
#undef PG8_WAIT_L
#undef PG8_BAR
#undef PG8_SCHED
}
}

constexpr int DM = 2048, NTOK = 8192, SEQ = 4096, GW = 4096, NGRP = 16, GDIM = 256, CHUNK = 128, NHEAD = 16, HD = 128;
constexpr float EPS = 1e-6f;
constexpr float LOG2E = 1.4426950408889634f;
constexpr float QSCALE = 0.08838834764831845f * LOG2E;

constexpr float GELU_C1 = -1.5957691216057308f * LOG2E, GELU_C2 = -0.07135481627260025f * LOG2E;
__device__ __forceinline__ float gelu_tanh(float x) {
    const float e = __builtin_amdgcn_exp2f(x * __builtin_fmaf(x * x, GELU_C2, GELU_C1));
    return x * __builtin_amdgcn_rcpf(1.0f + e);
}
__device__ __forceinline__ float gelu_silu(float u, float z) {
    const float e1 = __builtin_amdgcn_exp2f(u * __builtin_fmaf(u * u, GELU_C2, GELU_C1));
    const float e2 = __builtin_amdgcn_exp2f(z * -LOG2E);
    return (u * z) * __builtin_amdgcn_rcpf((1.0f + e1) * (1.0f + e2));
}
__device__ __forceinline__ float silu_f(float z) { return z * __builtin_amdgcn_rcpf(1.0f + __builtin_amdgcn_exp2f(-LOG2E * z)); }

namespace pg8 {
typedef unsigned u32x2 __attribute__((ext_vector_type(2)));
__device__ __forceinline__ void conv_load4(const float* __restrict__ W, int N, int item, int lane, f32x4 (&x)[16]) {
    const int nblk = N / 64, k0 = 64 * (item / nblk), n0 = 64 * (item % nblk);
#pragma unroll
    for (int i = 0; i < 16; ++i) x[i] = __builtin_nontemporal_load((const f32x4*)(W + (size_t)(k0 + 4 * i + (lane >> 4)) * N + n0 + 4 * (lane & 15)));
}
__device__ __forceinline__ void conv_xpose(f32x4 (&x)[16], int lane) {
    const bool a = (lane >> 4) & 1, b = (lane >> 5) & 1;
#pragma unroll
    for (int i = 0; i < 16; ++i) {
        f32x4 v = x[i];
        {
            const float s0 = a ? v[0] : v[1], s1 = a ? v[2] : v[3];
            const float r0 = __shfl_xor(s0, 16), r1 = __shfl_xor(s1, 16);
            if (a) { v[0] = r0; v[2] = r1; } else { v[1] = r0; v[3] = r1; }
        }
        {
            const float s0 = b ? v[0] : v[2], s1 = b ? v[1] : v[3];
            const float r0 = __shfl_xor(s0, 32), r1 = __shfl_xor(s1, 32);
            if (b) { v[0] = r0; v[1] = r1; } else { v[2] = r0; v[3] = r1; }
        }
        x[i] = v;
    }
}
__device__ __forceinline__ void conv_store4(int K, int N, bf16_t* __restrict__ WT, int item, int lane, const float* __restrict__ gk, const f32x4 (&x)[16]) {
    const int nblk = N / 64, k0 = 64 * (item / nblk), n0 = 64 * (item % nblk);
    const int n = n0 + 4 * (lane & 15) + (lane >> 4);
#pragma unroll
    for (int kc = 0; kc < 8; ++kc) {
        float g[8];
#pragma unroll
        for (int j = 0; j < 8; ++j) g[j] = gk ? gk[k0 + 8 * kc + j] : 1.0f;
        const f32x4 lo = x[2 * kc], hi = x[2 * kc + 1];
        u32x4 o; o.x = cvt_pk_bf16(lo[0] * g[0], lo[1] * g[1]); o.y = cvt_pk_bf16(lo[2] * g[2], lo[3] * g[3]);
        o.z = cvt_pk_bf16(hi[0] * g[4], hi[1] * g[5]); o.w = cvt_pk_bf16(hi[2] * g[6], hi[3] * g[7]);
        *(u32x4*)(WT + (size_t)n * K + k0 + 8 * kc) = o;
    }
}
__device__ __forceinline__ void conv_store4_lds(int K, int N, bf16_t* __restrict__ WT, int item, int lane, const float* __restrict__ gk, const f32x4 (&x)[16], PG8_LAS unsigned char* sw) {
    const int nblk = N / 64, k0 = 64 * (item / nblk), n0 = 64 * (item % nblk);
    const int nq = lane & 15, r = lane >> 4;
    u32x4 o[8];
#pragma unroll
    for (int kc = 0; kc < 8; ++kc) {
        float g[8];
#pragma unroll
        for (int j = 0; j < 8; ++j) g[j] = gk ? gk[k0 + 8 * kc + j] : 1.0f;
        const f32x4 lo = x[2 * kc], hi = x[2 * kc + 1];
        o[kc].x = cvt_pk_bf16(lo[0] * g[0], lo[1] * g[1]); o[kc].y = cvt_pk_bf16(lo[2] * g[2], lo[3] * g[3]);
        o[kc].z = cvt_pk_bf16(hi[0] * g[4], hi[1] * g[5]); o[kc].w = cvt_pk_bf16(hi[2] * g[6], hi[3] * g[7]);
    }
#pragma unroll
    for (int q = 0; q < 4; ++q) {
        if ((nq >> 2) == q) {
            PG8_LAS u32x4* wp = (PG8_LAS u32x4*)(sw + (4 * (nq & 3) + r) * 128);
#pragma unroll
            for (int kc = 0; kc < 8; ++kc) wp[kc] = o[kc];
        }
        asm volatile("s_waitcnt lgkmcnt(0)" ::: "memory");
#pragma unroll
        for (int h = 0; h < 2; ++h) { const int rl = (lane >> 3) + 8 * h;
            const u32x4 v = *(const PG8_LAS u32x4*)(sw + rl * 128 + (lane & 7) * 16);
            __builtin_nontemporal_store(v, (u32x4*)(WT + (size_t)(n0 + 16 * q + rl) * K + k0 + 8 * (lane & 7))); }
        asm volatile("s_waitcnt lgkmcnt(0)" ::: "memory");
    }
}
struct ConvOrder : StaticOrder {
    const float *w2, *w3, *w4, *g1; bf16_t *t2, *t3, *t4; int gw, ngw, trigger, ln; PG8_LAS unsigned char* sw; mutable int n_done;
    __device__ __forceinline__ void done(const Unit&) const {
        constexpr int I2 = (GW / 64) * (DM / 64), I3 = (DM / 64) * (4 * DM / 64), I4 = (DM / 64) * (DM / 64);
        const int u = n_done++;
#ifdef HOOK_SPREAD
        f32x4 va[16];
        if (u == 0 || u == 1) { for (int it = gw + u * ngw; it < I3; it += 2 * ngw) { conv_load4(w3, 4 * DM, it, ln, va); conv_xpose(va, ln); conv_store4(DM, 4 * DM, t3, it, ln, g1, va); } }
        else if (u == 2) { for (int it = gw; it < I2; it += ngw) { conv_load4(w2, DM, it, ln, va); conv_xpose(va, ln); conv_store4(GW, DM, t2, it, ln, nullptr, va); } }
        else if (u == 3) { for (int it = gw; it < I4; it += ngw) { conv_load4(w4, DM, it, ln, va); conv_xpose(va, ln); conv_store4(DM, DM, t4, it, ln, nullptr, va); } }
#else
        if (u != trigger) return;
        f32x4 va[16], vb[16];
        for (int it = gw; it < I3; it += 2 * ngw) {
            const bool two = it + ngw < I3;
            conv_load4(w3, 4 * DM, it, ln, va); if (two) conv_load4(w3, 4 * DM, it + ngw, ln, vb);
            conv_xpose(va, ln); if (two) conv_xpose(vb, ln);
            conv_store4_lds(DM, 4 * DM, t3, it, ln, g1, va, sw); if (two) conv_store4_lds(DM, 4 * DM, t3, it + ngw, ln, g1, vb, sw);
        }
        for (int it = gw; it < I2; it += ngw) {
            const bool two = it < I4;
            conv_load4(w2, DM, it, ln, va); if (two) conv_load4(w4, DM, it, ln, vb);
            conv_xpose(va, ln); if (two) conv_xpose(vb, ln);
            conv_store4_lds(GW, DM, t2, it, ln, nullptr, va, sw); if (two) conv_store4_lds(DM, DM, t4, it, ln, nullptr, vb, sw);
        }
#endif
    }
};
struct EpiGmlpIn {
    static constexpr bool PERM = true, AFTER_DRAIN = false;
    bf16_t *UZ, *V; float* vss;
    __device__ __forceinline__ void operator()(const f32x4 (&acc)[2][2][4][2], const Unit& u, int wr, int wc, int fr, int fq) const {
        const int row0 = u.pm * BM + wr * 64 + fr;
        const int tq = u.pn / 3, tr = u.pn - 3 * tq;
        if (tr < 2) {
            const int col0 = (2 * tq + tr) * HALF + wc * 32 + 8 * fq;
#pragma unroll
            for (int ai = 0; ai < 2; ++ai)
#pragma unroll
                for (int m = 0; m < 4; ++m) {
                    const int row = row0 + ai * HALF + m * 16;
                    f32x4 v0 = acc[ai][0][m][0], v1 = acc[ai][0][m][1]; const f32x4 z0 = acc[ai][1][m][0], z1 = acc[ai][1][m][1];
#pragma unroll
                    for (int e = 0; e < 4; ++e) { v0[e] = gelu_silu(v0[e], z0[e]); v1[e] = gelu_silu(v1[e], z1[e]); }
                    u32x4 w; w.x = cvt_pk_bf16(v0[0], v0[1]); w.y = cvt_pk_bf16(v0[2], v0[3]); w.z = cvt_pk_bf16(v1[0], v1[1]); w.w = cvt_pk_bf16(v1[2], v1[3]);
                    *(u32x4*)(UZ + (size_t)row * GW + col0) = w;
                }
        } else {
            const int tl = tq, col0 = tl * BM + wc * 32 + 8 * fq;
#pragma unroll
            for (int ai = 0; ai < 2; ++ai)
#pragma unroll
                for (int m = 0; m < 4; ++m) {
                    const int row = row0 + ai * HALF + m * 16;
                    bf16_t* rowp = V + (size_t)row * GW + col0;
                    float ss = 0.f;
#pragma unroll
                    for (int bj = 0; bj < 2; ++bj) {
                        f32x4 v0 = acc[ai][bj][m][0], v1 = acc[ai][bj][m][1];
#pragma unroll
                        for (int e = 0; e < 4; ++e) { v0[e] = gelu_tanh(v0[e]); v1[e] = gelu_tanh(v1[e]); ss += v0[e] * v0[e] + v1[e] * v1[e]; }
                        u32x4 w; w.x = cvt_pk_bf16(v0[0], v0[1]); w.y = cvt_pk_bf16(v0[2], v0[3]); w.z = cvt_pk_bf16(v1[0], v1[1]); w.w = cvt_pk_bf16(v1[2], v1[3]);
                        *(u32x4*)(rowp + bj * HALF) = w;
                    }
                    ss += __shfl_xor(ss, 16); ss += __shfl_xor(ss, 32);
                    if (fq == 0) vss[(size_t)row * 64 + tl * 4 + wc] = ss;
                }
        }
    }
};
struct EpiRes1 {
    static constexpr bool PERM = true, AFTER_DRAIN = false;
    const bf16_t* hn; const float* irs; bf16_t* hb; float* hss;
    __device__ __forceinline__ void operator()(const f32x4 (&acc)[2][2][4][2], const Unit& u, int wr, int wc, int fr, int fq) const {
        const int row0 = u.pm * BM + wr * 64 + fr, col0 = u.pn * BM + wc * 32 + 8 * fq;
        float rs[2][4];
#pragma unroll
        for (int ai = 0; ai < 2; ++ai)
#pragma unroll
            for (int m = 0; m < 4; ++m) rs[ai][m] = irs[row0 + ai * HALF + m * 16];
#pragma unroll
        for (int ai = 0; ai < 2; ++ai) {
            u32x4 xv[4][2];
#pragma unroll
            for (int m = 0; m < 4; ++m)
#pragma unroll
                for (int bj = 0; bj < 2; ++bj) xv[m][bj] = *(const u32x4*)(hn + (size_t)(row0 + ai * HALF + m * 16) * DM + col0 + bj * HALF);
#pragma unroll
            for (int m = 0; m < 4; ++m) {
                const int row = row0 + ai * HALF + m * 16;
                const size_t off = (size_t)row * DM + col0;
                float ss = 0.f;
#pragma unroll
                for (int bj = 0; bj < 2; ++bj) {
                    const u32x4 w4 = xv[m][bj];
                    f32x4 x0, x1;
                    x0[0] = __uint_as_float(w4.x << 16); x0[1] = __uint_as_float(w4.x & 0xffff0000u); x0[2] = __uint_as_float(w4.y << 16); x0[3] = __uint_as_float(w4.y & 0xffff0000u);
                    x1[0] = __uint_as_float(w4.z << 16); x1[1] = __uint_as_float(w4.z & 0xffff0000u); x1[2] = __uint_as_float(w4.w << 16); x1[3] = __uint_as_float(w4.w & 0xffff0000u);
                    const f32x4 h0 = x0 * rs[ai][m] + acc[ai][bj][m][0], h1 = x1 * rs[ai][m] + acc[ai][bj][m][1];
                    ss += ((h0[0] * h0[0] + h0[1] * h0[1]) + (h0[2] * h0[2] + h0[3] * h0[3])) + ((h1[0] * h1[0] + h1[1] * h1[1]) + (h1[2] * h1[2] + h1[3] * h1[3]));
                    u32x4 o; o.x = cvt_pk_bf16(h0[0], h0[1]); o.y = cvt_pk_bf16(h0[2], h0[3]); o.z = cvt_pk_bf16(h1[0], h1[1]); o.w = cvt_pk_bf16(h1[2], h1[3]);
                    *(u32x4*)(hb + off + bj * HALF) = o;
                }
                ss += __shfl_xor(ss, 16); ss += __shfl_xor(ss, 32);
                if (fq == 0) __hip_atomic_fetch_add(hss + row, ss, __ATOMIC_RELAXED, __HIP_MEMORY_SCOPE_AGENT);
            }
        }
    }
};
struct EpiFinal {
    static constexpr bool PERM = true, AFTER_DRAIN = false;
    const bf16_t* hb; const float* fg; float* out; float* hss; unsigned* cnt; bool fused;
    __device__ __forceinline__ void operator()(f32x4 (&acc)[2][2][4][2], const Unit& u, int wr, int wc, int fr, int fq) const {
        const int row0 = u.pm * BM + wr * 64 + fr, col0 = u.pn * BM + wc * 32 + 8 * fq;
#pragma unroll
        for (int ai = 0; ai < 2; ++ai)
#pragma unroll
            for (int m = 0; m < 4; ++m) {
                const int row = row0 + ai * HALF + m * 16;
                const size_t off = (size_t)row * DM + col0;
                float ss = 0.f;
#pragma unroll
                for (int bj = 0; bj < 2; ++bj) {
                    const u32x4 w = *(const u32x4*)(hb + off + bj * HALF);
                    f32x4 h0, h1;
                    h0[0] = __uint_as_float(w.x << 16); h0[1] = __uint_as_float(w.x & 0xffff0000u); h0[2] = __uint_as_float(w.y << 16); h0[3] = __uint_as_float(w.y & 0xffff0000u);
                    h1[0] = __uint_as_float(w.z << 16); h1[1] = __uint_as_float(w.z & 0xffff0000u); h1[2] = __uint_as_float(w.w << 16); h1[3] = __uint_as_float(w.w & 0xffff0000u);
                    h0 += acc[ai][bj][m][0]; h1 += acc[ai][bj][m][1];
                    acc[ai][bj][m][0] = h0; acc[ai][bj][m][1] = h1;
                    ss += ((h0[0] * h0[0] + h0[1] * h0[1]) + (h0[2] * h0[2] + h0[3] * h0[3])) + ((h1[0] * h1[0] + h1[1] * h1[1]) + (h1[2] * h1[2] + h1[3] * h1[3]));
                }
                ss += __shfl_xor(ss, 16); ss += __shfl_xor(ss, 32);
                if (fq == 0) __hip_atomic_fetch_add(hss + row, ss, __ATOMIC_RELAXED, __HIP_MEMORY_SCOPE_AGENT);
            }
        if (!fused) {
#pragma unroll
            for (int ai = 0; ai < 2; ++ai)
#pragma unroll
                for (int m = 0; m < 4; ++m)
#pragma unroll
                    for (int bj = 0; bj < 2; ++bj)
#pragma unroll
                        for (int n = 0; n < 2; ++n) *(f32x4*)(out + (size_t)(row0 + ai * HALF + m * 16) * DM + col0 + bj * HALF + n * 4) = acc[ai][bj][m][n];
            return;
        }
        asm volatile("s_waitcnt vmcnt(0)" ::: "memory");
        unsigned* pc = cnt + 64 * u.pm;
        if (lane_id() == 0) __hip_atomic_fetch_add(pc, 1u, __ATOMIC_RELAXED, __HIP_MEMORY_SCOPE_AGENT);
        for (int it = 0; it < (1 << 22); ++it) {
            if (__hip_atomic_load(pc, __ATOMIC_RELAXED, __HIP_MEMORY_SCOPE_AGENT) >= 64u) break;
            __builtin_amdgcn_s_sleep(2);
        }
        asm volatile("" ::: "memory");
        f32x4 gv[2][2];
#pragma unroll
        for (int bj = 0; bj < 2; ++bj)
#pragma unroll
            for (int n = 0; n < 2; ++n) gv[bj][n] = *(const f32x4*)(fg + col0 + bj * HALF + n * 4);
        float ssr[2][4];
#pragma unroll
        for (int ai = 0; ai < 2; ++ai)
#pragma unroll
            for (int m = 0; m < 4; ++m) ssr[ai][m] = __hip_atomic_load(hss + row0 + ai * HALF + m * 16, __ATOMIC_RELAXED, __HIP_MEMORY_SCOPE_AGENT);
#pragma unroll
        for (int ai = 0; ai < 2; ++ai)
#pragma unroll
            for (int m = 0; m < 4; ++m) {
                const int row = row0 + ai * HALF + m * 16;
                const size_t off = (size_t)row * DM + col0;
                const float rstd = __builtin_amdgcn_rsqf(ssr[ai][m] * (1.0f / DM) + EPS);
#pragma unroll
                for (int bj = 0; bj < 2; ++bj)
#pragma unroll
                    for (int n = 0; n < 2; ++n) *(f32x4*)(out + off + bj * HALF + n * 4) = acc[ai][bj][m][n] * rstd * gv[bj][n];
            }
    }
};
struct EpiSbIn {
    static constexpr bool PERM = true, AFTER_DRAIN = false;
    bf16_t* Q; size_t rstride; const float* hss;
    __device__ __forceinline__ void operator()(const f32x4 (&acc)[2][2][4][2], const Unit& u, int wr, int wc, int fr, int fq) const {
        const int region = u.pn >> 3, tl = u.pn & 7;
        bf16_t* base = Q + (size_t)region * rstride;
        const int row0 = u.pm * BM + wr * 64 + fr, col0 = tl * BM + wc * 32 + 8 * fq;
        float ssr[2][4];
#pragma unroll
        for (int ai = 0; ai < 2; ++ai)
#pragma unroll
            for (int m = 0; m < 4; ++m) ssr[ai][m] = hss[row0 + ai * HALF + m * 16];
#pragma unroll
        for (int ai = 0; ai < 2; ++ai)
#pragma unroll
            for (int m = 0; m < 4; ++m) {
                const int row = row0 + ai * HALF + m * 16;
                float sc = __builtin_amdgcn_rsqf(ssr[ai][m] * (1.0f / DM) + EPS);
                if (region == 0) sc *= QSCALE;
                bf16_t* rowp = base + (size_t)row * DM + col0;
#pragma unroll
                for (int bj = 0; bj < 2; ++bj) {
                    f32x4 v0 = acc[ai][bj][m][0] * sc, v1 = acc[ai][bj][m][1] * sc;
                    if (region == 3) {
#pragma unroll
                        for (int e = 0; e < 4; ++e) { v0[e] = silu_f(v0[e]); v1[e] = silu_f(v1[e]); }
                    }
                    u32x4 w; w.x = cvt_pk_bf16(v0[0], v0[1]); w.y = cvt_pk_bf16(v0[2], v0[3]); w.z = cvt_pk_bf16(v1[0], v1[1]); w.w = cvt_pk_bf16(v1[2], v1[3]);
                    *(u32x4*)(rowp + bj * HALF) = w;
                }
            }
    }
};
}

#define LAS __attribute__((address_space(3)))
typedef unsigned short bf16_t;
typedef short bf16x8 __attribute__((ext_vector_type(8)));
typedef short s16x4 __attribute__((ext_vector_type(4)));
typedef float f32x4 __attribute__((ext_vector_type(4)));
typedef float f32x16 __attribute__((ext_vector_type(16)));
typedef unsigned u32x4 __attribute__((ext_vector_type(4)));
typedef unsigned u32x2 __attribute__((ext_vector_type(2)));
__device__ __forceinline__ unsigned off_b(unsigned row, unsigned ch) { return 256u * row + 16u * (ch ^ (((row & 3u) << 2) | ((row >> 2) & 3u))); }
__device__ __forceinline__ s16x4 vtr(const LAS unsigned char* p) { return __builtin_bit_cast(s16x4, __builtin_amdgcn_ds_read_tr16_b64_v4i16((LAS s16x4*)p)); }
__device__ __forceinline__ unsigned pk_bf16(float lo, float hi) { return pg8::cvt_pk_bf16(lo, hi); }
__device__ __forceinline__ float bf_lo(unsigned w) { return __uint_as_float(w << 16); }
__device__ __forceinline__ float bf_hi(unsigned w) { return __uint_as_float(w & 0xffff0000u); }
__device__ __forceinline__ int crow(int r, int hi) { return (r & 3) + 8 * (r >> 2) + 4 * hi; }

#ifdef ATT_NOSB
#define ATT_SB() do {} while (0)
#else
#ifndef ATT_USE_SB
#define ATT_SB() do {} while (0)
#else
#define ATT_SB() __builtin_amdgcn_sched_barrier(0)
#endif
#endif
#define ATT_VLD(f) do { const int c_ = (f) >> 2, s_ = (f) & 3; const s16x4 lo_ = vtr(vbp + 4096 * s_ + vbase[0] + vcq[c_]); const s16x4 hh_ = vtr(vbp + 4096 * s_ + vbase[1] + vcq[c_]); \
        vf[f] = (bf16x8){lo_[0], lo_[1], lo_[2], lo_[3], hh_[0], hh_[1], hh_[2], hh_[3]}; } while (0)
#define ATT_PV(f) do { if (DO_PV) { o[(f) >> 2] = __builtin_amdgcn_mfma_f32_32x32x16_bf16(pa[(f) & 3], vf[f], o[(f) >> 2], 0, 0, 0); if ((f) + 4 < 16) ATT_VLD((f) + 4); } } while (0)
#define ATT_EXP8(i) do { _Pragma("unroll") for (int r_ = 0; r_ < 8; ++r_) p[(i) >> 1][8 * ((i) & 1) + r_] = __builtin_amdgcn_exp2f(fminf(p[(i) >> 1][8 * ((i) & 1) + r_], 30.f)); } while (0)
#define ATT_LBLK(j) do { const int ph_ = 1 - ((j) >> 2), g_ = 3 - ((j) & 3); \
        const float w0_ = 1.0f + p[ph_][4 * g_], w1_ = 1.0f + p[ph_][4 * g_ + 1], w2_ = 1.0f + p[ph_][4 * g_ + 2], w3_ = 1.0f + p[ph_][4 * g_ + 3]; \
        L[j] = __builtin_amdgcn_logf((w0_ * w1_) * (w2_ * w3_)); } while (0)
#define ATT_XCH(j) do { const float own_ = L[j]; const auto rr_ = __builtin_amdgcn_permlane32_swap(__float_as_uint(own_), __float_as_uint(own_), false, false); \
        const float a0_ = __uint_as_float(rr_[0]), a1_ = __uint_as_float(rr_[1]); const float oth_ = (a0_ == own_) ? a1_ : a0_; \
        T[j] = run + (hi ? 0.f : oth_) + own_; run += a0_ + a1_; } while (0)
#define ATT_WGT(j) do { const int ph_ = 1 - ((j) >> 2), g_ = 3 - ((j) & 3); float cf_ = __builtin_amdgcn_exp2f(-T[j]); \
        _Pragma("unroll") for (int e_ = 0; e_ < 4; ++e_) { const float ev_ = p[ph_][4 * g_ + e_]; p[ph_][4 * g_ + e_] = ev_ * cf_; if (e_ < 3) cf_ *= (1.0f + ev_); } } while (0)

template <bool DO_PV>
__device__ __forceinline__ void attn_tile(const LAS unsigned char* kb, const LAS unsigned char* vbp, const bf16x8 (&qf)[8], f32x16 (&o)[4], bf16x8 (&pa)[4], float& carry,
                                          const unsigned (&koff)[8], const unsigned (&vbase)[2], const unsigned (&vcq)[4], int k0, int qw0, int qabs, int hi) {
    f32x16 p[2];
#pragma unroll
    for (int r = 0; r < 16; ++r) { p[0][r] = 0.f; p[1][r] = 0.f; }
    bf16x8 vf[16];
    if (DO_PV) { ATT_VLD(0); ATT_VLD(1); ATT_VLD(2); ATT_VLD(3); }
    {
        bf16x8 ka[8], kc[8];
#pragma unroll
        for (int d0 = 0; d0 < 8; ++d0) { ka[d0] = *(const LAS bf16x8*)(kb + koff[d0]); kc[d0] = *(const LAS bf16x8*)(kb + 8192 + koff[d0]); }
        ATT_SB();
#pragma unroll
        for (int d0 = 0; d0 < 8; ++d0) {
            p[0] = __builtin_amdgcn_mfma_f32_32x32x16_bf16(ka[d0], qf[d0], p[0], 0, 0, 0);
            p[1] = __builtin_amdgcn_mfma_f32_32x32x16_bf16(kc[d0], qf[d0], p[1], 0, 0, 0);
        }
    }
    ATT_SB();
    const bool need_mask = (k0 + 63 >= qw0);
    float L[8], T[8];
    ATT_PV(0); ATT_EXP8(0); ATT_SB();
    ATT_PV(1); ATT_EXP8(1); ATT_SB();
    ATT_PV(2); ATT_EXP8(2); ATT_SB();
    ATT_PV(3); ATT_EXP8(3); ATT_SB();
    if (need_mask) {
#pragma unroll
        for (int ph = 0; ph < 2; ++ph)
#pragma unroll
            for (int r = 0; r < 16; ++r) { const int key = k0 + 32 * ph + crow(r, hi); if (key >= qabs) p[ph][r] = 0.f; }
    }
    ATT_SB();
    ATT_PV(4); ATT_LBLK(0); ATT_LBLK(1); ATT_SB();
    ATT_PV(5); ATT_LBLK(2); ATT_LBLK(3); ATT_SB();
    ATT_PV(6); ATT_LBLK(4); ATT_LBLK(5); ATT_SB();
    ATT_PV(7); ATT_LBLK(6); ATT_LBLK(7); ATT_SB();
    float run = carry;
    ATT_PV(8); ATT_XCH(0); ATT_XCH(1); ATT_SB();
    ATT_PV(9); ATT_XCH(2); ATT_XCH(3); ATT_SB();
    ATT_PV(10); ATT_XCH(4); ATT_XCH(5); ATT_SB();
    ATT_PV(11); ATT_XCH(6); ATT_XCH(7); ATT_SB();
    carry = run;
    ATT_PV(12); ATT_WGT(0); ATT_WGT(1); ATT_SB();
    ATT_PV(13); ATT_WGT(2); ATT_WGT(3); ATT_SB();
    ATT_PV(14); ATT_WGT(4); ATT_WGT(5); ATT_SB();
    ATT_PV(15); ATT_WGT(6); ATT_WGT(7); ATT_SB();
#pragma unroll
    for (int s = 0; s < 4; ++s) { const int ph = s >> 1, rb = 8 * (s & 1);
        u32x4 w; w.x = pk_bf16(p[ph][rb], p[ph][rb + 1]); w.y = pk_bf16(p[ph][rb + 2], p[ph][rb + 3]); w.z = pk_bf16(p[ph][rb + 4], p[ph][rb + 5]); w.w = pk_bf16(p[ph][rb + 6], p[ph][rb + 7]);
        pa[s] = __builtin_bit_cast(bf16x8, w); }
}

__device__ __forceinline__ void attn_unit(LAS unsigned char* lds, const int wid, int b, int h, int qb, const bf16_t* __restrict__ Q, const bf16_t* __restrict__ K,
                                          const bf16_t* __restrict__ V, const bf16_t* __restrict__ ZS, bf16_t* __restrict__ OG) {
    const int tid = tid_of(wid), lane = tid & 63, r32 = lane & 31, hi = lane >> 5;
    const size_t tok0 = (size_t)b * SEQ;
    const int q0 = qb * 256, qw0 = q0 + 32 * wid, qabs = qw0 + r32;
    bf16x8 qf[8];
    { const bf16_t* qp = Q + (tok0 + qabs) * DM + h * HD + 8 * hi;
#pragma unroll
      for (int d0 = 0; d0 < 8; ++d0) qf[d0] = *(const bf16x8*)(qp + 16 * d0); }
    f32x16 o[4];
#pragma unroll
    for (int c = 0; c < 4; ++c)
#pragma unroll
        for (int r = 0; r < 16; ++r) o[c][r] = 0.f;
    bf16x8 pa[4];
#pragma unroll
    for (int s = 0; s < 4; ++s) pa[s] = (bf16x8){0, 0, 0, 0, 0, 0, 0, 0};
    float carry = 0.f;
    const int NT = (q0 + 256) / 64;
    const int srow = tid >> 4, sch = (tid & 15) ^ (((srow & 3) << 2) | ((srow >> 2) & 3));
    const bf16_t* kg = K + (tok0 + srow) * DM + h * HD + sch * 8;
    const bf16_t* vg = V + (tok0 + srow) * DM + h * HD + sch * 8;
    LAS unsigned char* ldsw = lds + wid * 1024;
#define ATT_STAGE(t_, koff_, voff_) do { const size_t go_ = (size_t)(t_) * 64 * DM; \
        __builtin_amdgcn_global_load_lds((const unsigned*)(kg + go_), (LAS unsigned*)(ldsw + (koff_)), 16, 0, 0); \
        __builtin_amdgcn_global_load_lds((const unsigned*)(kg + go_ + 32 * DM), (LAS unsigned*)(ldsw + (koff_) + 8192), 16, 0, 0); \
        __builtin_amdgcn_global_load_lds((const unsigned*)(vg + go_), (LAS unsigned*)(ldsw + (voff_)), 16, 0, 0); \
        __builtin_amdgcn_global_load_lds((const unsigned*)(vg + go_ + 32 * DM), (LAS unsigned*)(ldsw + (voff_) + 8192), 16, 0, 0); } while (0)
    ATT_STAGE(NT - 1, 0, 32768);
    asm volatile("s_waitcnt vmcnt(0)" ::: "memory");
    __syncthreads();
    unsigned koff[8];
#pragma unroll
    for (int d0 = 0; d0 < 8; ++d0) koff[d0] = off_b(r32, 2 * d0 + hi);
    const unsigned qa = (lane & 15) >> 2, blk = (lane >> 4) & 1, pp = lane & 3;
    unsigned vbase[2], vcq[4];
#pragma unroll
    for (int t = 0; t < 2; ++t) vbase[t] = 256u * (8 * t + 4 * hi + qa) + 16u * ((2 * blk + (pp >> 1)) ^ ((2 * t + hi) & 3)) + 8u * (pp & 1);
#pragma unroll
    for (int c = 0; c < 4; ++c) vcq[c] = 64u * ((unsigned)c ^ qa);
    int kcur = 0, vprev = 2, vcur = 0, vnext = 1;
    bool prev_valid = false;
    for (int t = NT - 1; t >= 0; --t) {
        if (t > 0) ATT_STAGE(t - 1, (kcur ^ 1) * 16384, 32768 + vnext * 16384);
        const LAS unsigned char* kb = lds + kcur * 16384;
        const LAS unsigned char* vbp = lds + 32768 + vprev * 16384;
        const int k0 = 64 * t;
        const bool valid = (k0 < qw0 + 31);
        if (valid) {
            if (prev_valid) attn_tile<true>(kb, vbp, qf, o, pa, carry, koff, vbase, vcq, k0, qw0, qabs, hi);
            else            attn_tile<false>(kb, vbp, qf, o, pa, carry, koff, vbase, vcq, k0, qw0, qabs, hi);
        }
        prev_valid = valid;
        asm volatile("s_waitcnt vmcnt(0)" ::: "memory");
        __syncthreads();
        kcur ^= 1; { const int tmp = vprev; vprev = vcur; vcur = vnext; vnext = tmp; }
    }
    { const LAS unsigned char* vbp = lds + 32768 + vprev * 16384;
#pragma unroll
      for (int c = 0; c < 4; ++c)
#pragma unroll
          for (int s = 0; s < 4; ++s) {
              const s16x4 lo = vtr(vbp + 4096 * s + vbase[0] + vcq[c]);
              const s16x4 hh = vtr(vbp + 4096 * s + vbase[1] + vcq[c]);
              const bf16x8 vfr = (bf16x8){lo[0], lo[1], lo[2], lo[3], hh[0], hh[1], hh[2], hh[3]};
              o[c] = __builtin_amdgcn_mfma_f32_32x32x16_bf16(pa[s], vfr, o[c], 0, 0, 0);
          } }
    {
        int lane_e = lane_id(); asm volatile("" : "+v"(lane_e));
        const int r32e = lane_e & 31, hie = lane_e >> 5, rowq = lane_e >> 4, c4 = (lane_e & 15) * 4;
        LAS float* stg = (LAS float*)(lds + 81920 + wid * 8192);
        const size_t gbase = (tok0 + qw0) * DM + h * HD + c4;
        u32x2 zv[2][8];
#pragma unroll
        for (int ps = 0; ps < 2; ++ps)
#pragma unroll
            for (int j = 0; j < 8; ++j) zv[ps][j] = *(const u32x2*)(ZS + gbase + (size_t)(4 * j + rowq) * DM + 64 * ps);
#pragma unroll
        for (int ps = 0; ps < 2; ++ps) {
#pragma unroll
            for (int r = 0; r < 16; ++r) {
                stg[crow(r, hie) * 64 + r32e] = o[2 * ps][r];
                stg[crow(r, hie) * 64 + 32 + r32e] = o[2 * ps + 1][r];
            }
            asm volatile("s_waitcnt lgkmcnt(0)" ::: "memory");
#pragma unroll
            for (int j = 0; j < 8; ++j) {
                const f32x4 ov = *(const LAS f32x4*)(stg + (4 * j + rowq) * 64 + c4);
                const u32x2 z = zv[ps][j];
                u32x2 w; w.x = pk_bf16(ov[0] * bf_lo(z.x), ov[1] * bf_hi(z.x)); w.y = pk_bf16(ov[2] * bf_lo(z.y), ov[3] * bf_hi(z.y));
                *(u32x2*)(OG + gbase + (size_t)(4 * j + rowq) * DM + 64 * ps) = w;
            }
            asm volatile("s_waitcnt lgkmcnt(0)" ::: "memory");
        }
    }
    __syncthreads();
}
__device__ __forceinline__ void attn_phase(LAS unsigned char* lds, const int wid_, int vcu, int G, const bf16_t* Q, const bf16_t* K, const bf16_t* V, const bf16_t* ZS, bf16_t* OG) {
#ifndef NO_ATTN_PRIO
    if (wid_ >= 4) __builtin_amdgcn_s_setprio(1);
#endif
    for (int p = vcu; p < 256; p += G) {
        const int bh = p >> 3, s = p & 7;
#ifdef ATT_ONE_INSTANCE
#pragma unroll 1
        for (int uu = 0; uu < 2; ++uu) attn_unit(lds, wid_, bh >> 4, bh & 15, uu ? 15 - s : s, Q, K, V, ZS, OG);
#else
        attn_unit(lds, wid_, bh >> 4, bh & 15, s, Q, K, V, ZS, OG);
        attn_unit(lds, wid_, bh >> 4, bh & 15, 15 - s, Q, K, V, ZS, OG);
#endif
    }
    __builtin_amdgcn_s_setprio(0);
}

__device__ __forceinline__ void mix_unit(LAS unsigned char* lds, const int wid, int n, int g, const bf16_t* __restrict__ UZ, const bf16_t* __restrict__ V, const float* __restrict__ vss,
                                         const float* __restrict__ w_s, const float* __restrict__ b_s, const float* __restrict__ vg, bf16_t* __restrict__ Y) {
    const int tid = tid_of(wid), lane = tid & 63, r32 = lane & 31, hi = lane >> 5;
    const size_t row0 = (size_t)n * CHUNK;
    LAS float* rstdL = (LAS float*)(lds + 98304);
    const int cc = tid & 31;
    u32x4 uu[8];
#pragma unroll
    for (int i = 0; i < 8; ++i) { const int t = (tid >> 5) + 16 * i; uu[i] = __builtin_nontemporal_load((const u32x4*)(UZ + (row0 + t) * GW + g * GDIM + cc * 8)); }
    {
        u32x4 vr[8];
#pragma unroll
        for (int i = 0; i < 8; ++i) { const int c = tid + 512 * i, s = c >> 5, cc = c & 31;
            vr[i] = __builtin_nontemporal_load((const u32x4*)(V + (row0 + s) * GW + g * GDIM + cc * 8)); }
        if (tid < 128) { const f32x4* vp = (const f32x4*)(vss + (row0 + tid) * 64); f32x4 s4 = vp[0];
#pragma unroll
            for (int i = 1; i < 16; ++i) s4 += vp[i];
            rstdL[tid] = __builtin_amdgcn_rsqf(((s4[0] + s4[1]) + (s4[2] + s4[3])) * (1.0f / GW) + EPS); }
#pragma unroll
        for (int i = 0; i < 8; ++i) { const int c = tid + 512 * i, s = c >> 5, cc = c & 31;
            *(LAS u32x4*)(lds + 32768 + (cc >> 4) * 32768 + off_b(s, cc & 15)) = vr[i]; }
    }
    __syncthreads();
#pragma unroll
    for (int i = 0; i < 4; ++i) { const int c = tid + 512 * i, t = c >> 4, ch = c & 15, s0 = ch * 8;
        const f32x4 w0 = *(const f32x4*)(w_s + ((size_t)g * CHUNK + t) * CHUNK + s0), w1 = *(const f32x4*)(w_s + ((size_t)g * CHUNK + t) * CHUNK + s0 + 4);
        float wv[8] = {w0[0], w0[1], w0[2], w0[3], w1[0], w1[1], w1[2], w1[3]};
#pragma unroll
        for (int j = 0; j < 8; ++j) wv[j] = (s0 + j <= t) ? wv[j] * rstdL[s0 + j] : 0.f;
        u32x4 w; w.x = pk_bf16(wv[0], wv[1]); w.y = pk_bf16(wv[2], wv[3]); w.z = pk_bf16(wv[4], wv[5]); w.w = pk_bf16(wv[6], wv[7]);
        *(LAS u32x4*)(lds + off_b(t, ch)) = w; }
    __syncthreads();
    f32x16 acc[4];
#pragma unroll
    for (int i = 0; i < 4; ++i)
#pragma unroll
        for (int r = 0; r < 16; ++r) acc[i][r] = 0.f;
    {
        const LAS unsigned char* vimg = lds + 32768 + (wid >> 2) * 32768;
        const unsigned cblk = wid & 3, qa = (lane & 15) >> 2, blk = (lane >> 4) & 1, pp = lane & 3;
#pragma unroll
        for (int ks = 0; ks < 8; ++ks) {
            const s16x4 lo = vtr(vimg + off_b(16 * ks + 8 * hi + qa, 4 * cblk + 2 * blk + (pp >> 1)) + 8 * (pp & 1));
            const s16x4 hh = vtr(vimg + off_b(16 * ks + 8 * hi + 4 + qa, 4 * cblk + 2 * blk + (pp >> 1)) + 8 * (pp & 1));
            const bf16x8 vf = (bf16x8){lo[0], lo[1], lo[2], lo[3], hh[0], hh[1], hh[2], hh[3]};
#pragma unroll
            for (int i = 0; i < 4; ++i) if (ks <= 2 * i + 1) {
                const bf16x8 af = *(const LAS bf16x8*)(lds + off_b(32 * i + r32, 2 * ks + hi));
                acc[i] = __builtin_amdgcn_mfma_f32_32x32x16_bf16(af, vf, acc[i], 0, 0, 0);
            }
        }
    }
    __syncthreads();
    {
        LAS float* mx = (LAS float*)lds;
        const int c = 128 * (wid >> 2) + 32 * (wid & 3) + r32;
#pragma unroll
        for (int i = 0; i < 4; ++i)
#pragma unroll
            for (int r = 0; r < 16; ++r) mx[(32 * i + crow(r, hi)) * 256 + c] = acc[i][r];
    }
    __syncthreads();
    {
        const f32x4 g0 = *(const f32x4*)(vg + g * GDIM + cc * 8), g1 = *(const f32x4*)(vg + g * GDIM + cc * 8 + 4);
        float bb[8];
#pragma unroll
        for (int i = 0; i < 8; ++i) bb[i] = b_s[g * CHUNK + (tid >> 5) + 16 * i];
#pragma unroll
        for (int i = 0; i < 8; ++i) { const int t = (tid >> 5) + 16 * i;
            const f32x4 m0 = *(const LAS f32x4*)(lds + (t * 256 + cc * 8) * 4), m1 = *(const LAS f32x4*)(lds + (t * 256 + cc * 8 + 4) * 4);
            float y[8];
            y[0] = bf_lo(uu[i].x) * (m0[0] * g0[0] + bb[i]); y[1] = bf_hi(uu[i].x) * (m0[1] * g0[1] + bb[i]);
            y[2] = bf_lo(uu[i].y) * (m0[2] * g0[2] + bb[i]); y[3] = bf_hi(uu[i].y) * (m0[3] * g0[3] + bb[i]);
            y[4] = bf_lo(uu[i].z) * (m1[0] * g1[0] + bb[i]); y[5] = bf_hi(uu[i].z) * (m1[1] * g1[1] + bb[i]);
            y[6] = bf_lo(uu[i].w) * (m1[2] * g1[2] + bb[i]); y[7] = bf_hi(uu[i].w) * (m1[3] * g1[3] + bb[i]);
            u32x4 w; w.x = pk_bf16(y[0], y[1]); w.y = pk_bf16(y[2], y[3]); w.z = pk_bf16(y[4], y[5]); w.w = pk_bf16(y[6], y[7]);
            *(u32x4*)(Y + (row0 + t) * GW + g * GDIM + cc * 8) = w; }
    }
    __syncthreads();
}

__device__ __forceinline__ float wave_sum(float v) {
#pragma unroll
    for (int o = 1; o < 64; o <<= 1) v += __shfl_xor(v, o);
    return v;
}
__device__ __forceinline__ void tr_load(const float* __restrict__ W, int N, int item, int lane, f32x4 (&wv)[16]) {
    const int nblk = N / 64, k0 = 64 * (item / nblk), n0 = 64 * (item % nblk);
#pragma unroll
    for (int i = 0; i < 16; ++i) wv[i] = __builtin_nontemporal_load((const f32x4*)(W + (size_t)(k0 + 4 * i + (lane >> 4)) * N + n0 + 4 * (lane & 15)));
}
__device__ __forceinline__ void tr_to_lds(LAS float* scr, int lane, const f32x4 (&wv)[16]) {
#pragma unroll
    for (int i = 0; i < 16; ++i) { const int kk = 4 * i + (lane >> 4), nn = 4 * (lane & 15);
        LAS float* s = scr + kk * 65 + nn; s[0] = wv[i][0]; s[1] = wv[i][1]; s[2] = wv[i][2]; s[3] = wv[i][3]; }
    asm volatile("s_waitcnt lgkmcnt(0)" ::: "memory");
}
__device__ __forceinline__ void tr_store(int K, int N, bf16_t* __restrict__ WT, const LAS float* scr, int item, int lane, const float* __restrict__ gk, bool gmlp_perm) {
    const int nblk = N / 64, k0 = 64 * (item / nblk), n0 = 64 * (item % nblk);
    int r0 = n0;
    if (gmlp_perm) {
        if (n0 < GW) { const int cb = n0 >> 7; r0 = 256 * (3 * (cb >> 1) + (cb & 1)) + (n0 & 127); }
        else if (n0 < 2 * GW) { const int mv = n0 - GW; r0 = 256 * (3 * (mv >> 8) + 2) + (mv & 255); }
        else { const int mz = n0 - 2 * GW, cb = mz >> 7; r0 = 256 * (3 * (cb >> 1) + (cb & 1)) + 128 + (mz & 127); }
    }
    const int c = lane & 7;
    f32x4 ga = {1.f, 1.f, 1.f, 1.f}, gb = {1.f, 1.f, 1.f, 1.f};
    if (gk) { ga = *(const f32x4*)(gk + k0 + 8 * c); gb = *(const f32x4*)(gk + k0 + 8 * c + 4); }
#pragma unroll
    for (int j = 0; j < 8; ++j) { const int nn = (lane >> 3) + 8 * j; const LAS float* s = scr + (8 * c) * 65 + nn;
        u32x4 o; o.x = pk_bf16(s[0] * ga[0], s[65] * ga[1]); o.y = pk_bf16(s[2 * 65] * ga[2], s[3 * 65] * ga[3]); o.z = pk_bf16(s[4 * 65] * gb[0], s[5 * 65] * gb[1]); o.w = pk_bf16(s[6 * 65] * gb[2], s[7 * 65] * gb[3]);
        *(u32x4*)(WT + (size_t)(r0 + nn) * K + k0 + 8 * c) = o; }
    asm volatile("s_waitcnt lgkmcnt(0)" ::: "memory");
}
__device__ __forceinline__ void transpose_matrix(const float* __restrict__ W, int K, int N, bf16_t* __restrict__ WT, LAS float* scr, int first, int stride, int nitems, int lane,
                                                 const float* __restrict__ gk = nullptr, bool gmlp_perm = false) {
    f32x4 wv[16], wn[16];
    int it = first;
    if (it < nitems) tr_load(W, N, it, lane, wv);
    while (it < nitems) {
        const int nx = it + stride;
        tr_to_lds(scr, lane, wv);
        if (nx < nitems) tr_load(W, N, nx, lane, wn);
        tr_store(K, N, WT, scr, it, lane, gk, gmlp_perm);
#pragma unroll
        for (int i = 0; i < 16; ++i) wv[i] = wn[i];
        it = nx;
    }
}

#define XB_TMO      128
#define XB_XCNT(j)  (256  + 64 * (j))
#define XB_XSUB(j)  (1280 + 64 * (j))
#define XB_XGEN(j)  (2304 + 64 * (j))
#define XB_TOP      3328
#define XB_TOPGEN   3392
#define XCD_BAR_WORDS 3456
#define XB_SPIN_CAP (1u << 18)

__device__ __forceinline__ unsigned xb_ld(unsigned* p)              { return __hip_atomic_load(p, __ATOMIC_RELAXED, __HIP_MEMORY_SCOPE_AGENT); }
__device__ __forceinline__ unsigned xb_add(unsigned* p, unsigned v) { return __hip_atomic_fetch_add(p, v, __ATOMIC_RELAXED, __HIP_MEMORY_SCOPE_AGENT); }
__device__ __forceinline__ unsigned xb_xcc_id() { return (unsigned)__builtin_amdgcn_s_getreg((3 << 11) | 20) & 0xFu; }
#define XB_SPIN(cond, bar) do { unsigned _sp = 0; while (cond) { __builtin_amdgcn_s_sleep(1); \
    if ((++_sp & 255u) == 0u) { if (xb_ld(&(bar)[XB_TMO])) break; if (_sp > XB_SPIN_CAP) { atomicAdd(&(bar)[XB_TMO], 1u); break; } } } } while (0)

struct XcdBarrier {
    unsigned* bar; unsigned x; int w;
    volatile LAS unsigned* st;
};

__device__ __forceinline__ XcdBarrier xcd_barrier_post(unsigned* bar, volatile LAS unsigned* st, int wave) {
    XcdBarrier b; b.bar = bar; b.x = xb_xcc_id(); b.st = st; b.w = wave;
    if (tid_of(wave) == 0) (void)xb_add(&bar[XB_XCNT(b.x)], 1u);
    return b;
}
__device__ __forceinline__ void xcd_barrier_complete(unsigned* bar, unsigned x, unsigned& nloc, unsigned& nx) {
    const unsigned G = gridDim.x * gridDim.y * gridDim.z;
    unsigned sum, cnt, mine, sp = 0u;
    for (;;) {
        sum = 0u; cnt = 0u; mine = 0u;
#pragma unroll
        for (unsigned j = 0; j < 16; ++j) { const unsigned c = xb_ld(&bar[XB_XCNT(j)]); sum += c; cnt += (c > 0u) ? 1u : 0u; mine = (j == x) ? c : mine; }
        if (sum == G) break;
        __builtin_amdgcn_s_sleep(1);
        if ((++sp & 255u) == 0u) { if (xb_ld(&bar[XB_TMO])) break; if (sp > XB_SPIN_CAP) { atomicAdd(&bar[XB_TMO], 1u); break; } }
    }
    nloc = mine > 0u ? mine : 1u; nx = cnt > 0u ? cnt : 1u;
}

__device__ __forceinline__ void xcd_barrier(const XcdBarrier& b) {
    asm volatile("s_waitcnt vmcnt(0)" ::: "memory");
    __syncthreads();
    if (tid_of(b.w) == 0) {
        unsigned* bar = b.bar;
        __builtin_amdgcn_s_waitcnt(0);
        unsigned nloc = b.st[0], nx = b.st[1];
        if (nloc == 0u) { xcd_barrier_complete(bar, b.x, nloc, nx); b.st[0] = nloc; b.st[1] = nx; }
        const unsigned old = xb_add(&bar[XB_XSUB(b.x)], 1u);
        const unsigned gen = old / nloc;
        if (old + 1u == (gen + 1u) * nloc) {
            __builtin_amdgcn_fence(__ATOMIC_RELEASE, "agent");
            asm volatile("s_waitcnt vmcnt(0)" ::: "memory");
            const unsigned og = xb_add(&bar[XB_TOP], 1u);
            const unsigned tg = og / nx;
            if (og + 1u == (tg + 1u) * nx) xb_add(&bar[XB_TOPGEN], 1u);
            else XB_SPIN(xb_ld(&bar[XB_TOPGEN]) == tg, bar);
            __builtin_amdgcn_fence(__ATOMIC_ACQUIRE, "agent");
            xb_add(&bar[XB_XGEN(b.x)], 1u);
            asm volatile("s_waitcnt vmcnt(0)" ::: "memory");
        } else {
            XB_SPIN(xb_ld(&bar[XB_XGEN(b.x)]) == gen, bar);
            __builtin_amdgcn_fence(__ATOMIC_ACQUIRE, "agent");
            asm volatile("s_waitcnt vmcnt(0)" ::: "memory");
        }
    }
    __syncthreads();
}

constexpr size_t MiB = 1u << 20;
constexpr size_t WS_VSS = 0, WS_HSS1 = 2 * MiB, WS_HSS2 = 3 * MiB, WS_IRS0 = 3 * MiB + 32768, WS_CNT = 3 * MiB + 65536;
constexpr size_t WS_WT1 = 4 * MiB, WS_HN0 = 268 * MiB  , WS_WT2 = 84 * MiB, WS_WT3 = 100 * MiB, WS_WT4 = 132 * MiB;
constexpr size_t WS_U = 140 * MiB, WS_V = 204 * MiB, WS_ZS = 268 * MiB, WS_CTL = 364 * MiB, CTL_ZERO_BYTES = 32768, WS_END = 365 * MiB;
constexpr size_t WS_Y = 4 * MiB;
constexpr size_t WS_H1 = 140 * MiB, WS_H1B = 332 * MiB;
constexpr size_t WS_Q = 204 * MiB, WS_K = 236 * MiB, WS_V2 = 268 * MiB, WS_ZS2 = 300 * MiB, WS_OG = 4 * MiB;

constexpr int NWAVES = 8, LDS_BYTES = 151552;
#ifndef N_LAUNCHES
#define N_LAUNCHES 1
#endif
constexpr int N_PHASES = 7;
#ifndef CONV_TRIGGER
#define CONV_TRIGGER ((bx >> 3) % 6)
#endif
#ifndef GEMM_SP2
#define GEMM_SP2 true
#endif
#ifndef GEMM_ALIGN
#define GEMM_ALIGN true
#endif
#ifndef REPEAT_PHASE
#define REPEAT_PHASE -1
#endif
#define NREP(k) ((REPEAT_PHASE == (k)) ? 2 : 1)

struct Args { const float* in[10]; float* out; unsigned char* ws; int ph_lo, ph_hi, li, pad; };

__global__ void __launch_bounds__(NWAVES * 64, 2) fwd_kernel(Args a) {
    extern __shared__ __attribute__((aligned(16))) unsigned char lds_raw[];
    LAS unsigned char* lds = (LAS unsigned char*)lds_raw;
    cg::grid_group grid = cg::this_grid();
    const int wave = __builtin_amdgcn_readfirstlane(threadIdx.x >> 6);
#define tid tid_of(wave)
#define lane lane_id()
    const int G = gridDim.x, bx = blockIdx.x;
    const int vcu = (G % 8 == 0) ? (bx % 8) * (G / 8) + bx / 8 : bx;
    const float* x = a.in[0]; const float* norm_g = a.in[1]; const float* a_w_in = a.in[2]; const float* a_vg = a.in[3]; const float* a_w_s = a.in[4];
    const float* a_b_s = a.in[5]; const float* a_w_out = a.in[6]; const float* b_w_in = a.in[7]; const float* b_w_out = a.in[8]; const float* final_g = a.in[9];
    unsigned char* ws = a.ws;
    float* VSS = (float*)(ws + WS_VSS); float* HSS1 = (float*)(ws + WS_HSS1); float* HSS2 = (float*)(ws + WS_HSS2); float* IRS0 = (float*)(ws + WS_IRS0); unsigned* CNT = (unsigned*)(ws + WS_CNT);
    bf16_t* WT1 = (bf16_t*)(ws + WS_WT1); bf16_t* WT2 = (bf16_t*)(ws + WS_WT2); bf16_t* WT3 = (bf16_t*)(ws + WS_WT3); bf16_t* WT4 = (bf16_t*)(ws + WS_WT4);
    bf16_t* HN0 = (bf16_t*)(ws + WS_HN0); bf16_t* U = (bf16_t*)(ws + WS_U); bf16_t* V = (bf16_t*)(ws + WS_V); bf16_t* ZS = (bf16_t*)(ws + WS_ZS);
    bf16_t* Y = (bf16_t*)(ws + WS_Y); bf16_t* H1B = (bf16_t*)(ws + WS_H1B);
    bf16_t* Qb = (bf16_t*)(ws + WS_Q); bf16_t* Kb = (bf16_t*)(ws + WS_K); bf16_t* V2 = (bf16_t*)(ws + WS_V2); bf16_t* ZS2 = (bf16_t*)(ws + WS_ZS2); bf16_t* OG = (bf16_t*)(ws + WS_OG);
    const int lo = a.ph_lo, hi = a.ph_hi;
#define IN(k) (lo <= (k) && (k) < hi)
#define SEAM(k) do { if (IN(k) && IN((k) + 1)) xcd_barrier(bar); } while (0)
    volatile LAS unsigned* MISC = (volatile LAS unsigned*)(lds + LDS_BYTES - 64);
    if (tid < 16) MISC[tid] = 0u;
    __syncthreads();
    XcdBarrier bar = xcd_barrier_post((unsigned*)(ws + WS_CTL) + a.li * XCD_BAR_WORDS, MISC + 8, wave);
    if (lo > 1000) grid.sync();
    const int gw = vcu * NWAVES + wave, NGW = G * NWAVES;

    if (IN(0)) for (int rep = 0; rep < NREP(0); ++rep) {
        LAS float* scr = (LAS float*)(lds + wave * 16640);
        constexpr int I1 = (DM / 64) * (3 * GW / 64), I2 = (GW / 64) * (DM / 64), I3 = (DM / 64) * (4 * DM / 64), I4 = (DM / 64) * (DM / 64);
        transpose_matrix(a_w_in, DM, 3 * GW, WT1, scr, gw, NGW, I1, lane, norm_g, true);
        for (int m = bx * (NWAVES * 64) + tid; m < NTOK; m += G * NWAVES * 64) { HSS1[m] = 0.f; HSS2[m] = 0.f; if (m < 2048) CNT[m] = 0u; }
        for (int m = gw; m < NTOK; m += 2 * NGW) {
            const int m2 = m + NGW; const bool two = m2 < NTOK;
            const f32x4* xr = (const f32x4*)(x + (size_t)m * DM) + lane; const f32x4* xr2 = (const f32x4*)(x + (size_t)(two ? m2 : m) * DM) + lane;
            f32x4 v[8], v2[8]; float ss = 0.f, ss2 = 0.f;
#pragma unroll
            for (int j = 0; j < 8; ++j) { v[j] = __builtin_nontemporal_load(xr + 64 * j); v2[j] = __builtin_nontemporal_load(xr2 + 64 * j); }
#pragma unroll
            for (int j = 0; j < 8; ++j) { ss += (v[j][0] * v[j][0] + v[j][1] * v[j][1]) + (v[j][2] * v[j][2] + v[j][3] * v[j][3]); ss2 += (v2[j][0] * v2[j][0] + v2[j][1] * v2[j][1]) + (v2[j][2] * v2[j][2] + v2[j][3] * v2[j][3]); }
            const float ms = wave_sum(ss) * (1.0f / DM) + EPS, ms2 = wave_sum(ss2) * (1.0f / DM) + EPS;
            const float rstd = __builtin_amdgcn_rsqf(ms), rstd2 = __builtin_amdgcn_rsqf(ms2);
            if (lane == 0) { IRS0[m] = __builtin_amdgcn_sqrtf(ms); if (two) IRS0[m2] = __builtin_amdgcn_sqrtf(ms2); }
            u32x2* o8 = (u32x2*)(HN0 + (size_t)m * DM) + lane; u32x2* o82 = (u32x2*)(HN0 + (size_t)m2 * DM) + lane;
#pragma unroll
            for (int j = 0; j < 8; ++j) {
                u32x2 w; w.x = pk_bf16(v[j][0] * rstd, v[j][1] * rstd); w.y = pk_bf16(v[j][2] * rstd, v[j][3] * rstd); o8[64 * j] = w;
                if (two) { u32x2 w2; w2.x = pk_bf16(v2[j][0] * rstd2, v2[j][1] * rstd2); w2.y = pk_bf16(v2[j][2] * rstd2, v2[j][3] * rstd2); o82[64 * j] = w2; } }
        }
    }
    SEAM(0);
#ifdef EXTRA_SYNCS
    for (int i = 0; i < EXTRA_SYNCS; ++i) xcd_barrier(bar);
#endif
    if (IN(1)) for (int rep = 0; rep < NREP(1); ++rep) {
        pg8::Gemm g{HN0, WT1, NTOK, 3 * GW, DM}; pg8::ConvOrder S; S.init(NTOK, 3 * GW, G, bx);
        S.w2 = a_w_out; S.w3 = b_w_in; S.w4 = b_w_out; S.g1 = norm_g + DM; S.t2 = WT2; S.t3 = WT3; S.t4 = WT4; S.gw = gw; S.ngw = NGW; S.trigger = (G == 256) ? CONV_TRIGGER : 0; S.ln = lane; S.sw = lds + 131072 + wave * 2048; S.n_done = 0;
        pg8::EpiGmlpIn E{U, V, VSS};
        pg8::gemm_phase<pg8::EpiGmlpIn, pg8::ConvOrder, GEMM_ALIGN, GEMM_SP2>(lds, g, S, E, wave);
    }
    SEAM(1);
    if (IN(2)) for (int rep = 0; rep < NREP(2); ++rep) {
        for (int it = vcu; it < (NTOK / CHUNK) * NGRP; it += G) mix_unit(lds, wave, it >> 4, it & 15, U, V, VSS, a_w_s, a_b_s, a_vg, Y);
    }
    SEAM(2);
    if (IN(3)) for (int rep = 0; rep < NREP(3); ++rep) {
        pg8::Gemm g{Y, WT2, NTOK, DM, GW}; pg8::StaticOrder S; S.init(NTOK, DM, G, bx);
        pg8::EpiRes1 E{HN0, IRS0, H1B, HSS1};
        pg8::gemm_phase<pg8::EpiRes1, pg8::StaticOrder, GEMM_ALIGN, GEMM_SP2>(lds, g, S, E, wave);
    }
    SEAM(3);
    if (IN(4)) for (int rep = 0; rep < NREP(4); ++rep) {
        pg8::Gemm g{H1B, WT3, NTOK, 4 * DM, DM}; pg8::StaticOrder S; S.init(NTOK, 4 * DM, G, bx);
        pg8::EpiSbIn E{Qb, (size_t)(WS_K - WS_Q) / 2, HSS1};
        pg8::gemm_phase<pg8::EpiSbIn, pg8::StaticOrder, GEMM_ALIGN, GEMM_SP2>(lds, g, S, E, wave);
    }
    SEAM(4);
    if (IN(5)) for (int rep = 0; rep < NREP(5); ++rep) attn_phase(lds, wave, vcu, G, Qb, Kb, V2, ZS2, OG);
    SEAM(5);
    if (IN(6)) for (int rep = 0; rep < NREP(6); ++rep) {
        pg8::Gemm g{OG, WT4, NTOK, DM, DM}; pg8::StaticOrder S; S.init(NTOK, DM, G, bx);
        pg8::EpiFinal E{H1B, final_g, a.out, HSS2, CNT, G == 256};
        pg8::gemm_phase<pg8::EpiFinal, pg8::StaticOrder, GEMM_ALIGN, GEMM_SP2>(lds, g, S, E, wave);
    }
    if (IN(6) && G != 256) {
        xcd_barrier(bar);
        for (int m = gw; m < NTOK; m += NGW) {
            const float rstd = __builtin_amdgcn_rsqf(HSS2[m] * (1.0f / DM) + EPS);
            f32x4* orow = (f32x4*)(a.out + (size_t)m * DM) + lane; const f32x4* gr = (const f32x4*)final_g + lane;
#pragma unroll
            for (int j = 0; j < 8; ++j) { const f32x4 v = orow[64 * j]; orow[64 * j] = v * rstd * gr[64 * j]; }
        }
    }
#undef IN
#undef SEAM
#undef tid
#undef lane
}

extern "C" void kernel_launch(void* const* d_in, const int* in_sizes, int n_in, void* d_out, int out_size, void* d_ws, size_t ws_size, hipStream_t stream) {
    static int grid = 0;
    if (grid == 0) {
        if (n_in != 10 || out_size != NTOK * DM || ws_size < WS_END) { fprintf(stderr, "kernel_launch: unexpected shapes (n_in %d, out %d, ws %zu)\n", n_in, out_size, ws_size); grid = -1; return; }
        int dev = 0, cus = 0, per_cu = 0;
        (void)hipGetDevice(&dev); (void)hipDeviceGetAttribute(&cus, hipDeviceAttributeMultiprocessorCount, dev);
        if (hipFuncSetAttribute((const void*)fwd_kernel, hipFuncAttributeMaxDynamicSharedMemorySize, LDS_BYTES) != hipSuccess) { fprintf(stderr, "kernel_launch: hipFuncSetAttribute failed\n"); grid = -1; return; }
        if (hipOccupancyMaxActiveBlocksPerMultiprocessor(&per_cu, (const void*)fwd_kernel, NWAVES * 64, LDS_BYTES) != hipSuccess || per_cu < 1) { fprintf(stderr, "kernel_launch: occupancy query says %d\n", per_cu); per_cu = 1; }
        (void)hipGetLastError();
        grid = cus > 0 ? cus : 256;
    }
    if (grid < 0) return;
    if (hipMemsetAsync((char*)d_ws + WS_CTL, 0, CTL_ZERO_BYTES, stream) != hipSuccess) { fprintf(stderr, "kernel_launch: memset failed\n"); return; }
    Args a{};
    for (int i = 0; i < 10; ++i) a.in[i] = (const float*)d_in[i];
    a.out = (float*)d_out; a.ws = (unsigned char*)d_ws;
#ifdef PROBE_SPLIT
    const int nl = 2;
#else
    const int nl = N_LAUNCHES;
#endif
    for (int li = 0; li < nl; ++li) {
        a.ph_lo = (N_LAUNCHES == 1) ? 0 : li; a.ph_hi = (N_LAUNCHES == 1) ? N_PHASES : li + 1;
#ifdef PROBE_SPLIT
        a.ph_lo = li == 0 ? 0 : PROBE_SPLIT; a.ph_hi = li == 0 ? PROBE_SPLIT + 1 : N_PHASES;
#endif
        a.li = li;
        void* args[] = {&a};
        hipError_t e = hipLaunchCooperativeKernel((const void*)fwd_kernel, dim3(grid), dim3(NWAVES * 64), args, LDS_BYTES, stream);
        if (e != hipSuccess) { fprintf(stderr, "kernel_launch: cooperative launch %d failed: %s (grid %d)\n", li, hipGetErrorString(e), grid); break; }
    }
}
```

```cpp
#include <hip/hip_runtime.h>
#include <hip/hip_cooperative_groups.h>
#include <cstdio>
#include <cstdint>
namespace cg = cooperative_groups;
__device__ __forceinline__ int lane_id() { return (int)__builtin_amdgcn_mbcnt_hi(~0u, __builtin_amdgcn_mbcnt_lo(~0u, 0u)); }
__device__ __forceinline__ int tid_of(int wave) { return wave * 64 + lane_id(); }
#ifndef PG8_WGM
#define PG8_WGM 8
#endif
namespace pg8 {
#define PG8_LAS __attribute__((address_space(3)))
typedef unsigned short bf16_t;
typedef short bf16x8 __attribute__((ext_vector_type(8)));
typedef float f32x4 __attribute__((ext_vector_type(4)));
typedef unsigned u32x4 __attribute__((ext_vector_type(4)));
constexpr int BM = 256, BK = 64, HALF = 128, HTB = HALF * BK * 2  , STAGE_BYTES = 8 * HTB, NXCD = 8, WGM = PG8_WGM;

__host__ __device__ __forceinline__ int lds_byte(int r, int c) { const int st = (r >> 4) * 2 + (c >> 5), rr = r & 15, cc = c & 31, ob = rr * 64 + cc * 2; return st * 1024 + (ob ^ (((ob >> 9) & 1) << 5)); }
__host__ __device__ __forceinline__ void stage_rc(int b, int& R, int& C) { const int st = b / 1024, sb = b % 1024, swz = sb ^ (((sb >> 9) & 1) << 5); R = (st >> 1) * 16 + swz / 64; C = (st & 1) * 32 + (swz % 64) / 2; }
__host__ __device__ __forceinline__ int perm32(int rho) { const int n = rho >> 4, i = rho & 15; return 8 * (i >> 2) + 4 * n + (i & 3); }

struct Unit { int pm, pn; };
struct Gemm { const bf16_t* A; const bf16_t* Bt; int M, N, K; };

struct StaticOrder {
    int nM, nN, nwg, G, c;
    __host__ __device__ void init(int M, int N, int G_, int c_) { nM = M / BM; nN = N / BM; nwg = nM * nN; G = G_; c = c_; }
    __host__ __device__ bool next(int i, Unit& u) const {
        const long L = (long)i * G + c; if (L >= nwg) return false;
        int wgid = (int)L; { const int q = nwg / NXCD, r = nwg % NXCD, xcd = wgid % NXCD, off = wgid / NXCD; wgid = (xcd < r ? xcd * (q + 1) : r * (q + 1) + (xcd - r) * q) + off; }
        const int nig = WGM * nN, gid = wgid / nig, fm = gid * WGM, gsz = (nM - fm) < WGM ? (nM - fm) : WGM;
        u.pm = fm + ((wgid % nig) % gsz); u.pn = (wgid % nig) / gsz; return true;
    }
    __device__ __forceinline__ void a_ready(const Unit&) const {}
    __device__ __forceinline__ void done(const Unit&) const {}
};

__device__ __forceinline__ unsigned cvt_pk_bf16(float lo, float hi) { unsigned r; asm volatile("v_cvt_pk_bf16_f32 %0, %1, %2" : "=v"(r) : "v"(lo), "v"(hi)); return r; }
typedef float f32x2 __attribute__((ext_vector_type(2)));
typedef float f32x2 __attribute__((ext_vector_type(2)));
template <class Epi, class Sched, bool ALIGN_EPI = false, bool SP2 = false>
__device__ __forceinline__ void gemm_phase(PG8_LAS unsigned char* lds, const Gemm g, const Sched& S, const Epi& E, const int wave_) {
    const int tid = tid_of(wave_), wid = wave_, lane = tid & 63, wr = wid >> 2, wc = wid & 3, fr = lane & 15, fq = lane >> 4;
    const int K = g.K, nt = K / BK;
    unsigned voffA[2], voffB[2];
#pragma unroll
    for (int i = 0; i < 2; ++i) { int R, C; stage_rc(tid * 16 + i * 8192, R, C); const int Rb = Epi::PERM ? ((R & ~31) + perm32(R & 31)) : R;
        voffA[i] = (unsigned)(R * K + C) * 2u; voffB[i] = (unsigned)(Rb * K + C) * 2u; }
    const size_t kstep = (size_t)(BK * 2);
    const size_t hstep = (size_t)HALF * K * 2;
    const size_t tstep = 2 * hstep;
    const unsigned ldsw = (unsigned)wid * 1024u;
    const int aoff = lds_byte(wr * 64 + fr, fq * 8), boff = lds_byte(wc * 32 + fr, fq * 8);
#define PG8_SA(b, h) (((b) * 2 + (h)) * HTB)
#define PG8_SB(b, h) ((4 + (b) * 2 + (h)) * HTB)
#define PG8_STAGE(bufoff, gbase, voff) do { _Pragma("unroll") for (int _i = 0; _i < 2; ++_i) \
        __builtin_amdgcn_global_load_lds((const unsigned*)((const char*)(gbase) + (voff)[_i]), (PG8_LAS unsigned*)(lds + (bufoff) + ldsw + _i * 8192), 16, 0, 0); } while (0)
#define PG8_LDA(dst, b, h) do { _Pragma("unroll") for (int m = 0; m < 4; ++m) _Pragma("unroll") for (int k = 0; k < 2; ++k) dst[m][k] = *(const PG8_LAS bf16x8*)(lds + PG8_SA(b, h) + aoff + m * 2048 + k * 1024); } while (0)
#define PG8_LDB(dst, b, h) do { _Pragma("unroll") for (int n = 0; n < 2; ++n) _Pragma("unroll") for (int k = 0; k < 2; ++k) dst[n][k] = *(const PG8_LAS bf16x8*)(lds + PG8_SB(b, h) + boff + n * 2048 + k * 1024); } while (0)
#define PG8_MMA(ai, bj, At, Bt) do { __builtin_amdgcn_s_setprio(1); _Pragma("unroll") for (int m = 0; m < 4; ++m) _Pragma("unroll") for (int n = 0; n < 2; ++n) _Pragma("unroll") for (int k = 0; k < 2; ++k) \
        acc[ai][bj][m][n] = __builtin_amdgcn_mfma_f32_16x16x32_bf16(Bt[n][k], At[m][k], acc[ai][bj][m][n], 0, 0, 0); __builtin_amdgcn_s_setprio(0); } while (0)
#define PG8_WAIT_V(n) asm volatile("s_waitcnt vmcnt(" #n ")" ::: "memory")
#define PG8_WAIT_L(n) asm volatile("s_waitcnt lgkmcnt(" #n ")" ::: "memory")
#define PG8_BAR __builtin_amdgcn_s_barrier()
#define PG8_SCHED __builtin_amdgcn_sched_barrier(0)
    Unit cur, nxt; int ui = 0;
    if (!S.next(0, cur)) return;
    f32x4 acc[2][2][4][2];
#pragma unroll
    for (int a = 0; a < 2; ++a)
#pragma unroll
        for (int b = 0; b < 2; ++b)
#pragma unroll
            for (int m = 0; m < 4; ++m)
#pragma unroll
                for (int n = 0; n < 2; ++n) acc[a][b][m][n] = (f32x4){0.f, 0.f, 0.f, 0.f};
    bf16x8 At[4][2], B0[2][2], B1[2][2];
    const char* cA = (const char*)g.A + (size_t)cur.pm * tstep; const char* cB = (const char*)g.Bt + (size_t)cur.pn * tstep;
    S.a_ready(cur);
    if constexpr (SP2) {
        PG8_STAGE(PG8_SB(0, 0), cB, voffB); PG8_STAGE(PG8_SB(0, 1), cB + hstep, voffB); PG8_STAGE(PG8_SA(0, 0), cA, voffA); PG8_STAGE(PG8_SA(0, 1), cA + hstep, voffA);
        if (wr == 1) PG8_BAR;
        PG8_WAIT_V(2); PG8_BAR;
        PG8_STAGE(PG8_SB(1, 0), cB + kstep, voffB); PG8_STAGE(PG8_SA(1, 0), cA + kstep, voffA); PG8_STAGE(PG8_SB(1, 1), cB + hstep + kstep, voffB);
        PG8_WAIT_V(6); PG8_BAR;
    } else {
        PG8_STAGE(PG8_SB(0, 0), cB, voffB); PG8_STAGE(PG8_SA(0, 0), cA, voffA); PG8_STAGE(PG8_SB(0, 1), cB + hstep, voffB); PG8_STAGE(PG8_SA(0, 1), cA + hstep, voffA);
        if (wr == 1) PG8_BAR;
        PG8_WAIT_V(4); PG8_BAR;
        PG8_STAGE(PG8_SB(1, 0), cB + kstep, voffB); PG8_STAGE(PG8_SA(1, 0), cA + kstep, voffA); PG8_STAGE(PG8_SB(1, 1), cB + hstep + kstep, voffB);
        PG8_WAIT_V(6); PG8_BAR;
    }
    for (;;) {
        const bool has_next = S.next(ui + 1, nxt);
        const char* nA = has_next ? (const char*)g.A + (size_t)nxt.pm * tstep : cA; const char* nB = has_next ? (const char*)g.Bt + (size_t)nxt.pn * tstep : cB;
        for (int t = 0; t < nt; t += 2) {
            const bool last = (t == nt - 2);
            const char* a1 = cA + (size_t)(t + 1) * kstep;
            const char* a2 = last ? nA : cA + (size_t)(t + 2) * kstep; const char* b2 = last ? nB : cB + (size_t)(t + 2) * kstep;
            const char* a3 = a2 + kstep; const char* b3 = b2 + kstep;
            if (last && has_next) S.a_ready(nxt);
            if constexpr (SP2) {
            PG8_LDB(B0, 0, 0); PG8_LDB(B1, 0, 1); PG8_SCHED; PG8_LDA(At, 0, 0); PG8_STAGE(PG8_SA(1, 1), a1 + hstep, voffA);
            PG8_WAIT_V(8); PG8_WAIT_L(0); PG8_BAR; PG8_MMA(0, 0, At, B0); PG8_MMA(0, 1, At, B1); PG8_BAR; PG8_SCHED;
            PG8_LDA(At, 0, 1); PG8_STAGE(PG8_SB(0, 0), b2, voffB); PG8_STAGE(PG8_SB(0, 1), b2 + hstep, voffB); PG8_STAGE(PG8_SA(0, 0), a2, voffA);
            PG8_WAIT_V(8); PG8_WAIT_L(0); PG8_BAR; PG8_MMA(1, 0, At, B0); PG8_MMA(1, 1, At, B1); PG8_BAR; PG8_SCHED;
            PG8_LDB(B0, 1, 0); PG8_LDB(B1, 1, 1); PG8_SCHED; PG8_LDA(At, 1, 0); PG8_STAGE(PG8_SA(0, 1), a2 + hstep, voffA);
            PG8_WAIT_V(8); PG8_WAIT_L(0); PG8_BAR; PG8_MMA(0, 0, At, B0); PG8_MMA(0, 1, At, B1); PG8_BAR; PG8_SCHED;
            PG8_LDA(At, 1, 1); PG8_STAGE(PG8_SB(1, 0), b3, voffB); PG8_STAGE(PG8_SB(1, 1), b3 + hstep, voffB); PG8_STAGE(PG8_SA(1, 0), a3, voffA);
            PG8_WAIT_V(8); PG8_WAIT_L(0); PG8_BAR; PG8_MMA(1, 0, At, B0); PG8_MMA(1, 1, At, B1); PG8_BAR; PG8_SCHED;
            } else {
            PG8_LDB(B0, 0, 0); PG8_SCHED; PG8_LDA(At, 0, 0); PG8_STAGE(PG8_SA(1, 1), a1 + hstep, voffA);
            PG8_WAIT_L(8); PG8_BAR; PG8_WAIT_L(0); PG8_MMA(0, 0, At, B0); PG8_BAR; PG8_SCHED;
            PG8_LDB(B1, 0, 1); PG8_STAGE(PG8_SB(0, 0), b2, voffB);
            PG8_BAR; PG8_WAIT_L(0); PG8_MMA(0, 1, At, B1); PG8_BAR;
            PG8_LDA(At, 0, 1); PG8_STAGE(PG8_SA(0, 0), a2, voffA);
            PG8_BAR; PG8_WAIT_L(0); PG8_MMA(1, 0, At, B0); PG8_BAR; PG8_SCHED;
            PG8_STAGE(PG8_SB(0, 1), b2 + hstep, voffB);
            PG8_WAIT_V(6); PG8_BAR; PG8_MMA(1, 1, At, B1); PG8_BAR;
            PG8_LDB(B0, 1, 0); PG8_SCHED; PG8_LDA(At, 1, 0); PG8_STAGE(PG8_SA(0, 1), a2 + hstep, voffA);
            PG8_WAIT_L(8); PG8_BAR; PG8_WAIT_L(0); PG8_MMA(0, 0, At, B0); PG8_BAR; PG8_SCHED;
            PG8_LDB(B1, 1, 1); PG8_STAGE(PG8_SB(1, 0), b3, voffB);
            PG8_BAR; PG8_WAIT_L(0); PG8_MMA(0, 1, At, B1); PG8_BAR;
            PG8_LDA(At, 1, 1); PG8_STAGE(PG8_SA(1, 0), a3, voffA);
            PG8_BAR; PG8_WAIT_L(0); PG8_MMA(1, 0, At, B0); PG8_BAR; PG8_SCHED;
            PG8_STAGE(PG8_SB(1, 1), b3 + hstep, voffB);
            PG8_WAIT_V(6); PG8_BAR; PG8_MMA(1, 1, At, B1); PG8_BAR;
            }
        }
        if constexpr (ALIGN_EPI) { if (wr == 0) PG8_BAR; }
        if constexpr (!Epi::AFTER_DRAIN) { E(acc, cur, wr, wc, fr, fq); S.done(cur); }
        if (!has_next) break;
#pragma unroll
        for (int a = 0; a < 2; ++a)
#pragma unroll
            for (int b = 0; b < 2; ++b)
#pragma unroll
                for (int m = 0; m < 4; ++m)
#pragma unroll
                    for (int n = 0; n < 2; ++n) acc[a][b][m][n] = (f32x4){0.f, 0.f, 0.f, 0.f};
        cur = nxt; cA = nA; cB = nB; ++ui;
        if constexpr (ALIGN_EPI) { if (wr == 1) PG8_BAR; }
    }
    PG8_WAIT_V(0);
    if constexpr (!ALIGN_EPI) { if (wr == 0) PG8_BAR; }
    PG8_BAR;
    if constexpr (Epi::AFTER_DRAIN) { E.fused(acc, cur, wr, wc, fr, fq, lds, wid, lane); S.done(cur); }
#undef PG8_SA
#undef PG8_SB
#undef PG8_STAGE
#undef PG8_LDA
#undef PG8_LDB
#undef PG8_MMA
#undef PG8_WAIT_V
#undef PG8_WAIT_L
#undef PG8_BAR
#undef PG8_SCHED
}
}

constexpr int DM = 2048, NTOK = 8192, SEQ = 4096, GW = 4096, NGRP = 16, GDIM = 256, CHUNK = 128, NHEAD = 16, HD = 128;
constexpr float EPS = 1e-6f;
constexpr float LOG2E = 1.4426950408889634f;
constexpr float QSCALE = 0.08838834764831845f * LOG2E;

constexpr float GELU_C1 = -1.5957691216057308f * LOG2E, GELU_C2 = -0.07135481627260025f * LOG2E;
__device__ __forceinline__ float gelu_tanh(float x) {
    const float e = __builtin_amdgcn_exp2f(x * __builtin_fmaf(x * x, GELU_C2, GELU_C1));
    return x * __builtin_amdgcn_rcpf(1.0f + e);
}
__device__ __forceinline__ float gelu_silu(float u, float z) {
    const float e1 = __builtin_amdgcn_exp2f(u * __builtin_fmaf(u * u, GELU_C2, GELU_C1));
    const float e2 = __builtin_amdgcn_exp2f(z * -LOG2E);
    return (u * z) * __builtin_amdgcn_rcpf((1.0f + e1) * (1.0f + e2));
}
__device__ __forceinline__ float silu_f(float z) { return z * __builtin_amdgcn_rcpf(1.0f + __builtin_amdgcn_exp2f(-LOG2E * z)); }

namespace pg8 {
typedef unsigned u32x2 __attribute__((ext_vector_type(2)));
__device__ __forceinline__ void conv_load4(const float* __restrict__ W, int N, int item, int lane, f32x4 (&x)[16]) {
    const int nblk = N / 64, k0 = 64 * (item / nblk), n0 = 64 * (item % nblk);
#pragma unroll
    for (int i = 0; i < 16; ++i) x[i] = __builtin_nontemporal_load((const f32x4*)(W + (size_t)(k0 + 4 * i + (lane >> 4)) * N + n0 + 4 * (lane & 15)));
}
__device__ __forceinline__ void conv_xpose(f32x4 (&x)[16], int lane) {
    const bool a = (lane >> 4) & 1, b = (lane >> 5) & 1;
#pragma unroll
    for (int i = 0; i < 16; ++i) {
        f32x4 v = x[i];
        {
            const float s0 = a ? v[0] : v[1], s1 = a ? v[2] : v[3];
            const float r0 = __shfl_xor(s0, 16), r1 = __shfl_xor(s1, 16);
            if (a) { v[0] = r0; v[2] = r1; } else { v[1] = r0; v[3] = r1; }
        }
        {
            const float s0 = b ? v[0] : v[2], s1 = b ? v[1] : v[3];
            const float r0 = __shfl_xor(s0, 32), r1 = __shfl_xor(s1, 32);
            if (b) { v[0] = r0; v[1] = r1; } else { v[2] = r0; v[3] = r1; }
        }
        x[i] = v;
    }
}
__device__ __forceinline__ void conv_store4(int K, int N, bf16_t* __restrict__ WT, int item, int lane, const float* __restrict__ gk, const f32x4 (&x)[16]) {
    const int nblk = N / 64, k0 = 64 * (item / nblk), n0 = 64 * (item % nblk);
    const int n = n0 + 4 * (lane & 15) + (lane >> 4);
#pragma unroll
    for (int kc = 0; kc < 8; ++kc) {
        float g[8];
#pragma unroll
        for (int j = 0; j < 8; ++j) g[j] = gk ? gk[k0 + 8 * kc + j] : 1.0f;
        const f32x4 lo = x[2 * kc], hi = x[2 * kc + 1];
        u32x4 o; o.x = cvt_pk_bf16(lo[0] * g[0], lo[1] * g[1]); o.y = cvt_pk_bf16(lo[2] * g[2], lo[3] * g[3]);
        o.z = cvt_pk_bf16(hi[0] * g[4], hi[1] * g[5]); o.w = cvt_pk_bf16(hi[2] * g[6], hi[3] * g[7]);
        *(u32x4*)(WT + (size_t)n * K + k0 + 8 * kc) = o;
    }
}
__device__ __forceinline__ void conv_store4_lds(int K, int N, bf16_t* __restrict__ WT, int item, int lane, const float* __restrict__ gk, const f32x4 (&x)[16], PG8_LAS unsigned char* sw) {
    const int nblk = N / 64, k0 = 64 * (item / nblk), n0 = 64 * (item % nblk);
    const int nq = lane & 15, r = lane >> 4;
    u32x4 o[8];
#pragma unroll
    for (int kc = 0; kc < 8; ++kc) {
        float g[8];
#pragma unroll
        for (int j = 0; j < 8; ++j) g[j] = gk ? gk[k0 + 8 * kc + j] : 1.0f;
        const f32x4 lo = x[2 * kc], hi = x[2 * kc + 1];
        o[kc].x = cvt_pk_bf16(lo[0] * g[0], lo[1] * g[1]); o[kc].y = cvt_pk_bf16(lo[2] * g[2], lo[3] * g[3]);
        o[kc].z = cvt_pk_bf16(hi[0] * g[4], hi[1] * g[5]); o[kc].w = cvt_pk_bf16(hi[2] * g[6], hi[3] * g[7]);
    }
#pragma unroll
    for (int q = 0; q < 4; ++q) {
        if ((nq >> 2) == q) {
            PG8_LAS u32x4* wp = (PG8_LAS u32x4*)(sw + (4 * (nq & 3) + r) * 128);
#pragma unroll
            for (int kc = 0; kc < 8; ++kc) wp[kc] = o[kc];
        }
        asm volatile("s_waitcnt lgkmcnt(0)" ::: "memory");
#pragma unroll
        for (int h = 0; h < 2; ++h) { const int rl = (lane >> 3) + 8 * h;
            const u32x4 v = *(const PG8_LAS u32x4*)(sw + rl * 128 + (lane & 7) * 16);
            __builtin_nontemporal_store(v, (u32x4*)(WT + (size_t)(n0 + 16 * q + rl) * K + k0 + 8 * (lane & 7))); }
        asm volatile("s_waitcnt lgkmcnt(0)" ::: "memory");
    }
}
struct ConvOrder : StaticOrder {
    const float *w2, *w3, *w4, *g1; bf16_t *t2, *t3, *t4; int gw, ngw, trigger, ln; PG8_LAS unsigned char* sw; mutable int n_done;
    __device__ __forceinline__ void done(const Unit&) const {
        constexpr int I2 = (GW / 64) * (DM / 64), I3 = (DM / 64) * (4 * DM / 64), I4 = (DM / 64) * (DM / 64);
        const int u = n_done++;
#ifdef HOOK_SPREAD
        f32x4 va[16];
        if (u == 0 || u == 1) { for (int it = gw + u * ngw; it < I3; it += 2 * ngw) { conv_load4(w3, 4 * DM, it, ln, va); conv_xpose(va, ln); conv_store4(DM, 4 * DM, t3, it, ln, g1, va); } }
        else if (u == 2) { for (int it = gw; it < I2; it += ngw) { conv_load4(w2, DM, it, ln, va); conv_xpose(va, ln); conv_store4(GW, DM, t2, it, ln, nullptr, va); } }
        else if (u == 3) { for (int it = gw; it < I4; it += ngw) { conv_load4(w4, DM, it, ln, va); conv_xpose(va, ln); conv_store4(DM, DM, t4, it, ln, nullptr, va); } }
#else
        if (u != trigger) return;
        f32x4 va[16], vb[16];
        for (int it = gw; it < I3; it += 2 * ngw) {
            const bool two = it + ngw < I3;
            conv_load4(w3, 4 * DM, it, ln, va); if (two) conv_load4(w3, 4 * DM, it + ngw, ln, vb);
            conv_xpose(va, ln); if (two) conv_xpose(vb, ln);
            conv_store4_lds(DM, 4 * DM, t3, it, ln, g1, va, sw); if (two) conv_store4_lds(DM, 4 * DM, t3, it + ngw, ln, g1, vb, sw);
        }
        for (int it = gw; it < I2; it += ngw) {
            const bool two = it < I4;
            conv_load4(w2, DM, it, ln, va); if (two) conv_load4(w4, DM, it, ln, vb);
            conv_xpose(va, ln); if (two) conv_xpose(vb, ln);
            conv_store4_lds(GW, DM, t2, it, ln, nullptr, va, sw); if (two) conv_store4_lds(DM, DM, t4, it, ln, nullptr, vb, sw);
        }
#endif
    }
};
struct EpiGmlpIn {
    static constexpr bool PERM = true, AFTER_DRAIN = false;
    bf16_t *UZ, *V; float* vss;
    __device__ __forceinline__ void operator()(const f32x4 (&acc)[2][2][4][2], const Unit& u, int wr, int wc, int fr, int fq) const {
        const int row0 = u.pm * BM + wr * 64 + fr;
        const int tq = u.pn / 3, tr = u.pn - 3 * tq;
        if (tr < 2) {
            const int col0 = (2 * tq + tr) * HALF + wc * 32 + 8 * fq;
#pragma unroll
            for (int ai = 0; ai < 2; ++ai)
#pragma unroll
                for (int m = 0; m < 4; ++m) {
                    const int row = row0 + ai * HALF + m * 16;
                    f32x4 v0 = acc[ai][0][m][0], v1 = acc[ai][0][m][1]; const f32x4 z0 = acc[ai][1][m][0], z1 = acc[ai][1][m][1];
#pragma unroll
                    for (int e = 0; e < 4; ++e) { v0[e] = gelu_silu(v0[e], z0[e]); v1[e] = gelu_silu(v1[e], z1[e]); }
                    u32x4 w; w.x = cvt_pk_bf16(v0[0], v0[1]); w.y = cvt_pk_bf16(v0[2], v0[3]); w.z = cvt_pk_bf16(v1[0], v1[1]); w.w = cvt_pk_bf16(v1[2], v1[3]);
                    *(u32x4*)(UZ + (size_t)row * GW + col0) = w;
                }
        } else {
            const int tl = tq, col0 = tl * BM + wc * 32 + 8 * fq;
#pragma unroll
            for (int ai = 0; ai < 2; ++ai)
#pragma unroll
                for (int m = 0; m < 4; ++m) {
                    const int row = row0 + ai * HALF + m * 16;
                    bf16_t* rowp = V + (size_t)row * GW + col0;
                    float ss = 0.f;
#pragma unroll
                    for (int bj = 0; bj < 2; ++bj) {
                        f32x4 v0 = acc[ai][bj][m][0], v1 = acc[ai][bj][m][1];
#pragma unroll
                        for (int e = 0; e < 4; ++e) { v0[e] = gelu_tanh(v0[e]); v1[e] = gelu_tanh(v1[e]); ss += v0[e] * v0[e] + v1[e] * v1[e]; }
                        u32x4 w; w.x = cvt_pk_bf16(v0[0], v0[1]); w.y = cvt_pk_bf16(v0[2], v0[3]); w.z = cvt_pk_bf16(v1[0], v1[1]); w.w = cvt_pk_bf16(v1[2], v1[3]);
                        *(u32x4*)(rowp + bj * HALF) = w;
                    }
                    ss += __shfl_xor(ss, 16); ss += __shfl_xor(ss, 32);
                    if (fq == 0) vss[(size_t)row * 64 + tl * 4 + wc] = ss;
                }
        }
    }
};
struct EpiRes1 {
    static constexpr bool PERM = true, AFTER_DRAIN = false;
    const bf16_t* hn; const float* irs; bf16_t* hb; float* hss;
    __device__ __forceinline__ void operator()(const f32x4 (&acc)[2][2][4][2], const Unit& u, int wr, int wc, int fr, int fq) const {
        const int row0 = u.pm * BM + wr * 64 + fr, col0 = u.pn * BM + wc * 32 + 8 * fq;
        float rs[2][4];
#pragma unroll
        for (int ai = 0; ai < 2; ++ai)
#pragma unroll
            for (int m = 0; m < 4; ++m) rs[ai][m] = irs[row0 + ai * HALF + m * 16];
#pragma unroll
        for (int ai = 0; ai < 2; ++ai) {
            u32x4 xv[4][2];
#pragma unroll
            for (int m = 0; m < 4; ++m)
#pragma unroll
                for (int bj = 0; bj < 2; ++bj) xv[m][bj] = *(const u32x4*)(hn + (size_t)(row0 + ai * HALF + m * 16) * DM + col0 + bj * HALF);
#pragma unroll
            for (int m = 0; m < 4; ++m) {
                const int row = row0 + ai * HALF + m * 16;
                const size_t off = (size_t)row * DM + col0;
                float ss = 0.f;
#pragma unroll
                for (int bj = 0; bj < 2; ++bj) {
                    const u32x4 w4 = xv[m][bj];
                    f32x4 x0, x1;
                    x0[0] = __uint_as_float(w4.x << 16); x0[1] = __uint_as_float(w4.x & 0xffff0000u); x0[2] = __uint_as_float(w4.y << 16); x0[3] = __uint_as_float(w4.y & 0xffff0000u);
                    x1[0] = __uint_as_float(w4.z << 16); x1[1] = __uint_as_float(w4.z & 0xffff0000u); x1[2] = __uint_as_float(w4.w << 16); x1[3] = __uint_as_float(w4.w & 0xffff0000u);
                    const f32x4 h0 = x0 * rs[ai][m] + acc[ai][bj][m][0], h1 = x1 * rs[ai][m] + acc[ai][bj][m][1];
                    ss += ((h0[0] * h0[0] + h0[1] * h0[1]) + (h0[2] * h0[2] + h0[3] * h0[3])) + ((h1[0] * h1[0] + h1[1] * h1[1]) + (h1[2] * h1[2] + h1[3] * h1[3]));
                    u32x4 o; o.x = cvt_pk_bf16(h0[0], h0[1]); o.y = cvt_pk_bf16(h0[2], h0[3]); o.z = cvt_pk_bf16(h1[0], h1[1]); o.w = cvt_pk_bf16(h1[2], h1[3]);
                    *(u32x4*)(hb + off + bj * HALF) = o;
                }
                ss += __shfl_xor(ss, 16); ss += __shfl_xor(ss, 32);
                if (fq == 0) __hip_atomic_fetch_add(hss + row, ss, __ATOMIC_RELAXED, __HIP_MEMORY_SCOPE_AGENT);
            }
        }
    }
};
struct EpiFinal {
    static constexpr bool PERM = true, AFTER_DRAIN = false;
    const bf16_t* hb; const float* fg; float* out; float* hss; unsigned* cnt; bool fused;
    __device__ __forceinline__ void operator()(f32x4 (&acc)[2][2][4][2], const Unit& u, int wr, int wc, int fr, int fq) const {
        const int row0 = u.pm * BM + wr * 64 + fr, col0 = u.pn * BM + wc * 32 + 8 * fq;
#pragma unroll
        for (int ai = 0; ai < 2; ++ai)
#pragma unroll
            for (int m = 0; m < 4; ++m) {
                const int row = row0 + ai * HALF + m * 16;
                const size_t off = (size_t)row * DM + col0;
                float ss = 0.f;
#pragma unroll
                for (int bj = 0; bj < 2; ++bj) {
                    const u32x4 w = *(const u32x4*)(hb + off + bj * HALF);
                    f32x4 h0, h1;
                    h0[0] = __uint_as_float(w.x << 16); h0[1] = __uint_as_float(w.x & 0xffff0000u); h0[2] = __uint_as_float(w.y << 16); h0[3] = __uint_as_float(w.y & 0xffff0000u);
                    h1[0] = __uint_as_float(w.z << 16); h1[1] = __uint_as_float(w.z & 0xffff0000u); h1[2] = __uint_as_float(w.w << 16); h1[3] = __uint_as_float(w.w & 0xffff0000u);
                    h0 += acc[ai][bj][m][0]; h1 += acc[ai][bj][m][1];
                    acc[ai][bj][m][0] = h0; acc[ai][bj][m][1] = h1;
                    ss += ((h0[0] * h0[0] + h0[1] * h0[1]) + (h0[2] * h0[2] + h0[3] * h0[3])) + ((h1[0] * h1[0] + h1[1] * h1[1]) + (h1[2] * h1[2] + h1[3] * h1[3]));
                }
                ss += __shfl_xor(ss, 16); ss += __shfl_xor(ss, 32);
                if (fq == 0) __hip_atomic_fetch_add(hss + row, ss, __ATOMIC_RELAXED, __HIP_MEMORY_SCOPE_AGENT);
            }
        if (!fused) {
#pragma unroll
            for (int ai = 0; ai < 2; ++ai)
#pragma unroll
                for (int m = 0; m < 4; ++m)
#pragma unroll
                    for (int bj = 0; bj < 2; ++bj)
#pragma unroll
                        for (int n = 0; n < 2; ++n) *(f32x4*)(out + (size_t)(row0 + ai * HALF + m * 16) * DM + col0 + bj * HALF + n * 4) = acc[ai][bj][m][n];
            return;
        }
        asm volatile("s_waitcnt vmcnt(0)" ::: "memory");
        unsigned* pc = cnt + 64 * u.pm;
        if (lane_id() == 0) __hip_atomic_fetch_add(pc, 1u, __ATOMIC_RELAXED, __HIP_MEMORY_SCOPE_AGENT);
        for (int it = 0; it < (1 << 22); ++it) {
            if (__hip_atomic_load(pc, __ATOMIC_RELAXED, __HIP_MEMORY_SCOPE_AGENT) >= 64u) break;
            __builtin_amdgcn_s_sleep(2);
        }
        asm volatile("" ::: "memory");
        f32x4 gv[2][2];
#pragma unroll
        for (int bj = 0; bj < 2; ++bj)
#pragma unroll
            for (int n = 0; n < 2; ++n) gv[bj][n] = *(const f32x4*)(fg + col0 + bj * HALF + n * 4);
        float ssr[2][4];
#pragma unroll
        for (int ai = 0; ai < 2; ++ai)
#pragma unroll
            for (int m = 0; m < 4; ++m) ssr[ai][m] = __hip_atomic_load(hss + row0 + ai * HALF + m * 16, __ATOMIC_RELAXED, __HIP_MEMORY_SCOPE_AGENT);
#pragma unroll
        for (int ai = 0; ai < 2; ++ai)
#pragma unroll
            for (int m = 0; m < 4; ++m) {
                const int row = row0 + ai * HALF + m * 16;
                const size_t off = (size_t)row * DM + col0;
                const float rstd = __builtin_amdgcn_rsqf(ssr[ai][m] * (1.0f / DM) + EPS);
#pragma unroll
                for (int bj = 0; bj < 2; ++bj)
#pragma unroll
                    for (int n = 0; n < 2; ++n) *(f32x4*)(out + off + bj * HALF + n * 4) = acc[ai][bj][m][n] * rstd * gv[bj][n];
            }
    }
};
struct EpiSbIn {
    static constexpr bool PERM = true, AFTER_DRAIN = false;
    bf16_t* Q; size_t rstride; const float* hss;
    __device__ __forceinline__ void operator()(const f32x4 (&acc)[2][2][4][2], const Unit& u, int wr, int wc, int fr, int fq) const {
        const int region = u.pn >> 3, tl = u.pn & 7;
        bf16_t* base = Q + (size_t)region * rstride;
        const int row0 = u.pm * BM + wr * 64 + fr, col0 = tl * BM + wc * 32 + 8 * fq;
        float ssr[2][4];
#pragma unroll
        for (int ai = 0; ai < 2; ++ai)
#pragma unroll
            for (int m = 0; m < 4; ++m) ssr[ai][m] = hss[row0 + ai * HALF + m * 16];
#pragma unroll
        for (int ai = 0; ai < 2; ++ai)
#pragma unroll
            for (int m = 0; m < 4; ++m) {
                const int row = row0 + ai * HALF + m * 16;
                float sc = __builtin_amdgcn_rsqf(ssr[ai][m] * (1.0f / DM) + EPS);
                if (region == 0) sc *= QSCALE;
                bf16_t* rowp = base + (size_t)row * DM + col0;
#pragma unroll
                for (int bj = 0; bj < 2; ++bj) {
                    f32x4 v0 = acc[ai][bj][m][0] * sc, v1 = acc[ai][bj][m][1] * sc;
                    if (region == 3) {
#pragma unroll
                        for (int e = 0; e < 4; ++e) { v0[e] = silu_f(v0[e]); v1[e] = silu_f(v1[e]); }
                    }
                    u32x4 w; w.x = cvt_pk_bf16(v0[0], v0[1]); w.y = cvt_pk_bf16(v0[2], v0[3]); w.z = cvt_pk_bf16(v1[0], v1[1]); w.w = cvt_pk_bf16(v1[2], v1[3]);
                    *(u32x4*)(rowp + bj * HALF) = w;
                }
            }
    }
};
}

#define LAS __attribute__((address_space(3)))
typedef unsigned short bf16_t;
typedef short bf16x8 __attribute__((ext_vector_type(8)));
typedef short s16x4 __attribute__((ext_vector_type(4)));
typedef float f32x4 __attribute__((ext_vector_type(4)));
typedef float f32x16 __attribute__((ext_vector_type(16)));
typedef unsigned u32x4 __attribute__((ext_vector_type(4)));
typedef unsigned u32x2 __attribute__((ext_vector_type(2)));
__device__ __forceinline__ unsigned off_b(unsigned row, unsigned ch) { return 256u * row + 16u * (ch ^ (((row & 3u) << 2) | ((row >> 2) & 3u))); }
__device__ __forceinline__ s16x4 vtr(const LAS unsigned char* p) { return __builtin_bit_cast(s16x4, __builtin_amdgcn_ds_read_tr16_b64_v4i16((LAS s16x4*)p)); }
__device__ __forceinline__ unsigned pk_bf16(float lo, float hi) { return pg8::cvt_pk_bf16(lo, hi); }
__device__ __forceinline__ float bf_lo(unsigned w) { return __uint_as_float(w << 16); }
__device__ __forceinline__ float bf_hi(unsigned w) { return __uint_as_float(w & 0xffff0000u); }
__device__ __forceinline__ int crow(int r, int hi) { return (r & 3) + 8 * (r >> 2) + 4 * hi; }

#ifdef ATT_NOSB
#define ATT_SB() do {} while (0)
#else
#ifndef ATT_USE_SB
#define ATT_SB() do {} while (0)
#else
#define ATT_SB() __builtin_amdgcn_sched_barrier(0)
#endif
#endif
#define ATT_VLD(f) do { const int c_ = (f) >> 2, s_ = (f) & 3; const s16x4 lo_ = vtr(vbp + 4096 * s_ + vbase[0] + vcq[c_]); const s16x4 hh_ = vtr(vbp + 4096 * s_ + vbase[1] + vcq[c_]); \
        vf[f] = (bf16x8){lo_[0], lo_[1], lo_[2], lo_[3], hh_[0], hh_[1], hh_[2], hh_[3]}; } while (0)
#define ATT_PV(f) do { if (DO_PV) { o[(f) >> 2] = __builtin_amdgcn_mfma_f32_32x32x16_bf16(pa[(f) & 3], vf[f], o[(f) >> 2], 0, 0, 0); if ((f) + 4 < 16) ATT_VLD((f) + 4); } } while (0)
#define ATT_EXP8(i) do { _Pragma("unroll") for (int r_ = 0; r_ < 8; ++r_) p[(i) >> 1][8 * ((i) & 1) + r_] = __builtin_amdgcn_exp2f(fminf(p[(i) >> 1][8 * ((i) & 1) + r_], 30.f)); } while (0)
#define ATT_LBLK(j) do { const int ph_ = 1 - ((j) >> 2), g_ = 3 - ((j) & 3); \
        const float w0_ = 1.0f + p[ph_][4 * g_], w1_ = 1.0f + p[ph_][4 * g_ + 1], w2_ = 1.0f + p[ph_][4 * g_ + 2], w3_ = 1.0f + p[ph_][4 * g_ + 3]; \
        L[j] = __builtin_amdgcn_logf((w0_ * w1_) * (w2_ * w3_)); } while (0)
#define ATT_XCH(j) do { const float own_ = L[j]; const auto rr_ = __builtin_amdgcn_permlane32_swap(__float_as_uint(own_), __float_as_uint(own_), false, false); \
        const float a0_ = __uint_as_float(rr_[0]), a1_ = __uint_as_float(rr_[1]); const float oth_ = (a0_ == own_) ? a1_ : a0_; \
        T[j] = run + (hi ? 0.f : oth_) + own_; run += a0_ + a1_; } while (0)
#define ATT_WGT(j) do { const int ph_ = 1 - ((j) >> 2), g_ = 3 - ((j) & 3); float cf_ = __builtin_amdgcn_exp2f(-T[j]); \
        _Pragma("unroll") for (int e_ = 0; e_ < 4; ++e_) { const float ev_ = p[ph_][4 * g_ + e_]; p[ph_][4 * g_ + e_] = ev_ * cf_; if (e_ < 3) cf_ *= (1.0f + ev_); } } while (0)

template <bool DO_PV>
__device__ __forceinline__ void attn_tile(const LAS unsigned char* kb, const LAS unsigned char* vbp, const bf16x8 (&qf)[8], f32x16 (&o)[4], bf16x8 (&pa)[4], float& carry,
                                          const unsigned (&koff)[8], const unsigned (&vbase)[2], const unsigned (&vcq)[4], int k0, int qw0, int qabs, int hi) {
    f32x16 p[2];
#pragma unroll
    for (int r = 0; r < 16; ++r) { p[0][r] = 0.f; p[1][r] = 0.f; }
    bf16x8 vf[16];
    if (DO_PV) { ATT_VLD(0); ATT_VLD(1); ATT_VLD(2); ATT_VLD(3); }
    {
        bf16x8 ka[8], kc[8];
#pragma unroll
        for (int d0 = 0; d0 < 8; ++d0) { ka[d0] = *(const LAS bf16x8*)(kb + koff[d0]); kc[d0] = *(const LAS bf16x8*)(kb + 8192 + koff[d0]); }
        ATT_SB();
#pragma unroll
        for (int d0 = 0; d0 < 8; ++d0) {
            p[0] = __builtin_amdgcn_mfma_f32_32x32x16_bf16(ka[d0], qf[d0], p[0], 0, 0, 0);
            p[1] = __builtin_amdgcn_mfma_f32_32x32x16_bf16(kc[d0], qf[d0], p[1], 0, 0, 0);
        }
    }
    ATT_SB();
    const bool need_mask = (k0 + 63 >= qw0);
    float L[8], T[8];
    ATT_PV(0); ATT_EXP8(0); ATT_SB();
    ATT_PV(1); ATT_EXP8(1); ATT_SB();
    ATT_PV(2); ATT_EXP8(2); ATT_SB();
    ATT_PV(3); ATT_EXP8(3); ATT_SB();
    if (need_mask) {
#pragma unroll
        for (int ph = 0; ph < 2; ++ph)
#pragma unroll
            for (int r = 0; r < 16; ++r) { const int key = k0 + 32 * ph + crow(r, hi); if (key >= qabs) p[ph][r] = 0.f; }
    }
    ATT_SB();
    ATT_PV(4); ATT_LBLK(0); ATT_LBLK(1); ATT_SB();
    ATT_PV(5); ATT_LBLK(2); ATT_LBLK(3); ATT_SB();
    ATT_PV(6); ATT_LBLK(4); ATT_LBLK(5); ATT_SB();
    ATT_PV(7); ATT_LBLK(6); ATT_LBLK(7); ATT_SB();
    float run = carry;
    ATT_PV(8); ATT_XCH(0); ATT_XCH(1); ATT_SB();
    ATT_PV(9); ATT_XCH(2); ATT_XCH(3); ATT_SB();
    ATT_PV(10); ATT_XCH(4); ATT_XCH(5); ATT_SB();
    ATT_PV(11); ATT_XCH(6); ATT_XCH(7); ATT_SB();
    carry = run;
    ATT_PV(12); ATT_WGT(0); ATT_WGT(1); ATT_SB();
    ATT_PV(13); ATT_WGT(2); ATT_WGT(3); ATT_SB();
    ATT_PV(14); ATT_WGT(4); ATT_WGT(5); ATT_SB();
    ATT_PV(15); ATT_WGT(6); ATT_WGT(7); ATT_SB();
#pragma unroll
    for (int s = 0; s < 4; ++s) { const int ph = s >> 1, rb = 8 * (s & 1);
        u32x4 w; w.x = pk_bf16(p[ph][rb], p[ph][rb + 1]); w.y = pk_bf16(p[ph][rb + 2], p[ph][rb + 3]); w.z = pk_bf16(p[ph][rb + 4], p[ph][rb + 5]); w.w = pk_bf16(p[ph][rb + 6], p[ph][rb + 7]);
        pa[s] = __builtin_bit_cast(bf16x8, w); }
}

__device__ __forceinline__ void attn_unit(LAS unsigned char* lds, const int wid, int b, int h, int qb, const bf16_t* __restrict__ Q, const bf16_t* __restrict__ K,
                                          const bf16_t* __restrict__ V, const bf16_t* __restrict__ ZS, bf16_t* __restrict__ OG) {
    const int tid = tid_of(wid), lane = tid & 63, r32 = lane & 31, hi = lane >> 5;
    const size_t tok0 = (size_t)b * SEQ;
    const int q0 = qb * 256, qw0 = q0 + 32 * wid, qabs = qw0 + r32;
    bf16x8 qf[8];
    { const bf16_t* qp = Q + (tok0 + qabs) * DM + h * HD + 8 * hi;
#pragma unroll
      for (int d0 = 0; d0 < 8; ++d0) qf[d0] = *(const bf16x8*)(qp + 16 * d0); }
    f32x16 o[4];
#pragma unroll
    for (int c = 0; c < 4; ++c)
#pragma unroll
        for (int r = 0; r < 16; ++r) o[c][r] = 0.f;
    bf16x8 pa[4];
#pragma unroll
    for (int s = 0; s < 4; ++s) pa[s] = (bf16x8){0, 0, 0, 0, 0, 0, 0, 0};
    float carry = 0.f;
    const int NT = (q0 + 256) / 64;
    const int srow = tid >> 4, sch = (tid & 15) ^ (((srow & 3) << 2) | ((srow >> 2) & 3));
    const bf16_t* kg = K + (tok0 + srow) * DM + h * HD + sch * 8;
    const bf16_t* vg = V + (tok0 + srow) * DM + h * HD + sch * 8;
    LAS unsigned char* ldsw = lds + wid * 1024;
#define ATT_STAGE(t_, koff_, voff_) do { const size_t go_ = (size_t)(t_) * 64 * DM; \
        __builtin_amdgcn_global_load_lds((const unsigned*)(kg + go_), (LAS unsigned*)(ldsw + (koff_)), 16, 0, 0); \
        __builtin_amdgcn_global_load_lds((const unsigned*)(kg + go_ + 32 * DM), (LAS unsigned*)(ldsw + (koff_) + 8192), 16, 0, 0); \
        __builtin_amdgcn_global_load_lds((const unsigned*)(vg + go_), (LAS unsigned*)(ldsw + (voff_)), 16, 0, 0); \
        __builtin_amdgcn_global_load_lds((const unsigned*)(vg + go_ + 32 * DM), (LAS unsigned*)(ldsw + (voff_) + 8192), 16, 0, 0); } while (0)
    ATT_STAGE(NT - 1, 0, 32768);
    asm volatile("s_waitcnt vmcnt(0)" ::: "memory");
    __syncthreads();
    unsigned koff[8];
#pragma unroll
    for (int d0 = 0; d0 < 8; ++d0) koff[d0] = off_b(r32, 2 * d0 + hi);
    const unsigned qa = (lane & 15) >> 2, blk = (lane >> 4) & 1, pp = lane & 3;
    unsigned vbase[2], vcq[4];
#pragma unroll
    for (int t = 0; t < 2; ++t) vbase[t] = 256u * (8 * t + 4 * hi + qa) + 16u * ((2 * blk + (pp >> 1)) ^ ((2 * t + hi) & 3)) + 8u * (pp & 1);
#pragma unroll
    for (int c = 0; c < 4; ++c) vcq[c] = 64u * ((unsigned)c ^ qa);
    int kcur = 0, vprev = 2, vcur = 0, vnext = 1;
    bool prev_valid = false;
    for (int t = NT - 1; t >= 0; --t) {
        if (t > 0) ATT_STAGE(t - 1, (kcur ^ 1) * 16384, 32768 + vnext * 16384);
        const LAS unsigned char* kb = lds + kcur * 16384;
        const LAS unsigned char* vbp = lds + 32768 + vprev * 16384;
        const int k0 = 64 * t;
        const bool valid = (k0 < qw0 + 31);
        if (valid) {
            if (prev_valid) attn_tile<true>(kb, vbp, qf, o, pa, carry, koff, vbase, vcq, k0, qw0, qabs, hi);
            else            attn_tile<false>(kb, vbp, qf, o, pa, carry, koff, vbase, vcq, k0, qw0, qabs, hi);
        }
        prev_valid = valid;
        asm volatile("s_waitcnt vmcnt(0)" ::: "memory");
        __syncthreads();
        kcur ^= 1; { const int tmp = vprev; vprev = vcur; vcur = vnext; vnext = tmp; }
    }
    { const LAS unsigned char* vbp = lds + 32768 + vprev * 16384;
#pragma unroll
      for (int c = 0; c < 4; ++c)
#pragma unroll
          for (int s = 0; s < 4; ++s) {
              const s16x4 lo = vtr(vbp + 4096 * s + vbase[0] + vcq[c]);
              const s16x4 hh = vtr(vbp + 4096 * s + vbase[1] + vcq[c]);
              const bf16x8 vfr = (bf16x8){lo[0], lo[1], lo[2], lo[3], hh[0], hh[1], hh[2], hh[3]};
              o[c] = __builtin_amdgcn_mfma_f32_32x32x16_bf16(pa[s], vfr, o[c], 0, 0, 0);
          } }
    {
        int lane_e = lane_id(); asm volatile("" : "+v"(lane_e));
        const int r32e = lane_e & 31, hie = lane_e >> 5, rowq = lane_e >> 3, c8 = (lane_e & 7) * 8;
        LAS float* stg = (LAS float*)(lds + 81920 + wid * 8192);
        const size_t gbase = (tok0 + qw0) * DM + h * HD + c8;
        u32x4 zv[2][4];
#pragma unroll
        for (int ps = 0; ps < 2; ++ps)
#pragma unroll
            for (int j = 0; j < 4; ++j) zv[ps][j] = *(const u32x4*)(ZS + gbase + (size_t)(8 * j + rowq) * DM + 64 * ps);
#pragma unroll
        for (int ps = 0; ps < 2; ++ps) {
#pragma unroll
            for (int r = 0; r < 16; ++r) {
                stg[crow(r, hie) * 64 + r32e] = o[2 * ps][r];
                stg[crow(r, hie) * 64 + 32 + r32e] = o[2 * ps + 1][r];
            }
            asm volatile("s_waitcnt lgkmcnt(0)" ::: "memory");
#pragma unroll
            for (int j = 0; j < 4; ++j) {
                const f32x4 oa = *(const LAS f32x4*)(stg + (8 * j + rowq) * 64 + c8), ob = *(const LAS f32x4*)(stg + (8 * j + rowq) * 64 + c8 + 4);
                const u32x4 z = zv[ps][j];
                u32x4 w; w.x = pk_bf16(oa[0] * bf_lo(z.x), oa[1] * bf_hi(z.x)); w.y = pk_bf16(oa[2] * bf_lo(z.y), oa[3] * bf_hi(z.y));
                w.z = pk_bf16(ob[0] * bf_lo(z.z), ob[1] * bf_hi(z.z)); w.w = pk_bf16(ob[2] * bf_lo(z.w), ob[3] * bf_hi(z.w));
                *(u32x4*)(OG + gbase + (size_t)(8 * j + rowq) * DM + 64 * ps) = w;
            }
            asm volatile("s_waitcnt lgkmcnt(0)" ::: "memory");
        }
    }
    __syncthreads();
}
__device__ __forceinline__ void attn_phase(LAS unsigned char* lds, const int wid_, int vcu, int G, const bf16_t* Q, const bf16_t* K, const bf16_t* V, const bf16_t* ZS, bf16_t* OG) {
#ifndef NO_ATTN_PRIO
    if (wid_ >= 4) __builtin_amdgcn_s_setprio(1);
#endif
    for (int p = vcu; p < 256; p += G) {
        const int bh = p >> 3, s = p & 7;
#ifdef ATT_ONE_INSTANCE
#pragma unroll 1
        for (int uu = 0; uu < 2; ++uu) attn_unit(lds, wid_, bh >> 4, bh & 15, uu ? 15 - s : s, Q, K, V, ZS, OG);
#else
        attn_unit(lds, wid_, bh >> 4, bh & 15, s, Q, K, V, ZS, OG);
        attn_unit(lds, wid_, bh >> 4, bh & 15, 15 - s, Q, K, V, ZS, OG);
#endif
    }
    __builtin_amdgcn_s_setprio(0);
}

__device__ __forceinline__ void mix_unit(LAS unsigned char* lds, const int wid, int n, int g, const bf16_t* __restrict__ UZ, const bf16_t* __restrict__ V, const float* __restrict__ vss,
                                         const float* __restrict__ w_s, const float* __restrict__ b_s, const float* __restrict__ vg, bf16_t* __restrict__ Y) {
    const int tid = tid_of(wid), lane = tid & 63, r32 = lane & 31, hi = lane >> 5;
    const size_t row0 = (size_t)n * CHUNK;
    LAS float* rstdL = (LAS float*)(lds + 98304);
    const int cc = tid & 31;
    u32x4 uu[8];
#pragma unroll
    for (int i = 0; i < 8; ++i) { const int t = (tid >> 5) + 16 * i; uu[i] = __builtin_nontemporal_load((const u32x4*)(UZ + (row0 + t) * GW + g * GDIM + cc * 8)); }
    {
        u32x4 vr[8];
#pragma unroll
        for (int i = 0; i < 8; ++i) { const int c = tid + 512 * i, s = c >> 5, cc = c & 31;
            vr[i] = __builtin_nontemporal_load((const u32x4*)(V + (row0 + s) * GW + g * GDIM + cc * 8)); }
        if (tid < 128) { const f32x4* vp = (const f32x4*)(vss + (row0 + tid) * 64); f32x4 s4 = vp[0];
#pragma unroll
            for (int i = 1; i < 16; ++i) s4 += vp[i];
            rstdL[tid] = __builtin_amdgcn_rsqf(((s4[0] + s4[1]) + (s4[2] + s4[3])) * (1.0f / GW) + EPS); }
#pragma unroll
        for (int i = 0; i < 8; ++i) { const int c = tid + 512 * i, s = c >> 5, cc = c & 31;
            *(LAS u32x4*)(lds + 32768 + (cc >> 4) * 32768 + off_b(s, cc & 15)) = vr[i]; }
    }
    __syncthreads();
#pragma unroll
    for (int i = 0; i < 4; ++i) { const int c = tid + 512 * i, t = c >> 4, ch = c & 15, s0 = ch * 8;
        const f32x4 w0 = *(const f32x4*)(w_s + ((size_t)g * CHUNK + t) * CHUNK + s0), w1 = *(const f32x4*)(w_s + ((size_t)g * CHUNK + t) * CHUNK + s0 + 4);
        float wv[8] = {w0[0], w0[1], w0[2], w0[3], w1[0], w1[1], w1[2], w1[3]};
#pragma unroll
        for (int j = 0; j < 8; ++j) wv[j] = (s0 + j <= t) ? wv[j] * rstdL[s0 + j] : 0.f;
        u32x4 w; w.x = pk_bf16(wv[0], wv[1]); w.y = pk_bf16(wv[2], wv[3]); w.z = pk_bf16(wv[4], wv[5]); w.w = pk_bf16(wv[6], wv[7]);
        *(LAS u32x4*)(lds + off_b(t, ch)) = w; }
    __syncthreads();
    f32x16 acc[4];
#pragma unroll
    for (int i = 0; i < 4; ++i)
#pragma unroll
        for (int r = 0; r < 16; ++r) acc[i][r] = 0.f;
    {
        const LAS unsigned char* vimg = lds + 32768 + (wid >> 2) * 32768;
        const unsigned cblk = wid & 3, qa = (lane & 15) >> 2, blk = (lane >> 4) & 1, pp = lane & 3;
#pragma unroll
        for (int ks = 0; ks < 8; ++ks) {
            const s16x4 lo = vtr(vimg + off_b(16 * ks + 8 * hi + qa, 4 * cblk + 2 * blk + (pp >> 1)) + 8 * (pp & 1));
            const s16x4 hh = vtr(vimg + off_b(16 * ks + 8 * hi + 4 + qa, 4 * cblk + 2 * blk + (pp >> 1)) + 8 * (pp & 1));
            const bf16x8 vf = (bf16x8){lo[0], lo[1], lo[2], lo[3], hh[0], hh[1], hh[2], hh[3]};
#pragma unroll
            for (int i = 0; i < 4; ++i) if (ks <= 2 * i + 1) {
                const bf16x8 af = *(const LAS bf16x8*)(lds + off_b(32 * i + r32, 2 * ks + hi));
                acc[i] = __builtin_amdgcn_mfma_f32_32x32x16_bf16(af, vf, acc[i], 0, 0, 0);
            }
        }
    }
    __syncthreads();
    {
        LAS float* mx = (LAS float*)lds;
        const int c = 128 * (wid >> 2) + 32 * (wid & 3) + r32;
#pragma unroll
        for (int i = 0; i < 4; ++i)
#pragma unroll
            for (int r = 0; r < 16; ++r) mx[(32 * i + crow(r, hi)) * 256 + c] = acc[i][r];
    }
    __syncthreads();
    {
        const f32x4 g0 = *(const f32x4*)(vg + g * GDIM + cc * 8), g1 = *(const f32x4*)(vg + g * GDIM + cc * 8 + 4);
        float bb[8];
#pragma unroll
        for (int i = 0; i < 8; ++i) bb[i] = b_s[g * CHUNK + (tid >> 5) + 16 * i];
#pragma unroll
        for (int i = 0; i < 8; ++i) { const int t = (tid >> 5) + 16 * i;
            const f32x4 m0 = *(const LAS f32x4*)(lds + (t * 256 + cc * 8) * 4), m1 = *(const LAS f32x4*)(lds + (t * 256 + cc * 8 + 4) * 4);
            float y[8];
            y[0] = bf_lo(uu[i].x) * (m0[0] * g0[0] + bb[i]); y[1] = bf_hi(uu[i].x) * (m0[1] * g0[1] + bb[i]);
            y[2] = bf_lo(uu[i].y) * (m0[2] * g0[2] + bb[i]); y[3] = bf_hi(uu[i].y) * (m0[3] * g0[3] + bb[i]);
            y[4] = bf_lo(uu[i].z) * (m1[0] * g1[0] + bb[i]); y[5] = bf_hi(uu[i].z) * (m1[1] * g1[1] + bb[i]);
            y[6] = bf_lo(uu[i].w) * (m1[2] * g1[2] + bb[i]); y[7] = bf_hi(uu[i].w) * (m1[3] * g1[3] + bb[i]);
            u32x4 w; w.x = pk_bf16(y[0], y[1]); w.y = pk_bf16(y[2], y[3]); w.z = pk_bf16(y[4], y[5]); w.w = pk_bf16(y[6], y[7]);
            *(u32x4*)(Y + (row0 + t) * GW + g * GDIM + cc * 8) = w; }
    }
    __syncthreads();
}

__device__ __forceinline__ float wave_sum(float v) {
#pragma unroll
    for (int o = 1; o < 64; o <<= 1) v += __shfl_xor(v, o);
    return v;
}
__device__ __forceinline__ void tr_load(const float* __restrict__ W, int N, int item, int lane, f32x4 (&wv)[16]) {
    const int nblk = N / 64, k0 = 64 * (item / nblk), n0 = 64 * (item % nblk);
#pragma unroll
    for (int i = 0; i < 16; ++i) wv[i] = __builtin_nontemporal_load((const f32x4*)(W + (size_t)(k0 + 4 * i + (lane >> 4)) * N + n0 + 4 * (lane & 15)));
}
__device__ __forceinline__ void tr_to_lds(LAS float* scr, int lane, const f32x4 (&wv)[16]) {
#pragma unroll
    for (int i = 0; i < 16; ++i) { const int kk = 4 * i + (lane >> 4), nn = 4 * (lane & 15);
        LAS float* s = scr + kk * 65 + nn; s[0] = wv[i][0]; s[1] = wv[i][1]; s[2] = wv[i][2]; s[3] = wv[i][3]; }
    asm volatile("s_waitcnt lgkmcnt(0)" ::: "memory");
}
__device__ __forceinline__ void tr_store(int K, int N, bf16_t* __restrict__ WT, const LAS float* scr, int item, int lane, const float* __restrict__ gk, bool gmlp_perm) {
    const int nblk = N / 64, k0 = 64 * (item / nblk), n0 = 64 * (item % nblk);
    int r0 = n0;
    if (gmlp_perm) {
        if (n0 < GW) { const int cb = n0 >> 7; r0 = 256 * (3 * (cb >> 1) + (cb & 1)) + (n0 & 127); }
        else if (n0 < 2 * GW) { const int mv = n0 - GW; r0 = 256 * (3 * (mv >> 8) + 2) + (mv & 255); }
        else { const int mz = n0 - 2 * GW, cb = mz >> 7; r0 = 256 * (3 * (cb >> 1) + (cb & 1)) + 128 + (mz & 127); }
    }
    const int c = lane & 7;
    f32x4 ga = {1.f, 1.f, 1.f, 1.f}, gb = {1.f, 1.f, 1.f, 1.f};
    if (gk) { ga = *(const f32x4*)(gk + k0 + 8 * c); gb = *(const f32x4*)(gk + k0 + 8 * c + 4); }
#pragma unroll
    for (int j = 0; j < 8; ++j) { const int nn = (lane >> 3) + 8 * j; const LAS float* s = scr + (8 * c) * 65 + nn;
        u32x4 o; o.x = pk_bf16(s[0] * ga[0], s[65] * ga[1]); o.y = pk_bf16(s[2 * 65] * ga[2], s[3 * 65] * ga[3]); o.z = pk_bf16(s[4 * 65] * gb[0], s[5 * 65] * gb[1]); o.w = pk_bf16(s[6 * 65] * gb[2], s[7 * 65] * gb[3]);
        *(u32x4*)(WT + (size_t)(r0 + nn) * K + k0 + 8 * c) = o; }
    asm volatile("s_waitcnt lgkmcnt(0)" ::: "memory");
}
__device__ __forceinline__ void transpose_matrix(const float* __restrict__ W, int K, int N, bf16_t* __restrict__ WT, LAS float* scr, int first, int stride, int nitems, int lane,
                                                 const float* __restrict__ gk = nullptr, bool gmlp_perm = false) {
    f32x4 wv[16], wn[16];
    int it = first;
    if (it < nitems) tr_load(W, N, it, lane, wv);
    while (it < nitems) {
        const int nx = it + stride;
        tr_to_lds(scr, lane, wv);
        if (nx < nitems) tr_load(W, N, nx, lane, wn);
        tr_store(K, N, WT, scr, it, lane, gk, gmlp_perm);
#pragma unroll
        for (int i = 0; i < 16; ++i) wv[i] = wn[i];
        it = nx;
    }
}

#define XB_TMO      128
#define XB_XCNT(j)  (256  + 64 * (j))
#define XB_XSUB(j)  (1280 + 64 * (j))
#define XB_XGEN(j)  (2304 + 64 * (j))
#define XB_TOP      3328
#define XB_TOPGEN   3392
#define XCD_BAR_WORDS 3456
#define XB_SPIN_CAP (1u << 18)

__device__ __forceinline__ unsigned xb_ld(unsigned* p)              { return __hip_atomic_load(p, __ATOMIC_RELAXED, __HIP_MEMORY_SCOPE_AGENT); }
__device__ __forceinline__ unsigned xb_add(unsigned* p, unsigned v) { return __hip_atomic_fetch_add(p, v, __ATOMIC_RELAXED, __HIP_MEMORY_SCOPE_AGENT); }
__device__ __forceinline__ unsigned xb_xcc_id() { return (unsigned)__builtin_amdgcn_s_getreg((3 << 11) | 20) & 0xFu; }
#define XB_SPIN(cond, bar) do { unsigned _sp = 0; while (cond) { __builtin_amdgcn_s_sleep(1); \
    if ((++_sp & 255u) == 0u) { if (xb_ld(&(bar)[XB_TMO])) break; if (_sp > XB_SPIN_CAP) { atomicAdd(&(bar)[XB_TMO], 1u); break; } } } } while (0)

struct XcdBarrier {
    unsigned* bar; unsigned x; int w;
    volatile LAS unsigned* st;
};

__device__ __forceinline__ XcdBarrier xcd_barrier_post(unsigned* bar, volatile LAS unsigned* st, int wave) {
    XcdBarrier b; b.bar = bar; b.x = xb_xcc_id(); b.st = st; b.w = wave;
    if (tid_of(wave) == 0) (void)xb_add(&bar[XB_XCNT(b.x)], 1u);
    return b;
}
__device__ __forceinline__ void xcd_barrier_complete(unsigned* bar, unsigned x, unsigned& nloc, unsigned& nx) {
    const unsigned G = gridDim.x * gridDim.y * gridDim.z;
    unsigned sum, cnt, mine, sp = 0u;
    for (;;) {
        sum = 0u; cnt = 0u; mine = 0u;
#pragma unroll
        for (unsigned j = 0; j < 16; ++j) { const unsigned c = xb_ld(&bar[XB_XCNT(j)]); sum += c; cnt += (c > 0u) ? 1u : 0u; mine = (j == x) ? c : mine; }
        if (sum == G) break;
        __builtin_amdgcn_s_sleep(1);
        if ((++sp & 255u) == 0u) { if (xb_ld(&bar[XB_TMO])) break; if (sp > XB_SPIN_CAP) { atomicAdd(&bar[XB_TMO], 1u); break; } }
    }
    nloc = mine > 0u ? mine : 1u; nx = cnt > 0u ? cnt : 1u;
}

__device__ __forceinline__ void xcd_barrier(const XcdBarrier& b) {
    asm volatile("s_waitcnt vmcnt(0)" ::: "memory");
    __syncthreads();
    if (tid_of(b.w) == 0) {
        unsigned* bar = b.bar;
        __builtin_amdgcn_s_waitcnt(0);
        unsigned nloc = b.st[0], nx = b.st[1];
        if (nloc == 0u) { xcd_barrier_complete(bar, b.x, nloc, nx); b.st[0] = nloc; b.st[1] = nx; }
        const unsigned old = xb_add(&bar[XB_XSUB(b.x)], 1u);
        const unsigned gen = old / nloc;
        if (old + 1u == (gen + 1u) * nloc) {
            __builtin_amdgcn_fence(__ATOMIC_RELEASE, "agent");
            asm volatile("s_waitcnt vmcnt(0)" ::: "memory");
            const unsigned og = xb_add(&bar[XB_TOP], 1u);
            const unsigned tg = og / nx;
            if (og + 1u == (tg + 1u) * nx) xb_add(&bar[XB_TOPGEN], 1u);
            else XB_SPIN(xb_ld(&bar[XB_TOPGEN]) == tg, bar);
            __builtin_amdgcn_fence(__ATOMIC_ACQUIRE, "agent");
            xb_add(&bar[XB_XGEN(b.x)], 1u);
            asm volatile("s_waitcnt vmcnt(0)" ::: "memory");
        } else {
            XB_SPIN(xb_ld(&bar[XB_XGEN(b.x)]) == gen, bar);
            __builtin_amdgcn_fence(__ATOMIC_ACQUIRE, "agent");
            asm volatile("s_waitcnt vmcnt(0)" ::: "memory");
        }
    }
    __syncthreads();
}

constexpr size_t MiB = 1u << 20;
constexpr size_t WS_VSS = 0, WS_HSS1 = 2 * MiB, WS_HSS2 = 3 * MiB, WS_IRS0 = 3 * MiB + 32768, WS_CNT = 3 * MiB + 65536;
constexpr size_t WS_WT1 = 4 * MiB, WS_HN0 = 268 * MiB  , WS_WT2 = 84 * MiB, WS_WT3 = 100 * MiB, WS_WT4 = 132 * MiB;
constexpr size_t WS_U = 140 * MiB, WS_V = 204 * MiB, WS_ZS = 268 * MiB, WS_CTL = 364 * MiB, CTL_ZERO_BYTES = 32768, WS_END = 365 * MiB;
constexpr size_t WS_Y = 4 * MiB;
constexpr size_t WS_H1 = 140 * MiB, WS_H1B = 332 * MiB;
constexpr size_t WS_Q = 204 * MiB, WS_K = 236 * MiB, WS_V2 = 268 * MiB, WS_ZS2 = 300 * MiB, WS_OG = 4 * MiB;

constexpr int NWAVES = 8, LDS_BYTES = 151552;
#ifndef N_LAUNCHES
#define N_LAUNCHES 1
#endif
constexpr int N_PHASES = 7;
#ifndef CONV_TRIGGER
#define CONV_TRIGGER ((bx >> 3) % 6)
#endif
#ifndef GEMM_SP2
#define GEMM_SP2 true
#endif
#ifndef GEMM_ALIGN
#define GEMM_ALIGN true
#endif
#ifndef REPEAT_PHASE
#define REPEAT_PHASE -1
#endif
#define NREP(k) ((REPEAT_PHASE == (k)) ? 2 : 1)

struct Args { const float* in[10]; float* out; unsigned char* ws; int ph_lo, ph_hi, li, pad; };

__global__ void __launch_bounds__(NWAVES * 64, 2) fwd_kernel(Args a) {
    extern __shared__ __attribute__((aligned(16))) unsigned char lds_raw[];
    LAS unsigned char* lds = (LAS unsigned char*)lds_raw;
    cg::grid_group grid = cg::this_grid();
    const int wave = __builtin_amdgcn_readfirstlane(threadIdx.x >> 6);
#define tid tid_of(wave)
#define lane lane_id()
    const int G = gridDim.x, bx = blockIdx.x;
    const int vcu = (G % 8 == 0) ? (bx % 8) * (G / 8) + bx / 8 : bx;
    const float* x = a.in[0]; const float* norm_g = a.in[1]; const float* a_w_in = a.in[2]; const float* a_vg = a.in[3]; const float* a_w_s = a.in[4];
    const float* a_b_s = a.in[5]; const float* a_w_out = a.in[6]; const float* b_w_in = a.in[7]; const float* b_w_out = a.in[8]; const float* final_g = a.in[9];
    unsigned char* ws = a.ws;
    float* VSS = (float*)(ws + WS_VSS); float* HSS1 = (float*)(ws + WS_HSS1); float* HSS2 = (float*)(ws + WS_HSS2); float* IRS0 = (float*)(ws + WS_IRS0); unsigned* CNT = (unsigned*)(ws + WS_CNT);
    bf16_t* WT1 = (bf16_t*)(ws + WS_WT1); bf16_t* WT2 = (bf16_t*)(ws + WS_WT2); bf16_t* WT3 = (bf16_t*)(ws + WS_WT3); bf16_t* WT4 = (bf16_t*)(ws + WS_WT4);
    bf16_t* HN0 = (bf16_t*)(ws + WS_HN0); bf16_t* U = (bf16_t*)(ws + WS_U); bf16_t* V = (bf16_t*)(ws + WS_V); bf16_t* ZS = (bf16_t*)(ws + WS_ZS);
    bf16_t* Y = (bf16_t*)(ws + WS_Y); bf16_t* H1B = (bf16_t*)(ws + WS_H1B);
    bf16_t* Qb = (bf16_t*)(ws + WS_Q); bf16_t* Kb = (bf16_t*)(ws + WS_K); bf16_t* V2 = (bf16_t*)(ws + WS_V2); bf16_t* ZS2 = (bf16_t*)(ws + WS_ZS2); bf16_t* OG = (bf16_t*)(ws + WS_OG);
    const int lo = a.ph_lo, hi = a.ph_hi;
#define IN(k) (lo <= (k) && (k) < hi)
#define SEAM(k) do { if (IN(k) && IN((k) + 1)) xcd_barrier(bar); } while (0)
    volatile LAS unsigned* MISC = (volatile LAS unsigned*)(lds + LDS_BYTES - 64);
    if (tid < 16) MISC[tid] = 0u;
    __syncthreads();
    XcdBarrier bar = xcd_barrier_post((unsigned*)(ws + WS_CTL) + a.li * XCD_BAR_WORDS, MISC + 8, wave);
    if (lo > 1000) grid.sync();
    const int gw = vcu * NWAVES + wave, NGW = G * NWAVES;

    if (IN(0)) for (int rep = 0; rep < NREP(0); ++rep) {
        LAS float* scr = (LAS float*)(lds + wave * 16640);
        constexpr int I1 = (DM / 64) * (3 * GW / 64), I2 = (GW / 64) * (DM / 64), I3 = (DM / 64) * (4 * DM / 64), I4 = (DM / 64) * (DM / 64);
        transpose_matrix(a_w_in, DM, 3 * GW, WT1, scr, gw, NGW, I1, lane, norm_g, true);
        for (int m = bx * (NWAVES * 64) + tid; m < NTOK; m += G * NWAVES * 64) { HSS1[m] = 0.f; HSS2[m] = 0.f; if (m < 2048) CNT[m] = 0u; }
        for (int m = gw; m < NTOK; m += 2 * NGW) {
            const int m2 = m + NGW; const bool two = m2 < NTOK;
            const f32x4* xr = (const f32x4*)(x + (size_t)m * DM) + lane; const f32x4* xr2 = (const f32x4*)(x + (size_t)(two ? m2 : m) * DM) + lane;
            f32x4 v[8], v2[8]; float ss = 0.f, ss2 = 0.f;
#pragma unroll
            for (int j = 0; j < 8; ++j) { v[j] = __builtin_nontemporal_load(xr + 64 * j); v2[j] = __builtin_nontemporal_load(xr2 + 64 * j); }
#pragma unroll
            for (int j = 0; j < 8; ++j) { ss += (v[j][0] * v[j][0] + v[j][1] * v[j][1]) + (v[j][2] * v[j][2] + v[j][3] * v[j][3]); ss2 += (v2[j][0] * v2[j][0] + v2[j][1] * v2[j][1]) + (v2[j][2] * v2[j][2] + v2[j][3] * v2[j][3]); }
            const float ms = wave_sum(ss) * (1.0f / DM) + EPS, ms2 = wave_sum(ss2) * (1.0f / DM) + EPS;
            const float rstd = __builtin_amdgcn_rsqf(ms), rstd2 = __builtin_amdgcn_rsqf(ms2);
            if (lane == 0) { IRS0[m] = __builtin_amdgcn_sqrtf(ms); if (two) IRS0[m2] = __builtin_amdgcn_sqrtf(ms2); }
            u32x2* o8 = (u32x2*)(HN0 + (size_t)m * DM) + lane; u32x2* o82 = (u32x2*)(HN0 + (size_t)m2 * DM) + lane;
#pragma unroll
            for (int j = 0; j < 8; ++j) {
                u32x2 w; w.x = pk_bf16(v[j][0] * rstd, v[j][1] * rstd); w.y = pk_bf16(v[j][2] * rstd, v[j][3] * rstd); o8[64 * j] = w;
                if (two) { u32x2 w2; w2.x = pk_bf16(v2[j][0] * rstd2, v2[j][1] * rstd2); w2.y = pk_bf16(v2[j][2] * rstd2, v2[j][3] * rstd2); o82[64 * j] = w2; } }
        }
    }
    SEAM(0);
#ifdef EXTRA_SYNCS
    for (int i = 0; i < EXTRA_SYNCS; ++i) xcd_barrier(bar);
#endif
    if (IN(1)) for (int rep = 0; rep < NREP(1); ++rep) {
        pg8::Gemm g{HN0, WT1, NTOK, 3 * GW, DM}; pg8::ConvOrder S; S.init(NTOK, 3 * GW, G, bx);
        S.w2 = a_w_out; S.w3 = b_w_in; S.w4 = b_w_out; S.g1 = norm_g + DM; S.t2 = WT2; S.t3 = WT3; S.t4 = WT4; S.gw = gw; S.ngw = NGW; S.trigger = (G == 256) ? CONV_TRIGGER : 0; S.ln = lane; S.sw = lds + 131072 + wave * 2048; S.n_done = 0;
        pg8::EpiGmlpIn E{U, V, VSS};
        pg8::gemm_phase<pg8::EpiGmlpIn, pg8::ConvOrder, GEMM_ALIGN, GEMM_SP2>(lds, g, S, E, wave);
    }
    SEAM(1);
    if (IN(2)) for (int rep = 0; rep < NREP(2); ++rep) {
        for (int it = vcu; it < (NTOK / CHUNK) * NGRP; it += G) mix_unit(lds, wave, it >> 4, it & 15, U, V, VSS, a_w_s, a_b_s, a_vg, Y);
    }
    SEAM(2);
    if (IN(3)) for (int rep = 0; rep < NREP(3); ++rep) {
        pg8::Gemm g{Y, WT2, NTOK, DM, GW}; pg8::StaticOrder S; S.init(NTOK, DM, G, bx);
        pg8::EpiRes1 E{HN0, IRS0, H1B, HSS1};
        pg8::gemm_phase<pg8::EpiRes1, pg8::StaticOrder, GEMM_ALIGN, GEMM_SP2>(lds, g, S, E, wave);
    }
    SEAM(3);
    if (IN(4)) for (int rep = 0; rep < NREP(4); ++rep) {
        pg8::Gemm g{H1B, WT3, NTOK, 4 * DM, DM}; pg8::StaticOrder S; S.init(NTOK, 4 * DM, G, bx);
        pg8::EpiSbIn E{Qb, (size_t)(WS_K - WS_Q) / 2, HSS1};
        pg8::gemm_phase<pg8::EpiSbIn, pg8::StaticOrder, GEMM_ALIGN, GEMM_SP2>(lds, g, S, E, wave);
    }
    SEAM(4);
    if (IN(5)) for (int rep = 0; rep < NREP(5); ++rep) attn_phase(lds, wave, vcu, G, Qb, Kb, V2, ZS2, OG);
    SEAM(5);
    if (IN(6)) for (int rep = 0; rep < NREP(6); ++rep) {
        pg8::Gemm g{OG, WT4, NTOK, DM, DM}; pg8::StaticOrder S; S.init(NTOK, DM, G, bx);
        pg8::EpiFinal E{H1B, final_g, a.out, HSS2, CNT, G == 256};
        pg8::gemm_phase<pg8::EpiFinal, pg8::StaticOrder, GEMM_ALIGN, GEMM_SP2>(lds, g, S, E, wave);
    }
    if (IN(6) && G != 256) {
        xcd_barrier(bar);
        for (int m = gw; m < NTOK; m += NGW) {
            const float rstd = __builtin_amdgcn_rsqf(HSS2[m] * (1.0f / DM) + EPS);
            f32x4* orow = (f32x4*)(a.out + (size_t)m * DM) + lane; const f32x4* gr = (const f32x4*)final_g + lane;
#pragma unroll
            for (int j = 0; j < 8; ++j) { const f32x4 v = orow[64 * j]; orow[64 * j] = v * rstd * gr[64 * j]; }
        }
    }
#undef IN
#undef SEAM
#undef tid
#undef lane
}

extern "C" void kernel_launch(void* const* d_in, const int* in_sizes, int n_in, void* d_out, int out_size, void* d_ws, size_t ws_size, hipStream_t stream) {
    static int grid = 0;
    if (grid == 0) {
        if (n_in != 10 || out_size != NTOK * DM || ws_size < WS_END) { fprintf(stderr, "kernel_launch: unexpected shapes (n_in %d, out %d, ws %zu)\n", n_in, out_size, ws_size); grid = -1; return; }
        int dev = 0, cus = 0, per_cu = 0;
        (void)hipGetDevice(&dev); (void)hipDeviceGetAttribute(&cus, hipDeviceAttributeMultiprocessorCount, dev);
        if (hipFuncSetAttribute((const void*)fwd_kernel, hipFuncAttributeMaxDynamicSharedMemorySize, LDS_BYTES) != hipSuccess) { fprintf(stderr, "kernel_launch: hipFuncSetAttribute failed\n"); grid = -1; return; }
        if (hipOccupancyMaxActiveBlocksPerMultiprocessor(&per_cu, (const void*)fwd_kernel, NWAVES * 64, LDS_BYTES) != hipSuccess || per_cu < 1) { fprintf(stderr, "kernel_launch: occupancy query says %d\n", per_cu); per_cu = 1; }
        (void)hipGetLastError();
        grid = cus > 0 ? cus : 256;
    }
    if (grid < 0) return;
    if (hipMemsetAsync((char*)d_ws + WS_CTL, 0, CTL_ZERO_BYTES, stream) != hipSuccess) { fprintf(stderr, "kernel_launch: memset failed\n"); return; }
    Args a{};
    for (int i = 0; i < 10; ++i) a.in[i] = (const float*)d_in[i];
    a.out = (float*)d_out; a.ws = (unsigned char*)d_ws;
#ifdef PROBE_SPLIT
    const int nl = 2;
#else
    const int nl = N_LAUNCHES;
#endif
    for (int li = 0; li < nl; ++li) {
        a.ph_lo = (N_LAUNCHES == 1) ? 0 : li; a.ph_hi = (N_LAUNCHES == 1) ? N_PHASES : li + 1;
#ifdef PROBE_SPLIT
        a.ph_lo = li == 0 ? 0 : PROBE_SPLIT; a.ph_hi = li == 0 ? PROBE_SPLIT + 1 : N_PHASES;
#endif
        a.li = li;
        void* args[] = {&a};
        hipError_t e = hipLaunchCooperativeKernel((const void*)fwd_kernel, dim3(grid), dim3(NWAVES * 64), args, LDS_BYTES, stream);
        if (e != hipSuccess) { fprintf(stderr, "kernel_launch: cooperative launch %d failed: %s (grid %d)\n", li, hipGetErrorString(e), grid); break; }
    }
}
```

```cpp
#include <hip/hip_runtime.h>
#include <hip/hip_cooperative_groups.h>
#include <cstdio>
#include <cstdint>
namespace cg = cooperative_groups;
__device__ __forceinline__ int lane_id() { return (int)__builtin_amdgcn_mbcnt_hi(~0u, __builtin_amdgcn_mbcnt_lo(~0u, 0u)); }
__device__ __forceinline__ int tid_of(int wave) { return wave * 64 + lane_id(); }
#ifndef PG8_WGM
#define PG8_WGM 8
#endif
namespace pg8 {
#define PG8_LAS __attribute__((address_space(3)))
typedef unsigned short bf16_t;
typedef short bf16x8 __attribute__((ext_vector_type(8)));
typedef float f32x4 __attribute__((ext_vector_type(4)));
typedef unsigned u32x4 __attribute__((ext_vector_type(4)));
constexpr int BM = 256, BK = 64, HALF = 128, HTB = HALF * BK * 2  , STAGE_BYTES = 8 * HTB, NXCD = 8, WGM = PG8_WGM;

__host__ __device__ __forceinline__ int lds_byte(int r, int c) { const int st = (r >> 4) * 2 + (c >> 5), rr = r & 15, cc = c & 31, ob = rr * 64 + cc * 2; return st * 1024 + (ob ^ (((ob >> 9) & 1) << 5)); }
__host__ __device__ __forceinline__ void stage_rc(int b, int& R, int& C) { const int st = b / 1024, sb = b % 1024, swz = sb ^ (((sb >> 9) & 1) << 5); R = (st >> 1) * 16 + swz / 64; C = (st & 1) * 32 + (swz % 64) / 2; }
__host__ __device__ __forceinline__ int perm32(int rho) { const int n = rho >> 4, i = rho & 15; return 8 * (i >> 2) + 4 * n + (i & 3); }

struct Unit { int pm, pn; };
struct Gemm { const bf16_t* A; const bf16_t* Bt; int M, N, K; };

struct StaticOrder {
    int nM, nN, nwg, G, c;
    __host__ __device__ void init(int M, int N, int G_, int c_) { nM = M / BM; nN = N / BM; nwg = nM * nN; G = G_; c = c_; }
    __host__ __device__ bool next(int i, Unit& u) const {
        const long L = (long)i * G + c; if (L >= nwg) return false;
        int wgid = (int)L; { const int q = nwg / NXCD, r = nwg % NXCD, xcd = wgid % NXCD, off = wgid / NXCD; wgid = (xcd < r ? xcd * (q + 1) : r * (q + 1) + (xcd - r) * q) + off; }
        const int nig = WGM * nN, gid = wgid / nig, fm = gid * WGM, gsz = (nM - fm) < WGM ? (nM - fm) : WGM;
        u.pm = fm + ((wgid % nig) % gsz); u.pn = (wgid % nig) / gsz; return true;
    }
    __device__ __forceinline__ void a_ready(const Unit&) const {}
    __device__ __forceinline__ void done(const Unit&) const {}
};

__device__ __forceinline__ unsigned cvt_pk_bf16(float lo, float hi) { unsigned r; asm volatile("v_cvt_pk_bf16_f32 %0, %1, %2" : "=v"(r) : "v"(lo), "v"(hi)); return r; }
typedef float f32x2 __attribute__((ext_vector_type(2)));
typedef float f32x2 __attribute__((ext_vector_type(2)));
template <class Epi, class Sched, bool ALIGN_EPI = false, bool SP2 = false>
__device__ __forceinline__ void gemm_phase(PG8_LAS unsigned char* lds, const Gemm g, const Sched& S, const Epi& E, const int wave_) {
    const int tid = tid_of(wave_), wid = wave_, lane = tid & 63, wr = wid >> 2, wc = wid & 3, fr = lane & 15, fq = lane >> 4;
    const int K = g.K, nt = K / BK;
    unsigned voffA[2], voffB[2];
#pragma unroll
    for (int i = 0; i < 2; ++i) { int R, C; stage_rc(tid * 16 + i * 8192, R, C); const int Rb = Epi::PERM ? ((R & ~31) + perm32(R & 31)) : R;
        voffA[i] = (unsigned)(R * K + C) * 2u; voffB[i] = (unsigned)(Rb * K + C) * 2u; }
    const size_t kstep = (size_t)(BK * 2);
    const size_t hstep = (size_t)HALF * K * 2;
    const size_t tstep = 2 * hstep;
    const unsigned ldsw = (unsigned)wid * 1024u;
    const int aoff = lds_byte(wr * 64 + fr, fq * 8), boff = lds_byte(wc * 32 + fr, fq * 8);
#define PG8_SA(b, h) (((b) * 2 + (h)) * HTB)
#define PG8_SB(b, h) ((4 + (b) * 2 + (h)) * HTB)
#define PG8_STAGE(bufoff, gbase, voff) do { _Pragma("unroll") for (int _i = 0; _i < 2; ++_i) \
        __builtin_amdgcn_global_load_lds((const unsigned*)((const char*)(gbase) + (voff)[_i]), (PG8_LAS unsigned*)(lds + (bufoff) + ldsw + _i * 8192), 16, 0, 0); } while (0)
#define PG8_LDA(dst, b, h) do { _Pragma("unroll") for (int m = 0; m < 4; ++m) _Pragma("unroll") for (int k = 0; k < 2; ++k) dst[m][k] = *(const PG8_LAS bf16x8*)(lds + PG8_SA(b, h) + aoff + m * 2048 + k * 1024); } while (0)
#define PG8_LDB(dst, b, h) do { _Pragma("unroll") for (int n = 0; n < 2; ++n) _Pragma("unroll") for (int k = 0; k < 2; ++k) dst[n][k] = *(const PG8_LAS bf16x8*)(lds + PG8_SB(b, h) + boff + n * 2048 + k * 1024); } while (0)
#define PG8_MMA(ai, bj, At, Bt) do { __builtin_amdgcn_s_setprio(1); _Pragma("unroll") for (int m = 0; m < 4; ++m) _Pragma("unroll") for (int n = 0; n < 2; ++n) _Pragma("unroll") for (int k = 0; k < 2; ++k) \
        acc[ai][bj][m][n] = __builtin_amdgcn_mfma_f32_16x16x32_bf16(Bt[n][k], At[m][k], acc[ai][bj][m][n], 0, 0, 0); __builtin_amdgcn_s_setprio(0); } while (0)
#define PG8_WAIT_V(n) asm volatile("s_waitcnt vmcnt(" #n ")" ::: "memory")
#define PG8_WAIT_L(n) asm volatile("s_waitcnt lgkmcnt(" #n ")" ::: "memory")
#define PG8_BAR __builtin_amdgcn_s_barrier()
#define PG8_SCHED __builtin_amdgcn_sched_barrier(0)
    Unit cur, nxt; int ui = 0;
    if (!S.next(0, cur)) return;
    f32x4 acc[2][2][4][2];
#pragma unroll
    for (int a = 0; a < 2; ++a)
#pragma unroll
        for (int b = 0; b < 2; ++b)
#pragma unroll
            for (int m = 0; m < 4; ++m)
#pragma unroll
                for (int n = 0; n < 2; ++n) acc[a][b][m][n] = (f32x4){0.f, 0.f, 0.f, 0.f};
    bf16x8 At[4][2], B0[2][2], B1[2][2];
    const char* cA = (const char*)g.A + (size_t)cur.pm * tstep; const char* cB = (const char*)g.Bt + (size_t)cur.pn * tstep;
    S.a_ready(cur);
    if constexpr (SP2) {
        PG8_STAGE(PG8_SB(0, 0), cB, voffB); PG8_STAGE(PG8_SB(0, 1), cB + hstep, voffB); PG8_STAGE(PG8_SA(0, 0), cA, voffA); PG8_STAGE(PG8_SA(0, 1), cA + hstep, voffA);
        if (wr == 1) PG8_BAR;
        PG8_WAIT_V(2); PG8_BAR;
        PG8_STAGE(PG8_SB(1, 0), cB + kstep, voffB); PG8_STAGE(PG8_SA(1, 0), cA + kstep, voffA); PG8_STAGE(PG8_SB(1, 1), cB + hstep + kstep, voffB);
        PG8_WAIT_V(6); PG8_BAR;
    } else {
        PG8_STAGE(PG8_SB(0, 0), cB, voffB); PG8_STAGE(PG8_SA(0, 0), cA, voffA); PG8_STAGE(PG8_SB(0, 1), cB + hstep, voffB); PG8_STAGE(PG8_SA(0, 1), cA + hstep, voffA);
        if (wr == 1) PG8_BAR;
        PG8_WAIT_V(4); PG8_BAR;
        PG8_STAGE(PG8_SB(1, 0), cB + kstep, voffB); PG8_STAGE(PG8_SA(1, 0), cA + kstep, voffA); PG8_STAGE(PG8_SB(1, 1), cB + hstep + kstep, voffB);
        PG8_WAIT_V(6); PG8_BAR;
    }
    for (;;) {
        const bool has_next = S.next(ui + 1, nxt);
        const char* nA = has_next ? (const char*)g.A + (size_t)nxt.pm * tstep : cA; const char* nB = has_next ? (const char*)g.Bt + (size_t)nxt.pn * tstep : cB;
        for (int t = 0; t < nt; t += 2) {
            const bool last = (t == nt - 2);
            const char* a1 = cA + (size_t)(t + 1) * kstep;
            const char* a2 = last ? nA : cA + (size_t)(t + 2) * kstep; const char* b2 = last ? nB : cB + (size_t)(t + 2) * kstep;
            const char* a3 = a2 + kstep; const char* b3 = b2 + kstep;
            if (last && has_next) S.a_ready(nxt);
            if constexpr (SP2) {
            PG8_LDB(B0, 0, 0); PG8_LDB(B1, 0, 1); PG8_SCHED; PG8_LDA(At, 0, 0); PG8_STAGE(PG8_SA(1, 1), a1 + hstep, voffA);
            PG8_WAIT_V(8); PG8_WAIT_L(0); PG8_BAR; PG8_MMA(0, 0, At, B0); PG8_MMA(0, 1, At, B1); PG8_BAR; PG8_SCHED;
            PG8_LDA(At, 0, 1); PG8_STAGE(PG8_SB(0, 0), b2, voffB); PG8_STAGE(PG8_SB(0, 1), b2 + hstep, voffB); PG8_STAGE(PG8_SA(0, 0), a2, voffA);
            PG8_WAIT_V(8); PG8_WAIT_L(0); PG8_BAR; PG8_MMA(1, 0, At, B0); PG8_MMA(1, 1, At, B1); PG8_BAR; PG8_SCHED;
            PG8_LDB(B0, 1, 0); PG8_LDB(B1, 1, 1); PG8_SCHED; PG8_LDA(At, 1, 0); PG8_STAGE(PG8_SA(0, 1), a2 + hstep, voffA);
            PG8_WAIT_V(8); PG8_WAIT_L(0); PG8_BAR; PG8_MMA(0, 0, At, B0); PG8_MMA(0, 1, At, B1); PG8_BAR; PG8_SCHED;
            PG8_LDA(At, 1, 1); PG8_STAGE(PG8_SB(1, 0), b3, voffB); PG8_STAGE(PG8_SB(1, 1), b3 + hstep, voffB); PG8_STAGE(PG8_SA(1, 0), a3, voffA);
            PG8_WAIT_V(8); PG8_WAIT_L(0); PG8_BAR; PG8_MMA(1, 0, At, B0); PG8_MMA(1, 1, At, B1); PG8_BAR; PG8_SCHED;
            } else {
            PG8_LDB(B0, 0, 0); PG8_SCHED; PG8_LDA(At, 0, 0); PG8_STAGE(PG8_SA(1, 1), a1 + hstep, voffA);
            PG8_WAIT_L(8); PG8_BAR; PG8_WAIT_L(0); PG8_MMA(0, 0, At, B0); PG8_BAR; PG8_SCHED;
            PG8_LDB(B1, 0, 1); PG8_STAGE(PG8_SB(0, 0), b2, voffB);
            PG8_BAR; PG8_WAIT_L(0); PG8_MMA(0, 1, At, B1); PG8_BAR;
            PG8_LDA(At, 0, 1); PG8_STAGE(PG8_SA(0, 0), a2, voffA);
            PG8_BAR; PG8_WAIT_L(0); PG8_MMA(1, 0, At, B0); PG8_BAR; PG8_SCHED;
            PG8_STAGE(PG8_SB(0, 1), b2 + hstep, voffB);
            PG8_WAIT_V(6); PG8_BAR; PG8_MMA(1, 1, At, B1); PG8_BAR;
            PG8_LDB(B0, 1, 0); PG8_SCHED; PG8_LDA(At, 1, 0); PG8_STAGE(PG8_SA(0, 1), a2 + hstep, voffA);
            PG8_WAIT_L(8); PG8_BAR; PG8_WAIT_L(0); PG8_MMA(0, 0, At, B0); PG8_BAR; PG8_SCHED;
            PG8_LDB(B1, 1, 1); PG8_STAGE(PG8_SB(1, 0), b3, voffB);
            PG8_BAR; PG8_WAIT_L(0); PG8_MMA(0, 1, At, B1); PG8_BAR;
            PG8_LDA(At, 1, 1); PG8_STAGE(PG8_SA(1, 0), a3, voffA);
            PG8_BAR; PG8_WAIT_L(0); PG8_MMA(1, 0, At, B0); PG8_BAR; PG8_SCHED;
            PG8_STAGE(PG8_SB(1, 1), b3 + hstep, voffB);
            PG8_WAIT_V(6); PG8_BAR; PG8_MMA(1, 1, At, B1); PG8_BAR;
            }
        }
        if constexpr (ALIGN_EPI) { if (wr == 0) PG8_BAR; }
        if constexpr (!Epi::AFTER_DRAIN) { E(acc, cur, wr, wc, fr, fq); S.done(cur); }
        if (!has_next) break;
#pragma unroll
        for (int a = 0; a < 2; ++a)
#pragma unroll
            for (int b = 0; b < 2; ++b)
#pragma unroll
                for (int m = 0; m < 4; ++m)
#pragma unroll
                    for (int n = 0; n < 2; ++n) acc[a][b][m][n] = (f32x4){0.f, 0.f, 0.f, 0.f};
        cur = nxt; cA = nA; cB = nB; ++ui;
        if constexpr (ALIGN_EPI) { if (wr == 1) PG8_BAR; }
    }
    PG8_WAIT_V(0);
    if constexpr (!ALIGN_EPI) { if (wr == 0) PG8_BAR; }
    PG8_BAR;
    if constexpr (Epi::AFTER_DRAIN) { E.fused(acc, cur, wr, wc, fr, fq, lds, wid, lane); S.done(cur); }
#undef PG8_SA
#undef PG8_SB
#undef PG8_STAGE
#undef PG8_LDA
#undef PG8_LDB
#undef PG8_MMA
#undef PG8_WAIT_V
#undef PG8_WAIT_L
#undef PG8_BAR
#undef PG8_SCHED
}
}

constexpr int DM = 2048, NTOK = 8192, SEQ = 4096, GW = 4096, NGRP = 16, GDIM = 256, CHUNK = 128, NHEAD = 16, HD = 128;
constexpr float EPS = 1e-6f;
constexpr float LOG2E = 1.4426950408889634f;
constexpr float QSCALE = 0.08838834764831845f * LOG2E;

constexpr float GELU_C1 = -1.5957691216057308f * LOG2E, GELU_C2 = -0.07135481627260025f * LOG2E;
__device__ __forceinline__ float gelu_tanh(float x) {
    const float e = __builtin_amdgcn_exp2f(x * __builtin_fmaf(x * x, GELU_C2, GELU_C1));
    return x * __builtin_amdgcn_rcpf(1.0f + e);
}
__device__ __forceinline__ float gelu_silu(float u, float z) {
    const float e1 = __builtin_amdgcn_exp2f(u * __builtin_fmaf(u * u, GELU_C2, GELU_C1));
    const float e2 = __builtin_amdgcn_exp2f(z * -LOG2E);
    return (u * z) * __builtin_amdgcn_rcpf((1.0f + e1) * (1.0f + e2));
}
__device__ __forceinline__ float silu_f(float z) { return z * __builtin_amdgcn_rcpf(1.0f + __builtin_amdgcn_exp2f(-LOG2E * z)); }

namespace pg8 {
typedef unsigned u32x2 __attribute__((ext_vector_type(2)));
__device__ __forceinline__ void conv_load4(const float* __restrict__ W, int N, int item, int lane, f32x4 (&x)[16]) {
    const int nblk = N / 64, k0 = 64 * (item / nblk), n0 = 64 * (item % nblk);
#pragma unroll
    for (int i = 0; i < 16; ++i) x[i] = __builtin_nontemporal_load((const f32x4*)(W + (size_t)(k0 + 4 * i + (lane >> 4)) * N + n0 + 4 * (lane & 15)));
}
__device__ __forceinline__ void conv_xpose(f32x4 (&x)[16], int lane) {
    const bool a = (lane >> 4) & 1, b = (lane >> 5) & 1;
#pragma unroll
    for (int i = 0; i < 16; ++i) {
        f32x4 v = x[i];
        {
            const float s0 = a ? v[0] : v[1], s1 = a ? v[2] : v[3];
            const float r0 = __shfl_xor(s0, 16), r1 = __shfl_xor(s1, 16);
            if (a) { v[0] = r0; v[2] = r1; } else { v[1] = r0; v[3] = r1; }
        }
        {
            const float s0 = b ? v[0] : v[2], s1 = b ? v[1] : v[3];
            const float r0 = __shfl_xor(s0, 32), r1 = __shfl_xor(s1, 32);
            if (b) { v[0] = r0; v[1] = r1; } else { v[2] = r0; v[3] = r1; }
        }
        x[i] = v;
    }
}
__device__ __forceinline__ void conv_store4(int K, int N, bf16_t* __restrict__ WT, int item, int lane, const float* __restrict__ gk, const f32x4 (&x)[16]) {
    const int nblk = N / 64, k0 = 64 * (item / nblk), n0 = 64 * (item % nblk);
    const int n = n0 + 4 * (lane & 15) + (lane >> 4);
#pragma unroll
    for (int kc = 0; kc < 8; ++kc) {
        float g[8];
#pragma unroll
        for (int j = 0; j < 8; ++j) g[j] = gk ? gk[k0 + 8 * kc + j] : 1.0f;
        const f32x4 lo = x[2 * kc], hi = x[2 * kc + 1];
        u32x4 o; o.x = cvt_pk_bf16(lo[0] * g[0], lo[1] * g[1]); o.y = cvt_pk_bf16(lo[2] * g[2], lo[3] * g[3]);
        o.z = cvt_pk_bf16(hi[0] * g[4], hi[1] * g[5]); o.w = cvt_pk_bf16(hi[2] * g[6], hi[3] * g[7]);
        *(u32x4*)(WT + (size_t)n * K + k0 + 8 * kc) = o;
    }
}
__device__ __forceinline__ void conv_store4_lds(int K, int N, bf16_t* __restrict__ WT, int item, int lane, const float* __restrict__ gk, const f32x4 (&x)[16], PG8_LAS unsigned char* sw) {
    const int nblk = N / 64, k0 = 64 * (item / nblk), n0 = 64 * (item % nblk);
    const int nq = lane & 15, r = lane >> 4;
    u32x4 o[8];
#pragma unroll
    for (int kc = 0; kc < 8; ++kc) {
        float g[8];
#pragma unroll
        for (int j = 0; j < 8; ++j) g[j] = gk ? gk[k0 + 8 * kc + j] : 1.0f;
        const f32x4 lo = x[2 * kc], hi = x[2 * kc + 1];
        o[kc].x = cvt_pk_bf16(lo[0] * g[0], lo[1] * g[1]); o[kc].y = cvt_pk_bf16(lo[2] * g[2], lo[3] * g[3]);
        o[kc].z = cvt_pk_bf16(hi[0] * g[4], hi[1] * g[5]); o[kc].w = cvt_pk_bf16(hi[2] * g[6], hi[3] * g[7]);
    }
#pragma unroll
    for (int q = 0; q < 4; ++q) {
        if ((nq >> 2) == q) {
            PG8_LAS u32x4* wp = (PG8_LAS u32x4*)(sw + (4 * (nq & 3) + r) * 128);
#pragma unroll
            for (int kc = 0; kc < 8; ++kc) wp[kc] = o[kc];
        }
        asm volatile("s_waitcnt lgkmcnt(0)" ::: "memory");
#pragma unroll
        for (int h = 0; h < 2; ++h) { const int rl = (lane >> 3) + 8 * h;
            const u32x4 v = *(const PG8_LAS u32x4*)(sw + rl * 128 + (lane & 7) * 16);
            __builtin_nontemporal_store(v, (u32x4*)(WT + (size_t)(n0 + 16 * q + rl) * K + k0 + 8 * (lane & 7))); }
        asm volatile("s_waitcnt lgkmcnt(0)" ::: "memory");
    }
}
struct ConvOrder : StaticOrder {
    const float *w2, *w3, *w4, *g1; bf16_t *t2, *t3, *t4; int gw, ngw, trigger, ln; PG8_LAS unsigned char* sw; mutable int n_done;
    __device__ __forceinline__ void done(const Unit&) const {
        constexpr int I2 = (GW / 64) * (DM / 64), I3 = (DM / 64) * (4 * DM / 64), I4 = (DM / 64) * (DM / 64);
        const int u = n_done++;
#ifdef HOOK_SPREAD
        f32x4 va[16];
        if (u == 0 || u == 1) { for (int it = gw + u * ngw; it < I3; it += 2 * ngw) { conv_load4(w3, 4 * DM, it, ln, va); conv_xpose(va, ln); conv_store4(DM, 4 * DM, t3, it, ln, g1, va); } }
        else if (u == 2) { for (int it = gw; it < I2; it += ngw) { conv_load4(w2, DM, it, ln, va); conv_xpose(va, ln); conv_store4(GW, DM, t2, it, ln, nullptr, va); } }
        else if (u == 3) { for (int it = gw; it < I4; it += ngw) { conv_load4(w4, DM, it, ln, va); conv_xpose(va, ln); conv_store4(DM, DM, t4, it, ln, nullptr, va); } }
#else
        if (u != trigger) return;
        f32x4 va[16], vb[16];
        for (int it = gw; it < I3; it += 2 * ngw) {
            const bool two = it + ngw < I3;
            conv_load4(w3, 4 * DM, it, ln, va); if (two) conv_load4(w3, 4 * DM, it + ngw, ln, vb);
            conv_xpose(va, ln); if (two) conv_xpose(vb, ln);
            conv_store4_lds(DM, 4 * DM, t3, it, ln, g1, va, sw); if (two) conv_store4_lds(DM, 4 * DM, t3, it + ngw, ln, g1, vb, sw);
        }
        for (int it = gw; it < I2; it += ngw) {
            const bool two = it < I4;
            conv_load4(w2, DM, it, ln, va); if (two) conv_load4(w4, DM, it, ln, vb);
            conv_xpose(va, ln); if (two) conv_xpose(vb, ln);
            conv_store4_lds(GW, DM, t2, it, ln, nullptr, va, sw); if (two) conv_store4_lds(DM, DM, t4, it, ln, nullptr, vb, sw);
        }
#endif
    }
};
struct EpiGmlpIn {
    static constexpr bool PERM = true, AFTER_DRAIN = false;
    bf16_t *UZ, *V; float* vss;
    __device__ __forceinline__ void operator()(const f32x4 (&acc)[2][2][4][2], const Unit& u, int wr, int wc, int fr, int fq) const {
        const int row0 = u.pm * BM + wr * 64 + fr;
        const int tq = u.pn / 3, tr = u.pn - 3 * tq;
        if (tr < 2) {
            const int col0 = (2 * tq + tr) * HALF + wc * 32 + 8 * fq;
#pragma unroll
            for (int ai = 0; ai < 2; ++ai)
#pragma unroll
                for (int m = 0; m < 4; ++m) {
                    const int row = row0 + ai * HALF + m * 16;
                    f32x4 v0 = acc[ai][0][m][0], v1 = acc[ai][0][m][1]; const f32x4 z0 = acc[ai][1][m][0], z1 = acc[ai][1][m][1];
#pragma unroll
                    for (int e = 0; e < 4; ++e) { v0[e] = gelu_silu(v0[e], z0[e]); v1[e] = gelu_silu(v1[e], z1[e]); }
                    u32x4 w; w.x = cvt_pk_bf16(v0[0], v0[1]); w.y = cvt_pk_bf16(v0[2], v0[3]); w.z = cvt_pk_bf16(v1[0], v1[1]); w.w = cvt_pk_bf16(v1[2], v1[3]);
                    *(u32x4*)(UZ + (size_t)row * GW + col0) = w;
                }
        } else {
            const int tl = tq, col0 = tl * BM + wc * 32 + 8 * fq;
#pragma unroll
            for (int ai = 0; ai < 2; ++ai)
#pragma unroll
                for (int m = 0; m < 4; ++m) {
                    const int row = row0 + ai * HALF + m * 16;
                    bf16_t* rowp = V + (size_t)row * GW + col0;
                    float ss = 0.f;
#pragma unroll
                    for (int bj = 0; bj < 2; ++bj) {
                        f32x4 v0 = acc[ai][bj][m][0], v1 = acc[ai][bj][m][1];
#pragma unroll
                        for (int e = 0; e < 4; ++e) { v0[e] = gelu_tanh(v0[e]); v1[e] = gelu_tanh(v1[e]); ss += v0[e] * v0[e] + v1[e] * v1[e]; }
                        u32x4 w; w.x = cvt_pk_bf16(v0[0], v0[1]); w.y = cvt_pk_bf16(v0[2], v0[3]); w.z = cvt_pk_bf16(v1[0], v1[1]); w.w = cvt_pk_bf16(v1[2], v1[3]);
                        *(u32x4*)(rowp + bj * HALF) = w;
                    }
                    ss += __shfl_xor(ss, 16); ss += __shfl_xor(ss, 32);
                    if (fq == 0) __hip_atomic_fetch_add(vss + row, ss, __ATOMIC_RELAXED, __HIP_MEMORY_SCOPE_AGENT);
                }
        }
    }
};
struct EpiRes1 {
    static constexpr bool PERM = true, AFTER_DRAIN = false;
    const bf16_t* hn; const float* irs; bf16_t* hb; float* hss;
    __device__ __forceinline__ void operator()(const f32x4 (&acc)[2][2][4][2], const Unit& u, int wr, int wc, int fr, int fq) const {
        const int row0 = u.pm * BM + wr * 64 + fr, col0 = u.pn * BM + wc * 32 + 8 * fq;
        float rs[2][4];
#pragma unroll
        for (int ai = 0; ai < 2; ++ai)
#pragma unroll
            for (int m = 0; m < 4; ++m) rs[ai][m] = irs[row0 + ai * HALF + m * 16];
#pragma unroll
        for (int ai = 0; ai < 2; ++ai) {
            u32x4 xv[4][2];
#pragma unroll
            for (int m = 0; m < 4; ++m)
#pragma unroll
                for (int bj = 0; bj < 2; ++bj) xv[m][bj] = *(const u32x4*)(hn + (size_t)(row0 + ai * HALF + m * 16) * DM + col0 + bj * HALF);
#pragma unroll
            for (int m = 0; m < 4; ++m) {
                const int row = row0 + ai * HALF + m * 16;
                const size_t off = (size_t)row * DM + col0;
                float ss = 0.f;
#pragma unroll
                for (int bj = 0; bj < 2; ++bj) {
                    const u32x4 w4 = xv[m][bj];
                    f32x4 x0, x1;
                    x0[0] = __uint_as_float(w4.x << 16); x0[1] = __uint_as_float(w4.x & 0xffff0000u); x0[2] = __uint_as_float(w4.y << 16); x0[3] = __uint_as_float(w4.y & 0xffff0000u);
                    x1[0] = __uint_as_float(w4.z << 16); x1[1] = __uint_as_float(w4.z & 0xffff0000u); x1[2] = __uint_as_float(w4.w << 16); x1[3] = __uint_as_float(w4.w & 0xffff0000u);
                    const f32x4 h0 = x0 * rs[ai][m] + acc[ai][bj][m][0], h1 = x1 * rs[ai][m] + acc[ai][bj][m][1];
                    ss += ((h0[0] * h0[0] + h0[1] * h0[1]) + (h0[2] * h0[2] + h0[3] * h0[3])) + ((h1[0] * h1[0] + h1[1] * h1[1]) + (h1[2] * h1[2] + h1[3] * h1[3]));
                    u32x4 o; o.x = cvt_pk_bf16(h0[0], h0[1]); o.y = cvt_pk_bf16(h0[2], h0[3]); o.z = cvt_pk_bf16(h1[0], h1[1]); o.w = cvt_pk_bf16(h1[2], h1[3]);
                    *(u32x4*)(hb + off + bj * HALF) = o;
                }
                ss += __shfl_xor(ss, 16); ss += __shfl_xor(ss, 32);
                if (fq == 0) __hip_atomic_fetch_add(hss + row, ss, __ATOMIC_RELAXED, __HIP_MEMORY_SCOPE_AGENT);
            }
        }
    }
};
struct EpiFinal {
    static constexpr bool PERM = true, AFTER_DRAIN = false;
    const bf16_t* hb; const float* fg; float* out; float* hss; unsigned* cnt; bool fused;
    __device__ __forceinline__ void operator()(f32x4 (&acc)[2][2][4][2], const Unit& u, int wr, int wc, int fr, int fq) const {
        const int row0 = u.pm * BM + wr * 64 + fr, col0 = u.pn * BM + wc * 32 + 8 * fq;
#pragma unroll
        for (int ai = 0; ai < 2; ++ai)
#pragma unroll
            for (int m = 0; m < 4; ++m) {
                const int row = row0 + ai * HALF + m * 16;
                const size_t off = (size_t)row * DM + col0;
                float ss = 0.f;
#pragma unroll
                for (int bj = 0; bj < 2; ++bj) {
                    const u32x4 w = *(const u32x4*)(hb + off + bj * HALF);
                    f32x4 h0, h1;
                    h0[0] = __uint_as_float(w.x << 16); h0[1] = __uint_as_float(w.x & 0xffff0000u); h0[2] = __uint_as_float(w.y << 16); h0[3] = __uint_as_float(w.y & 0xffff0000u);
                    h1[0] = __uint_as_float(w.z << 16); h1[1] = __uint_as_float(w.z & 0xffff0000u); h1[2] = __uint_as_float(w.w << 16); h1[3] = __uint_as_float(w.w & 0xffff0000u);
                    h0 += acc[ai][bj][m][0]; h1 += acc[ai][bj][m][1];
                    acc[ai][bj][m][0] = h0; acc[ai][bj][m][1] = h1;
                    ss += ((h0[0] * h0[0] + h0[1] * h0[1]) + (h0[2] * h0[2] + h0[3] * h0[3])) + ((h1[0] * h1[0] + h1[1] * h1[1]) + (h1[2] * h1[2] + h1[3] * h1[3]));
                }
                ss += __shfl_xor(ss, 16); ss += __shfl_xor(ss, 32);
                if (fq == 0) __hip_atomic_fetch_add(hss + row, ss, __ATOMIC_RELAXED, __HIP_MEMORY_SCOPE_AGENT);
            }
        if (!fused) {
#pragma unroll
            for (int ai = 0; ai < 2; ++ai)
#pragma unroll
                for (int m = 0; m < 4; ++m)
#pragma unroll
                    for (int bj = 0; bj < 2; ++bj)
#pragma unroll
                        for (int n = 0; n < 2; ++n) *(f32x4*)(out + (size_t)(row0 + ai * HALF + m * 16) * DM + col0 + bj * HALF + n * 4) = acc[ai][bj][m][n];
            return;
        }
        asm volatile("s_waitcnt vmcnt(0)" ::: "memory");
        unsigned* pc = cnt + 64 * u.pm;
        if (lane_id() == 0) __hip_atomic_fetch_add(pc, 1u, __ATOMIC_RELAXED, __HIP_MEMORY_SCOPE_AGENT);
        for (int it = 0; it < (1 << 22); ++it) {
            if (__hip_atomic_load(pc, __ATOMIC_RELAXED, __HIP_MEMORY_SCOPE_AGENT) >= 64u) break;
            __builtin_amdgcn_s_sleep(2);
        }
        asm volatile("" ::: "memory");
        f32x4 gv[2][2];
#pragma unroll
        for (int bj = 0; bj < 2; ++bj)
#pragma unroll
            for (int n = 0; n < 2; ++n) gv[bj][n] = *(const f32x4*)(fg + col0 + bj * HALF + n * 4);
        float ssr[2][4];
#pragma unroll
        for (int ai = 0; ai < 2; ++ai)
#pragma unroll
            for (int m = 0; m < 4; ++m) ssr[ai][m] = __hip_atomic_load(hss + row0 + ai * HALF + m * 16, __ATOMIC_RELAXED, __HIP_MEMORY_SCOPE_AGENT);
#pragma unroll
        for (int ai = 0; ai < 2; ++ai)
#pragma unroll
            for (int m = 0; m < 4; ++m) {
                const int row = row0 + ai * HALF + m * 16;
                const size_t off = (size_t)row * DM + col0;
                const float rstd = __builtin_amdgcn_rsqf(ssr[ai][m] * (1.0f / DM) + EPS);
#pragma unroll
                for (int bj = 0; bj < 2; ++bj)
#pragma unroll
                    for (int n = 0; n < 2; ++n) *(f32x4*)(out + off + bj * HALF + n * 4) = acc[ai][bj][m][n] * rstd * gv[bj][n];
            }
    }
};
struct EpiSbIn {
    static constexpr bool PERM = true, AFTER_DRAIN = false;
    bf16_t* Q; size_t rstride; const float* hss;
    __device__ __forceinline__ void operator()(const f32x4 (&acc)[2][2][4][2], const Unit& u, int wr, int wc, int fr, int fq) const {
        const int region = u.pn >> 3, tl = u.pn & 7;
        bf16_t* base = Q + (size_t)region * rstride;
        const int row0 = u.pm * BM + wr * 64 + fr, col0 = tl * BM + wc * 32 + 8 * fq;
        float ssr[2][4];
#pragma unroll
        for (int ai = 0; ai < 2; ++ai)
#pragma unroll
            for (int m = 0; m < 4; ++m) ssr[ai][m] = hss[row0 + ai * HALF + m * 16];
#pragma unroll
        for (int ai = 0; ai < 2; ++ai)
#pragma unroll
            for (int m = 0; m < 4; ++m) {
                const int row = row0 + ai * HALF + m * 16;
                float sc = __builtin_amdgcn_rsqf(ssr[ai][m] * (1.0f / DM) + EPS);
                if (region == 0) sc *= QSCALE;
                bf16_t* rowp = base + (size_t)row * DM + col0;
#pragma unroll
                for (int bj = 0; bj < 2; ++bj) {
                    f32x4 v0 = acc[ai][bj][m][0] * sc, v1 = acc[ai][bj][m][1] * sc;
                    if (region == 3) {
#pragma unroll
                        for (int e = 0; e < 4; ++e) { v0[e] = silu_f(v0[e]); v1[e] = silu_f(v1[e]); }
                    }
                    u32x4 w; w.x = cvt_pk_bf16(v0[0], v0[1]); w.y = cvt_pk_bf16(v0[2], v0[3]); w.z = cvt_pk_bf16(v1[0], v1[1]); w.w = cvt_pk_bf16(v1[2], v1[3]);
                    *(u32x4*)(rowp + bj * HALF) = w;
                }
            }
    }
};
}

#define LAS __attribute__((address_space(3)))
typedef unsigned short bf16_t;
typedef short bf16x8 __attribute__((ext_vector_type(8)));
typedef short s16x4 __attribute__((ext_vector_type(4)));
typedef float f32x4 __attribute__((ext_vector_type(4)));
typedef float f32x16 __attribute__((ext_vector_type(16)));
typedef unsigned u32x4 __attribute__((ext_vector_type(4)));
typedef unsigned u32x2 __attribute__((ext_vector_type(2)));
__device__ __forceinline__ unsigned off_b(unsigned row, unsigned ch) { return 256u * row + 16u * (ch ^ (((row & 3u) << 2) | ((row >> 2) & 3u))); }
__device__ __forceinline__ s16x4 vtr(const LAS unsigned char* p) { return __builtin_bit_cast(s16x4, __builtin_amdgcn_ds_read_tr16_b64_v4i16((LAS s16x4*)p)); }
__device__ __forceinline__ unsigned pk_bf16(float lo, float hi) { return pg8::cvt_pk_bf16(lo, hi); }
__device__ __forceinline__ float bf_lo(unsigned w) { return __uint_as_float(w << 16); }
__device__ __forceinline__ float bf_hi(unsigned w) { return __uint_as_float(w & 0xffff0000u); }
__device__ __forceinline__ int crow(int r, int hi) { return (r & 3) + 8 * (r >> 2) + 4 * hi; }

#ifdef ATT_NOSB
#define ATT_SB() do {} while (0)
#else
#ifndef ATT_USE_SB
#define ATT_SB() do {} while (0)
#else
#define ATT_SB() __builtin_amdgcn_sched_barrier(0)
#endif
#endif
#define ATT_VLD(f) do { const int c_ = (f) >> 2, s_ = (f) & 3; const s16x4 lo_ = vtr(vbp + 4096 * s_ + vbase[0] + vcq[c_]); const s16x4 hh_ = vtr(vbp + 4096 * s_ + vbase[1] + vcq[c_]); \
        vf[f] = (bf16x8){lo_[0], lo_[1], lo_[2], lo_[3], hh_[0], hh_[1], hh_[2], hh_[3]}; } while (0)
#define ATT_PV(f) do { if (DO_PV) { o[(f) >> 2] = __builtin_amdgcn_mfma_f32_32x32x16_bf16(pa[(f) & 3], vf[f], o[(f) >> 2], 0, 0, 0); if ((f) + 4 < 16) ATT_VLD((f) + 4); } } while (0)
#define ATT_EXP8(i) do { _Pragma("unroll") for (int r_ = 0; r_ < 8; ++r_) p[(i) >> 1][8 * ((i) & 1) + r_] = __builtin_amdgcn_exp2f(fminf(p[(i) >> 1][8 * ((i) & 1) + r_], 30.f)); } while (0)
#define ATT_LBLK(j) do { const int ph_ = 1 - ((j) >> 2), g_ = 3 - ((j) & 3); \
        const float w0_ = 1.0f + p[ph_][4 * g_], w1_ = 1.0f + p[ph_][4 * g_ + 1], w2_ = 1.0f + p[ph_][4 * g_ + 2], w3_ = 1.0f + p[ph_][4 * g_ + 3]; \
        L[j] = __builtin_amdgcn_logf((w0_ * w1_) * (w2_ * w3_)); } while (0)
#define ATT_XCH(j) do { const float own_ = L[j]; const auto rr_ = __builtin_amdgcn_permlane32_swap(__float_as_uint(own_), __float_as_uint(own_), false, false); \
        const float a0_ = __uint_as_float(rr_[0]), a1_ = __uint_as_float(rr_[1]); const float oth_ = (a0_ == own_) ? a1_ : a0_; \
        T[j] = run + (hi ? 0.f : oth_) + own_; run += a0_ + a1_; } while (0)
#define ATT_WGT(j) do { const int ph_ = 1 - ((j) >> 2), g_ = 3 - ((j) & 3); float cf_ = __builtin_amdgcn_exp2f(-T[j]); \
        _Pragma("unroll") for (int e_ = 0; e_ < 4; ++e_) { const float ev_ = p[ph_][4 * g_ + e_]; p[ph_][4 * g_ + e_] = ev_ * cf_; if (e_ < 3) cf_ *= (1.0f + ev_); } } while (0)

template <bool DO_PV>
__device__ __forceinline__ void attn_tile(const LAS unsigned char* kb, const LAS unsigned char* vbp, const bf16x8 (&qf)[8], f32x16 (&o)[4], bf16x8 (&pa)[4], float& carry,
                                          const unsigned (&koff)[8], const unsigned (&vbase)[2], const unsigned (&vcq)[4], int k0, int qw0, int qabs, int hi) {
    f32x16 p[2];
#pragma unroll
    for (int r = 0; r < 16; ++r) { p[0][r] = 0.f; p[1][r] = 0.f; }
    bf16x8 vf[16];
    if (DO_PV) { ATT_VLD(0); ATT_VLD(1); ATT_VLD(2); ATT_VLD(3); }
    {
        bf16x8 ka[8], kc[8];
#pragma unroll
        for (int d0 = 0; d0 < 8; ++d0) { ka[d0] = *(const LAS bf16x8*)(kb + koff[d0]); kc[d0] = *(const LAS bf16x8*)(kb + 8192 + koff[d0]); }
        ATT_SB();
#pragma unroll
        for (int d0 = 0; d0 < 8; ++d0) {
            p[0] = __builtin_amdgcn_mfma_f32_32x32x16_bf16(ka[d0], qf[d0], p[0], 0, 0, 0);
            p[1] = __builtin_amdgcn_mfma_f32_32x32x16_bf16(kc[d0], qf[d0], p[1], 0, 0, 0);
        }
    }
    ATT_SB();
    const bool need_mask = (k0 + 63 >= qw0);
    float L[8], T[8];
    ATT_PV(0); ATT_EXP8(0); ATT_SB();
    ATT_PV(1); ATT_EXP8(1); ATT_SB();
    ATT_PV(2); ATT_EXP8(2); ATT_SB();
    ATT_PV(3); ATT_EXP8(3); ATT_SB();
    if (need_mask) {
#pragma unroll
        for (int ph = 0; ph < 2; ++ph)
#pragma unroll
            for (int r = 0; r < 16; ++r) { const int key = k0 + 32 * ph + crow(r, hi); if (key >= qabs) p[ph][r] = 0.f; }
    }
    ATT_SB();
    ATT_PV(4); ATT_LBLK(0); ATT_LBLK(1); ATT_SB();
    ATT_PV(5); ATT_LBLK(2); ATT_LBLK(3); ATT_SB();
    ATT_PV(6); ATT_LBLK(4); ATT_LBLK(5); ATT_SB();
    ATT_PV(7); ATT_LBLK(6); ATT_LBLK(7); ATT_SB();
    float run = carry;
    ATT_PV(8); ATT_XCH(0); ATT_XCH(1); ATT_SB();
    ATT_PV(9); ATT_XCH(2); ATT_XCH(3); ATT_SB();
    ATT_PV(10); ATT_XCH(4); ATT_XCH(5); ATT_SB();
    ATT_PV(11); ATT_XCH(6); ATT_XCH(7); ATT_SB();
    carry = run;
    ATT_PV(12); ATT_WGT(0); ATT_WGT(1); ATT_SB();
    ATT_PV(13); ATT_WGT(2); ATT_WGT(3); ATT_SB();
    ATT_PV(14); ATT_WGT(4); ATT_WGT(5); ATT_SB();
    ATT_PV(15); ATT_WGT(6); ATT_WGT(7); ATT_SB();
#pragma unroll
    for (int s = 0; s < 4; ++s) { const int ph = s >> 1, rb = 8 * (s & 1);
        u32x4 w; w.x = pk_bf16(p[ph][rb], p[ph][rb + 1]); w.y = pk_bf16(p[ph][rb + 2], p[ph][rb + 3]); w.z = pk_bf16(p[ph][rb + 4], p[ph][rb + 5]); w.w = pk_bf16(p[ph][rb + 6], p[ph][rb + 7]);
        pa[s] = __builtin_bit_cast(bf16x8, w); }
}

__device__ __forceinline__ void attn_unit(LAS unsigned char* lds, const int wid, int b, int h, int qb, const bf16_t* __restrict__ Q, const bf16_t* __restrict__ K,
                                          const bf16_t* __restrict__ V, const bf16_t* __restrict__ ZS, bf16_t* __restrict__ OG) {
    const int tid = tid_of(wid), lane = tid & 63, r32 = lane & 31, hi = lane >> 5;
    const size_t tok0 = (size_t)b * SEQ;
    const int q0 = qb * 256, qw0 = q0 + 32 * wid, qabs = qw0 + r32;
    bf16x8 qf[8];
    { const bf16_t* qp = Q + (tok0 + qabs) * DM + h * HD + 8 * hi;
#pragma unroll
      for (int d0 = 0; d0 < 8; ++d0) qf[d0] = *(const bf16x8*)(qp + 16 * d0); }
    f32x16 o[4];
#pragma unroll
    for (int c = 0; c < 4; ++c)
#pragma unroll
        for (int r = 0; r < 16; ++r) o[c][r] = 0.f;
    bf16x8 pa[4];
#pragma unroll
    for (int s = 0; s < 4; ++s) pa[s] = (bf16x8){0, 0, 0, 0, 0, 0, 0, 0};
    float carry = 0.f;
    const int NT = (q0 + 256) / 64;
    const int srow = tid >> 4, sch = (tid & 15) ^ (((srow & 3) << 2) | ((srow >> 2) & 3));
    const bf16_t* kg = K + (tok0 + srow) * DM + h * HD + sch * 8;
    const bf16_t* vg = V + (tok0 + srow) * DM + h * HD + sch * 8;
    LAS unsigned char* ldsw = lds + wid * 1024;
#define ATT_STAGE(t_, koff_, voff_) do { const size_t go_ = (size_t)(t_) * 64 * DM; \
        __builtin_amdgcn_global_load_lds((const unsigned*)(kg + go_), (LAS unsigned*)(ldsw + (koff_)), 16, 0, 0); \
        __builtin_amdgcn_global_load_lds((const unsigned*)(kg + go_ + 32 * DM), (LAS unsigned*)(ldsw + (koff_) + 8192), 16, 0, 0); \
        __builtin_amdgcn_global_load_lds((const unsigned*)(vg + go_), (LAS unsigned*)(ldsw + (voff_)), 16, 0, 0); \
        __builtin_amdgcn_global_load_lds((const unsigned*)(vg + go_ + 32 * DM), (LAS unsigned*)(ldsw + (voff_) + 8192), 16, 0, 0); } while (0)
    ATT_STAGE(NT - 1, 0, 32768);
    asm volatile("s_waitcnt vmcnt(0)" ::: "memory");
    __syncthreads();
    unsigned koff[8];
#pragma unroll
    for (int d0 = 0; d0 < 8; ++d0) koff[d0] = off_b(r32, 2 * d0 + hi);
    const unsigned qa = (lane & 15) >> 2, blk = (lane >> 4) & 1, pp = lane & 3;
    unsigned vbase[2], vcq[4];
#pragma unroll
    for (int t = 0; t < 2; ++t) vbase[t] = 256u * (8 * t + 4 * hi + qa) + 16u * ((2 * blk + (pp >> 1)) ^ ((2 * t + hi) & 3)) + 8u * (pp & 1);
#pragma unroll
    for (int c = 0; c < 4; ++c) vcq[c] = 64u * ((unsigned)c ^ qa);
    int kcur = 0, vprev = 2, vcur = 0, vnext = 1;
    bool prev_valid = false;
    for (int t = NT - 1; t >= 0; --t) {
        if (t > 0) ATT_STAGE(t - 1, (kcur ^ 1) * 16384, 32768 + vnext * 16384);
        const LAS unsigned char* kb = lds + kcur * 16384;
        const LAS unsigned char* vbp = lds + 32768 + vprev * 16384;
        const int k0 = 64 * t;
        const bool valid = (k0 < qw0 + 31);
        if (valid) {
            if (prev_valid) attn_tile<true>(kb, vbp, qf, o, pa, carry, koff, vbase, vcq, k0, qw0, qabs, hi);
            else            attn_tile<false>(kb, vbp, qf, o, pa, carry, koff, vbase, vcq, k0, qw0, qabs, hi);
        }
        prev_valid = valid;
        asm volatile("s_waitcnt vmcnt(0)" ::: "memory");
        __syncthreads();
        kcur ^= 1; { const int tmp = vprev; vprev = vcur; vcur = vnext; vnext = tmp; }
    }
    { const LAS unsigned char* vbp = lds + 32768 + vprev * 16384;
#pragma unroll
      for (int c = 0; c < 4; ++c)
#pragma unroll
          for (int s = 0; s < 4; ++s) {
              const s16x4 lo = vtr(vbp + 4096 * s + vbase[0] + vcq[c]);
              const s16x4 hh = vtr(vbp + 4096 * s + vbase[1] + vcq[c]);
              const bf16x8 vfr = (bf16x8){lo[0], lo[1], lo[2], lo[3], hh[0], hh[1], hh[2], hh[3]};
              o[c] = __builtin_amdgcn_mfma_f32_32x32x16_bf16(pa[s], vfr, o[c], 0, 0, 0);
          } }
    {
        int lane_e = lane_id(); asm volatile("" : "+v"(lane_e));
        const int r32e = lane_e & 31, hie = lane_e >> 5, rowq = lane_e >> 3, c8 = (lane_e & 7) * 8;
        LAS float* stg = (LAS float*)(lds + 81920 + wid * 8192);
        const size_t gbase = (tok0 + qw0) * DM + h * HD + c8;
        u32x4 zv[2][4];
#pragma unroll
        for (int ps = 0; ps < 2; ++ps)
#pragma unroll
            for (int j = 0; j < 4; ++j) zv[ps][j] = *(const u32x4*)(ZS + gbase + (size_t)(8 * j + rowq) * DM + 64 * ps);
#pragma unroll
        for (int ps = 0; ps < 2; ++ps) {
#pragma unroll
            for (int r = 0; r < 16; ++r) {
                stg[crow(r, hie) * 64 + r32e] = o[2 * ps][r];
                stg[crow(r, hie) * 64 + 32 + r32e] = o[2 * ps + 1][r];
            }
            asm volatile("s_waitcnt lgkmcnt(0)" ::: "memory");
#pragma unroll
            for (int j = 0; j < 4; ++j) {
                const f32x4 oa = *(const LAS f32x4*)(stg + (8 * j + rowq) * 64 + c8), ob = *(const LAS f32x4*)(stg + (8 * j + rowq) * 64 + c8 + 4);
                const u32x4 z = zv[ps][j];
                u32x4 w; w.x = pk_bf16(oa[0] * bf_lo(z.x), oa[1] * bf_hi(z.x)); w.y = pk_bf16(oa[2] * bf_lo(z.y), oa[3] * bf_hi(z.y));
                w.z = pk_bf16(ob[0] * bf_lo(z.z), ob[1] * bf_hi(z.z)); w.w = pk_bf16(ob[2] * bf_lo(z.w), ob[3] * bf_hi(z.w));
                *(u32x4*)(OG + gbase + (size_t)(8 * j + rowq) * DM + 64 * ps) = w;
            }
            asm volatile("s_waitcnt lgkmcnt(0)" ::: "memory");
        }
    }
    __syncthreads();
}
__device__ __forceinline__ void attn_phase(LAS unsigned char* lds, const int wid_, int vcu, int G, const bf16_t* Q, const bf16_t* K, const bf16_t* V, const bf16_t* ZS, bf16_t* OG) {
#ifndef NO_ATTN_PRIO
    if (wid_ >= 4) __builtin_amdgcn_s_setprio(1);
#endif
    for (int p = vcu; p < 256; p += G) {
        const int bh = p >> 3, s = p & 7;
#ifdef ATT_ONE_INSTANCE
#pragma unroll 1
        for (int uu = 0; uu < 2; ++uu) attn_unit(lds, wid_, bh >> 4, bh & 15, uu ? 15 - s : s, Q, K, V, ZS, OG);
#else
        attn_unit(lds, wid_, bh >> 4, bh & 15, s, Q, K, V, ZS, OG);
        attn_unit(lds, wid_, bh >> 4, bh & 15, 15 - s, Q, K, V, ZS, OG);
#endif
    }
    __builtin_amdgcn_s_setprio(0);
}

__device__ __forceinline__ void mix_unit(LAS unsigned char* lds, const int wid, int n, int g, const bf16_t* __restrict__ UZ, const bf16_t* __restrict__ V, const float* __restrict__ vss,
                                         const float* __restrict__ w_s, const float* __restrict__ b_s, const float* __restrict__ vg, bf16_t* __restrict__ Y) {
    const int tid = tid_of(wid), lane = tid & 63, r32 = lane & 31, hi = lane >> 5;
    const size_t row0 = (size_t)n * CHUNK;
    LAS float* rstdL = (LAS float*)(lds + 98304);
    const int cc = tid & 31;
    u32x4 uu[8];
#pragma unroll
    for (int i = 0; i < 8; ++i) { const int t = (tid >> 5) + 16 * i; uu[i] = __builtin_nontemporal_load((const u32x4*)(UZ + (row0 + t) * GW + g * GDIM + cc * 8)); }
    {
        u32x4 vr[8];
#pragma unroll
        for (int i = 0; i < 8; ++i) { const int c = tid + 512 * i, s = c >> 5, cc = c & 31;
            vr[i] = __builtin_nontemporal_load((const u32x4*)(V + (row0 + s) * GW + g * GDIM + cc * 8)); }
        if (tid < 128) rstdL[tid] = __builtin_amdgcn_rsqf(vss[row0 + tid] * (1.0f / GW) + EPS);
#pragma unroll
        for (int i = 0; i < 8; ++i) { const int c = tid + 512 * i, s = c >> 5, cc = c & 31;
            *(LAS u32x4*)(lds + 32768 + (cc >> 4) * 32768 + off_b(s, cc & 15)) = vr[i]; }
    }
    __syncthreads();
#pragma unroll
    for (int i = 0; i < 4; ++i) { const int c = tid + 512 * i, t = c >> 4, ch = c & 15, s0 = ch * 8;
        const f32x4 w0 = *(const f32x4*)(w_s + ((size_t)g * CHUNK + t) * CHUNK + s0), w1 = *(const f32x4*)(w_s + ((size_t)g * CHUNK + t) * CHUNK + s0 + 4);
        float wv[8] = {w0[0], w0[1], w0[2], w0[3], w1[0], w1[1], w1[2], w1[3]};
#pragma unroll
        for (int j = 0; j < 8; ++j) wv[j] = (s0 + j <= t) ? wv[j] * rstdL[s0 + j] : 0.f;
        u32x4 w; w.x = pk_bf16(wv[0], wv[1]); w.y = pk_bf16(wv[2], wv[3]); w.z = pk_bf16(wv[4], wv[5]); w.w = pk_bf16(wv[6], wv[7]);
        *(LAS u32x4*)(lds + off_b(t, ch)) = w; }
    __syncthreads();
    f32x16 acc[4];
#pragma unroll
    for (int i = 0; i < 4; ++i)
#pragma unroll
        for (int r = 0; r < 16; ++r) acc[i][r] = 0.f;
    {
        const LAS unsigned char* vimg = lds + 32768 + (wid >> 2) * 32768;
        const unsigned cblk = wid & 3, qa = (lane & 15) >> 2, blk = (lane >> 4) & 1, pp = lane & 3;
#pragma unroll
        for (int ks = 0; ks < 8; ++ks) {
            const s16x4 lo = vtr(vimg + off_b(16 * ks + 8 * hi + qa, 4 * cblk + 2 * blk + (pp >> 1)) + 8 * (pp & 1));
            const s16x4 hh = vtr(vimg + off_b(16 * ks + 8 * hi + 4 + qa, 4 * cblk + 2 * blk + (pp >> 1)) + 8 * (pp & 1));
            const bf16x8 vf = (bf16x8){lo[0], lo[1], lo[2], lo[3], hh[0], hh[1], hh[2], hh[3]};
#pragma unroll
            for (int i = 0; i < 4; ++i) if (ks <= 2 * i + 1) {
                const bf16x8 af = *(const LAS bf16x8*)(lds + off_b(32 * i + r32, 2 * ks + hi));
                acc[i] = __builtin_amdgcn_mfma_f32_32x32x16_bf16(af, vf, acc[i], 0, 0, 0);
            }
        }
    }
    __syncthreads();
    {
        LAS float* mx = (LAS float*)lds;
        const int c = 128 * (wid >> 2) + 32 * (wid & 3) + r32;
#pragma unroll
        for (int i = 0; i < 4; ++i)
#pragma unroll
            for (int r = 0; r < 16; ++r) mx[(32 * i + crow(r, hi)) * 256 + c] = acc[i][r];
    }
    __syncthreads();
    {
        const f32x4 g0 = *(const f32x4*)(vg + g * GDIM + cc * 8), g1 = *(const f32x4*)(vg + g * GDIM + cc * 8 + 4);
        float bb[8];
#pragma unroll
        for (int i = 0; i < 8; ++i) bb[i] = b_s[g * CHUNK + (tid >> 5) + 16 * i];
#pragma unroll
        for (int i = 0; i < 8; ++i) { const int t = (tid >> 5) + 16 * i;
            const f32x4 m0 = *(const LAS f32x4*)(lds + (t * 256 + cc * 8) * 4), m1 = *(const LAS f32x4*)(lds + (t * 256 + cc * 8 + 4) * 4);
            float y[8];
            y[0] = bf_lo(uu[i].x) * (m0[0] * g0[0] + bb[i]); y[1] = bf_hi(uu[i].x) * (m0[1] * g0[1] + bb[i]);
            y[2] = bf_lo(uu[i].y) * (m0[2] * g0[2] + bb[i]); y[3] = bf_hi(uu[i].y) * (m0[3] * g0[3] + bb[i]);
            y[4] = bf_lo(uu[i].z) * (m1[0] * g1[0] + bb[i]); y[5] = bf_hi(uu[i].z) * (m1[1] * g1[1] + bb[i]);
            y[6] = bf_lo(uu[i].w) * (m1[2] * g1[2] + bb[i]); y[7] = bf_hi(uu[i].w) * (m1[3] * g1[3] + bb[i]);
            u32x4 w; w.x = pk_bf16(y[0], y[1]); w.y = pk_bf16(y[2], y[3]); w.z = pk_bf16(y[4], y[5]); w.w = pk_bf16(y[6], y[7]);
            *(u32x4*)(Y + (row0 + t) * GW + g * GDIM + cc * 8) = w; }
    }
    __syncthreads();
}

__device__ __forceinline__ float wave_sum(float v) {
#pragma unroll
    for (int o = 1; o < 64; o <<= 1) v += __shfl_xor(v, o);
    return v;
}
__device__ __forceinline__ void tr_load(const float* __restrict__ W, int N, int item, int lane, f32x4 (&wv)[16]) {
    const int nblk = N / 64, k0 = 64 * (item / nblk), n0 = 64 * (item % nblk);
#pragma unroll
    for (int i = 0; i < 16; ++i) wv[i] = __builtin_nontemporal_load((const f32x4*)(W + (size_t)(k0 + 4 * i + (lane >> 4)) * N + n0 + 4 * (lane & 15)));
}
__device__ __forceinline__ void tr_to_lds(LAS float* scr, int lane, const f32x4 (&wv)[16]) {
#pragma unroll
    for (int i = 0; i < 16; ++i) { const int kk = 4 * i + (lane >> 4), nn = 4 * (lane & 15);
        LAS float* s = scr + kk * 65 + nn; s[0] = wv[i][0]; s[1] = wv[i][1]; s[2] = wv[i][2]; s[3] = wv[i][3]; }
    asm volatile("s_waitcnt lgkmcnt(0)" ::: "memory");
}
__device__ __forceinline__ void tr_store(int K, int N, bf16_t* __restrict__ WT, const LAS float* scr, int item, int lane, const float* __restrict__ gk, bool gmlp_perm) {
    const int nblk = N / 64, k0 = 64 * (item / nblk), n0 = 64 * (item % nblk);
    int r0 = n0;
    if (gmlp_perm) {
        if (n0 < GW) { const int cb = n0 >> 7; r0 = 256 * (3 * (cb >> 1) + (cb & 1)) + (n0 & 127); }
        else if (n0 < 2 * GW) { const int mv = n0 - GW; r0 = 256 * (3 * (mv >> 8) + 2) + (mv & 255); }
        else { const int mz = n0 - 2 * GW, cb = mz >> 7; r0 = 256 * (3 * (cb >> 1) + (cb & 1)) + 128 + (mz & 127); }
    }
    const int c = lane & 7;
    f32x4 ga = {1.f, 1.f, 1.f, 1.f}, gb = {1.f, 1.f, 1.f, 1.f};
    if (gk) { ga = *(const f32x4*)(gk + k0 + 8 * c); gb = *(const f32x4*)(gk + k0 + 8 * c + 4); }
#pragma unroll
    for (int j = 0; j < 8; ++j) { const int nn = (lane >> 3) + 8 * j; const LAS float* s = scr + (8 * c) * 65 + nn;
        u32x4 o; o.x = pk_bf16(s[0] * ga[0], s[65] * ga[1]); o.y = pk_bf16(s[2 * 65] * ga[2], s[3 * 65] * ga[3]); o.z = pk_bf16(s[4 * 65] * gb[0], s[5 * 65] * gb[1]); o.w = pk_bf16(s[6 * 65] * gb[2], s[7 * 65] * gb[3]);
        *(u32x4*)(WT + (size_t)(r0 + nn) * K + k0 + 8 * c) = o; }
    asm volatile("s_waitcnt lgkmcnt(0)" ::: "memory");
}
__device__ __forceinline__ void transpose_matrix(const float* __restrict__ W, int K, int N, bf16_t* __restrict__ WT, LAS float* scr, int first, int stride, int nitems, int lane,
                                                 const float* __restrict__ gk = nullptr, bool gmlp_perm = false) {
    f32x4 wv[16], wn[16];
    int it = first;
    if (it < nitems) tr_load(W, N, it, lane, wv);
    while (it < nitems) {
        const int nx = it + stride;
        tr_to_lds(scr, lane, wv);
        if (nx < nitems) tr_load(W, N, nx, lane, wn);
        tr_store(K, N, WT, scr, it, lane, gk, gmlp_perm);
#pragma unroll
        for (int i = 0; i < 16; ++i) wv[i] = wn[i];
        it = nx;
    }
}

#define XB_TMO      128
#define XB_XCNT(j)  (256  + 64 * (j))
#define XB_XSUB(j)  (1280 + 64 * (j))
#define XB_XGEN(j)  (2304 + 64 * (j))
#define XB_TOP      3328
#define XB_TOPGEN   3392
#define XCD_BAR_WORDS 3456
#define XB_SPIN_CAP (1u << 18)

__device__ __forceinline__ unsigned xb_ld(unsigned* p)              { return __hip_atomic_load(p, __ATOMIC_RELAXED, __HIP_MEMORY_SCOPE_AGENT); }
__device__ __forceinline__ unsigned xb_add(unsigned* p, unsigned v) { return __hip_atomic_fetch_add(p, v, __ATOMIC_RELAXED, __HIP_MEMORY_SCOPE_AGENT); }
__device__ __forceinline__ unsigned xb_xcc_id() { return (unsigned)__builtin_amdgcn_s_getreg((3 << 11) | 20) & 0xFu; }
#define XB_SPIN(cond, bar) do { unsigned _sp = 0; while (cond) { __builtin_amdgcn_s_sleep(1); \
    if ((++_sp & 255u) == 0u) { if (xb_ld(&(bar)[XB_TMO])) break; if (_sp > XB_SPIN_CAP) { atomicAdd(&(bar)[XB_TMO], 1u); break; } } } } while (0)

struct XcdBarrier {
    unsigned* bar; unsigned x; int w;
    volatile LAS unsigned* st;
};

__device__ __forceinline__ XcdBarrier xcd_barrier_post(unsigned* bar, volatile LAS unsigned* st, int wave) {
    XcdBarrier b; b.bar = bar; b.x = xb_xcc_id(); b.st = st; b.w = wave;
    if (tid_of(wave) == 0) (void)xb_add(&bar[XB_XCNT(b.x)], 1u);
    return b;
}
__device__ __forceinline__ void xcd_barrier_complete(unsigned* bar, unsigned x, unsigned& nloc, unsigned& nx) {
    const unsigned G = gridDim.x * gridDim.y * gridDim.z;
    unsigned sum, cnt, mine, sp = 0u;
    for (;;) {
        sum = 0u; cnt = 0u; mine = 0u;
#pragma unroll
        for (unsigned j = 0; j < 16; ++j) { const unsigned c = xb_ld(&bar[XB_XCNT(j)]); sum += c; cnt += (c > 0u) ? 1u : 0u; mine = (j == x) ? c : mine; }
        if (sum == G) break;
        __builtin_amdgcn_s_sleep(1);
        if ((++sp & 255u) == 0u) { if (xb_ld(&bar[XB_TMO])) break; if (sp > XB_SPIN_CAP) { atomicAdd(&bar[XB_TMO], 1u); break; } }
    }
    nloc = mine > 0u ? mine : 1u; nx = cnt > 0u ? cnt : 1u;
}

__device__ __forceinline__ void xcd_barrier(const XcdBarrier& b) {
    asm volatile("s_waitcnt vmcnt(0)" ::: "memory");
    __syncthreads();
    if (tid_of(b.w) == 0) {
        unsigned* bar = b.bar;
        __builtin_amdgcn_s_waitcnt(0);
        unsigned nloc = b.st[0], nx = b.st[1];
        if (nloc == 0u) { xcd_barrier_complete(bar, b.x, nloc, nx); b.st[0] = nloc; b.st[1] = nx; }
        const unsigned old = xb_add(&bar[XB_XSUB(b.x)], 1u);
        const unsigned gen = old / nloc;
        if (old + 1u == (gen + 1u) * nloc) {
            __builtin_amdgcn_fence(__ATOMIC_RELEASE, "agent");
            asm volatile("s_waitcnt vmcnt(0)" ::: "memory");
            const unsigned og = xb_add(&bar[XB_TOP], 1u);
            const unsigned tg = og / nx;
            if (og + 1u == (tg + 1u) * nx) xb_add(&bar[XB_TOPGEN], 1u);
            else XB_SPIN(xb_ld(&bar[XB_TOPGEN]) == tg, bar);
            __builtin_amdgcn_fence(__ATOMIC_ACQUIRE, "agent");
            xb_add(&bar[XB_XGEN(b.x)], 1u);
            asm volatile("s_waitcnt vmcnt(0)" ::: "memory");
        } else {
            XB_SPIN(xb_ld(&bar[XB_XGEN(b.x)]) == gen, bar);
            __builtin_amdgcn_fence(__ATOMIC_ACQUIRE, "agent");
            asm volatile("s_waitcnt vmcnt(0)" ::: "memory");
        }
    }
    __syncthreads();
}

constexpr size_t MiB = 1u << 20;
constexpr size_t WS_VSS = 0, WS_HSS1 = 2 * MiB, WS_HSS2 = 3 * MiB, WS_IRS0 = 3 * MiB + 32768, WS_CNT = 3 * MiB + 65536;
constexpr size_t WS_WT1 = 4 * MiB, WS_HN0 = 268 * MiB  , WS_WT2 = 84 * MiB, WS_WT3 = 100 * MiB, WS_WT4 = 132 * MiB;
constexpr size_t WS_U = 140 * MiB, WS_V = 204 * MiB, WS_ZS = 268 * MiB, WS_CTL = 364 * MiB, CTL_ZERO_BYTES = 32768, WS_END = 365 * MiB;
constexpr size_t WS_Y = 4 * MiB;
constexpr size_t WS_H1 = 140 * MiB, WS_H1B = 332 * MiB;
constexpr size_t WS_Q = 204 * MiB, WS_K = 236 * MiB, WS_V2 = 268 * MiB, WS_ZS2 = 300 * MiB, WS_OG = 4 * MiB;

constexpr int NWAVES = 8, LDS_BYTES = 151552;
#ifndef N_LAUNCHES
#define N_LAUNCHES 1
#endif
constexpr int N_PHASES = 7;
#ifndef CONV_TRIGGER
#define CONV_TRIGGER ((bx >> 3) % 6)
#endif
#ifndef GEMM_SP2
#define GEMM_SP2 true
#endif
#ifndef GEMM_ALIGN
#define GEMM_ALIGN true
#endif
#ifndef REPEAT_PHASE
#define REPEAT_PHASE -1
#endif
#define NREP(k) ((REPEAT_PHASE == (k)) ? 2 : 1)

struct Args { const float* in[10]; float* out; unsigned char* ws; int ph_lo, ph_hi, li, pad; };

__global__ void __launch_bounds__(NWAVES * 64, 2) fwd_kernel(Args a) {
    extern __shared__ __attribute__((aligned(16))) unsigned char lds_raw[];
    LAS unsigned char* lds = (LAS unsigned char*)lds_raw;
    cg::grid_group grid = cg::this_grid();
    const int wave = __builtin_amdgcn_readfirstlane(threadIdx.x >> 6);
#define tid tid_of(wave)
#define lane lane_id()
    const int G = gridDim.x, bx = blockIdx.x;
    const int vcu = (G % 8 == 0) ? (bx % 8) * (G / 8) + bx / 8 : bx;
    const float* x = a.in[0]; const float* norm_g = a.in[1]; const float* a_w_in = a.in[2]; const float* a_vg = a.in[3]; const float* a_w_s = a.in[4];
    const float* a_b_s = a.in[5]; const float* a_w_out = a.in[6]; const float* b_w_in = a.in[7]; const float* b_w_out = a.in[8]; const float* final_g = a.in[9];
    unsigned char* ws = a.ws;
    float* VSS = (float*)(ws + WS_VSS); float* HSS1 = (float*)(ws + WS_HSS1); float* HSS2 = (float*)(ws + WS_HSS2); float* IRS0 = (float*)(ws + WS_IRS0); unsigned* CNT = (unsigned*)(ws + WS_CNT);
    bf16_t* WT1 = (bf16_t*)(ws + WS_WT1); bf16_t* WT2 = (bf16_t*)(ws + WS_WT2); bf16_t* WT3 = (bf16_t*)(ws + WS_WT3); bf16_t* WT4 = (bf16_t*)(ws + WS_WT4);
    bf16_t* HN0 = (bf16_t*)(ws + WS_HN0); bf16_t* U = (bf16_t*)(ws + WS_U); bf16_t* V = (bf16_t*)(ws + WS_V); bf16_t* ZS = (bf16_t*)(ws + WS_ZS);
    bf16_t* Y = (bf16_t*)(ws + WS_Y); bf16_t* H1B = (bf16_t*)(ws + WS_H1B);
    bf16_t* Qb = (bf16_t*)(ws + WS_Q); bf16_t* Kb = (bf16_t*)(ws + WS_K); bf16_t* V2 = (bf16_t*)(ws + WS_V2); bf16_t* ZS2 = (bf16_t*)(ws + WS_ZS2); bf16_t* OG = (bf16_t*)(ws + WS_OG);
    const int lo = a.ph_lo, hi = a.ph_hi;
#define IN(k) (lo <= (k) && (k) < hi)
#define SEAM(k) do { if (IN(k) && IN((k) + 1)) xcd_barrier(bar); } while (0)
    volatile LAS unsigned* MISC = (volatile LAS unsigned*)(lds + LDS_BYTES - 64);
    if (tid < 16) MISC[tid] = 0u;
    __syncthreads();
    XcdBarrier bar = xcd_barrier_post((unsigned*)(ws + WS_CTL) + a.li * XCD_BAR_WORDS, MISC + 8, wave);
    if (lo > 1000) grid.sync();
    const int gw = vcu * NWAVES + wave, NGW = G * NWAVES;

    if (IN(0)) for (int rep = 0; rep < NREP(0); ++rep) {
        LAS float* scr = (LAS float*)(lds + wave * 16640);
        constexpr int I1 = (DM / 64) * (3 * GW / 64), I2 = (GW / 64) * (DM / 64), I3 = (DM / 64) * (4 * DM / 64), I4 = (DM / 64) * (DM / 64);
        transpose_matrix(a_w_in, DM, 3 * GW, WT1, scr, gw, NGW, I1, lane, norm_g, true);
        for (int m = bx * (NWAVES * 64) + tid; m < NTOK; m += G * NWAVES * 64) { HSS1[m] = 0.f; HSS2[m] = 0.f; VSS[m] = 0.f; if (m < 2048) CNT[m] = 0u; }
        for (int m = gw; m < NTOK; m += 2 * NGW) {
            const int m2 = m + NGW; const bool two = m2 < NTOK;
            const f32x4* xr = (const f32x4*)(x + (size_t)m * DM) + lane; const f32x4* xr2 = (const f32x4*)(x + (size_t)(two ? m2 : m) * DM) + lane;
            f32x4 v[8], v2[8]; float ss = 0.f, ss2 = 0.f;
#pragma unroll
            for (int j = 0; j < 8; ++j) { v[j] = __builtin_nontemporal_load(xr + 64 * j); v2[j] = __builtin_nontemporal_load(xr2 + 64 * j); }
#pragma unroll
            for (int j = 0; j < 8; ++j) { ss += (v[j][0] * v[j][0] + v[j][1] * v[j][1]) + (v[j][2] * v[j][2] + v[j][3] * v[j][3]); ss2 += (v2[j][0] * v2[j][0] + v2[j][1] * v2[j][1]) + (v2[j][2] * v2[j][2] + v2[j][3] * v2[j][3]); }
            const float ms = wave_sum(ss) * (1.0f / DM) + EPS, ms2 = wave_sum(ss2) * (1.0f / DM) + EPS;
            const float rstd = __builtin_amdgcn_rsqf(ms), rstd2 = __builtin_amdgcn_rsqf(ms2);
            if (lane == 0) { IRS0[m] = __builtin_amdgcn_sqrtf(ms); if (two) IRS0[m2] = __builtin_amdgcn_sqrtf(ms2); }
            u32x2* o8 = (u32x2*)(HN0 + (size_t)m * DM) + lane; u32x2* o82 = (u32x2*)(HN0 + (size_t)m2 * DM) + lane;
#pragma unroll
            for (int j = 0; j < 8; ++j) {
                u32x2 w; w.x = pk_bf16(v[j][0] * rstd, v[j][1] * rstd); w.y = pk_bf16(v[j][2] * rstd, v[j][3] * rstd); o8[64 * j] = w;
                if (two) { u32x2 w2; w2.x = pk_bf16(v2[j][0] * rstd2, v2[j][1] * rstd2); w2.y = pk_bf16(v2[j][2] * rstd2, v2[j][3] * rstd2); o82[64 * j] = w2; } }
        }
    }
    SEAM(0);
#ifdef EXTRA_SYNCS
    for (int i = 0; i < EXTRA_SYNCS; ++i) xcd_barrier(bar);
#endif
    if (IN(1)) for (int rep = 0; rep < NREP(1); ++rep) {
        pg8::Gemm g{HN0, WT1, NTOK, 3 * GW, DM}; pg8::ConvOrder S; S.init(NTOK, 3 * GW, G, bx);
        S.w2 = a_w_out; S.w3 = b_w_in; S.w4 = b_w_out; S.g1 = norm_g + DM; S.t2 = WT2; S.t3 = WT3; S.t4 = WT4; S.gw = gw; S.ngw = NGW; S.trigger = (G == 256) ? CONV_TRIGGER : 0; S.ln = lane; S.sw = lds + 131072 + wave * 2048; S.n_done = 0;
        pg8::EpiGmlpIn E{U, V, VSS};
        pg8::gemm_phase<pg8::EpiGmlpIn, pg8::ConvOrder, GEMM_ALIGN, GEMM_SP2>(lds, g, S, E, wave);
    }
    SEAM(1);
    if (IN(2)) for (int rep = 0; rep < NREP(2); ++rep) {
        for (int it = vcu; it < (NTOK / CHUNK) * NGRP; it += G) mix_unit(lds, wave, it >> 4, it & 15, U, V, VSS, a_w_s, a_b_s, a_vg, Y);
    }
    SEAM(2);
    if (IN(3)) for (int rep = 0; rep < NREP(3); ++rep) {
        pg8::Gemm g{Y, WT2, NTOK, DM, GW}; pg8::StaticOrder S; S.init(NTOK, DM, G, bx);
        pg8::EpiRes1 E{HN0, IRS0, H1B, HSS1};
        pg8::gemm_phase<pg8::EpiRes1, pg8::StaticOrder, GEMM_ALIGN, GEMM_SP2>(lds, g, S, E, wave);
    }
    SEAM(3);
    if (IN(4)) for (int rep = 0; rep < NREP(4); ++rep) {
        pg8::Gemm g{H1B, WT3, NTOK, 4 * DM, DM}; pg8::StaticOrder S; S.init(NTOK, 4 * DM, G, bx);
        pg8::EpiSbIn E{Qb, (size_t)(WS_K - WS_Q) / 2, HSS1};
        pg8::gemm_phase<pg8::EpiSbIn, pg8::StaticOrder, GEMM_ALIGN, GEMM_SP2>(lds, g, S, E, wave);
    }
    SEAM(4);
    if (IN(5)) for (int rep = 0; rep < NREP(5); ++rep) attn_phase(lds, wave, vcu, G, Qb, Kb, V2, ZS2, OG);
    SEAM(5);
    if (IN(6)) for (int rep = 0; rep < NREP(6); ++rep) {
        pg8::Gemm g{OG, WT4, NTOK, DM, DM}; pg8::StaticOrder S; S.init(NTOK, DM, G, bx);
        pg8::EpiFinal E{H1B, final_g, a.out, HSS2, CNT, G == 256};
        pg8::gemm_phase<pg8::EpiFinal, pg8::StaticOrder, GEMM_ALIGN, GEMM_SP2>(lds, g, S, E, wave);
    }
    if (IN(6) && G != 256) {
        xcd_barrier(bar);
        for (int m = gw; m < NTOK; m += NGW) {
            const float rstd = __builtin_amdgcn_rsqf(HSS2[m] * (1.0f / DM) + EPS);
            f32x4* orow = (f32x4*)(a.out + (size_t)m * DM) + lane; const f32x4* gr = (const f32x4*)final_g + lane;
#pragma unroll
            for (int j = 0; j < 8; ++j) { const f32x4 v = orow[64 * j]; orow[64 * j] = v * rstd * gr[64 * j]; }
        }
    }
#undef IN
#undef SEAM
#undef tid
#undef lane
}

extern "C" void kernel_launch(void* const* d_in, const int* in_sizes, int n_in, void* d_out, int out_size, void* d_ws, size_t ws_size, hipStream_t stream) {
    static int grid = 0;
    if (grid == 0) {
        if (n_in != 10 || out_size != NTOK * DM || ws_size < WS_END) { fprintf(stderr, "kernel_launch: unexpected shapes (n_in %d, out %d, ws %zu)\n", n_in, out_size, ws_size); grid = -1; return; }
        int dev = 0, cus = 0, per_cu = 0;
        (void)hipGetDevice(&dev); (void)hipDeviceGetAttribute(&cus, hipDeviceAttributeMultiprocessorCount, dev);
        if (hipFuncSetAttribute((const void*)fwd_kernel, hipFuncAttributeMaxDynamicSharedMemorySize, LDS_BYTES) != hipSuccess) { fprintf(stderr, "kernel_launch: hipFuncSetAttribute failed\n"); grid = -1; return; }
        if (hipOccupancyMaxActiveBlocksPerMultiprocessor(&per_cu, (const void*)fwd_kernel, NWAVES * 64, LDS_BYTES) != hipSuccess || per_cu < 1) { fprintf(stderr, "kernel_launch: occupancy query says %d\n", per_cu); per_cu = 1; }
        (void)hipGetLastError();
        grid = cus > 0 ? cus : 256;
    }
    if (grid < 0) return;
    if (hipMemsetAsync((char*)d_ws + WS_CTL, 0, CTL_ZERO_BYTES, stream) != hipSuccess) { fprintf(stderr, "kernel_launch: memset failed\n"); return; }
    Args a{};
    for (int i = 0; i < 10; ++i) a.in[i] = (const float*)d_in[i];
    a.out = (float*)d_out; a.ws = (unsigned char*)d_ws;
#ifdef PROBE_SPLIT
    const int nl = 2;
#else
    const int nl = N_LAUNCHES;
#endif
    for (int li = 0; li < nl; ++li) {
        a.ph_lo = (N_LAUNCHES == 1) ? 0 : li; a.ph_hi = (N_LAUNCHES == 1) ? N_PHASES : li + 1;
#ifdef PROBE_SPLIT
        a.ph_lo = li == 0 ? 0 : PROBE_SPLIT; a.ph_hi = li == 0 ? PROBE_SPLIT + 1 : N_PHASES;
#endif
        a.li = li;
        void* args[] = {&a};
        hipError_t e = hipLaunchCooperativeKernel((const void*)fwd_kernel, dim3(grid), dim3(NWAVES * 64), args, LDS_BYTES, stream);
        if (e != hipSuccess) { fprintf(stderr, "kernel_launch: cooperative launch %d failed: %s (grid %d)\n", li, hipGetErrorString(e), grid); break; }
    }
}
```
